# Optimizing an MI355X kernel written in HIP

```python
import jax, jax.numpy as jnp
from jax import lax
import numpy as np

D_MODEL = 1024
BATCH = 32
SEQ = 2048
DEPTH = 4

HEAD_DIM = 64
N_HEADS_TOTAL = D_MODEL // HEAD_DIM
N_HEADS_A = N_HEADS_TOTAL // 4
N_HEADS_B = N_HEADS_TOTAL // 4
N_HEADS_C = N_HEADS_TOTAL // 2
N_KV_C = N_HEADS_C // 4
N_IDX_HEADS = 4
IDX_DIM = HEAD_DIM
TOPK_MAX = 256
WINDOW = 128
BLOCK = 128
ROPE_THETA = 10000.0
NORM_EPS = 1e-6
MIX_WIDTH = N_HEADS_TOTAL * HEAD_DIM
D_FF = -(-8 * D_MODEL // (3 * 256)) * 256
_COLS = (N_HEADS_A * HEAD_DIM, HEAD_DIM, HEAD_DIM,
         N_IDX_HEADS * IDX_DIM, IDX_DIM, N_IDX_HEADS,
         N_HEADS_B * HEAD_DIM, N_HEADS_B * HEAD_DIM, N_HEADS_B * HEAD_DIM,
         N_HEADS_C * HEAD_DIM, N_KV_C * HEAD_DIM, N_KV_C * HEAD_DIM)
IN_COLS = sum(_COLS)

kernel_name = "hymba_style_dsa_stickbreak_swa_hybrid"


def _rms(x, g):
    xf = x.astype(jnp.float32)
    y = xf * lax.rsqrt(jnp.mean(xf * xf, axis=-1, keepdims=True) + NORM_EPS)
    return (y * g.astype(jnp.float32)).astype(x.dtype)


def _rope_tables(L):
    inv = 1.0 / (ROPE_THETA ** (jnp.arange(0, HEAD_DIM, 2, dtype=jnp.float32) / HEAD_DIM))
    ang = jnp.arange(L, dtype=jnp.float32)[:, None] * inv[None, :]
    return jnp.cos(ang), jnp.sin(ang)


def _rope(x, cos, sin):
    c = cos[None, :, None, :].astype(x.dtype)
    s = sin[None, :, None, :].astype(x.dtype)
    x1, x2 = jnp.split(x, 2, axis=-1)
    return jnp.concatenate([x1 * c - x2 * s, x2 * c + x1 * s], axis=-1)


def _blocks(a):
    B, L = a.shape[:2]
    return jnp.moveaxis(a.reshape((B, L // BLOCK, BLOCK) + a.shape[2:]), 1, 0)


def _unblocks(a):
    nb, B = a.shape[:2]
    return jnp.moveaxis(a, 0, 1).reshape((B, nb * BLOCK) + a.shape[3:])


def _split_points():
    pts, acc = [], 0
    for w in _COLS[:-1]:
        acc += w
        pts.append(acc)
    return pts


def _dsa(q, k, v, qi, ki, wi):
    B, L, H, D = q.shape
    n_sel = min(TOPK_MAX, L // 4)
    scale = D ** -0.5
    idx_scale = (N_IDX_HEADS * IDX_DIM) ** -0.5
    kpos = jnp.arange(L)

    def one_block(inp):
        qn, qin, win, n = inp
        tq = n * BLOCK + jnp.arange(BLOCK)
        rel = jax.nn.relu(jnp.einsum('bqhd,bsd->bqhs', qin, ki).astype(jnp.float32))
        score = jnp.einsum('bqh,bqhs->bqs', win.astype(jnp.float32), rel) * idx_scale
        causal = kpos[None, :] <= tq[:, None]
        score = jnp.where(causal[None], score, -jnp.inf)
        _, sel = lax.top_k(score, n_sel)
        valid = sel <= tq[None, :, None]
        ks = jax.vmap(lambda a, i: a[i])(k, sel)
        vs = jax.vmap(lambda a, i: a[i])(v, sel)
        s = jnp.einsum('bqhd,bqkd->bhqk', qn, ks).astype(jnp.float32) * scale
        s = jnp.where(valid[:, None], s, -jnp.inf)
        p = jax.nn.softmax(s, axis=-1)
        return jnp.einsum('bhqk,bqkd->bqhd', p.astype(vs.dtype), vs)

    out = lax.map(one_block, (_blocks(q), _blocks(qi), _blocks(wi), jnp.arange(L // BLOCK)))
    return _unblocks(out)


def _stick_breaking(q, k, v):
    B, L, H, D = q.shape
    scale = D ** -0.5
    kpos = jnp.arange(L)

    def one_block(inp):
        qn, n = inp
        tq = n * BLOCK + jnp.arange(BLOCK)
        strict = (kpos[None, :] < tq[:, None])[None, None]
        z = jnp.einsum('bqhd,bshd->bhqs', qn, k).astype(jnp.float32) * scale
        log_keep = jnp.where(strict, jax.nn.log_sigmoid(-z), 0.0)
        log_between = lax.cumsum(log_keep, axis=3, reverse=True) - log_keep
        a = jnp.where(strict, jnp.exp(jax.nn.log_sigmoid(z) + log_between), 0.0)
        return jnp.einsum('bhqs,bshd->bqhd', a.astype(v.dtype), v)

    out = lax.map(one_block, (_blocks(q), jnp.arange(L // BLOCK)))
    return _unblocks(out)


def _swa_sinks(q, k, v, sinks):
    B, L, H, D = q.shape
    G = H // N_KV_C
    nb = L // BLOCK
    scale = D ** -0.5
    pad = ((0, 0), (1, 0), (0, 0), (0, 0), (0, 0))
    kb = k.reshape(B, nb, BLOCK, N_KV_C, D)
    vb = v.reshape(B, nb, BLOCK, N_KV_C, D)
    kk = jnp.concatenate([jnp.pad(kb, pad)[:, :-1], kb], axis=2)
    vv = jnp.concatenate([jnp.pad(vb, pad)[:, :-1], vb], axis=2)
    qg = q.reshape(B, nb, BLOCK, N_KV_C, G, D)
    kloc = jnp.arange(2 * BLOCK)
    diff = (jnp.arange(BLOCK)[:, None] + BLOCK) - kloc[None, :]
    band = (diff >= 0) & (diff < WINDOW)
    sink = sinks.astype(jnp.float32).reshape(N_KV_C, G)[None, :, :, None, None]

    def one_block(inp):
        qn, kn, vn, n = inp
        s = jnp.einsum('bqkgd,bskd->bkgqs', qn, kn).astype(jnp.float32) * scale
        mask = band & ((n > 0) | (kloc >= BLOCK))[None, :]
        s = jnp.where(mask, s, -jnp.inf)
        m = jnp.maximum(jnp.max(s, axis=-1, keepdims=True), sink)
        e = jnp.exp(s - m)
        p = e / (jnp.sum(e, axis=-1, keepdims=True) + jnp.exp(sink - m))
        return jnp.einsum('bkgqs,bskd->bqkgd', p.astype(vn.dtype), vn)

    out = lax.map(one_block, (jnp.moveaxis(qg, 1, 0), jnp.moveaxis(kk, 1, 0),
                              jnp.moveaxis(vv, 1, 0), jnp.arange(nb)))
    return _unblocks(out).reshape(B, L, H, D)


def _mixing(h, w_in, qn_a, kn_a, qn_c, kn_c, sinks, g_out, w_o, cos, sin):
    B, L, _ = h.shape
    p = h @ w_in
    qa, ka, va, qi, ki, wi, qb, kb, vb, qc, kc, vc = jnp.split(p, _split_points(), axis=-1)
    qa = _rope(_rms(qa.reshape(B, L, N_HEADS_A, HEAD_DIM), qn_a), cos, sin)
    ka = _rope(_rms(ka.reshape(B, L, 1, HEAD_DIM), kn_a), cos, sin)[:, :, 0]
    qi = _rope(qi.reshape(B, L, N_IDX_HEADS, IDX_DIM), cos, sin)
    ki = _rope(ki.reshape(B, L, 1, IDX_DIM), cos, sin)[:, :, 0]
    oa = _dsa(qa, ka, va, qi, ki, wi)
    ob = _stick_breaking(qb.reshape(B, L, N_HEADS_B, HEAD_DIM),
                         kb.reshape(B, L, N_HEADS_B, HEAD_DIM),
                         vb.reshape(B, L, N_HEADS_B, HEAD_DIM))
    qc = _rope(_rms(qc.reshape(B, L, N_HEADS_C, HEAD_DIM), qn_c), cos, sin)
    kc = _rope(_rms(kc.reshape(B, L, N_KV_C, HEAD_DIM), kn_c), cos, sin)
    oc = _swa_sinks(qc, kc, vc.reshape(B, L, N_KV_C, HEAD_DIM), sinks)
    o = jnp.concatenate([oa, ob, oc], axis=2)
    o = _rms(o, g_out).reshape(B, L, MIX_WIDTH)
    return o @ w_o


def _swiglu(h, w_gate, w_up, w_down):
    return (jax.nn.silu(h @ w_gate) * (h @ w_up)) @ w_down


def setup_inputs(seed: int = 0) -> dict:
    key = jax.random.key(seed)
    ks = jax.random.split(key, 20)
    f = jnp.float32
    D = D_MODEL

    def nrm(k, shape, scale):
        return jax.random.normal(k, shape, f) * scale

    def gain(k, shape):
        return 1.0 + 0.02 * jax.random.normal(k, shape, f)

    return {
        "x": nrm(ks[0], (BATCH, SEQ, D), 1.0),
        "c": nrm(ks[1], (BATCH, D), 1.0),
        "ln1": gain(ks[2], (DEPTH, D)),
        "ln2": gain(ks[3], (DEPTH, D)),
        "w_mod": nrm(ks[4], (DEPTH, D, 6 * D), 0.5 * D ** -0.5),
        "b_mod": nrm(ks[5], (DEPTH, 6 * D), 0.02),
        "w_in": nrm(ks[6], (DEPTH, D, IN_COLS), D ** -0.5),
        "qn_a": gain(ks[7], (DEPTH, HEAD_DIM)),
        "kn_a": gain(ks[8], (DEPTH, HEAD_DIM)),
        "qn_c": gain(ks[9], (DEPTH, HEAD_DIM)),
        "kn_c": gain(ks[10], (DEPTH, HEAD_DIM)),
        "sinks": nrm(ks[11], (DEPTH, N_HEADS_C), 0.5),
        "g_out": gain(ks[12], (DEPTH, N_HEADS_TOTAL, HEAD_DIM)),
        "w_o": nrm(ks[13], (DEPTH, MIX_WIDTH, D), MIX_WIDTH ** -0.5),
        "w_gate": nrm(ks[14], (DEPTH, D, D_FF), D ** -0.5),
        "w_up": nrm(ks[15], (DEPTH, D, D_FF), D ** -0.5),
        "w_down": nrm(ks[16], (DEPTH, D_FF, D), D_FF ** -0.5),
    }


def reference(x, c, ln1, ln2, w_mod, b_mod, w_in, qn_a, kn_a, qn_c, kn_c, sinks, g_out, w_o,
              w_gate, w_up, w_down):
    L = x.shape[1]
    cos, sin = _rope_tables(L)
    c_act = jax.nn.silu(c)
    for l in range(DEPTH):
        mod = c_act @ w_mod[l] + b_mod[l]
        sh1, sc1, g1, sh2, sc2, g2 = [m[:, None, :] for m in jnp.split(mod, 6, axis=-1)]
        h = _rms(x, ln1[l]) * (1 + sc1) + sh1
        x = x + g1 * _mixing(h, w_in[l], qn_a[l], kn_a[l], qn_c[l], kn_c[l], sinks[l],
                             g_out[l], w_o[l], cos, sin)
        h = _rms(x, ln2[l]) * (1 + sc2) + sh2
        x = x + g2 * _swiglu(h, w_gate[l], w_up[l], w_down[l])
    return x
```

```cpp
#include <hip/hip_runtime.h>
#include <cstdio>
#include <cstdint>

#ifndef MK_MULTI
#define MK_MULTI 1
#endif

#define LAS __attribute__((address_space(3)))
#define GAS __attribute__((address_space(1)))
namespace pg8 {
#define PG8_LAS __attribute__((address_space(3)))
typedef unsigned short bf16_t;
typedef short bf16x8 __attribute__((ext_vector_type(8)));
typedef float f32x4 __attribute__((ext_vector_type(4)));
typedef unsigned u32x4 __attribute__((ext_vector_type(4)));
constexpr int BM = 256, BK = 64, HALF = 128, HTB = HALF * BK * 2  , STAGE_BYTES = 8 * HTB, NXCD = 8, WGM = 8;

__host__ __device__ __forceinline__ int lds_byte(int r, int c) { const int st = (r >> 4) * 2 + (c >> 5), rr = r & 15, cc = c & 31, ob = rr * 64 + cc * 2; return st * 1024 + (ob ^ (((ob >> 9) & 1) << 5)); }
__host__ __device__ __forceinline__ void stage_rc(int b, int& R, int& C) { const int st = b / 1024, sb = b % 1024, swz = sb ^ (((sb >> 9) & 1) << 5); R = (st >> 1) * 16 + swz / 64; C = (st & 1) * 32 + (swz % 64) / 2; }
__host__ __device__ __forceinline__ int perm32(int rho) { const int n = rho >> 4, i = rho & 15; return 8 * (i >> 2) + 4 * n + (i & 3); }

struct Unit { int pm, pn; };
struct Gemm { const bf16_t* A; const bf16_t* Bt; int M, N, K; };

struct StaticOrder {
    int nM, nN, nwg, G, c;
    __host__ __device__ void init(int M, int N, int G_, int c_) { nM = M / BM; nN = N / BM; nwg = nM * nN; G = G_; c = c_; }
    __host__ __device__ bool next(int i, Unit& u) const {
        const long L = (long)i * G + c; if (L >= nwg) return false;
        int wgid = (int)L; { const int q = nwg / NXCD, r = nwg % NXCD, xcd = wgid % NXCD, off = wgid / NXCD; wgid = (xcd < r ? xcd * (q + 1) : r * (q + 1) + (xcd - r) * q) + off; }
        const int nig = WGM * nN, gid = wgid / nig, fm = gid * WGM, gsz = (nM - fm) < WGM ? (nM - fm) : WGM;
        u.pm = fm + ((wgid % nig) % gsz); u.pn = (wgid % nig) / gsz; return true;
    }
    __device__ __forceinline__ void a_ready(const Unit&) const {}
    __device__ __forceinline__ void done(const Unit&) const {}
};
template <class Epi, class Sched, bool ALIGN_EPI = false, bool SP2 = false>
__device__ __forceinline__ void gemm_phase(PG8_LAS unsigned char* lds, const Gemm g, const Sched& S, const Epi& E) {
    int tid_o = threadIdx.x; asm volatile("" : "+v"(tid_o));
    const int tid = tid_o, wid = __builtin_amdgcn_readfirstlane(tid >> 6), lane = tid & 63, wr = wid >> 2, wc = wid & 3, fr = lane & 15, fq = lane >> 4;
    const int K = g.K, nt = K / BK;
    unsigned voffA[2], voffB[2];
#pragma unroll
    for (int i = 0; i < 2; ++i) { int R, C; stage_rc(tid * 16 + i * 8192, R, C); const int Rb = Epi::PERM ? ((R & ~31) + perm32(R & 31)) : R;
        voffA[i] = (unsigned)(R * K + C) * 2u; voffB[i] = (unsigned)(Rb * K + C) * 2u; }
    const size_t kstep = (size_t)(BK * 2);
    const size_t hstep = (size_t)HALF * K * 2;
    const size_t tstep = 2 * hstep;
    const unsigned ldsw = (unsigned)wid * 1024u;
    const int aoff = lds_byte(wr * 64 + fr, fq * 8), boff = lds_byte(wc * 32 + fr, fq * 8);
#define PG8_SA(b, h) (((b) * 2 + (h)) * HTB)
#define PG8_SB(b, h) ((4 + (b) * 2 + (h)) * HTB)
#define PG8_STAGE(bufoff, gbase, voff) do { _Pragma("unroll") for (int _i = 0; _i < 2; ++_i) \
        __builtin_amdgcn_global_load_lds((const unsigned*)((const char*)(gbase) + (voff)[_i]), (PG8_LAS unsigned*)(lds + (bufoff) + ldsw + _i * 8192), 16, 0, 0); } while (0)
#define PG8_LDA(dst, b, h) do { _Pragma("unroll") for (int m = 0; m < 4; ++m) _Pragma("unroll") for (int k = 0; k < 2; ++k) dst[m][k] = *(const PG8_LAS bf16x8*)(lds + PG8_SA(b, h) + aoff + m * 2048 + k * 1024); } while (0)
#define PG8_LDB(dst, b, h) do { _Pragma("unroll") for (int n = 0; n < 2; ++n) _Pragma("unroll") for (int k = 0; k < 2; ++k) dst[n][k] = *(const PG8_LAS bf16x8*)(lds + PG8_SB(b, h) + boff + n * 2048 + k * 1024); } while (0)
#define PG8_MMA(ai, bj, At, Bt) do { __builtin_amdgcn_s_setprio(1); _Pragma("unroll") for (int m = 0; m < 4; ++m) _Pragma("unroll") for (int n = 0; n < 2; ++n) _Pragma("unroll") for (int k = 0; k < 2; ++k) \
        acc[ai][bj][m][n] = __builtin_amdgcn_mfma_f32_16x16x32_bf16(Bt[n][k], At[m][k], acc[ai][bj][m][n], 0, 0, 0); __builtin_amdgcn_s_setprio(0); } while (0)
#define PG8_WAIT_V(n) asm volatile("s_waitcnt vmcnt(" #n ")" ::: "memory")
#define PG8_WAIT_L(n) asm volatile("s_waitcnt lgkmcnt(" #n ")" ::: "memory")
#define PG8_BAR __builtin_amdgcn_s_barrier()
#define PG8_SCHED __builtin_amdgcn_sched_barrier(0)
    Unit cur, nxt; int ui = 0;
    if (!S.next(0, cur)) return;
    f32x4 acc[2][2][4][2];
#pragma unroll
    for (int a = 0; a < 2; ++a)
#pragma unroll
        for (int b = 0; b < 2; ++b)
#pragma unroll
            for (int m = 0; m < 4; ++m)
#pragma unroll
                for (int n = 0; n < 2; ++n) acc[a][b][m][n] = (f32x4){0.f, 0.f, 0.f, 0.f};
    bf16x8 At[4][2], B0[2][2], B1[2][2];
    const char* cA = (const char*)g.A + (size_t)cur.pm * tstep; const char* cB = (const char*)g.Bt + (size_t)cur.pn * tstep;
    S.a_ready(cur);
    if constexpr (SP2) {
        PG8_STAGE(PG8_SB(0, 0), cB, voffB); PG8_STAGE(PG8_SB(0, 1), cB + hstep, voffB); PG8_STAGE(PG8_SA(0, 0), cA, voffA); PG8_STAGE(PG8_SA(0, 1), cA + hstep, voffA);
        if (wr == 1) PG8_BAR;
        PG8_WAIT_V(2); PG8_BAR;
        PG8_STAGE(PG8_SB(1, 0), cB + kstep, voffB); PG8_STAGE(PG8_SA(1, 0), cA + kstep, voffA); PG8_STAGE(PG8_SB(1, 1), cB + hstep + kstep, voffB);
        PG8_WAIT_V(6); PG8_BAR;
    } else {
        PG8_STAGE(PG8_SB(0, 0), cB, voffB); PG8_STAGE(PG8_SA(0, 0), cA, voffA); PG8_STAGE(PG8_SB(0, 1), cB + hstep, voffB); PG8_STAGE(PG8_SA(0, 1), cA + hstep, voffA);
        if (wr == 1) PG8_BAR;
        PG8_WAIT_V(4); PG8_BAR;
        PG8_STAGE(PG8_SB(1, 0), cB + kstep, voffB); PG8_STAGE(PG8_SA(1, 0), cA + kstep, voffA); PG8_STAGE(PG8_SB(1, 1), cB + hstep + kstep, voffB);
        PG8_WAIT_V(6); PG8_BAR;
    }
    for (;;) {
        const bool has_next = S.next(ui + 1, nxt);
        const char* nA = has_next ? (const char*)g.A + (size_t)nxt.pm * tstep : cA; const char* nB = has_next ? (const char*)g.Bt + (size_t)nxt.pn * tstep : cB;
        for (int t = 0; t < nt; t += 2) {
            const bool last = (t == nt - 2);
            const char* a1 = cA + (size_t)(t + 1) * kstep;
            const char* a2 = last ? nA : cA + (size_t)(t + 2) * kstep; const char* b2 = last ? nB : cB + (size_t)(t + 2) * kstep;
            const char* a3 = a2 + kstep; const char* b3 = b2 + kstep;
            if (last && has_next) S.a_ready(nxt);
            if constexpr (SP2) {
            PG8_LDB(B0, 0, 0); PG8_LDB(B1, 0, 1); PG8_SCHED; PG8_LDA(At, 0, 0); PG8_STAGE(PG8_SA(1, 1), a1 + hstep, voffA);
            PG8_WAIT_V(8); PG8_WAIT_L(0); PG8_BAR; PG8_MMA(0, 0, At, B0); PG8_MMA(0, 1, At, B1); PG8_BAR; PG8_SCHED;
            PG8_LDA(At, 0, 1); PG8_STAGE(PG8_SB(0, 0), b2, voffB); PG8_STAGE(PG8_SB(0, 1), b2 + hstep, voffB); PG8_STAGE(PG8_SA(0, 0), a2, voffA);
            PG8_WAIT_V(8); PG8_WAIT_L(0); PG8_BAR; PG8_MMA(1, 0, At, B0); PG8_MMA(1, 1, At, B1); PG8_BAR; PG8_SCHED;
            PG8_LDB(B0, 1, 0); PG8_LDB(B1, 1, 1); PG8_SCHED; PG8_LDA(At, 1, 0); PG8_STAGE(PG8_SA(0, 1), a2 + hstep, voffA);
            PG8_WAIT_V(8); PG8_WAIT_L(0); PG8_BAR; PG8_MMA(0, 0, At, B0); PG8_MMA(0, 1, At, B1); PG8_BAR; PG8_SCHED;
            PG8_LDA(At, 1, 1); PG8_STAGE(PG8_SB(1, 0), b3, voffB); PG8_STAGE(PG8_SB(1, 1), b3 + hstep, voffB); PG8_STAGE(PG8_SA(1, 0), a3, voffA);
            PG8_WAIT_V(8); PG8_WAIT_L(0); PG8_BAR; PG8_MMA(1, 0, At, B0); PG8_MMA(1, 1, At, B1); PG8_BAR; PG8_SCHED;
            } else {
            PG8_LDB(B0, 0, 0); PG8_SCHED; PG8_LDA(At, 0, 0); PG8_STAGE(PG8_SA(1, 1), a1 + hstep, voffA);
            PG8_WAIT_L(8); PG8_BAR; PG8_WAIT_L(0); PG8_MMA(0, 0, At, B0); PG8_BAR; PG8_SCHED;
            PG8_LDB(B1, 0, 1); PG8_STAGE(PG8_SB(0, 0), b2, voffB);
            PG8_BAR; PG8_WAIT_L(0); PG8_MMA(0, 1, At, B1); PG8_BAR;
            PG8_LDA(At, 0, 1); PG8_STAGE(PG8_SA(0, 0), a2, voffA);
            PG8_BAR; PG8_WAIT_L(0); PG8_MMA(1, 0, At, B0); PG8_BAR; PG8_SCHED;
            PG8_STAGE(PG8_SB(0, 1), b2 + hstep, voffB);
            PG8_WAIT_V(6); PG8_BAR; PG8_MMA(1, 1, At, B1); PG8_BAR;
            PG8_LDB(B0, 1, 0); PG8_SCHED; PG8_LDA(At, 1, 0); PG8_STAGE(PG8_SA(0, 1), a2 + hstep, voffA);
            PG8_WAIT_L(8); PG8_BAR; PG8_WAIT_L(0); PG8_MMA(0, 0, At, B0); PG8_BAR; PG8_SCHED;
            PG8_LDB(B1, 1, 1); PG8_STAGE(PG8_SB(1, 0), b3, voffB);
            PG8_BAR; PG8_WAIT_L(0); PG8_MMA(0, 1, At, B1); PG8_BAR;
            PG8_LDA(At, 1, 1); PG8_STAGE(PG8_SA(1, 0), a3, voffA);
            PG8_BAR; PG8_WAIT_L(0); PG8_MMA(1, 0, At, B0); PG8_BAR; PG8_SCHED;
            PG8_STAGE(PG8_SB(1, 1), b3 + hstep, voffB);
            PG8_WAIT_V(6); PG8_BAR; PG8_MMA(1, 1, At, B1); PG8_BAR;
            }
        }
        if constexpr (ALIGN_EPI) { if (wr == 0) PG8_BAR; }
        if constexpr (!Epi::AFTER_DRAIN) { E(acc, cur, wr, wc, fr, fq); S.done(cur); }
        if (!has_next) break;
#pragma unroll
        for (int a = 0; a < 2; ++a)
#pragma unroll
            for (int b = 0; b < 2; ++b)
#pragma unroll
                for (int m = 0; m < 4; ++m)
#pragma unroll
                    for (int n = 0; n < 2; ++n) acc[a][b][m][n] = (f32x4){0.f, 0.f, 0.f, 0.f};
        cur = nxt; cA = nA; cB = nB; ++ui;
        if constexpr (ALIGN_EPI) { if (wr == 1) PG8_BAR; }
    }
    PG8_WAIT_V(0);
    if constexpr (!ALIGN_EPI) { if (wr == 0) PG8_BAR; }
    PG8_BAR;
    if constexpr (Epi::AFTER_DRAIN) { E.fused(acc, cur, wr, wc, fr, fq, lds, wid, lane); S.done(cur); }
#undef PG8_SA
#undef PG8_SB
#undef PG8_STAGE
#undef PG8_LDA
#undef PG8_LDB
#undef PG8_MMA
#undef PG8_WAIT_V
#undef PG8_WAIT_L
#undef PG8_BAR
#undef PG8_SCHED
}
}

#define XB_TMO      128
#define XB_XCNT(j)  (256  + 64 * (j))
#define XB_XSUB(j)  (1280 + 64 * (j))
#define XB_XGEN(j)  (2304 + 64 * (j))
#define XB_TOP      3328
#define XB_TOPGEN   3392
#define XCD_BAR_WORDS 3456
#define XB_SPIN_CAP (1u << 24)

__device__ __forceinline__ unsigned xb_ld(unsigned* p)              { return __hip_atomic_load(p, __ATOMIC_RELAXED, __HIP_MEMORY_SCOPE_AGENT); }
__device__ __forceinline__ unsigned xb_add(unsigned* p, unsigned v) { return __hip_atomic_fetch_add(p, v, __ATOMIC_RELAXED, __HIP_MEMORY_SCOPE_AGENT); }
__device__ __forceinline__ unsigned xb_xcc_id() { return (unsigned)__builtin_amdgcn_s_getreg((3 << 11) | 20) & 0xFu; }
#define XB_SPIN(cond, bar) do { unsigned _sp = 0; while (cond) { __builtin_amdgcn_s_sleep(1); \
    if ((++_sp & 255u) == 0u) { if (xb_ld(&(bar)[XB_TMO])) break; if (_sp > XB_SPIN_CAP) { atomicAdd(&(bar)[XB_TMO], 1u); break; } } } } while (0)

struct XcdBarrier {
    unsigned* bar; unsigned x;
    volatile LAS unsigned* st;
};

__device__ __forceinline__ XcdBarrier xcd_barrier_post(unsigned* bar, volatile LAS unsigned* st) {
    XcdBarrier b; b.bar = bar; b.x = xb_xcc_id(); b.st = st;
    if (threadIdx.x == 0) (void)xb_add(&bar[XB_XCNT(b.x)], 1u);
    return b;
}
__device__ __forceinline__ void xcd_barrier_complete(unsigned* bar, unsigned x, unsigned& nloc, unsigned& nx) {
    const unsigned G = gridDim.x * gridDim.y * gridDim.z;
    unsigned sum, cnt, mine, sp = 0u;
    for (;;) {
        sum = 0u; cnt = 0u; mine = 0u;
#pragma unroll
        for (unsigned j = 0; j < 16; ++j) { const unsigned c = xb_ld(&bar[XB_XCNT(j)]); sum += c; cnt += (c > 0u) ? 1u : 0u; mine = (j == x) ? c : mine; }
        if (sum == G) break;
        __builtin_amdgcn_s_sleep(1);
        if ((++sp & 255u) == 0u) { if (xb_ld(&bar[XB_TMO])) break; if (sp > XB_SPIN_CAP) { atomicAdd(&bar[XB_TMO], 1u); break; } }
    }
    nloc = mine > 0u ? mine : 1u; nx = cnt > 0u ? cnt : 1u;
}

__device__ __forceinline__ void xcd_barrier(const XcdBarrier& b) {
    asm volatile("s_waitcnt vmcnt(0)" ::: "memory");
    __syncthreads();
    if (threadIdx.x == 0) {
        unsigned* bar = b.bar;
        __builtin_amdgcn_s_waitcnt(0);
        unsigned nloc = b.st[0], nx = b.st[1];
        if (nloc == 0u) { xcd_barrier_complete(bar, b.x, nloc, nx); b.st[0] = nloc; b.st[1] = nx; }
        const unsigned old = xb_add(&bar[XB_XSUB(b.x)], 1u);
        const unsigned gen = old / nloc;
        if (old + 1u == (gen + 1u) * nloc) {
            __builtin_amdgcn_fence(__ATOMIC_RELEASE, "agent");
            asm volatile("s_waitcnt vmcnt(0)" ::: "memory");
            const unsigned og = xb_add(&bar[XB_TOP], 1u);
            const unsigned tg = og / nx;
            if (og + 1u == (tg + 1u) * nx) xb_add(&bar[XB_TOPGEN], 1u);
            else XB_SPIN(xb_ld(&bar[XB_TOPGEN]) == tg, bar);
            __builtin_amdgcn_fence(__ATOMIC_ACQUIRE, "agent");
            xb_add(&bar[XB_XGEN(b.x)], 1u);
            asm volatile("s_waitcnt vmcnt(0)" ::: "memory");
        } else {
            XB_SPIN(xb_ld(&bar[XB_XGEN(b.x)]) == gen, bar);
            __builtin_amdgcn_fence(__ATOMIC_ACQUIRE, "agent");
            asm volatile("s_waitcnt vmcnt(0)" ::: "memory");
        }
    }
    __syncthreads();
}

#define LAS __attribute__((address_space(3)))
#define GAS __attribute__((address_space(1)))
typedef unsigned short bf16_t;
typedef short bf16x8 __attribute__((ext_vector_type(8)));
typedef float f32x4 __attribute__((ext_vector_type(4)));
typedef float f32x2 __attribute__((ext_vector_type(2)));
typedef float f32x16 __attribute__((ext_vector_type(16)));
typedef unsigned u32x4 __attribute__((ext_vector_type(4)));
typedef unsigned u32x2 __attribute__((ext_vector_type(2)));
typedef __bf16 bf16x2v __attribute__((ext_vector_type(2)));

constexpr int NWAVES = 8;
constexpr int BATCH = 32, SEQ = 2048, DM = 1024, DEPTH = 4, MROWS = BATCH * SEQ;
constexpr int NIN = 2304, INCOLS = 2244, DFF = 2816, NGU = 2 * DFF, NVS = 7;
constexpr float EPS = 1e-6f, LOG2E = 1.4426950408889634f, C2 = 0.18033688011112042f;
constexpr int NSTEPS = 1 + 7 * DEPTH;
#ifndef PHMASK
#define PHMASK 0xffff
#endif
#define PH(i) ((PHMASK >> (i)) & 1)
#ifndef DSA_S
#define DSA_S 15
#endif

constexpr size_t MiB = 1u << 20;
constexpr size_t WS_CTL = 0, CTL_BYTES = MiB;
constexpr size_t WS_ROPE = 1 * MiB;
constexpr size_t WS_MOD = 2 * MiB;
constexpr size_t WS_WI = 5 * MiB;
constexpr size_t WS_W = 8 * MiB, W_LAYER = 23 * MiB;
constexpr size_t W_IN = 0, W_O = 4608 * 1024, W_GU = W_O + 2 * MiB, W_D = W_GU + 11 * MiB;
constexpr size_t WS_H = 104 * MiB;
constexpr size_t WS_ACT = 232 * MiB;
constexpr size_t WS_P = WS_ACT;
constexpr size_t WS_VT = WS_ACT + 288 * MiB;
constexpr size_t WS_END = 584 * MiB;
static_assert(W_D + (size_t)DM * DFF * 2 <= W_LAYER && WS_W + DEPTH * W_LAYER <= WS_H && WS_VT + (size_t)BATCH * NVS * 64 * SEQ * 2 <= WS_END, "ws map");
static_assert((size_t)MROWS * NIN * 2 == 288 * MiB && (size_t)MROWS * DFF * 2 == 352 * MiB, "ws map 2");

constexpr int CW_BAR = 4096, CW_QUEUE = 8192;

constexpr int SC_STRIDE = 2052;
constexpr int LDS_SC = 0;
constexpr int LDS_MASK = 131328, MASK_STRIDE = 66;
constexpr int LDS_LSUM = LDS_MASK + 16 * MASK_STRIDE * 4;
constexpr int LDS_SSUM = LDS_LSUM + 2048;
constexpr int LDS_MISC = LDS_SSUM + 2048;
constexpr int LDS_BYTES = 147456;
static_assert(LDS_MISC + 64 <= LDS_BYTES && 16 * SC_STRIDE * 4 == LDS_MASK && 8 * 64 * 64 * 4 <= LDS_MASK && (LDS_MISC % 16) == 0, "lds map");

#define LDS_WAIT() asm volatile("s_waitcnt lgkmcnt(0)" ::: "memory")
__device__ __forceinline__ unsigned cvtpk(float lo, float hi) { f32x2 v = {lo, hi}; bf16x2v b = __builtin_convertvector(v, bf16x2v); return __builtin_bit_cast(unsigned, b); }
__device__ __forceinline__ bf16x8 ldg16(const bf16_t* p) { return *(const GAS bf16x8*)p; }
__device__ __forceinline__ float ex2(float x) { return __builtin_amdgcn_exp2f(x); }
__device__ __forceinline__ float lg2(float x) { return __builtin_amdgcn_logf(x); }
__device__ __forceinline__ int crow(int i, int h) { return (i & 3) + 8 * (i >> 2) + 4 * h; }
#define MFMA32(a, b, c) __builtin_amdgcn_mfma_f32_32x32x16_bf16((a), (b), (c), 0, 0, 0)
#define MFMA16(a, b, c) __builtin_amdgcn_mfma_f32_16x16x32_bf16((a), (b), (c), 0, 0, 0)
__device__ __forceinline__ bf16x8 pack8(const f32x16& x, int s) {
    u32x4 p; p.x = cvtpk(x[8 * s], x[8 * s + 1]); p.y = cvtpk(x[8 * s + 2], x[8 * s + 3]); p.z = cvtpk(x[8 * s + 4], x[8 * s + 5]); p.w = cvtpk(x[8 * s + 6], x[8 * s + 7]);
    return __builtin_bit_cast(bf16x8, p);
}
__device__ __forceinline__ f32x16 zero16() { f32x16 z; for (int i = 0; i < 16; ++i) z[i] = 0.f; return z; }
__device__ __forceinline__ float wave_max(float v) {
#pragma unroll
    for (int o = 1; o < 64; o <<= 1) v = fmaxf(v, __shfl_xor(v, o));
    return v;
}
__device__ __forceinline__ float wave_sum(float v) {
#pragma unroll
    for (int o = 1; o < 64; o <<= 1) v += __shfl_xor(v, o);
    return v;
}

__device__ __forceinline__ int slot_col(int s) {
    if (s < 4) return 64 * s;
    if (s < 8) return 384 + 64 * (s - 4);
    if (s == 8) return 256;
    if (s == 9) return 320;
    if (s == 10) return 640;
    if (s == 11) return 704;
    if (s < 16) return 708 + 64 * (s - 12);
    if (s < 20) return 964 + 64 * (s - 16);
    if (s < 24) return 1220 + 64 * (s - 20);
    if (s < 32) return 1476 + 64 * (s - 24);
    if (s < 34) return 1988 + 64 * (s - 32);
    return 2116 + 64 * (s - 34);
}

namespace pg8 {
struct EpiInProj {
    static constexpr bool PERM = true, AFTER_DRAIN = false;
    bf16_t* P; bf16_t* VT; float* WI; const float* cs; const float* sn; const float* qn_a; const float* kn_a; const float* qn_c; const float* kn_c;
    __device__ __forceinline__ void operator()(const f32x4 (&acc)[2][2][4][2], const Unit& u, int wr, int wc, int fr, int fq) const {
        const int slot = u.pn * 4 + wc;
        int mode = 0; const float* gain = nullptr; float osc = 1.f; int vslot = 0;
        if (slot < 4) { mode = 2; gain = qn_a; osc = C2; }
        else if (slot < 8) { mode = 1; }
        else if (slot == 8) { mode = 2; gain = kn_a; }
        else if (slot == 9) { mode = 3; vslot = 0; }
        else if (slot == 10) { mode = 1; }
        else if (slot == 11) { mode = 4; }
        else if (slot < 16) { mode = 0; osc = C2; }
        else if (slot < 20) { mode = 0; }
        else if (slot < 24) { mode = 3; vslot = 1 + (slot - 20); }
        else if (slot < 32) { mode = 2; gain = qn_c; osc = C2; }
        else if (slot < 34) { mode = 2; gain = kn_c; }
        else { mode = 3; vslot = 5 + (slot - 34); }
        const int rowt = u.pm * BM + wr * 64 + fr;
        if (mode == 3) {
            const int b = rowt / SEQ; const int tt = rowt % SEQ;
            const int pfr = (fr & 3) | ((fr & 4) << 1) | ((fr & 8) >> 1);
            bf16_t* vb = VT + ((size_t)(b * NVS + vslot) * 64) * SEQ;
#pragma unroll
            for (int ai = 0; ai < 2; ++ai)
#pragma unroll
                for (int m = 0; m < 4; ++m) { const unsigned voff = (unsigned)(8 * fq * SEQ + (((tt + ai * HALF + m * 16) & ~15) + pfr));
#pragma unroll
                    for (int bj = 0; bj < 2; ++bj)
#pragma unroll
                        for (int n = 0; n < 2; ++n)
#pragma unroll
                            for (int e = 0; e < 4; ++e) { bf16_t* sb = vb + (32 * bj + 4 * n + e) * SEQ;
                                sb[voff] = (bf16_t)(cvtpk(acc[ai][bj][m][n][e], 0.f) & 0xffffu); }
                    asm volatile("" ::: "memory"); }
            return;
        }
        if (mode == 4) {
            if (fq == 0) {
#pragma unroll
                for (int ai = 0; ai < 2; ++ai)
#pragma unroll
                    for (int m = 0; m < 4; ++m) *(f32x4*)(WI + (size_t)(rowt + ai * HALF + m * 16) * 4) = acc[ai][0][m][0];
            }
            return;
        }
        f32x4 g1[2], g2[2];
        if (mode == 2) {
#pragma unroll
            for (int n = 0; n < 2; ++n) { g1[n] = *(const f32x4*)(gain + 8 * fq + 4 * n); g2[n] = *(const f32x4*)(gain + 32 + 8 * fq + 4 * n); }
        }
#pragma unroll
        for (int ai = 0; ai < 2; ++ai)
#pragma unroll
            for (int m = 0; m < 4; ++m) {
                const int row = rowt + ai * HALF + m * 16;
                f32x4 v1[2] = {acc[ai][0][m][0], acc[ai][0][m][1]}, v2[2] = {acc[ai][1][m][0], acc[ai][1][m][1]};
                if (mode == 2) {
                    float ss = 0.f;
#pragma unroll
                    for (int n = 0; n < 2; ++n)
#pragma unroll
                        for (int e = 0; e < 4; ++e) ss += v1[n][e] * v1[n][e] + v2[n][e] * v2[n][e];
                    ss += __shfl_xor(ss, 16); ss += __shfl_xor(ss, 32);
                    const float ri = __builtin_amdgcn_rsqf(ss * (1.f / 64.f) + EPS);
#pragma unroll
                    for (int n = 0; n < 2; ++n) { v1[n] = (v1[n] * ri) * g1[n]; v2[n] = (v2[n] * ri) * g2[n]; }
                }
                if (mode >= 1) {
                    const int t = row % SEQ;
#pragma unroll
                    for (int n = 0; n < 2; ++n) {
                        const f32x4 c = *(const f32x4*)(cs + t * 32 + 8 * fq + 4 * n), s = *(const f32x4*)(sn + t * 32 + 8 * fq + 4 * n);
                        const f32x4 a = v1[n], b = v2[n];
                        v1[n] = a * c - b * s; v2[n] = b * c + a * s;
                    }
                }
                u32x4 w1, w2;
                w1.x = cvtpk(v1[0][0] * osc, v1[0][1] * osc); w1.y = cvtpk(v1[0][2] * osc, v1[0][3] * osc); w1.z = cvtpk(v1[1][0] * osc, v1[1][1] * osc); w1.w = cvtpk(v1[1][2] * osc, v1[1][3] * osc);
                w2.x = cvtpk(v2[0][0] * osc, v2[0][1] * osc); w2.y = cvtpk(v2[0][2] * osc, v2[0][3] * osc); w2.z = cvtpk(v2[1][0] * osc, v2[1][1] * osc); w2.w = cvtpk(v2[1][2] * osc, v2[1][3] * osc);
                bf16_t* op = P + (size_t)row * NIN + slot * 64 + 8 * fq;
                *(u32x4*)op = w1; *(u32x4*)(op + 32) = w2;
                asm volatile("" ::: "memory");
            }
    }
};
struct EpiResid {
    static constexpr bool PERM = false, AFTER_DRAIN = false;
    const float* base; float* out; const float* gate;
    __device__ __forceinline__ void operator()(const f32x4 (&acc)[2][2][4][2], const Unit& u, int wr, int wc, int fr, int fq) const {
        const int row0 = u.pm * BM + wr * 64 + fr, col0 = u.pn * BM + wc * 32 + 4 * fq;
        const float* gp = gate + (size_t)((u.pm * BM) / SEQ) * 6144 + col0;
        f32x4 gv[2][2];
#pragma unroll
        for (int bj = 0; bj < 2; ++bj)
#pragma unroll
            for (int n = 0; n < 2; ++n) gv[bj][n] = *(const f32x4*)(gp + bj * HALF + n * 16);
#pragma unroll
        for (int ai = 0; ai < 2; ++ai)
#pragma unroll
            for (int m = 0; m < 4; ++m) { const size_t off = (size_t)(row0 + ai * HALF + m * 16) * DM + col0;
#pragma unroll
                for (int bj = 0; bj < 2; ++bj)
#pragma unroll
                    for (int n = 0; n < 2; ++n) { const f32x4 bs = *(const f32x4*)(base + off + bj * HALF + n * 16);
                        *(f32x4*)(out + off + bj * HALF + n * 16) = bs + gv[bj][n] * acc[ai][bj][m][n]; } }
    }
};
struct EpiSwiGLU {
    static constexpr bool PERM = true, AFTER_DRAIN = false;
    bf16_t* ACT;
    __device__ __forceinline__ void operator()(const f32x4 (&acc)[2][2][4][2], const Unit& u, int wr, int wc, int fr, int fq) const {
        const int row0 = u.pm * BM + wr * 64 + fr, col0 = u.pn * HALF + wc * 32 + 8 * fq;
#pragma unroll
        for (int ai = 0; ai < 2; ++ai)
#pragma unroll
            for (int m = 0; m < 4; ++m) {
                float r[8];
#pragma unroll
                for (int n = 0; n < 2; ++n)
#pragma unroll
                    for (int e = 0; e < 4; ++e) { const float g = acc[ai][0][m][n][e], up = acc[ai][1][m][n][e];
                        r[4 * n + e] = g * __builtin_amdgcn_rcpf(1.f + ex2(-g * LOG2E)) * up; }
                u32x4 w; w.x = cvtpk(r[0], r[1]); w.y = cvtpk(r[2], r[3]); w.z = cvtpk(r[4], r[5]); w.w = cvtpk(r[6], r[7]);
                *(u32x4*)(ACT + (size_t)(row0 + ai * HALF + m * 16) * DFF + col0) = w;
            }
    }
};
}

__device__ __forceinline__ void tr_item(const float* W, int ldw, int K, bf16_t* WT, int k0, int drow0, int sc, LAS float* scr, int lane) {
#pragma unroll 8
    for (int i = 0; i < 32; ++i) { const int kk = 2 * i + (lane >> 5); float v = 0.f; if (sc >= 0) v = W[(size_t)(k0 + kk) * ldw + sc]; scr[kk * 33 + (lane & 31)] = v; }
    LDS_WAIT(); asm volatile("" ::: "memory");
    const int c = lane & 7;
#pragma unroll
    for (int j = 0; j < 4; ++j) { const int n = (lane >> 3) + 8 * j; const LAS float* s = scr + (8 * c) * 33 + n;
        u32x4 o; o.x = cvtpk(s[0 * 33], s[1 * 33]); o.y = cvtpk(s[2 * 33], s[3 * 33]); o.z = cvtpk(s[4 * 33], s[5 * 33]); o.w = cvtpk(s[6 * 33], s[7 * 33]);
        *(GAS u32x4*)(WT + (size_t)(drow0 + n) * K + k0 + 8 * c) = o; }
    LDS_WAIT(); asm volatile("" ::: "memory");
}

struct Args { const float* in[17]; float* out; unsigned char* ws; int lo, hi; };

__device__ __forceinline__ void prologue(const Args& a, LAS unsigned char* lds, int tid, int lane, int wave, int G) {
    unsigned char* ws = a.ws;
    const float* w_in = a.in[6]; const float* w_o = a.in[13]; const float* w_gate = a.in[14]; const float* w_up = a.in[15]; const float* w_down = a.in[16];
    LAS float* scr = (LAS float*)(lds + wave * 16384);
    const int gw = blockIdx.x * NWAVES + wave, NGW = G * NWAVES;
    constexpr int I_IN = 16 * 72, I_O = 16 * 32, I_GU = 16 * 176, I_D = 44 * 32, I_L = I_IN + I_O + I_GU + I_D;
    for (int it = gw; it < DEPTH * I_L; it += NGW) {
        const int l = it / I_L; int r = it % I_L;
        bf16_t* wl = (bf16_t*)(ws + WS_W + (size_t)l * W_LAYER);
        if (r < I_IN) {
            const int kb = r / 72, nb = r % 72, np = 32 * nb + (lane & 31), p = np & 255;
            const int slot = (np >> 8) * 4 + ((p & 127) >> 5), dim = 32 * (p >> 7) + (p & 31);
            int sc = slot_col(slot) + dim; if (slot == 11 && dim >= 4) sc = -1;
            tr_item(w_in + (size_t)l * DM * INCOLS, INCOLS, DM, wl + W_IN / 2, 64 * kb, 32 * nb, sc, scr, lane); continue; }
        r -= I_IN;
        if (r < I_O) { const int kb = r / 32, nb = r % 32;
            tr_item(w_o + (size_t)l * DM * DM, DM, DM, wl + W_O / 2, 64 * kb, 32 * nb, 32 * nb + (lane & 31), scr, lane); continue; }
        r -= I_O;
        if (r < I_GU) { const int kb = r / 176, nb = r % 176, d0 = 32 * nb, p0 = d0 & 255;
            const float* src = (p0 < 128 ? w_gate : w_up) + (size_t)l * DM * DFF;
            tr_item(src, DFF, DM, wl + W_GU / 2, 64 * kb, d0, (d0 >> 8) * 128 + (p0 & 127) + (lane & 31), scr, lane); continue; }
        r -= I_GU;
        { const int kb = r / 32, nb = r % 32;
            tr_item(w_down + (size_t)l * DFF * DM, DM, DFF, wl + W_D / 2, 64 * kb, 32 * nb, 32 * nb + (lane & 31), scr, lane); }
    }
    {
        float* cs = (float*)(ws + WS_ROPE); float* sn = cs + SEQ * 32;
        for (int idx = blockIdx.x * 512 + tid; idx < SEQ * 32; idx += G * 512) {
            const int t = idx >> 5, i = idx & 31;
            double inv = 1.0; for (int k = 0; k < i; ++k) inv *= 0.7498942093324559;
            const float ang = (float)t * (float)inv;
            double rv = (double)ang * 0.15915494309189535; rv -= __builtin_floor(rv);
            const float fr = (float)rv;
            cs[idx] = __builtin_amdgcn_cosf(fr); sn[idx] = __builtin_amdgcn_sinf(fr);
        }
    }
    __syncthreads();
    {
        const float* c = a.in[1]; const float* w_mod = a.in[4]; const float* b_mod = a.in[5];
        float* mod = (float*)(ws + WS_MOD);
        LAS float* cact = (LAS float*)lds;
        for (int idx = tid; idx < BATCH * DM; idx += 512) { const int b = idx >> 10, k = idx & 1023; const float v = c[idx]; cact[k * 32 + b] = v * __builtin_amdgcn_rcpf(1.f + ex2(-v * LOG2E)); }
        __syncthreads();
        for (int unit = blockIdx.x; unit < DEPTH * 6144 / 64; unit += G) {
            const int col = unit * 64 + lane, l = col / 6144, j = col % 6144;
            const float* wp = w_mod + (size_t)l * DM * 6144 + j;
            float acc0 = 0.f, acc1 = 0.f, acc2 = 0.f, acc3 = 0.f;
#pragma unroll 8
            for (int k = 0; k < DM; ++k) { const float wv = wp[(size_t)k * 6144]; const f32x4 c4 = *(const LAS f32x4*)(cact + k * 32 + 4 * wave);
                acc0 += c4[0] * wv; acc1 += c4[1] * wv; acc2 += c4[2] * wv; acc3 += c4[3] * wv; }
            const float bm = b_mod[l * 6144 + j];
            float* mo = mod + ((size_t)l * BATCH + 4 * wave) * 6144 + j;
            mo[0] = acc0 + bm; mo[6144] = acc1 + bm; mo[2 * 6144] = acc2 + bm; mo[3 * 6144] = acc3 + bm;
        }
    }
    __syncthreads();
}

__device__ __forceinline__ void norm_phase(const float* x, const float* ln, const float* modl  , int sh_off, bf16_t* H, int lane, int gw, int NGW) {
    for (int m = gw; m < MROWS; m += NGW) {
        const int b = m / SEQ;
        const GAS f32x4* xr = (const GAS f32x4*)(x + (size_t)m * DM) + lane;
        f32x4 v[4]; float s = 0.f;
#pragma unroll
        for (int j = 0; j < 4; ++j) { v[j] = xr[64 * j]; s += (v[j].x * v[j].x + v[j].y * v[j].y) + (v[j].z * v[j].z + v[j].w * v[j].w); }
        const float ri = __builtin_amdgcn_rsqf(wave_sum(s) * (1.f / DM) + EPS);
        const float* mb = modl + (size_t)b * 6144 + sh_off;
        GAS u32x2* o8 = (GAS u32x2*)(H + (size_t)m * DM) + lane;
#pragma unroll
        for (int j = 0; j < 4; ++j) {
            const f32x4 g = *((const GAS f32x4*)ln + lane + 64 * j), shv = *((const GAS f32x4*)mb + lane + 64 * j), scv = *((const GAS f32x4*)(mb + DM) + lane + 64 * j);
            const f32x4 y = ((v[j] * ri) * g) * (scv + 1.f) + shv;
            u32x2 w; w.x = cvtpk(y.x, y.y); w.y = cvtpk(y.z, y.w); o8[64 * j] = w;
        }
    }
}

__device__ __forceinline__ void store_head(const f32x16& o0, const f32x16& o1, float inv, const float* gout, bf16_t* orow, int h) {
    float ss = 0.f;
#pragma unroll
    for (int i = 0; i < 16; ++i) { const float a = o0[i] * inv, b = o1[i] * inv; ss += a * a + b * b; }
    ss += __shfl_xor(ss, 32);
    const float rn = __builtin_amdgcn_rsqf(ss * (1.f / 64.f) + EPS) * inv;
#pragma unroll
    for (int g = 0; g < 4; ++g) {
        const int d0 = 8 * g + 4 * h;
        const f32x4 ga = *(const f32x4*)(gout + d0), gb = *(const f32x4*)(gout + 32 + d0);
        u32x2 wa, wb;
        wa.x = cvtpk(o0[4 * g] * rn * ga[0], o0[4 * g + 1] * rn * ga[1]); wa.y = cvtpk(o0[4 * g + 2] * rn * ga[2], o0[4 * g + 3] * rn * ga[3]);
        wb.x = cvtpk(o1[4 * g] * rn * gb[0], o1[4 * g + 1] * rn * gb[1]); wb.y = cvtpk(o1[4 * g + 2] * rn * gb[2], o1[4 * g + 3] * rn * gb[3]);
        *(GAS u32x2*)(orow + d0) = wa; *(GAS u32x2*)(orow + 32 + d0) = wb;
    }
}

__device__ __forceinline__ void swa_unit(int b, int hc, int qt, const bf16_t* P, const bf16_t* VT, bf16_t* O, float M2, float sink2, const float* gout, int lane) {
    const int r = lane & 31, h = lane >> 5, t0 = qt * 32, kv = hc >> 2;
    const size_t rowbase = (size_t)b * SEQ;
    bf16x8 qf[4];
    { const bf16_t* qp = P + (rowbase + t0 + r) * NIN + (24 + hc) * 64 + 8 * h;
#pragma unroll
      for (int ks = 0; ks < 4; ++ks) qf[ks] = ldg16(qp + 16 * ks); }
    const bf16_t* kbase = P + rowbase * NIN + (32 + kv) * 64 + 8 * h + (size_t)r * NIN;
    const bf16_t* vbase = VT + ((size_t)(b * NVS + 5 + kv) * 64 + r) * SEQ + 8 * h;
    f32x16 o0 = zero16(), o1 = zero16(); float lsum = 0.f;
    const int t = t0 + r;
    const int kt_lo = qt - 4 < 0 ? 0 : qt - 4;
    for (int kt = kt_lo; kt <= qt; ++kt) {
        bf16x8 kf[4], vf[2][2];
        const bf16_t* kp = kbase + (size_t)(kt * 32) * NIN;
#pragma unroll
        for (int ks = 0; ks < 4; ++ks) kf[ks] = ldg16(kp + 16 * ks);
#pragma unroll
        for (int dt = 0; dt < 2; ++dt)
#pragma unroll
            for (int s = 0; s < 2; ++s) vf[dt][s] = ldg16(vbase + (size_t)(dt * 32) * SEQ + kt * 32 + 16 * s);
        f32x16 sc = zero16();
#pragma unroll
        for (int ks = 0; ks < 4; ++ks) sc = MFMA32(kf[ks], qf[ks], sc);
#pragma unroll
        for (int i = 0; i < 16; ++i) { const int key = kt * 32 + crow(i, h); const bool valid = (unsigned)(t - key) < 128u;
            const float p = valid ? ex2(sc[i] - M2) : 0.f; sc[i] = p; lsum += p; }
        const bf16x8 p0 = pack8(sc, 0), p1 = pack8(sc, 1);
        o0 = MFMA32(vf[0][0], p0, o0); o0 = MFMA32(vf[0][1], p1, o0);
        o1 = MFMA32(vf[1][0], p0, o1); o1 = MFMA32(vf[1][1], p1, o1);
    }
    lsum += __shfl_xor(lsum, 32); lsum += ex2(sink2 - M2);
    store_head(o0, o1, 1.f / lsum, gout, O + (rowbase + t0 + r) * DM + (8 + hc) * 64, h);
}

__device__ __forceinline__ void sb_unit(int b, int hb, int qt, const bf16_t* P, const bf16_t* VT, bf16_t* O, const float* gout, int lane) {
    const int r = lane & 31, h = lane >> 5, t0 = qt * 32;
    const size_t rowbase = (size_t)b * SEQ;
    bf16x8 qf[4];
    { const bf16_t* qp = P + (rowbase + t0 + r) * NIN + (12 + hb) * 64 + 8 * h;
#pragma unroll
      for (int ks = 0; ks < 4; ++ks) qf[ks] = ldg16(qp + 16 * ks); }
    const bf16_t* kbase = P + rowbase * NIN + (16 + hb) * 64 + 8 * h + (size_t)r * NIN;
    const bf16_t* vbase = VT + ((size_t)(b * NVS + 1 + hb) * 64 + r) * SEQ + 8 * h;
    f32x16 o0 = zero16(), o1 = zero16(); float C = 0.f;
    const int t = t0 + r;
    for (int kt = qt; kt >= 0; --kt) {
        bf16x8 kf[4], vf[2][2];
        const bf16_t* kp = kbase + (size_t)(kt * 32) * NIN;
#pragma unroll
        for (int ks = 0; ks < 4; ++ks) kf[ks] = ldg16(kp + 16 * ks);
#pragma unroll
        for (int dt = 0; dt < 2; ++dt)
#pragma unroll
            for (int s = 0; s < 2; ++s) vf[dt][s] = ldg16(vbase + (size_t)(dt * 32) * SEQ + kt * 32 + 16 * s);
        f32x16 z = zero16();
#pragma unroll
        for (int ks = 0; ks < 4; ++ks) z = MFMA32(kf[ks], qf[ks], z);
        float L[16];
#pragma unroll
        for (int i = 0; i < 16; ++i) { const int key = kt * 32 + crow(i, h); const float zz = z[i];
            const float sp = fmaxf(zz, 0.f) + lg2(1.f + ex2(-fabsf(zz)));
            L[i] = (key < t) ? -sp : 0.f; }
        float G4[4], Gp[4], ps[4], aft[4];
#pragma unroll
        for (int g = 0; g < 4; ++g) { G4[g] = (L[4 * g] + L[4 * g + 1]) + (L[4 * g + 2] + L[4 * g + 3]); Gp[g] = __shfl_xor(G4[g], 32); ps[g] = G4[g] + Gp[g]; }
        aft[3] = 0.f; aft[2] = ps[3]; aft[1] = aft[2] + ps[2]; aft[0] = aft[1] + ps[1];
#pragma unroll
        for (int g = 0; g < 4; ++g) {
            const float bg = C + aft[g] + (h == 0 ? Gp[g] : 0.f);
            const float b3 = bg, b2 = b3 + L[4 * g + 3], b1 = b2 + L[4 * g + 2], b0 = b1 + L[4 * g + 1];
            const float bt[4] = {b0, b1, b2, b3};
#pragma unroll
            for (int e = 0; e < 4; ++e) { const int i = 4 * g + e; const int key = kt * 32 + crow(i, h);
                z[i] = (key < t) ? ex2(z[i] + L[i] + bt[e]) : 0.f; }
        }
        C += aft[0] + ps[0];
        const bf16x8 p0 = pack8(z, 0), p1 = pack8(z, 1);
        o0 = MFMA32(vf[0][0], p0, o0); o0 = MFMA32(vf[0][1], p1, o0);
        o1 = MFMA32(vf[1][0], p0, o1); o1 = MFMA32(vf[1][1], p1, o1);
        if (__all(C < -160.f)) break;
    }
    store_head(o0, o1, 1.f, gout, O + (rowbase + t0 + r) * DM + (4 + hb) * 64, h);
}

__device__ __forceinline__ void dsa_phase(const bf16_t* P, const bf16_t* VT, const float* WI, bf16_t* O, const float* gout  , float M2, unsigned* queue,
                                          LAS unsigned char* lds, int tid, int lane, int wave) {
    LAS float* SC = (LAS float*)(lds + LDS_SC);
    LAS unsigned* MASK = (LAS unsigned*)(lds + LDS_MASK);
    LAS float* LSUM = (LAS float*)(lds + LDS_LSUM);
    LAS float* SSUM = (LAS float*)(lds + LDS_SSUM);
    volatile LAS unsigned* QW = (volatile LAS unsigned*)(lds + LDS_MISC);
    for (;;) {
        if (tid == 0) QW[0] = __hip_atomic_fetch_add(queue, 1u, __ATOMIC_RELAXED, __HIP_MEMORY_SCOPE_AGENT);
        __syncthreads();
        const int q = (int)QW[0];
        if (q >= BATCH * 128) break;
        const int tau = 127 - (q >> 5), b = q & 31, t0 = 16 * tau;
        const size_t rowbase = (size_t)b * SEQ;
        if (DSA_S & 1) {
            int lane1 = lane; asm volatile("" : "+v"(lane1));
            const int c = lane1 & 15, g = lane1 >> 4;
            bf16x8 qi[4][2];
            const bf16_t* qp = P + (rowbase + t0 + c) * NIN + 4 * 64 + 8 * g;
#pragma unroll
            for (int hh = 0; hh < 4; ++hh) { qi[hh][0] = ldg16(qp + hh * 64); qi[hh][1] = ldg16(qp + hh * 64 + 32); }
            const f32x4 w = *(const GAS f32x4*)(WI + (rowbase + t0 + c) * 4);
            const bf16_t* kp0 = P + (rowbase + c) * NIN + 10 * 64 + 8 * g;
            for (int kt = wave; kt <= tau; kt += NWAVES) {
                const bf16_t* kp = kp0 + (size_t)(kt * 16) * NIN;
                const bf16x8 k0 = ldg16(kp), k1 = ldg16(kp + 32);
                f32x4 sc = {0.f, 0.f, 0.f, 0.f};
#pragma unroll
                for (int hh = 0; hh < 4; ++hh) { f32x4 a = {0.f, 0.f, 0.f, 0.f}; a = MFMA16(k0, qi[hh][0], a); a = MFMA16(k1, qi[hh][1], a);
#pragma unroll
                    for (int j = 0; j < 4; ++j) sc[j] += w[hh] * fmaxf(a[j], 0.f); }
                *(LAS f32x4*)(SC + c * SC_STRIDE + kt * 16 + 4 * g) = sc;
            }
        }
        __syncthreads();
#pragma unroll 1
        for (int rr = 0; rr < ((DSA_S & 2) ? 2 : 0); ++rr) {
            const int r = 2 * wave + rr, t = t0 + r, n = t + 1;
            unsigned u[32];
#pragma unroll
            for (int j = 0; j < 32; ++j) { const int s = 64 * j + lane; unsigned bb = __float_as_uint(SC[r * SC_STRIDE + s]);
                bb = (bb == 0x80000000u) ? 0u : bb; bb = (bb & 0x80000000u) ? ~bb : (bb | 0x80000000u); u[j] = (s <= t) ? bb : 0u; }
            unsigned T = 0u;
            if (n > 256) {
                const int nsl = (n + 63) >> 6;
                for (int bit = 31; bit >= 0; --bit) {
                    const unsigned cand = T | (1u << bit); int cnt = 0;
#pragma unroll
                    for (int g = 0; g < 8; ++g) if (4 * g < nsl) {
#pragma unroll
                        for (int e = 0; e < 4; ++e) cnt += __builtin_popcountll(__ballot(u[4 * g + e] >= cand)); }
                    if (cnt >= 256) { T = cand; if (cnt == 256) break; }
                }
            }
            unsigned long long mym = 0ull;
            if (n <= 256) {
#pragma unroll
                for (int j = 0; j < 32; ++j) { const unsigned long long m = __ballot(64 * j + lane <= t); mym = (lane == j) ? m : mym; }
            } else {
                int cgt = 0;
#pragma unroll
                for (int j = 0; j < 32; ++j) cgt += __builtin_popcountll(__ballot(u[j] > T));
                int need = 256 - cgt;
#pragma unroll
                for (int j = 0; j < 32; ++j) {
                    const unsigned long long gt = __ballot(u[j] > T); unsigned long long eq = __ballot(u[j] == T);
                    const int ce = __builtin_popcountll(eq); unsigned long long sel;
                    if (need >= ce) { sel = eq; need -= ce; }
                    else { sel = 0ull; while (need > 0) { const unsigned long long low = eq & (0ull - eq); sel |= low; eq ^= low; --need; } }
                    const unsigned long long m = gt | sel; mym = (lane == j) ? m : mym;
                }
            }
            if (lane < 32) { MASK[r * MASK_STRIDE + 2 * lane] = (unsigned)mym; MASK[r * MASK_STRIDE + 2 * lane + 1] = (unsigned)(mym >> 32); }
        }
        __syncthreads();
        if (DSA_S & 4) {
            int lane3 = lane; asm volatile("" : "+v"(lane3));
            const int r = lane3 & 31, h = lane3 >> 5, c = r & 15;
            bf16x8 qf[2][4];
#pragma unroll
            for (int nt = 0; nt < 2; ++nt) { const bf16_t* qp = P + (rowbase + t0 + c) * NIN + (2 * nt + (r >> 4)) * 64 + 8 * h;
#pragma unroll
                for (int ks = 0; ks < 4; ++ks) qf[nt][ks] = ldg16(qp + 16 * ks); }
            f32x16 o[2][2]; o[0][0] = zero16(); o[0][1] = zero16(); o[1][0] = zero16(); o[1][1] = zero16();
            float ls[2] = {0.f, 0.f};
            const bf16_t* kbase = P + (rowbase + r) * NIN + 8 * 64 + 8 * h;
            const bf16_t* vbase = VT + ((size_t)(b * NVS) * 64 + r) * SEQ + 8 * h;
            const int nkt = ((t0 + 15) >> 5) + 1;
            for (int kt = wave; kt < nkt; kt += NWAVES) {
                bf16x8 kf[4], vf[2][2];
                const bf16_t* kp = kbase + (size_t)(kt * 32) * NIN;
#pragma unroll
                for (int ks = 0; ks < 4; ++ks) kf[ks] = ldg16(kp + 16 * ks);
#pragma unroll
                for (int dt = 0; dt < 2; ++dt)
#pragma unroll
                    for (int s = 0; s < 2; ++s) vf[dt][s] = ldg16(vbase + (size_t)(dt * 32) * SEQ + kt * 32 + 16 * s);
                const unsigned mw = MASK[c * MASK_STRIDE + kt];
#pragma unroll
                for (int nt = 0; nt < 2; ++nt) {
                    f32x16 sc = zero16();
#pragma unroll
                    for (int ks = 0; ks < 4; ++ks) sc = MFMA32(kf[ks], qf[nt][ks], sc);
#pragma unroll
                    for (int i = 0; i < 16; ++i) { const float p = ((mw >> crow(i, h)) & 1u) ? ex2(sc[i] - M2) : 0.f; sc[i] = p; ls[nt] += p; }
                    const bf16x8 p0 = pack8(sc, 0), p1 = pack8(sc, 1);
                    o[nt][0] = MFMA32(vf[0][0], p0, o[nt][0]); o[nt][0] = MFMA32(vf[0][1], p1, o[nt][0]);
                    o[nt][1] = MFMA32(vf[1][0], p0, o[nt][1]); o[nt][1] = MFMA32(vf[1][1], p1, o[nt][1]);
                }
            }
#pragma unroll
            for (int nt = 0; nt < 2; ++nt) {
#pragma unroll
                for (int dt = 0; dt < 2; ++dt)
#pragma unroll
                    for (int i = 0; i < 16; ++i) SC[(wave * 64 + 32 * dt + crow(i, h)) * 64 + 32 * nt + r] = o[nt][dt][i];
                float l2 = ls[nt]; l2 += __shfl_xor(l2, 32);
                if (h == 0) LSUM[wave * 64 + 32 * nt + r] = l2;
            }
        }
        __syncthreads();
        if (DSA_S & 8) {
            int n = lane; asm volatile("" : "+v"(n));
            float l = 0.f;
#pragma unroll
            for (int w = 0; w < NWAVES; ++w) l += LSUM[w * 64 + n];
            const float inv = 1.f / l;
            float ov[8]; float ssp = 0.f;
#pragma unroll
            for (int dd = 0; dd < 8; ++dd) { float a = 0.f;
#pragma unroll
                for (int w = 0; w < NWAVES; ++w) a += SC[(w * 64 + 8 * wave + dd) * 64 + n];
                ov[dd] = a * inv; ssp += ov[dd] * ov[dd]; }
            SSUM[wave * 64 + n] = ssp;
            __syncthreads();
            float ss = 0.f;
#pragma unroll
            for (int w = 0; w < NWAVES; ++w) ss += SSUM[w * 64 + n];
            const float rn = __builtin_amdgcn_rsqf(ss * (1.f / 64.f) + EPS);
            const int head = n >> 4, c = n & 15;
            const f32x4 ga = *(const f32x4*)(gout + head * 64 + 8 * wave), gb = *(const f32x4*)(gout + head * 64 + 8 * wave + 4);
            u32x4 wv; wv.x = cvtpk(ov[0] * rn * ga[0], ov[1] * rn * ga[1]); wv.y = cvtpk(ov[2] * rn * ga[2], ov[3] * rn * ga[3]);
            wv.z = cvtpk(ov[4] * rn * gb[0], ov[5] * rn * gb[1]); wv.w = cvtpk(ov[6] * rn * gb[2], ov[7] * rn * gb[3]);
            *(GAS u32x4*)(O + (rowbase + t0 + c) * DM + head * 64 + 8 * wave) = wv;
        }
        __syncthreads();
    }
}

__global__ void __launch_bounds__(NWAVES * 64, 2) fwd(Args args) {
    extern __shared__ __attribute__((aligned(16))) unsigned char lds_raw[];
    LAS unsigned char* lds = (LAS unsigned char*)lds_raw;
    const int wave = __builtin_amdgcn_readfirstlane(threadIdx.x >> 6);
    const int G = gridDim.x;
    const int gw = blockIdx.x * NWAVES + wave, NGW = G * NWAVES;
    unsigned char* ws = args.ws;
    unsigned* ctl = (unsigned*)(ws + WS_CTL);
    volatile LAS unsigned* MISC = (volatile LAS unsigned*)(lds + LDS_MISC);
    if (threadIdx.x < 16) MISC[threadIdx.x] = 0u;
    __syncthreads();
    XcdBarrier bar; bar.bar = ctl + CW_BAR; bar.x = 0; bar.st = nullptr;
    if (!MK_MULTI) bar = xcd_barrier_post(ctl + CW_BAR, MISC + 4);
    const int lo = args.lo, hi = args.hi;
#define IN(k) (lo <= (k) && (k) < hi)
#define SEAM(k) do { if (IN(k) && IN((k) + 1)) xcd_barrier(bar); } while (0)

    bf16_t* H = (bf16_t*)(ws + WS_H); bf16_t* ACT = (bf16_t*)(ws + WS_ACT); bf16_t* P = (bf16_t*)(ws + WS_P); bf16_t* VT = (bf16_t*)(ws + WS_VT);
    float* WI = (float*)(ws + WS_WI); const float* cs = (const float*)(ws + WS_ROPE); const float* sn = cs + SEQ * 32;
    const float* mod = (const float*)(ws + WS_MOD);
    float* xout = args.out;

#define OPQ() int tid = threadIdx.x; asm volatile("" : "+v"(tid)); const int lane = tid & 63; (void)lane
    if (PH(0) && IN(0)) { OPQ(); prologue(args, lds, tid, lane, wave, G); }
    SEAM(0);

    for (int l = 0; l < DEPTH; ++l) {
        const int s0 = 1 + 7 * l;
        const float* xin = (l == 0) ? args.in[0] : (const float*)xout;
        const float* modl = mod + (size_t)l * BATCH * 6144;
        const bf16_t* wl = (const bf16_t*)(ws + WS_W + (size_t)l * W_LAYER);
        if (PH(1) && IN(s0 + 0)) { OPQ(); norm_phase(xin, args.in[2] + l * DM, modl, 0, H, lane, gw, NGW); }
        SEAM(s0 + 0);
        if (PH(2) && IN(s0 + 1)) {
            pg8::Gemm g{H, wl + W_IN / 2, MROWS, NIN, DM}; pg8::StaticOrder S; S.init(MROWS, NIN, G, (int)blockIdx.x);
            pg8::EpiInProj E{P, VT, WI, cs, sn, args.in[7] + l * 64, args.in[8] + l * 64, args.in[9] + l * 64, args.in[10] + l * 64};
            pg8::gemm_phase<pg8::EpiInProj, pg8::StaticOrder, true, true>(lds, g, S, E);
        }
        SEAM(s0 + 1);
        if (PH(3) && IN(s0 + 2)) {
            OPQ();
            const float* gout = args.in[12] + l * 1024;
            const float gqa = wave_max(fabsf(args.in[7][l * 64 + lane])), gka = wave_max(fabsf(args.in[8][l * 64 + lane]));
            const float gqc = wave_max(fabsf(args.in[9][l * 64 + lane])), gkc = wave_max(fabsf(args.in[10][l * 64 + lane]));
            const float M2a = 8.f * gqa * gka * LOG2E, M2c = 8.f * gqc * gkc * LOG2E;
            if (PH(8)) for (int u = gw; u < BATCH * 8 * 64; u += NGW) { const int qt = u & 63, hc = (u >> 6) & 7, b = u >> 9;
                swa_unit(b, hc, qt, P, VT, H, M2c, args.in[11][l * 8 + hc] * LOG2E, gout + (8 + hc) * 64, lane); }
            if (PH(9)) for (int u = gw; u < BATCH * 4 * 64; u += NGW) { const int qt = u & 63, hb = (u >> 6) & 3, b = u >> 8;
                sb_unit(b, hb, qt, P, VT, H, gout + (4 + hb) * 64, lane); }
            if (PH(10)) dsa_phase(P, VT, WI, H, gout, M2a, ctl + CW_QUEUE + 64 * l, lds, tid, lane, wave);
        }
        SEAM(s0 + 2);
        if (PH(4) && IN(s0 + 3)) {
            pg8::Gemm g{H, wl + W_O / 2, MROWS, DM, DM}; pg8::StaticOrder S; S.init(MROWS, DM, G, (int)blockIdx.x);
            pg8::EpiResid E{xin, xout, modl + 2 * DM};
            pg8::gemm_phase<pg8::EpiResid, pg8::StaticOrder, true, true>(lds, g, S, E);
        }
        SEAM(s0 + 3);
        if (PH(5) && IN(s0 + 4)) { OPQ(); norm_phase(xout, args.in[3] + l * DM, modl, 3 * DM, H, lane, gw, NGW); }
        SEAM(s0 + 4);
        if (PH(6) && IN(s0 + 5)) {
            pg8::Gemm g{H, wl + W_GU / 2, MROWS, NGU, DM}; pg8::StaticOrder S; S.init(MROWS, NGU, G, (int)blockIdx.x);
            pg8::EpiSwiGLU E{ACT};
            pg8::gemm_phase<pg8::EpiSwiGLU, pg8::StaticOrder, true, true>(lds, g, S, E);
        }
        SEAM(s0 + 5);
        if (PH(7) && IN(s0 + 6)) {
            pg8::Gemm g{ACT, wl + W_D / 2, MROWS, DM, DFF}; pg8::StaticOrder S; S.init(MROWS, DM, G, (int)blockIdx.x);
            pg8::EpiResid E{xout, xout, modl + 5 * DM};
            pg8::gemm_phase<pg8::EpiResid, pg8::StaticOrder, true, true>(lds, g, S, E);
        }
        SEAM(s0 + 6);
    }
#undef IN
#undef SEAM
}

extern "C" void kernel_launch(void* const* d_in, const int* in_sizes, int n_in, void* d_out, int out_size, void* d_ws, size_t ws_size, hipStream_t stream) {
    static int grid = 0;
    if (grid == 0) {
        if (n_in != 17 || in_sizes[0] != MROWS * DM || out_size != MROWS * DM || ws_size < WS_END) {
            fprintf(stderr, "kernel_launch: unexpected problem (n_in %d, in0 %d, out %d, ws %zu); nothing launched\n", n_in, n_in > 0 ? in_sizes[0] : -1, out_size, ws_size); grid = -1; return; }
        int dev = 0, cus = 0, per_cu = 0;
        if (hipGetDevice(&dev) != hipSuccess || hipDeviceGetAttribute(&cus, hipDeviceAttributeMultiprocessorCount, dev) != hipSuccess) { grid = -1; return; }
        if (hipFuncSetAttribute((const void*)fwd, hipFuncAttributeMaxDynamicSharedMemorySize, LDS_BYTES) != hipSuccess) { fprintf(stderr, "kernel_launch: hipFuncSetAttribute failed\n"); grid = -1; return; }
        if (hipOccupancyMaxActiveBlocksPerMultiprocessor(&per_cu, (const void*)fwd, NWAVES * 64, LDS_BYTES) != hipSuccess || per_cu < 1) {
            fprintf(stderr, "kernel_launch: occupancy query reports %d workgroups per CU\n", per_cu); per_cu = 1; }
        (void)hipGetLastError();
        grid = cus;
    }
    if (grid < 0) return;
    if (hipMemsetAsync((char*)d_ws + WS_CTL, 0, CTL_BYTES, stream) != hipSuccess) return;
    Args a{};
    for (int i = 0; i < 17; ++i) a.in[i] = (const float*)d_in[i];
    a.out = (float*)d_out; a.ws = (unsigned char*)d_ws;
#if MK_MULTI
    for (int s = 0; s < NSTEPS; ++s) { a.lo = s; a.hi = s + 1; hipLaunchKernelGGL(fwd, dim3(grid), dim3(NWAVES * 64), LDS_BYTES, stream, a); }
#else
    a.lo = 0; a.hi = NSTEPS;
    hipLaunchKernelGGL(fwd, dim3(grid), dim3(NWAVES * 64), LDS_BYTES, stream, a);
#endif
}
```

```cpp
#include <hip/hip_runtime.h>
#include <cstdio>
#include <cstdint>

#ifndef MK_MULTI
#define MK_MULTI 0
#endif

#define LAS __attribute__((address_space(3)))
#define GAS __attribute__((address_space(1)))
namespace pg8 {
#define PG8_LAS __attribute__((address_space(3)))
typedef unsigned short bf16_t;
typedef short bf16x8 __attribute__((ext_vector_type(8)));
typedef float f32x4 __attribute__((ext_vector_type(4)));
typedef unsigned u32x4 __attribute__((ext_vector_type(4)));
constexpr int BM = 256, BK = 64, HALF = 128, HTB = HALF * BK * 2  , STAGE_BYTES = 8 * HTB, NXCD = 8, WGM = 8;

__host__ __device__ __forceinline__ int lds_byte(int r, int c) { const int st = (r >> 4) * 2 + (c >> 5), rr = r & 15, cc = c & 31, ob = rr * 64 + cc * 2; return st * 1024 + (ob ^ (((ob >> 9) & 1) << 5)); }
__host__ __device__ __forceinline__ void stage_rc(int b, int& R, int& C) { const int st = b / 1024, sb = b % 1024, swz = sb ^ (((sb >> 9) & 1) << 5); R = (st >> 1) * 16 + swz / 64; C = (st & 1) * 32 + (swz % 64) / 2; }
__host__ __device__ __forceinline__ int perm32(int rho) { const int n = rho >> 4, i = rho & 15; return 8 * (i >> 2) + 4 * n + (i & 3); }

struct Unit { int pm, pn; };
struct Gemm { const bf16_t* A; const bf16_t* Bt; int M, N, K; };

struct StaticOrder {
    int nM, nN, nwg, G, c;
    __host__ __device__ void init(int M, int N, int G_, int c_) { nM = M / BM; nN = N / BM; nwg = nM * nN; G = G_; c = c_; }
    __host__ __device__ bool next(int i, Unit& u) const {
        const long L = (long)i * G + c; if (L >= nwg) return false;
        int wgid = (int)L; { const int q = nwg / NXCD, r = nwg % NXCD, xcd = wgid % NXCD, off = wgid / NXCD; wgid = (xcd < r ? xcd * (q + 1) : r * (q + 1) + (xcd - r) * q) + off; }
        const int nig = WGM * nN, gid = wgid / nig, fm = gid * WGM, gsz = (nM - fm) < WGM ? (nM - fm) : WGM;
        u.pm = fm + ((wgid % nig) % gsz); u.pn = (wgid % nig) / gsz; return true;
    }
    __device__ __forceinline__ void a_ready(const Unit&) const {}
    __device__ __forceinline__ void done(const Unit&) const {}
};
template <class Epi, class Sched, bool ALIGN_EPI = false, bool SP2 = false>
__device__ __forceinline__ void gemm_phase(PG8_LAS unsigned char* lds, const Gemm g, const Sched& S, const Epi& E) {
    int tid_o = threadIdx.x; asm volatile("" : "+v"(tid_o));
    const int tid = tid_o, wid = __builtin_amdgcn_readfirstlane(tid >> 6), lane = tid & 63, wr = wid >> 2, wc = wid & 3, fr = lane & 15, fq = lane >> 4;
    const int K = g.K, nt = K / BK;
    unsigned voffA[2], voffB[2];
#pragma unroll
    for (int i = 0; i < 2; ++i) { int R, C; stage_rc(tid * 16 + i * 8192, R, C); const int Rb = Epi::PERM ? ((R & ~31) + perm32(R & 31)) : R;
        voffA[i] = (unsigned)(R * K + C) * 2u; voffB[i] = (unsigned)(Rb * K + C) * 2u; }
    const size_t kstep = (size_t)(BK * 2);
    const size_t hstep = (size_t)HALF * K * 2;
    const size_t tstep = 2 * hstep;
    const unsigned ldsw = (unsigned)wid * 1024u;
    const int aoff = lds_byte(wr * 64 + fr, fq * 8), boff = lds_byte(wc * 32 + fr, fq * 8);
#define PG8_SA(b, h) (((b) * 2 + (h)) * HTB)
#define PG8_SB(b, h) ((4 + (b) * 2 + (h)) * HTB)
#define PG8_STAGE(bufoff, gbase, voff) do { _Pragma("unroll") for (int _i = 0; _i < 2; ++_i) \
        __builtin_amdgcn_global_load_lds((const unsigned*)((const char*)(gbase) + (voff)[_i]), (PG8_LAS unsigned*)(lds + (bufoff) + ldsw + _i * 8192), 16, 0, 0); } while (0)
#define PG8_LDA(dst, b, h) do { _Pragma("unroll") for (int m = 0; m < 4; ++m) _Pragma("unroll") for (int k = 0; k < 2; ++k) dst[m][k] = *(const PG8_LAS bf16x8*)(lds + PG8_SA(b, h) + aoff + m * 2048 + k * 1024); } while (0)
#define PG8_LDB(dst, b, h) do { _Pragma("unroll") for (int n = 0; n < 2; ++n) _Pragma("unroll") for (int k = 0; k < 2; ++k) dst[n][k] = *(const PG8_LAS bf16x8*)(lds + PG8_SB(b, h) + boff + n * 2048 + k * 1024); } while (0)
#define PG8_MMA(ai, bj, At, Bt) do { __builtin_amdgcn_s_setprio(1); _Pragma("unroll") for (int m = 0; m < 4; ++m) _Pragma("unroll") for (int n = 0; n < 2; ++n) _Pragma("unroll") for (int k = 0; k < 2; ++k) \
        acc[ai][bj][m][n] = __builtin_amdgcn_mfma_f32_16x16x32_bf16(Bt[n][k], At[m][k], acc[ai][bj][m][n], 0, 0, 0); __builtin_amdgcn_s_setprio(0); } while (0)
#define PG8_WAIT_V(n) asm volatile("s_waitcnt vmcnt(" #n ")" ::: "memory")
#define PG8_WAIT_L(n) asm volatile("s_waitcnt lgkmcnt(" #n ")" ::: "memory")
#define PG8_BAR __builtin_amdgcn_s_barrier()
#define PG8_SCHED __builtin_amdgcn_sched_barrier(0)
    Unit cur, nxt; int ui = 0;
    if (!S.next(0, cur)) return;
    f32x4 acc[2][2][4][2];
#pragma unroll
    for (int a = 0; a < 2; ++a)
#pragma unroll
        for (int b = 0; b < 2; ++b)
#pragma unroll
            for (int m = 0; m < 4; ++m)
#pragma unroll
                for (int n = 0; n < 2; ++n) acc[a][b][m][n] = (f32x4){0.f, 0.f, 0.f, 0.f};
    bf16x8 At[4][2], B0[2][2], B1[2][2];
    const char* cA = (const char*)g.A + (size_t)cur.pm * tstep; const char* cB = (const char*)g.Bt + (size_t)cur.pn * tstep;
    S.a_ready(cur);
    if constexpr (SP2) {
        PG8_STAGE(PG8_SB(0, 0), cB, voffB); PG8_STAGE(PG8_SB(0, 1), cB + hstep, voffB); PG8_STAGE(PG8_SA(0, 0), cA, voffA); PG8_STAGE(PG8_SA(0, 1), cA + hstep, voffA);
        if (wr == 1) PG8_BAR;
        PG8_WAIT_V(2); PG8_BAR;
        PG8_STAGE(PG8_SB(1, 0), cB + kstep, voffB); PG8_STAGE(PG8_SA(1, 0), cA + kstep, voffA); PG8_STAGE(PG8_SB(1, 1), cB + hstep + kstep, voffB);
        PG8_WAIT_V(6); PG8_BAR;
    } else {
        PG8_STAGE(PG8_SB(0, 0), cB, voffB); PG8_STAGE(PG8_SA(0, 0), cA, voffA); PG8_STAGE(PG8_SB(0, 1), cB + hstep, voffB); PG8_STAGE(PG8_SA(0, 1), cA + hstep, voffA);
        if (wr == 1) PG8_BAR;
        PG8_WAIT_V(4); PG8_BAR;
        PG8_STAGE(PG8_SB(1, 0), cB + kstep, voffB); PG8_STAGE(PG8_SA(1, 0), cA + kstep, voffA); PG8_STAGE(PG8_SB(1, 1), cB + hstep + kstep, voffB);
        PG8_WAIT_V(6); PG8_BAR;
    }
    for (;;) {
        const bool has_next = S.next(ui + 1, nxt);
        const char* nA = has_next ? (const char*)g.A + (size_t)nxt.pm * tstep : cA; const char* nB = has_next ? (const char*)g.Bt + (size_t)nxt.pn * tstep : cB;
        for (int t = 0; t < nt; t += 2) {
            const bool last = (t == nt - 2);
            const char* a1 = cA + (size_t)(t + 1) * kstep;
            const char* a2 = last ? nA : cA + (size_t)(t + 2) * kstep; const char* b2 = last ? nB : cB + (size_t)(t + 2) * kstep;
            const char* a3 = a2 + kstep; const char* b3 = b2 + kstep;
            if (last && has_next) S.a_ready(nxt);
            if constexpr (SP2) {
            PG8_LDB(B0, 0, 0); PG8_LDB(B1, 0, 1); PG8_SCHED; PG8_LDA(At, 0, 0); PG8_STAGE(PG8_SA(1, 1), a1 + hstep, voffA);
            PG8_WAIT_V(8); PG8_WAIT_L(0); PG8_BAR; PG8_MMA(0, 0, At, B0); PG8_MMA(0, 1, At, B1); PG8_BAR; PG8_SCHED;
            PG8_LDA(At, 0, 1); PG8_STAGE(PG8_SB(0, 0), b2, voffB); PG8_STAGE(PG8_SB(0, 1), b2 + hstep, voffB); PG8_STAGE(PG8_SA(0, 0), a2, voffA);
            PG8_WAIT_V(8); PG8_WAIT_L(0); PG8_BAR; PG8_MMA(1, 0, At, B0); PG8_MMA(1, 1, At, B1); PG8_BAR; PG8_SCHED;
            PG8_LDB(B0, 1, 0); PG8_LDB(B1, 1, 1); PG8_SCHED; PG8_LDA(At, 1, 0); PG8_STAGE(PG8_SA(0, 1), a2 + hstep, voffA);
            PG8_WAIT_V(8); PG8_WAIT_L(0); PG8_BAR; PG8_MMA(0, 0, At, B0); PG8_MMA(0, 1, At, B1); PG8_BAR; PG8_SCHED;
            PG8_LDA(At, 1, 1); PG8_STAGE(PG8_SB(1, 0), b3, voffB); PG8_STAGE(PG8_SB(1, 1), b3 + hstep, voffB); PG8_STAGE(PG8_SA(1, 0), a3, voffA);
            PG8_WAIT_V(8); PG8_WAIT_L(0); PG8_BAR; PG8_MMA(1, 0, At, B0); PG8_MMA(1, 1, At, B1); PG8_BAR; PG8_SCHED;
            } else {
            PG8_LDB(B0, 0, 0); PG8_SCHED; PG8_LDA(At, 0, 0); PG8_STAGE(PG8_SA(1, 1), a1 + hstep, voffA);
            PG8_WAIT_L(8); PG8_BAR; PG8_WAIT_L(0); PG8_MMA(0, 0, At, B0); PG8_BAR; PG8_SCHED;
            PG8_LDB(B1, 0, 1); PG8_STAGE(PG8_SB(0, 0), b2, voffB);
            PG8_BAR; PG8_WAIT_L(0); PG8_MMA(0, 1, At, B1); PG8_BAR;
            PG8_LDA(At, 0, 1); PG8_STAGE(PG8_SA(0, 0), a2, voffA);
            PG8_BAR; PG8_WAIT_L(0); PG8_MMA(1, 0, At, B0); PG8_BAR; PG8_SCHED;
            PG8_STAGE(PG8_SB(0, 1), b2 + hstep, voffB);
            PG8_WAIT_V(6); PG8_BAR; PG8_MMA(1, 1, At, B1); PG8_BAR;
            PG8_LDB(B0, 1, 0); PG8_SCHED; PG8_LDA(At, 1, 0); PG8_STAGE(PG8_SA(0, 1), a2 + hstep, voffA);
            PG8_WAIT_L(8); PG8_BAR; PG8_WAIT_L(0); PG8_MMA(0, 0, At, B0); PG8_BAR; PG8_SCHED;
            PG8_LDB(B1, 1, 1); PG8_STAGE(PG8_SB(1, 0), b3, voffB);
            PG8_BAR; PG8_WAIT_L(0); PG8_MMA(0, 1, At, B1); PG8_BAR;
            PG8_LDA(At, 1, 1); PG8_STAGE(PG8_SA(1, 0), a3, voffA);
            PG8_BAR; PG8_WAIT_L(0); PG8_MMA(1, 0, At, B0); PG8_BAR; PG8_SCHED;
            PG8_STAGE(PG8_SB(1, 1), b3 + hstep, voffB);
            PG8_WAIT_V(6); PG8_BAR; PG8_MMA(1, 1, At, B1); PG8_BAR;
            }
        }
        if constexpr (ALIGN_EPI) { if (wr == 0) PG8_BAR; }
        if constexpr (!Epi::AFTER_DRAIN) { E(acc, cur, wr, wc, fr, fq); S.done(cur); }
        if (!has_next) break;
#pragma unroll
        for (int a = 0; a < 2; ++a)
#pragma unroll
            for (int b = 0; b < 2; ++b)
#pragma unroll
                for (int m = 0; m < 4; ++m)
#pragma unroll
                    for (int n = 0; n < 2; ++n) acc[a][b][m][n] = (f32x4){0.f, 0.f, 0.f, 0.f};
        cur = nxt; cA = nA; cB = nB; ++ui;
        if constexpr (ALIGN_EPI) { if (wr == 1) PG8_BAR; }
    }
    PG8_WAIT_V(0);
    if constexpr (!ALIGN_EPI) { if (wr == 0) PG8_BAR; }
    PG8_BAR;
    if constexpr (Epi::AFTER_DRAIN) { E.fused(acc, cur, wr, wc, fr, fq, lds, wid, lane); S.done(cur); }
#undef PG8_SA
#undef PG8_SB
#undef PG8_STAGE
#undef PG8_LDA
#undef PG8_LDB
#undef PG8_MMA
#undef PG8_WAIT_V
#undef PG8_WAIT_L
#undef PG8_BAR
#undef PG8_SCHED
}
}

#define XB_TMO      128
#define XB_XCNT(j)  (256  + 64 * (j))
#define XB_XSUB(j)  (1280 + 64 * (j))
#define XB_XGEN(j)  (2304 + 64 * (j))
#define XB_TOP      3328
#define XB_TOPGEN   3392
#define XCD_BAR_WORDS 3456
#define XB_SPIN_CAP (1u << 24)

__device__ __forceinline__ unsigned xb_ld(unsigned* p)              { return __hip_atomic_load(p, __ATOMIC_RELAXED, __HIP_MEMORY_SCOPE_AGENT); }
__device__ __forceinline__ unsigned xb_add(unsigned* p, unsigned v) { return __hip_atomic_fetch_add(p, v, __ATOMIC_RELAXED, __HIP_MEMORY_SCOPE_AGENT); }
__device__ __forceinline__ unsigned xb_xcc_id() { return (unsigned)__builtin_amdgcn_s_getreg((3 << 11) | 20) & 0xFu; }
#define XB_SPIN(cond, bar) do { unsigned _sp = 0; while (cond) { __builtin_amdgcn_s_sleep(1); \
    if ((++_sp & 255u) == 0u) { if (xb_ld(&(bar)[XB_TMO])) break; if (_sp > XB_SPIN_CAP) { atomicAdd(&(bar)[XB_TMO], 1u); break; } } } } while (0)

struct XcdBarrier {
    unsigned* bar; unsigned x;
    volatile LAS unsigned* st;
};

__device__ __forceinline__ XcdBarrier xcd_barrier_post(unsigned* bar, volatile LAS unsigned* st) {
    XcdBarrier b; b.bar = bar; b.x = xb_xcc_id(); b.st = st;
    if (threadIdx.x == 0) (void)xb_add(&bar[XB_XCNT(b.x)], 1u);
    return b;
}
__device__ __forceinline__ void xcd_barrier_complete(unsigned* bar, unsigned x, unsigned& nloc, unsigned& nx) {
    const unsigned G = gridDim.x * gridDim.y * gridDim.z;
    unsigned sum, cnt, mine, sp = 0u;
    for (;;) {
        sum = 0u; cnt = 0u; mine = 0u;
#pragma unroll
        for (unsigned j = 0; j < 16; ++j) { const unsigned c = xb_ld(&bar[XB_XCNT(j)]); sum += c; cnt += (c > 0u) ? 1u : 0u; mine = (j == x) ? c : mine; }
        if (sum == G) break;
        __builtin_amdgcn_s_sleep(1);
        if ((++sp & 255u) == 0u) { if (xb_ld(&bar[XB_TMO])) break; if (sp > XB_SPIN_CAP) { atomicAdd(&bar[XB_TMO], 1u); break; } }
    }
    nloc = mine > 0u ? mine : 1u; nx = cnt > 0u ? cnt : 1u;
}

__device__ __forceinline__ void xcd_barrier(const XcdBarrier& b) {
    asm volatile("s_waitcnt vmcnt(0)" ::: "memory");
    __syncthreads();
    if (threadIdx.x == 0) {
        unsigned* bar = b.bar;
        __builtin_amdgcn_s_waitcnt(0);
        unsigned nloc = b.st[0], nx = b.st[1];
        if (nloc == 0u) { xcd_barrier_complete(bar, b.x, nloc, nx); b.st[0] = nloc; b.st[1] = nx; }
        const unsigned old = xb_add(&bar[XB_XSUB(b.x)], 1u);
        const unsigned gen = old / nloc;
        if (old + 1u == (gen + 1u) * nloc) {
            __builtin_amdgcn_fence(__ATOMIC_RELEASE, "agent");
            asm volatile("s_waitcnt vmcnt(0)" ::: "memory");
            const unsigned og = xb_add(&bar[XB_TOP], 1u);
            const unsigned tg = og / nx;
            if (og + 1u == (tg + 1u) * nx) xb_add(&bar[XB_TOPGEN], 1u);
            else XB_SPIN(xb_ld(&bar[XB_TOPGEN]) == tg, bar);
            __builtin_amdgcn_fence(__ATOMIC_ACQUIRE, "agent");
            xb_add(&bar[XB_XGEN(b.x)], 1u);
            asm volatile("s_waitcnt vmcnt(0)" ::: "memory");
        } else {
            XB_SPIN(xb_ld(&bar[XB_XGEN(b.x)]) == gen, bar);
            __builtin_amdgcn_fence(__ATOMIC_ACQUIRE, "agent");
            asm volatile("s_waitcnt vmcnt(0)" ::: "memory");
        }
    }
    __syncthreads();
}

#define LAS __attribute__((address_space(3)))
#define GAS __attribute__((address_space(1)))
typedef unsigned short bf16_t;
typedef short bf16x8 __attribute__((ext_vector_type(8)));
typedef float f32x4 __attribute__((ext_vector_type(4)));
typedef float f32x2 __attribute__((ext_vector_type(2)));
typedef float f32x16 __attribute__((ext_vector_type(16)));
typedef unsigned u32x4 __attribute__((ext_vector_type(4)));
typedef unsigned u32x2 __attribute__((ext_vector_type(2)));
typedef __bf16 bf16x2v __attribute__((ext_vector_type(2)));

constexpr int NWAVES = 8;
constexpr int BATCH = 32, SEQ = 2048, DM = 1024, DEPTH = 4, MROWS = BATCH * SEQ;
constexpr int NIN = 2304, INCOLS = 2244, DFF = 2816, NGU = 2 * DFF, NVS = 7;
constexpr float EPS = 1e-6f, LOG2E = 1.4426950408889634f, C2 = 0.18033688011112042f;
constexpr int NSTEPS = 1 + 7 * DEPTH;
#ifndef PHMASK
#define PHMASK 0xffff
#endif
#define PH(i) ((PHMASK >> (i)) & 1)
#ifndef DSA_S
#define DSA_S 15
#endif

constexpr size_t MiB = 1u << 20;
constexpr size_t WS_CTL = 0, CTL_BYTES = MiB;
constexpr size_t WS_ROPE = 1 * MiB;
constexpr size_t WS_MOD = 2 * MiB;
constexpr size_t WS_WI = 5 * MiB;
constexpr size_t WS_W = 8 * MiB, W_LAYER = 23 * MiB;
constexpr size_t W_IN = 0, W_O = 4608 * 1024, W_GU = W_O + 2 * MiB, W_D = W_GU + 11 * MiB;
constexpr size_t WS_H = 104 * MiB;
constexpr size_t WS_ACT = 232 * MiB;
constexpr size_t WS_P = WS_ACT;
constexpr size_t WS_VT = WS_ACT + 288 * MiB;
constexpr size_t WS_END = 584 * MiB;
static_assert(W_D + (size_t)DM * DFF * 2 <= W_LAYER && WS_W + DEPTH * W_LAYER <= WS_H && WS_VT + (size_t)BATCH * NVS * 64 * SEQ * 2 <= WS_END, "ws map");
static_assert((size_t)MROWS * NIN * 2 == 288 * MiB && (size_t)MROWS * DFF * 2 == 352 * MiB, "ws map 2");

constexpr int CW_BAR = 4096, CW_QUEUE = 8192;

constexpr int SC_STRIDE = 2052;
constexpr int LDS_SC = 0;
constexpr int LDS_MASK = 131328, MASK_STRIDE = 66;
constexpr int LDS_LSUM = LDS_MASK + 16 * MASK_STRIDE * 4;
constexpr int LDS_SSUM = LDS_LSUM + 2048;
constexpr int LDS_MISC = LDS_SSUM + 2048;
constexpr int LDS_BYTES = 147456;
static_assert(LDS_MISC + 64 <= LDS_BYTES && 16 * SC_STRIDE * 4 == LDS_MASK && 8 * 64 * 64 * 4 <= LDS_MASK && (LDS_MISC % 16) == 0, "lds map");

#define LDS_WAIT() asm volatile("s_waitcnt lgkmcnt(0)" ::: "memory")
__device__ __forceinline__ unsigned cvtpk(float lo, float hi) { f32x2 v = {lo, hi}; bf16x2v b = __builtin_convertvector(v, bf16x2v); return __builtin_bit_cast(unsigned, b); }
__device__ __forceinline__ bf16x8 ldg16(const bf16_t* p) { return *(const GAS bf16x8*)p; }
__device__ __forceinline__ float ex2(float x) { return __builtin_amdgcn_exp2f(x); }
__device__ __forceinline__ float lg2(float x) { return __builtin_amdgcn_logf(x); }
__device__ __forceinline__ int crow(int i, int h) { return (i & 3) + 8 * (i >> 2) + 4 * h; }
#define MFMA32(a, b, c) __builtin_amdgcn_mfma_f32_32x32x16_bf16((a), (b), (c), 0, 0, 0)
#define MFMA16(a, b, c) __builtin_amdgcn_mfma_f32_16x16x32_bf16((a), (b), (c), 0, 0, 0)
__device__ __forceinline__ bf16x8 pack8(const f32x16& x, int s) {
    u32x4 p; p.x = cvtpk(x[8 * s], x[8 * s + 1]); p.y = cvtpk(x[8 * s + 2], x[8 * s + 3]); p.z = cvtpk(x[8 * s + 4], x[8 * s + 5]); p.w = cvtpk(x[8 * s + 6], x[8 * s + 7]);
    return __builtin_bit_cast(bf16x8, p);
}
__device__ __forceinline__ f32x16 zero16() { f32x16 z; for (int i = 0; i < 16; ++i) z[i] = 0.f; return z; }
__device__ __forceinline__ float wave_max(float v) {
#pragma unroll
    for (int o = 1; o < 64; o <<= 1) v = fmaxf(v, __shfl_xor(v, o));
    return v;
}
__device__ __forceinline__ float wave_sum(float v) {
#pragma unroll
    for (int o = 1; o < 64; o <<= 1) v += __shfl_xor(v, o);
    return v;
}

__device__ __forceinline__ int slot_col(int s) {
    if (s < 4) return 64 * s;
    if (s < 8) return 384 + 64 * (s - 4);
    if (s == 8) return 256;
    if (s == 9) return 320;
    if (s == 10) return 640;
    if (s == 11) return 704;
    if (s < 16) return 708 + 64 * (s - 12);
    if (s < 20) return 964 + 64 * (s - 16);
    if (s < 24) return 1220 + 64 * (s - 20);
    if (s < 32) return 1476 + 64 * (s - 24);
    if (s < 34) return 1988 + 64 * (s - 32);
    return 2116 + 64 * (s - 34);
}

namespace pg8 {
struct EpiInProj {
    static constexpr bool PERM = true, AFTER_DRAIN = false;
    bf16_t* P; bf16_t* VT; float* WI; const float* cs; const float* sn; const float* qn_a; const float* kn_a; const float* qn_c; const float* kn_c;
    __device__ __forceinline__ void operator()(const f32x4 (&acc)[2][2][4][2], const Unit& u, int wr, int wc, int fr, int fq) const {
        const int slot = u.pn * 4 + wc;
        int mode = 0; const float* gain = nullptr; float osc = 1.f; int vslot = 0;
        if (slot < 4) { mode = 2; gain = qn_a; osc = C2; }
        else if (slot < 8) { mode = 1; }
        else if (slot == 8) { mode = 2; gain = kn_a; }
        else if (slot == 9) { mode = 3; vslot = 0; }
        else if (slot == 10) { mode = 1; }
        else if (slot == 11) { mode = 4; }
        else if (slot < 16) { mode = 0; osc = C2; }
        else if (slot < 20) { mode = 0; }
        else if (slot < 24) { mode = 3; vslot = 1 + (slot - 20); }
        else if (slot < 32) { mode = 2; gain = qn_c; osc = C2; }
        else if (slot < 34) { mode = 2; gain = kn_c; }
        else { mode = 3; vslot = 5 + (slot - 34); }
        const int rowt = u.pm * BM + wr * 64 + fr;
        if (mode == 3) {
            const int b = rowt / SEQ; const int tt = rowt % SEQ;
            const int pfr = (fr & 3) | ((fr & 4) << 1) | ((fr & 8) >> 1);
            bf16_t* vb = VT + ((size_t)(b * NVS + vslot) * 64) * SEQ;
#pragma unroll
            for (int ai = 0; ai < 2; ++ai)
#pragma unroll
                for (int m = 0; m < 4; ++m) { const unsigned voff = (unsigned)(8 * fq * SEQ + (((tt + ai * HALF + m * 16) & ~15) + pfr));
#pragma unroll
                    for (int bj = 0; bj < 2; ++bj)
#pragma unroll
                        for (int n = 0; n < 2; ++n)
#pragma unroll
                            for (int e = 0; e < 4; ++e) { bf16_t* sb = vb + (32 * bj + 4 * n + e) * SEQ;
                                sb[voff] = (bf16_t)(cvtpk(acc[ai][bj][m][n][e], 0.f) & 0xffffu); }
                    asm volatile("" ::: "memory"); }
            return;
        }
        if (mode == 4) {
            if (fq == 0) {
#pragma unroll
                for (int ai = 0; ai < 2; ++ai)
#pragma unroll
                    for (int m = 0; m < 4; ++m) *(f32x4*)(WI + (size_t)(rowt + ai * HALF + m * 16) * 4) = acc[ai][0][m][0];
            }
            return;
        }
        f32x4 g1[2], g2[2];
        if (mode == 2) {
#pragma unroll
            for (int n = 0; n < 2; ++n) { g1[n] = *(const f32x4*)(gain + 8 * fq + 4 * n); g2[n] = *(const f32x4*)(gain + 32 + 8 * fq + 4 * n); }
        }
#pragma unroll
        for (int ai = 0; ai < 2; ++ai)
#pragma unroll
            for (int m = 0; m < 4; ++m) {
                const int row = rowt + ai * HALF + m * 16;
                f32x4 v1[2] = {acc[ai][0][m][0], acc[ai][0][m][1]}, v2[2] = {acc[ai][1][m][0], acc[ai][1][m][1]};
                if (mode == 2) {
                    float ss = 0.f;
#pragma unroll
                    for (int n = 0; n < 2; ++n)
#pragma unroll
                        for (int e = 0; e < 4; ++e) ss += v1[n][e] * v1[n][e] + v2[n][e] * v2[n][e];
                    ss += __shfl_xor(ss, 16); ss += __shfl_xor(ss, 32);
                    const float ri = __builtin_amdgcn_rsqf(ss * (1.f / 64.f) + EPS);
#pragma unroll
                    for (int n = 0; n < 2; ++n) { v1[n] = (v1[n] * ri) * g1[n]; v2[n] = (v2[n] * ri) * g2[n]; }
                }
                if (mode >= 1) {
                    const int t = row % SEQ;
#pragma unroll
                    for (int n = 0; n < 2; ++n) {
                        const f32x4 c = *(const f32x4*)(cs + t * 32 + 8 * fq + 4 * n), s = *(const f32x4*)(sn + t * 32 + 8 * fq + 4 * n);
                        const f32x4 a = v1[n], b = v2[n];
                        v1[n] = a * c - b * s; v2[n] = b * c + a * s;
                    }
                }
                u32x4 w1, w2;
                w1.x = cvtpk(v1[0][0] * osc, v1[0][1] * osc); w1.y = cvtpk(v1[0][2] * osc, v1[0][3] * osc); w1.z = cvtpk(v1[1][0] * osc, v1[1][1] * osc); w1.w = cvtpk(v1[1][2] * osc, v1[1][3] * osc);
                w2.x = cvtpk(v2[0][0] * osc, v2[0][1] * osc); w2.y = cvtpk(v2[0][2] * osc, v2[0][3] * osc); w2.z = cvtpk(v2[1][0] * osc, v2[1][1] * osc); w2.w = cvtpk(v2[1][2] * osc, v2[1][3] * osc);
                bf16_t* op = P + (size_t)row * NIN + slot * 64 + 8 * fq;
                *(u32x4*)op = w1; *(u32x4*)(op + 32) = w2;
                asm volatile("" ::: "memory");
            }
    }
};
struct EpiResid {
    static constexpr bool PERM = false, AFTER_DRAIN = false;
    const float* base; float* out; const float* gate;
    __device__ __forceinline__ void operator()(const f32x4 (&acc)[2][2][4][2], const Unit& u, int wr, int wc, int fr, int fq) const {
        const int row0 = u.pm * BM + wr * 64 + fr, col0 = u.pn * BM + wc * 32 + 4 * fq;
        const float* gp = gate + (size_t)((u.pm * BM) / SEQ) * 6144 + col0;
        f32x4 gv[2][2];
#pragma unroll
        for (int bj = 0; bj < 2; ++bj)
#pragma unroll
            for (int n = 0; n < 2; ++n) gv[bj][n] = *(const f32x4*)(gp + bj * HALF + n * 16);
#pragma unroll
        for (int ai = 0; ai < 2; ++ai)
#pragma unroll
            for (int m = 0; m < 4; ++m) { const size_t off = (size_t)(row0 + ai * HALF + m * 16) * DM + col0;
#pragma unroll
                for (int bj = 0; bj < 2; ++bj)
#pragma unroll
                    for (int n = 0; n < 2; ++n) { const f32x4 bs = *(const f32x4*)(base + off + bj * HALF + n * 16);
                        *(f32x4*)(out + off + bj * HALF + n * 16) = bs + gv[bj][n] * acc[ai][bj][m][n]; } }
    }
};
struct EpiSwiGLU {
    static constexpr bool PERM = true, AFTER_DRAIN = false;
    bf16_t* ACT;
    __device__ __forceinline__ void operator()(const f32x4 (&acc)[2][2][4][2], const Unit& u, int wr, int wc, int fr, int fq) const {
        const int row0 = u.pm * BM + wr * 64 + fr, col0 = u.pn * HALF + wc * 32 + 8 * fq;
#pragma unroll
        for (int ai = 0; ai < 2; ++ai)
#pragma unroll
            for (int m = 0; m < 4; ++m) {
                float r[8];
#pragma unroll
                for (int n = 0; n < 2; ++n)
#pragma unroll
                    for (int e = 0; e < 4; ++e) { const float g = acc[ai][0][m][n][e], up = acc[ai][1][m][n][e];
                        r[4 * n + e] = g * __builtin_amdgcn_rcpf(1.f + ex2(-g * LOG2E)) * up; }
                u32x4 w; w.x = cvtpk(r[0], r[1]); w.y = cvtpk(r[2], r[3]); w.z = cvtpk(r[4], r[5]); w.w = cvtpk(r[6], r[7]);
                *(u32x4*)(ACT + (size_t)(row0 + ai * HALF + m * 16) * DFF + col0) = w;
            }
    }
};
}

__device__ __forceinline__ void tr_item(const float* W, int ldw, int K, bf16_t* WT, int k0, int drow0, int sc, LAS float* scr, int lane) {
#pragma unroll 8
    for (int i = 0; i < 32; ++i) { const int kk = 2 * i + (lane >> 5); float v = 0.f; if (sc >= 0) v = W[(size_t)(k0 + kk) * ldw + sc]; scr[kk * 33 + (lane & 31)] = v; }
    LDS_WAIT(); asm volatile("" ::: "memory");
    const int c = lane & 7;
#pragma unroll
    for (int j = 0; j < 4; ++j) { const int n = (lane >> 3) + 8 * j; const LAS float* s = scr + (8 * c) * 33 + n;
        u32x4 o; o.x = cvtpk(s[0 * 33], s[1 * 33]); o.y = cvtpk(s[2 * 33], s[3 * 33]); o.z = cvtpk(s[4 * 33], s[5 * 33]); o.w = cvtpk(s[6 * 33], s[7 * 33]);
        *(GAS u32x4*)(WT + (size_t)(drow0 + n) * K + k0 + 8 * c) = o; }
    LDS_WAIT(); asm volatile("" ::: "memory");
}

struct Args { const float* in[17]; float* out; unsigned char* ws; int lo, hi; };

__device__ __forceinline__ void prologue(const Args& a, LAS unsigned char* lds, int tid, int lane, int wave, int G) {
    unsigned char* ws = a.ws;
    const float* w_in = a.in[6]; const float* w_o = a.in[13]; const float* w_gate = a.in[14]; const float* w_up = a.in[15]; const float* w_down = a.in[16];
    LAS float* scr = (LAS float*)(lds + wave * 16384);
    const int gw = blockIdx.x * NWAVES + wave, NGW = G * NWAVES;
    constexpr int I_IN = 16 * 72, I_O = 16 * 32, I_GU = 16 * 176, I_D = 44 * 32, I_L = I_IN + I_O + I_GU + I_D;
    for (int it = gw; it < DEPTH * I_L; it += NGW) {
        const int l = it / I_L; int r = it % I_L;
        bf16_t* wl = (bf16_t*)(ws + WS_W + (size_t)l * W_LAYER);
        if (r < I_IN) {
            const int kb = r / 72, nb = r % 72, np = 32 * nb + (lane & 31), p = np & 255;
            const int slot = (np >> 8) * 4 + ((p & 127) >> 5), dim = 32 * (p >> 7) + (p & 31);
            int sc = slot_col(slot) + dim; if (slot == 11 && dim >= 4) sc = -1;
            tr_item(w_in + (size_t)l * DM * INCOLS, INCOLS, DM, wl + W_IN / 2, 64 * kb, 32 * nb, sc, scr, lane); continue; }
        r -= I_IN;
        if (r < I_O) { const int kb = r / 32, nb = r % 32;
            tr_item(w_o + (size_t)l * DM * DM, DM, DM, wl + W_O / 2, 64 * kb, 32 * nb, 32 * nb + (lane & 31), scr, lane); continue; }
        r -= I_O;
        if (r < I_GU) { const int kb = r / 176, nb = r % 176, d0 = 32 * nb, p0 = d0 & 255;
            const float* src = (p0 < 128 ? w_gate : w_up) + (size_t)l * DM * DFF;
            tr_item(src, DFF, DM, wl + W_GU / 2, 64 * kb, d0, (d0 >> 8) * 128 + (p0 & 127) + (lane & 31), scr, lane); continue; }
        r -= I_GU;
        { const int kb = r / 32, nb = r % 32;
            tr_item(w_down + (size_t)l * DFF * DM, DM, DFF, wl + W_D / 2, 64 * kb, 32 * nb, 32 * nb + (lane & 31), scr, lane); }
    }
    {
        float* cs = (float*)(ws + WS_ROPE); float* sn = cs + SEQ * 32;
        for (int idx = blockIdx.x * 512 + tid; idx < SEQ * 32; idx += G * 512) {
            const int t = idx >> 5, i = idx & 31;
            double inv = 1.0; for (int k = 0; k < i; ++k) inv *= 0.7498942093324559;
            const float ang = (float)t * (float)inv;
            double rv = (double)ang * 0.15915494309189535; rv -= __builtin_floor(rv);
            const float fr = (float)rv;
            cs[idx] = __builtin_amdgcn_cosf(fr); sn[idx] = __builtin_amdgcn_sinf(fr);
        }
    }
    __syncthreads();
    {
        const float* c = a.in[1]; const float* w_mod = a.in[4]; const float* b_mod = a.in[5];
        float* mod = (float*)(ws + WS_MOD);
        LAS float* cact = (LAS float*)lds;
        for (int idx = tid; idx < BATCH * DM; idx += 512) { const int b = idx >> 10, k = idx & 1023; const float v = c[idx]; cact[k * 32 + b] = v * __builtin_amdgcn_rcpf(1.f + ex2(-v * LOG2E)); }
        __syncthreads();
        for (int unit = blockIdx.x; unit < DEPTH * 6144 / 64; unit += G) {
            const int col = unit * 64 + lane, l = col / 6144, j = col % 6144;
            const float* wp = w_mod + (size_t)l * DM * 6144 + j;
            float acc0 = 0.f, acc1 = 0.f, acc2 = 0.f, acc3 = 0.f;
#pragma unroll 8
            for (int k = 0; k < DM; ++k) { const float wv = wp[(size_t)k * 6144]; const f32x4 c4 = *(const LAS f32x4*)(cact + k * 32 + 4 * wave);
                acc0 += c4[0] * wv; acc1 += c4[1] * wv; acc2 += c4[2] * wv; acc3 += c4[3] * wv; }
            const float bm = b_mod[l * 6144 + j];
            float* mo = mod + ((size_t)l * BATCH + 4 * wave) * 6144 + j;
            mo[0] = acc0 + bm; mo[6144] = acc1 + bm; mo[2 * 6144] = acc2 + bm; mo[3 * 6144] = acc3 + bm;
        }
    }
    __syncthreads();
}

__device__ __forceinline__ void norm_phase(const float* x, const float* ln, const float* modl  , int sh_off, bf16_t* H, int lane, int gw, int NGW) {
    for (int m = gw; m < MROWS; m += NGW) {
        const int b = m / SEQ;
        const GAS f32x4* xr = (const GAS f32x4*)(x + (size_t)m * DM) + lane;
        f32x4 v[4]; float s = 0.f;
#pragma unroll
        for (int j = 0; j < 4; ++j) { v[j] = xr[64 * j]; s += (v[j].x * v[j].x + v[j].y * v[j].y) + (v[j].z * v[j].z + v[j].w * v[j].w); }
        const float ri = __builtin_amdgcn_rsqf(wave_sum(s) * (1.f / DM) + EPS);
        const float* mb = modl + (size_t)b * 6144 + sh_off;
        GAS u32x2* o8 = (GAS u32x2*)(H + (size_t)m * DM) + lane;
#pragma unroll
        for (int j = 0; j < 4; ++j) {
            const f32x4 g = *((const GAS f32x4*)ln + lane + 64 * j), shv = *((const GAS f32x4*)mb + lane + 64 * j), scv = *((const GAS f32x4*)(mb + DM) + lane + 64 * j);
            const f32x4 y = ((v[j] * ri) * g) * (scv + 1.f) + shv;
            u32x2 w; w.x = cvtpk(y.x, y.y); w.y = cvtpk(y.z, y.w); o8[64 * j] = w;
        }
    }
}

__device__ __forceinline__ void store_head(const f32x16& o0, const f32x16& o1, float inv, const float* gout, bf16_t* orow, int h) {
    float ss = 0.f;
#pragma unroll
    for (int i = 0; i < 16; ++i) { const float a = o0[i] * inv, b = o1[i] * inv; ss += a * a + b * b; }
    ss += __shfl_xor(ss, 32);
    const float rn = __builtin_amdgcn_rsqf(ss * (1.f / 64.f) + EPS) * inv;
#pragma unroll
    for (int g = 0; g < 4; ++g) {
        const int d0 = 8 * g + 4 * h;
        const f32x4 ga = *(const f32x4*)(gout + d0), gb = *(const f32x4*)(gout + 32 + d0);
        u32x2 wa, wb;
        wa.x = cvtpk(o0[4 * g] * rn * ga[0], o0[4 * g + 1] * rn * ga[1]); wa.y = cvtpk(o0[4 * g + 2] * rn * ga[2], o0[4 * g + 3] * rn * ga[3]);
        wb.x = cvtpk(o1[4 * g] * rn * gb[0], o1[4 * g + 1] * rn * gb[1]); wb.y = cvtpk(o1[4 * g + 2] * rn * gb[2], o1[4 * g + 3] * rn * gb[3]);
        *(GAS u32x2*)(orow + d0) = wa; *(GAS u32x2*)(orow + 32 + d0) = wb;
    }
}

__device__ __forceinline__ void swa_unit(int b, int hc, int qt, const bf16_t* P, const bf16_t* VT, bf16_t* O, float M2, float sink2, const float* gout, int lane) {
    const int r = lane & 31, h = lane >> 5, t0 = qt * 32, kv = hc >> 2;
    const size_t rowbase = (size_t)b * SEQ;
    bf16x8 qf[4];
    { const bf16_t* qp = P + (rowbase + t0 + r) * NIN + (24 + hc) * 64 + 8 * h;
#pragma unroll
      for (int ks = 0; ks < 4; ++ks) qf[ks] = ldg16(qp + 16 * ks); }
    const bf16_t* kbase = P + rowbase * NIN + (32 + kv) * 64 + 8 * h + (size_t)r * NIN;
    const bf16_t* vbase = VT + ((size_t)(b * NVS + 5 + kv) * 64 + r) * SEQ + 8 * h;
    f32x16 o0 = zero16(), o1 = zero16(); float lsum = 0.f;
    const int t = t0 + r;
    const int kt_lo = qt - 4 < 0 ? 0 : qt - 4;
    for (int kt = kt_lo; kt <= qt; ++kt) {
        bf16x8 kf[4], vf[2][2];
        const bf16_t* kp = kbase + (size_t)(kt * 32) * NIN;
#pragma unroll
        for (int ks = 0; ks < 4; ++ks) kf[ks] = ldg16(kp + 16 * ks);
#pragma unroll
        for (int dt = 0; dt < 2; ++dt)
#pragma unroll
            for (int s = 0; s < 2; ++s) vf[dt][s] = ldg16(vbase + (size_t)(dt * 32) * SEQ + kt * 32 + 16 * s);
        f32x16 sc = zero16();
#pragma unroll
        for (int ks = 0; ks < 4; ++ks) sc = MFMA32(kf[ks], qf[ks], sc);
#pragma unroll
        for (int i = 0; i < 16; ++i) { const int key = kt * 32 + crow(i, h); const bool valid = (unsigned)(t - key) < 128u;
            const float p = valid ? ex2(sc[i] - M2) : 0.f; sc[i] = p; lsum += p; }
        const bf16x8 p0 = pack8(sc, 0), p1 = pack8(sc, 1);
        o0 = MFMA32(vf[0][0], p0, o0); o0 = MFMA32(vf[0][1], p1, o0);
        o1 = MFMA32(vf[1][0], p0, o1); o1 = MFMA32(vf[1][1], p1, o1);
    }
    lsum += __shfl_xor(lsum, 32); lsum += ex2(sink2 - M2);
    store_head(o0, o1, 1.f / lsum, gout, O + (rowbase + t0 + r) * DM + (8 + hc) * 64, h);
}

__device__ __forceinline__ void sb_unit(int b, int hb, int qt, const bf16_t* P, const bf16_t* VT, bf16_t* O, const float* gout, int lane) {
    const int r = lane & 31, h = lane >> 5, t0 = qt * 32;
    const size_t rowbase = (size_t)b * SEQ;
    bf16x8 qf[4];
    { const bf16_t* qp = P + (rowbase + t0 + r) * NIN + (12 + hb) * 64 + 8 * h;
#pragma unroll
      for (int ks = 0; ks < 4; ++ks) qf[ks] = ldg16(qp + 16 * ks); }
    const bf16_t* kbase = P + rowbase * NIN + (16 + hb) * 64 + 8 * h + (size_t)r * NIN;
    const bf16_t* vbase = VT + ((size_t)(b * NVS + 1 + hb) * 64 + r) * SEQ + 8 * h;
    f32x16 o0 = zero16(), o1 = zero16(); float C = 0.f;
    const int t = t0 + r;
    for (int kt = qt; kt >= 0; --kt) {
        bf16x8 kf[4], vf[2][2];
        const bf16_t* kp = kbase + (size_t)(kt * 32) * NIN;
#pragma unroll
        for (int ks = 0; ks < 4; ++ks) kf[ks] = ldg16(kp + 16 * ks);
#pragma unroll
        for (int dt = 0; dt < 2; ++dt)
#pragma unroll
            for (int s = 0; s < 2; ++s) vf[dt][s] = ldg16(vbase + (size_t)(dt * 32) * SEQ + kt * 32 + 16 * s);
        f32x16 z = zero16();
#pragma unroll
        for (int ks = 0; ks < 4; ++ks) z = MFMA32(kf[ks], qf[ks], z);
        float L[16];
#pragma unroll
        for (int i = 0; i < 16; ++i) { const int key = kt * 32 + crow(i, h); const float zz = z[i];
            const float sp = fmaxf(zz, 0.f) + lg2(1.f + ex2(-fabsf(zz)));
            L[i] = (key < t) ? -sp : 0.f; }
        float G4[4], Gp[4], ps[4], aft[4];
#pragma unroll
        for (int g = 0; g < 4; ++g) { G4[g] = (L[4 * g] + L[4 * g + 1]) + (L[4 * g + 2] + L[4 * g + 3]); Gp[g] = __shfl_xor(G4[g], 32); ps[g] = G4[g] + Gp[g]; }
        aft[3] = 0.f; aft[2] = ps[3]; aft[1] = aft[2] + ps[2]; aft[0] = aft[1] + ps[1];
#pragma unroll
        for (int g = 0; g < 4; ++g) {
            const float bg = C + aft[g] + (h == 0 ? Gp[g] : 0.f);
            const float b3 = bg, b2 = b3 + L[4 * g + 3], b1 = b2 + L[4 * g + 2], b0 = b1 + L[4 * g + 1];
            const float bt[4] = {b0, b1, b2, b3};
#pragma unroll
            for (int e = 0; e < 4; ++e) { const int i = 4 * g + e; const int key = kt * 32 + crow(i, h);
                z[i] = (key < t) ? ex2(z[i] + L[i] + bt[e]) : 0.f; }
        }
        C += aft[0] + ps[0];
        const bf16x8 p0 = pack8(z, 0), p1 = pack8(z, 1);
        o0 = MFMA32(vf[0][0], p0, o0); o0 = MFMA32(vf[0][1], p1, o0);
        o1 = MFMA32(vf[1][0], p0, o1); o1 = MFMA32(vf[1][1], p1, o1);
        if (__all(C < -160.f)) break;
    }
    store_head(o0, o1, 1.f, gout, O + (rowbase + t0 + r) * DM + (4 + hb) * 64, h);
}

__device__ __forceinline__ void dsa_phase(const bf16_t* P, const bf16_t* VT, const float* WI, bf16_t* O, const float* gout  , float M2, unsigned* queue,
                                          LAS unsigned char* lds, int tid, int lane, int wave) {
    LAS float* SC = (LAS float*)(lds + LDS_SC);
    LAS unsigned* MASK = (LAS unsigned*)(lds + LDS_MASK);
    LAS float* LSUM = (LAS float*)(lds + LDS_LSUM);
    LAS float* SSUM = (LAS float*)(lds + LDS_SSUM);
    volatile LAS unsigned* QW = (volatile LAS unsigned*)(lds + LDS_MISC);
    for (;;) {
        if (tid == 0) QW[0] = __hip_atomic_fetch_add(queue, 1u, __ATOMIC_RELAXED, __HIP_MEMORY_SCOPE_AGENT);
        __syncthreads();
        const int q = (int)QW[0];
        if (q >= BATCH * 128) break;
        const int tau = 127 - (q >> 5), b = q & 31, t0 = 16 * tau;
        const size_t rowbase = (size_t)b * SEQ;
        if (DSA_S & 1) {
            int lane1 = lane; asm volatile("" : "+v"(lane1));
            const int c = lane1 & 15, g = lane1 >> 4;
            bf16x8 qi[4][2];
            const bf16_t* qp = P + (rowbase + t0 + c) * NIN + 4 * 64 + 8 * g;
#pragma unroll
            for (int hh = 0; hh < 4; ++hh) { qi[hh][0] = ldg16(qp + hh * 64); qi[hh][1] = ldg16(qp + hh * 64 + 32); }
            const f32x4 w = *(const GAS f32x4*)(WI + (rowbase + t0 + c) * 4);
            const bf16_t* kp0 = P + (rowbase + c) * NIN + 10 * 64 + 8 * g;
            for (int kt = wave; kt <= tau; kt += NWAVES) {
                const bf16_t* kp = kp0 + (size_t)(kt * 16) * NIN;
                const bf16x8 k0 = ldg16(kp), k1 = ldg16(kp + 32);
                f32x4 sc = {0.f, 0.f, 0.f, 0.f};
#pragma unroll
                for (int hh = 0; hh < 4; ++hh) { f32x4 a = {0.f, 0.f, 0.f, 0.f}; a = MFMA16(k0, qi[hh][0], a); a = MFMA16(k1, qi[hh][1], a);
#pragma unroll
                    for (int j = 0; j < 4; ++j) sc[j] += w[hh] * fmaxf(a[j], 0.f); }
                *(LAS f32x4*)(SC + c * SC_STRIDE + kt * 16 + 4 * g) = sc;
            }
        }
        __syncthreads();
#pragma unroll 1
        for (int rr = 0; rr < ((DSA_S & 2) ? 2 : 0); ++rr) {
            const int r = 2 * wave + rr, t = t0 + r, n = t + 1;
            unsigned u[32];
#pragma unroll
            for (int j = 0; j < 32; ++j) { const int s = 64 * j + lane; unsigned bb = __float_as_uint(SC[r * SC_STRIDE + s]);
                bb = (bb == 0x80000000u) ? 0u : bb; bb = (bb & 0x80000000u) ? ~bb : (bb | 0x80000000u); u[j] = (s <= t) ? bb : 0u; }
            unsigned T = 0u;
            if (n > 256) {
                const int nsl = (n + 63) >> 6;
                for (int bit = 31; bit >= 0; --bit) {
                    const unsigned cand = T | (1u << bit); int cnt = 0;
#pragma unroll
                    for (int g = 0; g < 8; ++g) if (4 * g < nsl) {
#pragma unroll
                        for (int e = 0; e < 4; ++e) cnt += __builtin_popcountll(__ballot(u[4 * g + e] >= cand)); }
                    if (cnt >= 256) { T = cand; if (cnt == 256) break; }
                }
            }
            unsigned long long mym = 0ull;
            if (n <= 256) {
#pragma unroll
                for (int j = 0; j < 32; ++j) { const unsigned long long m = __ballot(64 * j + lane <= t); mym = (lane == j) ? m : mym; }
            } else {
                int cgt = 0;
#pragma unroll
                for (int j = 0; j < 32; ++j) cgt += __builtin_popcountll(__ballot(u[j] > T));
                int need = 256 - cgt;
#pragma unroll
                for (int j = 0; j < 32; ++j) {
                    const unsigned long long gt = __ballot(u[j] > T); unsigned long long eq = __ballot(u[j] == T);
                    const int ce = __builtin_popcountll(eq); unsigned long long sel;
                    if (need >= ce) { sel = eq; need -= ce; }
                    else { sel = 0ull; while (need > 0) { const unsigned long long low = eq & (0ull - eq); sel |= low; eq ^= low; --need; } }
                    const unsigned long long m = gt | sel; mym = (lane == j) ? m : mym;
                }
            }
            if (lane < 32) { MASK[r * MASK_STRIDE + 2 * lane] = (unsigned)mym; MASK[r * MASK_STRIDE + 2 * lane + 1] = (unsigned)(mym >> 32); }
        }
        __syncthreads();
        if (DSA_S & 4) {
            int lane3 = lane; asm volatile("" : "+v"(lane3));
            const int r = lane3 & 31, h = lane3 >> 5, c = r & 15;
            bf16x8 qf[2][4];
#pragma unroll
            for (int nt = 0; nt < 2; ++nt) { const bf16_t* qp = P + (rowbase + t0 + c) * NIN + (2 * nt + (r >> 4)) * 64 + 8 * h;
#pragma unroll
                for (int ks = 0; ks < 4; ++ks) qf[nt][ks] = ldg16(qp + 16 * ks); }
            f32x16 o[2][2]; o[0][0] = zero16(); o[0][1] = zero16(); o[1][0] = zero16(); o[1][1] = zero16();
            float ls[2] = {0.f, 0.f};
            const bf16_t* kbase = P + (rowbase + r) * NIN + 8 * 64 + 8 * h;
            const bf16_t* vbase = VT + ((size_t)(b * NVS) * 64 + r) * SEQ + 8 * h;
            const int nkt = ((t0 + 15) >> 5) + 1;
            for (int kt = wave; kt < nkt; kt += NWAVES) {
                bf16x8 kf[4], vf[2][2];
                const bf16_t* kp = kbase + (size_t)(kt * 32) * NIN;
#pragma unroll
                for (int ks = 0; ks < 4; ++ks) kf[ks] = ldg16(kp + 16 * ks);
#pragma unroll
                for (int dt = 0; dt < 2; ++dt)
#pragma unroll
                    for (int s = 0; s < 2; ++s) vf[dt][s] = ldg16(vbase + (size_t)(dt * 32) * SEQ + kt * 32 + 16 * s);
                const unsigned mw = MASK[c * MASK_STRIDE + kt];
#pragma unroll
                for (int nt = 0; nt < 2; ++nt) {
                    f32x16 sc = zero16();
#pragma unroll
                    for (int ks = 0; ks < 4; ++ks) sc = MFMA32(kf[ks], qf[nt][ks], sc);
#pragma unroll
                    for (int i = 0; i < 16; ++i) { const float p = ((mw >> crow(i, h)) & 1u) ? ex2(sc[i] - M2) : 0.f; sc[i] = p; ls[nt] += p; }
                    const bf16x8 p0 = pack8(sc, 0), p1 = pack8(sc, 1);
                    o[nt][0] = MFMA32(vf[0][0], p0, o[nt][0]); o[nt][0] = MFMA32(vf[0][1], p1, o[nt][0]);
                    o[nt][1] = MFMA32(vf[1][0], p0, o[nt][1]); o[nt][1] = MFMA32(vf[1][1], p1, o[nt][1]);
                }
            }
#pragma unroll
            for (int nt = 0; nt < 2; ++nt) {
#pragma unroll
                for (int dt = 0; dt < 2; ++dt)
#pragma unroll
                    for (int i = 0; i < 16; ++i) SC[(wave * 64 + 32 * dt + crow(i, h)) * 64 + 32 * nt + r] = o[nt][dt][i];
                float l2 = ls[nt]; l2 += __shfl_xor(l2, 32);
                if (h == 0) LSUM[wave * 64 + 32 * nt + r] = l2;
            }
        }
        __syncthreads();
        if (DSA_S & 8) {
            int n = lane; asm volatile("" : "+v"(n));
            float l = 0.f;
#pragma unroll
            for (int w = 0; w < NWAVES; ++w) l += LSUM[w * 64 + n];
            const float inv = 1.f / l;
            float ov[8]; float ssp = 0.f;
#pragma unroll
            for (int dd = 0; dd < 8; ++dd) { float a = 0.f;
#pragma unroll
                for (int w = 0; w < NWAVES; ++w) a += SC[(w * 64 + 8 * wave + dd) * 64 + n];
                ov[dd] = a * inv; ssp += ov[dd] * ov[dd]; }
            SSUM[wave * 64 + n] = ssp;
            __syncthreads();
            float ss = 0.f;
#pragma unroll
            for (int w = 0; w < NWAVES; ++w) ss += SSUM[w * 64 + n];
            const float rn = __builtin_amdgcn_rsqf(ss * (1.f / 64.f) + EPS);
            const int head = n >> 4, c = n & 15;
            const f32x4 ga = *(const f32x4*)(gout + head * 64 + 8 * wave), gb = *(const f32x4*)(gout + head * 64 + 8 * wave + 4);
            u32x4 wv; wv.x = cvtpk(ov[0] * rn * ga[0], ov[1] * rn * ga[1]); wv.y = cvtpk(ov[2] * rn * ga[2], ov[3] * rn * ga[3]);
            wv.z = cvtpk(ov[4] * rn * gb[0], ov[5] * rn * gb[1]); wv.w = cvtpk(ov[6] * rn * gb[2], ov[7] * rn * gb[3]);
            *(GAS u32x4*)(O + (rowbase + t0 + c) * DM + head * 64 + 8 * wave) = wv;
        }
        __syncthreads();
    }
}

__global__ void __launch_bounds__(NWAVES * 64, 2) fwd(Args args) {
    extern __shared__ __attribute__((aligned(16))) unsigned char lds_raw[];
    LAS unsigned char* lds = (LAS unsigned char*)lds_raw;
    const int wave = __builtin_amdgcn_readfirstlane(threadIdx.x >> 6);
    const int G = gridDim.x;
    const int gw = blockIdx.x * NWAVES + wave, NGW = G * NWAVES;
    unsigned char* ws = args.ws;
    unsigned* ctl = (unsigned*)(ws + WS_CTL);
    volatile LAS unsigned* MISC = (volatile LAS unsigned*)(lds + LDS_MISC);
    if (threadIdx.x < 16) MISC[threadIdx.x] = 0u;
    __syncthreads();
    XcdBarrier bar; bar.bar = ctl + CW_BAR; bar.x = 0; bar.st = nullptr;
    if (!MK_MULTI) bar = xcd_barrier_post(ctl + CW_BAR, MISC + 4);
    const int lo = args.lo, hi = args.hi;
#define IN(k) (lo <= (k) && (k) < hi)
#define SEAM(k) do { if (IN(k) && IN((k) + 1)) xcd_barrier(bar); } while (0)

    bf16_t* H = (bf16_t*)(ws + WS_H); bf16_t* ACT = (bf16_t*)(ws + WS_ACT); bf16_t* P = (bf16_t*)(ws + WS_P); bf16_t* VT = (bf16_t*)(ws + WS_VT);
    float* WI = (float*)(ws + WS_WI); const float* cs = (const float*)(ws + WS_ROPE); const float* sn = cs + SEQ * 32;
    const float* mod = (const float*)(ws + WS_MOD);
    float* xout = args.out;

#define OPQ() int tid = threadIdx.x; asm volatile("" : "+v"(tid)); const int lane = tid & 63; (void)lane
    if (PH(0) && IN(0)) { OPQ(); prologue(args, lds, tid, lane, wave, G); }
    SEAM(0);

    for (int l = 0; l < DEPTH; ++l) {
        const int s0 = 1 + 7 * l;
        const float* xin = (l == 0) ? args.in[0] : (const float*)xout;
        const float* modl = mod + (size_t)l * BATCH * 6144;
        const bf16_t* wl = (const bf16_t*)(ws + WS_W + (size_t)l * W_LAYER);
        if (PH(1) && IN(s0 + 0)) { OPQ(); norm_phase(xin, args.in[2] + l * DM, modl, 0, H, lane, gw, NGW); }
        SEAM(s0 + 0);
        if (PH(2) && IN(s0 + 1)) {
            pg8::Gemm g{H, wl + W_IN / 2, MROWS, NIN, DM}; pg8::StaticOrder S; S.init(MROWS, NIN, G, (int)blockIdx.x);
            pg8::EpiInProj E{P, VT, WI, cs, sn, args.in[7] + l * 64, args.in[8] + l * 64, args.in[9] + l * 64, args.in[10] + l * 64};
            pg8::gemm_phase<pg8::EpiInProj, pg8::StaticOrder, true, true>(lds, g, S, E);
        }
        SEAM(s0 + 1);
        if (PH(3) && IN(s0 + 2)) {
            OPQ();
            const float* gout = args.in[12] + l * 1024;
            const float gqa = wave_max(fabsf(args.in[7][l * 64 + lane])), gka = wave_max(fabsf(args.in[8][l * 64 + lane]));
            const float gqc = wave_max(fabsf(args.in[9][l * 64 + lane])), gkc = wave_max(fabsf(args.in[10][l * 64 + lane]));
            const float M2a = 8.f * gqa * gka * LOG2E, M2c = 8.f * gqc * gkc * LOG2E;
            if (PH(8)) for (int u = gw; u < BATCH * 8 * 64; u += NGW) { const int qt = u & 63, hc = (u >> 6) & 7, b = u >> 9;
                swa_unit(b, hc, qt, P, VT, H, M2c, args.in[11][l * 8 + hc] * LOG2E, gout + (8 + hc) * 64, lane); }
            if (PH(9)) for (int u = gw; u < BATCH * 4 * 64; u += NGW) { const int qt = u & 63, hb = (u >> 6) & 3, b = u >> 8;
                sb_unit(b, hb, qt, P, VT, H, gout + (4 + hb) * 64, lane); }
            if (PH(10)) dsa_phase(P, VT, WI, H, gout, M2a, ctl + CW_QUEUE + 64 * l, lds, tid, lane, wave);
        }
        SEAM(s0 + 2);
        if (PH(4) && IN(s0 + 3)) {
            pg8::Gemm g{H, wl + W_O / 2, MROWS, DM, DM}; pg8::StaticOrder S; S.init(MROWS, DM, G, (int)blockIdx.x);
            pg8::EpiResid E{xin, xout, modl + 2 * DM};
            pg8::gemm_phase<pg8::EpiResid, pg8::StaticOrder, true, true>(lds, g, S, E);
        }
        SEAM(s0 + 3);
        if (PH(5) && IN(s0 + 4)) { OPQ(); norm_phase(xout, args.in[3] + l * DM, modl, 3 * DM, H, lane, gw, NGW); }
        SEAM(s0 + 4);
        if (PH(6) && IN(s0 + 5)) {
            pg8::Gemm g{H, wl + W_GU / 2, MROWS, NGU, DM}; pg8::StaticOrder S; S.init(MROWS, NGU, G, (int)blockIdx.x);
            pg8::EpiSwiGLU E{ACT};
            pg8::gemm_phase<pg8::EpiSwiGLU, pg8::StaticOrder, true, true>(lds, g, S, E);
        }
        SEAM(s0 + 5);
        if (PH(7) && IN(s0 + 6)) {
            pg8::Gemm g{ACT, wl + W_D / 2, MROWS, DM, DFF}; pg8::StaticOrder S; S.init(MROWS, DM, G, (int)blockIdx.x);
            pg8::EpiResid E{xout, xout, modl + 5 * DM};
            pg8::gemm_phase<pg8::EpiResid, pg8::StaticOrder, true, true>(lds, g, S, E);
        }
        SEAM(s0 + 6);
    }
#undef IN
#undef SEAM
}

extern "C" void kernel_launch(void* const* d_in, const int* in_sizes, int n_in, void* d_out, int out_size, void* d_ws, size_t ws_size, hipStream_t stream) {
    static int grid = 0;
    if (grid == 0) {
        if (n_in != 17 || in_sizes[0] != MROWS * DM || out_size != MROWS * DM || ws_size < WS_END) {
            fprintf(stderr, "kernel_launch: unexpected problem (n_in %d, in0 %d, out %d, ws %zu); nothing launched\n", n_in, n_in > 0 ? in_sizes[0] : -1, out_size, ws_size); grid = -1; return; }
        int dev = 0, cus = 0, per_cu = 0;
        if (hipGetDevice(&dev) != hipSuccess || hipDeviceGetAttribute(&cus, hipDeviceAttributeMultiprocessorCount, dev) != hipSuccess) { grid = -1; return; }
        if (hipFuncSetAttribute((const void*)fwd, hipFuncAttributeMaxDynamicSharedMemorySize, LDS_BYTES) != hipSuccess) { fprintf(stderr, "kernel_launch: hipFuncSetAttribute failed\n"); grid = -1; return; }
        if (hipOccupancyMaxActiveBlocksPerMultiprocessor(&per_cu, (const void*)fwd, NWAVES * 64, LDS_BYTES) != hipSuccess || per_cu < 1) {
            fprintf(stderr, "kernel_launch: occupancy query reports %d workgroups per CU\n", per_cu); per_cu = 1; }
        (void)hipGetLastError();
        grid = cus;
    }
    if (grid < 0) return;
    if (hipMemsetAsync((char*)d_ws + WS_CTL, 0, CTL_BYTES, stream) != hipSuccess) return;
    Args a{};
    for (int i = 0; i < 17; ++i) a.in[i] = (const float*)d_in[i];
    a.out = (float*)d_out; a.ws = (unsigned char*)d_ws;
#if MK_MULTI
    for (int s = 0; s < NSTEPS; ++s) { a.lo = s; a.hi = s + 1; hipLaunchKernelGGL(fwd, dim3(grid), dim3(NWAVES * 64), LDS_BYTES, stream, a); }
#else
    a.lo = 0; a.hi = NSTEPS;
    hipLaunchKernelGGL(fwd, dim3(grid), dim3(NWAVES * 64), LDS_BYTES, stream, a);
#endif
}
```

```cpp
#include <hip/hip_runtime.h>
#include <cstdio>
#include <cstdint>

#ifndef MK_MULTI
#define MK_MULTI 0
#endif

#define LAS __attribute__((address_space(3)))
#define GAS __attribute__((address_space(1)))
namespace pg8 {
#define PG8_LAS __attribute__((address_space(3)))
typedef unsigned short bf16_t;
typedef short bf16x8 __attribute__((ext_vector_type(8)));
typedef float f32x4 __attribute__((ext_vector_type(4)));
typedef unsigned u32x4 __attribute__((ext_vector_type(4)));
constexpr int BM = 256, BK = 64, HALF = 128, HTB = HALF * BK * 2  , STAGE_BYTES = 8 * HTB, NXCD = 8, WGM = 8;

__host__ __device__ __forceinline__ int lds_byte(int r, int c) { const int st = (r >> 4) * 2 + (c >> 5), rr = r & 15, cc = c & 31, ob = rr * 64 + cc * 2; return st * 1024 + (ob ^ (((ob >> 9) & 1) << 5)); }
__host__ __device__ __forceinline__ void stage_rc(int b, int& R, int& C) { const int st = b / 1024, sb = b % 1024, swz = sb ^ (((sb >> 9) & 1) << 5); R = (st >> 1) * 16 + swz / 64; C = (st & 1) * 32 + (swz % 64) / 2; }
__host__ __device__ __forceinline__ int perm32(int rho) { const int n = rho >> 4, i = rho & 15; return 8 * (i >> 2) + 4 * n + (i & 3); }

struct Unit { int pm, pn; };
struct Gemm { const bf16_t* A; const bf16_t* Bt; int M, N, K; };

struct StaticOrder {
    int nM, nN, nwg, G, c;
    __host__ __device__ void init(int M, int N, int G_, int c_) { nM = M / BM; nN = N / BM; nwg = nM * nN; G = G_; c = c_; }
    __host__ __device__ bool next(int i, Unit& u) const {
        const long L = (long)i * G + c; if (L >= nwg) return false;
        int wgid = (int)L; { const int q = nwg / NXCD, r = nwg % NXCD, xcd = wgid % NXCD, off = wgid / NXCD; wgid = (xcd < r ? xcd * (q + 1) : r * (q + 1) + (xcd - r) * q) + off; }
        const int nig = WGM * nN, gid = wgid / nig, fm = gid * WGM, gsz = (nM - fm) < WGM ? (nM - fm) : WGM;
        u.pm = fm + ((wgid % nig) % gsz); u.pn = (wgid % nig) / gsz; return true;
    }
    __device__ __forceinline__ void a_ready(const Unit&) const {}
    __device__ __forceinline__ void done(const Unit&) const {}
};
template <class Epi, class Sched, bool ALIGN_EPI = false, bool SP2 = false>
__device__ __forceinline__ void gemm_phase(PG8_LAS unsigned char* lds, const Gemm g, const Sched& S, const Epi& E) {
    int tid_o = threadIdx.x; asm volatile("" : "+v"(tid_o));
    const int tid = tid_o, wid = __builtin_amdgcn_readfirstlane(tid >> 6), lane = tid & 63, wr = wid >> 2, wc = wid & 3, fr = lane & 15, fq = lane >> 4;
    const int K = g.K, nt = K / BK;
    unsigned voffA[2], voffB[2];
#pragma unroll
    for (int i = 0; i < 2; ++i) { int R, C; stage_rc(tid * 16 + i * 8192, R, C); const int Rb = Epi::PERM ? ((R & ~31) + perm32(R & 31)) : R;
        voffA[i] = (unsigned)(R * K + C) * 2u; voffB[i] = (unsigned)(Rb * K + C) * 2u; }
    const size_t kstep = (size_t)(BK * 2);
    const size_t hstep = (size_t)HALF * K * 2;
    const size_t tstep = 2 * hstep;
    const unsigned ldsw = (unsigned)wid * 1024u;
    const int aoff = lds_byte(wr * 64 + fr, fq * 8), boff = lds_byte(wc * 32 + fr, fq * 8);
#define PG8_SA(b, h) (((b) * 2 + (h)) * HTB)
#define PG8_SB(b, h) ((4 + (b) * 2 + (h)) * HTB)
#define PG8_STAGE(bufoff, gbase, voff) do { _Pragma("unroll") for (int _i = 0; _i < 2; ++_i) \
        __builtin_amdgcn_global_load_lds((const unsigned*)((const char*)(gbase) + (voff)[_i]), (PG8_LAS unsigned*)(lds + (bufoff) + ldsw + _i * 8192), 16, 0, 0); } while (0)
#define PG8_LDA(dst, b, h) do { _Pragma("unroll") for (int m = 0; m < 4; ++m) _Pragma("unroll") for (int k = 0; k < 2; ++k) dst[m][k] = *(const PG8_LAS bf16x8*)(lds + PG8_SA(b, h) + aoff + m * 2048 + k * 1024); } while (0)
#define PG8_LDB(dst, b, h) do { _Pragma("unroll") for (int n = 0; n < 2; ++n) _Pragma("unroll") for (int k = 0; k < 2; ++k) dst[n][k] = *(const PG8_LAS bf16x8*)(lds + PG8_SB(b, h) + boff + n * 2048 + k * 1024); } while (0)
#define PG8_MMA(ai, bj, At, Bt) do { __builtin_amdgcn_s_setprio(1); _Pragma("unroll") for (int m = 0; m < 4; ++m) _Pragma("unroll") for (int n = 0; n < 2; ++n) _Pragma("unroll") for (int k = 0; k < 2; ++k) \
        acc[ai][bj][m][n] = __builtin_amdgcn_mfma_f32_16x16x32_bf16(Bt[n][k], At[m][k], acc[ai][bj][m][n], 0, 0, 0); __builtin_amdgcn_s_setprio(0); } while (0)
#define PG8_WAIT_V(n) asm volatile("s_waitcnt vmcnt(" #n ")" ::: "memory")
#define PG8_WAIT_L(n) asm volatile("s_waitcnt lgkmcnt(" #n ")" ::: "memory")
#define PG8_BAR __builtin_amdgcn_s_barrier()
#define PG8_SCHED __builtin_amdgcn_sched_barrier(0)
    Unit cur, nxt; int ui = 0;
    if (!S.next(0, cur)) return;
    f32x4 acc[2][2][4][2];
#pragma unroll
    for (int a = 0; a < 2; ++a)
#pragma unroll
        for (int b = 0; b < 2; ++b)
#pragma unroll
            for (int m = 0; m < 4; ++m)
#pragma unroll
                for (int n = 0; n < 2; ++n) acc[a][b][m][n] = (f32x4){0.f, 0.f, 0.f, 0.f};
    bf16x8 At[4][2], B0[2][2], B1[2][2];
    const char* cA = (const char*)g.A + (size_t)cur.pm * tstep; const char* cB = (const char*)g.Bt + (size_t)cur.pn * tstep;
    S.a_ready(cur);
    if constexpr (SP2) {
        PG8_STAGE(PG8_SB(0, 0), cB, voffB); PG8_STAGE(PG8_SB(0, 1), cB + hstep, voffB); PG8_STAGE(PG8_SA(0, 0), cA, voffA); PG8_STAGE(PG8_SA(0, 1), cA + hstep, voffA);
        if (wr == 1) PG8_BAR;
        PG8_WAIT_V(2); PG8_BAR;
        PG8_STAGE(PG8_SB(1, 0), cB + kstep, voffB); PG8_STAGE(PG8_SA(1, 0), cA + kstep, voffA); PG8_STAGE(PG8_SB(1, 1), cB + hstep + kstep, voffB);
        PG8_WAIT_V(6); PG8_BAR;
    } else {
        PG8_STAGE(PG8_SB(0, 0), cB, voffB); PG8_STAGE(PG8_SA(0, 0), cA, voffA); PG8_STAGE(PG8_SB(0, 1), cB + hstep, voffB); PG8_STAGE(PG8_SA(0, 1), cA + hstep, voffA);
        if (wr == 1) PG8_BAR;
        PG8_WAIT_V(4); PG8_BAR;
        PG8_STAGE(PG8_SB(1, 0), cB + kstep, voffB); PG8_STAGE(PG8_SA(1, 0), cA + kstep, voffA); PG8_STAGE(PG8_SB(1, 1), cB + hstep + kstep, voffB);
        PG8_WAIT_V(6); PG8_BAR;
    }
    for (;;) {
        const bool has_next = S.next(ui + 1, nxt);
        const char* nA = has_next ? (const char*)g.A + (size_t)nxt.pm * tstep : cA; const char* nB = has_next ? (const char*)g.Bt + (size_t)nxt.pn * tstep : cB;
        for (int t = 0; t < nt; t += 2) {
            const bool last = (t == nt - 2);
            const char* a1 = cA + (size_t)(t + 1) * kstep;
            const char* a2 = last ? nA : cA + (size_t)(t + 2) * kstep; const char* b2 = last ? nB : cB + (size_t)(t + 2) * kstep;
            const char* a3 = a2 + kstep; const char* b3 = b2 + kstep;
            if (last && has_next) S.a_ready(nxt);
            if constexpr (SP2) {
            PG8_LDB(B0, 0, 0); PG8_LDB(B1, 0, 1); PG8_SCHED; PG8_LDA(At, 0, 0); PG8_STAGE(PG8_SA(1, 1), a1 + hstep, voffA);
            PG8_WAIT_V(8); PG8_WAIT_L(0); PG8_BAR; PG8_MMA(0, 0, At, B0); PG8_MMA(0, 1, At, B1); PG8_BAR; PG8_SCHED;
            PG8_LDA(At, 0, 1); PG8_STAGE(PG8_SB(0, 0), b2, voffB); PG8_STAGE(PG8_SB(0, 1), b2 + hstep, voffB); PG8_STAGE(PG8_SA(0, 0), a2, voffA);
            PG8_WAIT_V(8); PG8_WAIT_L(0); PG8_BAR; PG8_MMA(1, 0, At, B0); PG8_MMA(1, 1, At, B1); PG8_BAR; PG8_SCHED;
            PG8_LDB(B0, 1, 0); PG8_LDB(B1, 1, 1); PG8_SCHED; PG8_LDA(At, 1, 0); PG8_STAGE(PG8_SA(0, 1), a2 + hstep, voffA);
            PG8_WAIT_V(8); PG8_WAIT_L(0); PG8_BAR; PG8_MMA(0, 0, At, B0); PG8_MMA(0, 1, At, B1); PG8_BAR; PG8_SCHED;
            PG8_LDA(At, 1, 1); PG8_STAGE(PG8_SB(1, 0), b3, voffB); PG8_STAGE(PG8_SB(1, 1), b3 + hstep, voffB); PG8_STAGE(PG8_SA(1, 0), a3, voffA);
            PG8_WAIT_V(8); PG8_WAIT_L(0); PG8_BAR; PG8_MMA(1, 0, At, B0); PG8_MMA(1, 1, At, B1); PG8_BAR; PG8_SCHED;
            } else {
            PG8_LDB(B0, 0, 0); PG8_SCHED; PG8_LDA(At, 0, 0); PG8_STAGE(PG8_SA(1, 1), a1 + hstep, voffA);
            PG8_WAIT_L(8); PG8_BAR; PG8_WAIT_L(0); PG8_MMA(0, 0, At, B0); PG8_BAR; PG8_SCHED;
            PG8_LDB(B1, 0, 1); PG8_STAGE(PG8_SB(0, 0), b2, voffB);
            PG8_BAR; PG8_WAIT_L(0); PG8_MMA(0, 1, At, B1); PG8_BAR;
            PG8_LDA(At, 0, 1); PG8_STAGE(PG8_SA(0, 0), a2, voffA);
            PG8_BAR; PG8_WAIT_L(0); PG8_MMA(1, 0, At, B0); PG8_BAR; PG8_SCHED;
            PG8_STAGE(PG8_SB(0, 1), b2 + hstep, voffB);
            PG8_WAIT_V(6); PG8_BAR; PG8_MMA(1, 1, At, B1); PG8_BAR;
            PG8_LDB(B0, 1, 0); PG8_SCHED; PG8_LDA(At, 1, 0); PG8_STAGE(PG8_SA(0, 1), a2 + hstep, voffA);
            PG8_WAIT_L(8); PG8_BAR; PG8_WAIT_L(0); PG8_MMA(0, 0, At, B0); PG8_BAR; PG8_SCHED;
            PG8_LDB(B1, 1, 1); PG8_STAGE(PG8_SB(1, 0), b3, voffB);
            PG8_BAR; PG8_WAIT_L(0); PG8_MMA(0, 1, At, B1); PG8_BAR;
            PG8_LDA(At, 1, 1); PG8_STAGE(PG8_SA(1, 0), a3, voffA);
            PG8_BAR; PG8_WAIT_L(0); PG8_MMA(1, 0, At, B0); PG8_BAR; PG8_SCHED;
            PG8_STAGE(PG8_SB(1, 1), b3 + hstep, voffB);
            PG8_WAIT_V(6); PG8_BAR; PG8_MMA(1, 1, At, B1); PG8_BAR;
            }
        }
        if constexpr (ALIGN_EPI) { if (wr == 0) PG8_BAR; }
        if constexpr (!Epi::AFTER_DRAIN) { E(acc, cur, wr, wc, fr, fq); S.done(cur); }
        if (!has_next) break;
#pragma unroll
        for (int a = 0; a < 2; ++a)
#pragma unroll
            for (int b = 0; b < 2; ++b)
#pragma unroll
                for (int m = 0; m < 4; ++m)
#pragma unroll
                    for (int n = 0; n < 2; ++n) acc[a][b][m][n] = (f32x4){0.f, 0.f, 0.f, 0.f};
        cur = nxt; cA = nA; cB = nB; ++ui;
        if constexpr (ALIGN_EPI) { if (wr == 1) PG8_BAR; }
    }
    PG8_WAIT_V(0);
    if constexpr (!ALIGN_EPI) { if (wr == 0) PG8_BAR; }
    PG8_BAR;
    if constexpr (Epi::AFTER_DRAIN) { E.fused(acc, cur, wr, wc, fr, fq, lds, wid, lane); S.done(cur); }
#undef PG8_SA
#undef PG8_SB
#undef PG8_STAGE
#undef PG8_LDA
#undef PG8_LDB
#undef PG8_MMA
#undef PG8_WAIT_V
#undef PG8_WAIT_L
#undef PG8_BAR
#undef PG8_SCHED
}
}

#define XB_TMO      128
#define XB_XCNT(j)  (256  + 64 * (j))
#define XB_XSUB(j)  (1280 + 64 * (j))
#define XB_XGEN(j)  (2304 + 64 * (j))
#define XB_TOP      3328
#define XB_TOPGEN   3392
#define XCD_BAR_WORDS 3456
#define XB_SPIN_CAP (1u << 24)

__device__ __forceinline__ unsigned xb_ld(unsigned* p)              { return __hip_atomic_load(p, __ATOMIC_RELAXED, __HIP_MEMORY_SCOPE_AGENT); }
__device__ __forceinline__ unsigned xb_add(unsigned* p, unsigned v) { return __hip_atomic_fetch_add(p, v, __ATOMIC_RELAXED, __HIP_MEMORY_SCOPE_AGENT); }
__device__ __forceinline__ unsigned xb_xcc_id() { return (unsigned)__builtin_amdgcn_s_getreg((3 << 11) | 20) & 0xFu; }
#define XB_SPIN(cond, bar) do { unsigned _sp = 0; while (cond) { __builtin_amdgcn_s_sleep(1); \
    if ((++_sp & 255u) == 0u) { if (xb_ld(&(bar)[XB_TMO])) break; if (_sp > XB_SPIN_CAP) { atomicAdd(&(bar)[XB_TMO], 1u); break; } } } } while (0)

struct XcdBarrier {
    unsigned* bar; unsigned x;
    volatile LAS unsigned* st;
};

__device__ __forceinline__ XcdBarrier xcd_barrier_post(unsigned* bar, volatile LAS unsigned* st) {
    XcdBarrier b; b.bar = bar; b.x = xb_xcc_id(); b.st = st;
    if (threadIdx.x == 0) (void)xb_add(&bar[XB_XCNT(b.x)], 1u);
    return b;
}
__device__ __forceinline__ void xcd_barrier_complete(unsigned* bar, unsigned x, unsigned& nloc, unsigned& nx) {
    const unsigned G = gridDim.x * gridDim.y * gridDim.z;
    unsigned sum, cnt, mine, sp = 0u;
    for (;;) {
        sum = 0u; cnt = 0u; mine = 0u;
#pragma unroll
        for (unsigned j = 0; j < 16; ++j) { const unsigned c = xb_ld(&bar[XB_XCNT(j)]); sum += c; cnt += (c > 0u) ? 1u : 0u; mine = (j == x) ? c : mine; }
        if (sum == G) break;
        __builtin_amdgcn_s_sleep(1);
        if ((++sp & 255u) == 0u) { if (xb_ld(&bar[XB_TMO])) break; if (sp > XB_SPIN_CAP) { atomicAdd(&bar[XB_TMO], 1u); break; } }
    }
    nloc = mine > 0u ? mine : 1u; nx = cnt > 0u ? cnt : 1u;
}

__device__ __forceinline__ void xcd_barrier(const XcdBarrier& b) {
    asm volatile("s_waitcnt vmcnt(0)" ::: "memory");
    __syncthreads();
    if (threadIdx.x == 0) {
        unsigned* bar = b.bar;
        __builtin_amdgcn_s_waitcnt(0);
        unsigned nloc = b.st[0], nx = b.st[1];
        if (nloc == 0u) { xcd_barrier_complete(bar, b.x, nloc, nx); b.st[0] = nloc; b.st[1] = nx; }
        const unsigned old = xb_add(&bar[XB_XSUB(b.x)], 1u);
        const unsigned gen = old / nloc;
        if (old + 1u == (gen + 1u) * nloc) {
            __builtin_amdgcn_fence(__ATOMIC_RELEASE, "agent");
            asm volatile("s_waitcnt vmcnt(0)" ::: "memory");
            const unsigned og = xb_add(&bar[XB_TOP], 1u);
            const unsigned tg = og / nx;
            if (og + 1u == (tg + 1u) * nx) xb_add(&bar[XB_TOPGEN], 1u);
            else XB_SPIN(xb_ld(&bar[XB_TOPGEN]) == tg, bar);
            __builtin_amdgcn_fence(__ATOMIC_ACQUIRE, "agent");
            xb_add(&bar[XB_XGEN(b.x)], 1u);
            asm volatile("s_waitcnt vmcnt(0)" ::: "memory");
        } else {
            XB_SPIN(xb_ld(&bar[XB_XGEN(b.x)]) == gen, bar);
            __builtin_amdgcn_fence(__ATOMIC_ACQUIRE, "agent");
            asm volatile("s_waitcnt vmcnt(0)" ::: "memory");
        }
    }
    __syncthreads();
}

#define LAS __attribute__((address_space(3)))
#define GAS __attribute__((address_space(1)))
typedef unsigned short bf16_t;
typedef short bf16x8 __attribute__((ext_vector_type(8)));
typedef float f32x4 __attribute__((ext_vector_type(4)));
typedef float f32x2 __attribute__((ext_vector_type(2)));
typedef float f32x16 __attribute__((ext_vector_type(16)));
typedef unsigned u32x4 __attribute__((ext_vector_type(4)));
typedef unsigned u32x2 __attribute__((ext_vector_type(2)));
typedef __bf16 bf16x2v __attribute__((ext_vector_type(2)));

constexpr int NWAVES = 8;
constexpr int BATCH = 32, SEQ = 2048, DM = 1024, DEPTH = 4, MROWS = BATCH * SEQ;
constexpr int NIN = 2304, INCOLS = 2244, DFF = 2816, NGU = 2 * DFF, NVS = 7;
constexpr float EPS = 1e-6f, LOG2E = 1.4426950408889634f, C2 = 0.18033688011112042f;
constexpr int NSTEPS = 1 + 7 * DEPTH;
#ifndef PHMASK
#define PHMASK 0xffff
#endif
#define PH(i) ((PHMASK >> (i)) & 1)
#ifndef DSA_S
#define DSA_S 15
#endif
#ifndef REP_ATT
#define REP_ATT 1
#endif
#ifndef REP_SWA
#define REP_SWA 1
#endif
#ifndef REP_SB
#define REP_SB 1
#endif
#ifndef REP_DSA
#define REP_DSA 1
#endif
#ifndef DSA_R1
#define DSA_R1 1
#endif
#ifndef DSA_R2
#define DSA_R2 1
#endif
#ifndef DSA_R3
#define DSA_R3 1
#endif
#ifndef REP_BIS
#define REP_BIS 1
#endif
#ifndef REP_G
#define REP_G 1
#endif
#ifndef REP_N
#define REP_N 1
#endif

constexpr size_t MiB = 1u << 20;
constexpr size_t WS_CTL = 0, CTL_BYTES = MiB;
constexpr size_t WS_ROPE = 1 * MiB;
constexpr size_t WS_MOD = 2 * MiB;
constexpr size_t WS_WI = 5 * MiB;
constexpr size_t WS_W = 8 * MiB, W_LAYER = 23 * MiB;
constexpr size_t W_IN = 0, W_O = 4608 * 1024, W_GU = W_O + 2 * MiB, W_D = W_GU + 11 * MiB;
constexpr size_t WS_H = 104 * MiB;
constexpr size_t WS_ACT = 232 * MiB;
constexpr size_t WS_P = WS_ACT;
constexpr size_t WS_VT = WS_ACT + 288 * MiB;
constexpr size_t WS_END = 584 * MiB;
static_assert(W_D + (size_t)DM * DFF * 2 <= W_LAYER && WS_W + DEPTH * W_LAYER <= WS_H && WS_VT + (size_t)BATCH * NVS * 64 * SEQ * 2 <= WS_END, "ws map");
static_assert((size_t)MROWS * NIN * 2 == 288 * MiB && (size_t)MROWS * DFF * 2 == 352 * MiB, "ws map 2");

constexpr int CW_BAR = 4096, CW_QUEUE = 8192;

constexpr int SC_STRIDE = 2052;
constexpr int LDS_SC = 0;
constexpr int LDS_MASK = 131328, MASK_STRIDE = 66;
constexpr int LDS_LSUM = LDS_MASK + 16 * MASK_STRIDE * 4;
constexpr int LDS_SSUM = LDS_LSUM + 2048;
constexpr int LDS_MISC = LDS_SSUM + 2048;
constexpr int LDS_BYTES = 147456;
static_assert(LDS_MISC + 64 <= LDS_BYTES && 16 * SC_STRIDE * 4 == LDS_MASK && 8 * 64 * 64 * 4 <= LDS_MASK && (LDS_MISC % 16) == 0, "lds map");

#define LDS_WAIT() asm volatile("s_waitcnt lgkmcnt(0)" ::: "memory")
__device__ __forceinline__ unsigned cvtpk(float lo, float hi) { f32x2 v = {lo, hi}; bf16x2v b = __builtin_convertvector(v, bf16x2v); return __builtin_bit_cast(unsigned, b); }
__device__ __forceinline__ bf16x8 ldg16(const bf16_t* p) { return *(const GAS bf16x8*)p; }
__device__ __forceinline__ float ex2(float x) { return __builtin_amdgcn_exp2f(x); }
__device__ __forceinline__ float lg2(float x) { return __builtin_amdgcn_logf(x); }
__device__ __forceinline__ int crow(int i, int h) { return (i & 3) + 8 * (i >> 2) + 4 * h; }
#define MFMA32(a, b, c) __builtin_amdgcn_mfma_f32_32x32x16_bf16((a), (b), (c), 0, 0, 0)
#define MFMA16(a, b, c) __builtin_amdgcn_mfma_f32_16x16x32_bf16((a), (b), (c), 0, 0, 0)
__device__ __forceinline__ bf16x8 pack8(const f32x16& x, int s) {
    u32x4 p; p.x = cvtpk(x[8 * s], x[8 * s + 1]); p.y = cvtpk(x[8 * s + 2], x[8 * s + 3]); p.z = cvtpk(x[8 * s + 4], x[8 * s + 5]); p.w = cvtpk(x[8 * s + 6], x[8 * s + 7]);
    return __builtin_bit_cast(bf16x8, p);
}
__device__ __forceinline__ f32x16 zero16() { f32x16 z; for (int i = 0; i < 16; ++i) z[i] = 0.f; return z; }
__device__ __forceinline__ int wsum_i(int v) {
    v += __builtin_amdgcn_update_dpp(0, v, 0x111, 0xf, 0xf, false);
    v += __builtin_amdgcn_update_dpp(0, v, 0x112, 0xf, 0xf, false);
    v += __builtin_amdgcn_update_dpp(0, v, 0x114, 0xf, 0xf, false);
    v += __builtin_amdgcn_update_dpp(0, v, 0x118, 0xf, 0xf, false);
    v += __builtin_amdgcn_update_dpp(0, v, 0x142, 0xa, 0xf, false);
    v += __builtin_amdgcn_update_dpp(0, v, 0x143, 0xc, 0xf, false);
    return __builtin_amdgcn_readlane(v, 63);
}
__device__ __forceinline__ float wave_max(float v) {
#pragma unroll
    for (int o = 1; o < 64; o <<= 1) v = fmaxf(v, __shfl_xor(v, o));
    return v;
}
__device__ __forceinline__ float wave_sum(float v) {
#pragma unroll
    for (int o = 1; o < 64; o <<= 1) v += __shfl_xor(v, o);
    return v;
}

__device__ __forceinline__ int slot_col(int s) {
    if (s < 4) return 64 * s;
    if (s < 8) return 384 + 64 * (s - 4);
    if (s == 8) return 256;
    if (s == 9) return 320;
    if (s == 10) return 640;
    if (s == 11) return 704;
    if (s < 16) return 708 + 64 * (s - 12);
    if (s < 20) return 964 + 64 * (s - 16);
    if (s < 24) return 1220 + 64 * (s - 20);
    if (s < 32) return 1476 + 64 * (s - 24);
    if (s < 34) return 1988 + 64 * (s - 32);
    return 2116 + 64 * (s - 34);
}

namespace pg8 {
struct EpiInProj {
    static constexpr bool PERM = true, AFTER_DRAIN = false;
    bf16_t* P; bf16_t* VT; float* WI; const float* cs; const float* sn; const float* qn_a; const float* kn_a; const float* qn_c; const float* kn_c;
    __device__ __forceinline__ void operator()(const f32x4 (&acc)[2][2][4][2], const Unit& u, int wr, int wc, int fr, int fq) const {
        const int slot = u.pn * 4 + wc;
        int mode = 0; const float* gain = nullptr; float osc = 1.f; int vslot = 0;
        if (slot < 4) { mode = 2; gain = qn_a; osc = C2; }
        else if (slot < 8) { mode = 1; }
        else if (slot == 8) { mode = 2; gain = kn_a; }
        else if (slot == 9) { mode = 3; vslot = 0; }
        else if (slot == 10) { mode = 1; }
        else if (slot == 11) { mode = 4; }
        else if (slot < 16) { mode = 0; osc = C2; }
        else if (slot < 20) { mode = 0; }
        else if (slot < 24) { mode = 3; vslot = 1 + (slot - 20); }
        else if (slot < 32) { mode = 2; gain = qn_c; osc = C2; }
        else if (slot < 34) { mode = 2; gain = kn_c; }
        else { mode = 3; vslot = 5 + (slot - 34); }
        const int rowt = u.pm * BM + wr * 64 + fr;
        if (mode == 3) {
            const int b = rowt / SEQ; const int tt = rowt % SEQ;
            const int pfr = (fr & 3) | ((fr & 4) << 1) | ((fr & 8) >> 1);
            bf16_t* vb = VT + ((size_t)(b * NVS + vslot) * 64) * SEQ;
#pragma unroll
            for (int ai = 0; ai < 2; ++ai)
#pragma unroll
                for (int m = 0; m < 4; ++m) { const unsigned voff = (unsigned)(8 * fq * SEQ + (((tt + ai * HALF + m * 16) & ~15) + pfr));
#pragma unroll
                    for (int bj = 0; bj < 2; ++bj)
#pragma unroll
                        for (int n = 0; n < 2; ++n)
#pragma unroll
                            for (int e = 0; e < 4; ++e) { bf16_t* sb = vb + (32 * bj + 4 * n + e) * SEQ;
                                sb[voff] = (bf16_t)(cvtpk(acc[ai][bj][m][n][e], 0.f) & 0xffffu); }
                    asm volatile("" ::: "memory"); }
            return;
        }
        if (mode == 4) {
            if (fq == 0) {
#pragma unroll
                for (int ai = 0; ai < 2; ++ai)
#pragma unroll
                    for (int m = 0; m < 4; ++m) *(f32x4*)(WI + (size_t)(rowt + ai * HALF + m * 16) * 4) = acc[ai][0][m][0];
            }
            return;
        }
        f32x4 g1[2], g2[2];
        if (mode == 2) {
#pragma unroll
            for (int n = 0; n < 2; ++n) { g1[n] = *(const f32x4*)(gain + 8 * fq + 4 * n); g2[n] = *(const f32x4*)(gain + 32 + 8 * fq + 4 * n); }
        }
#pragma unroll
        for (int ai = 0; ai < 2; ++ai)
#pragma unroll
            for (int m = 0; m < 4; ++m) {
                const int row = rowt + ai * HALF + m * 16;
                f32x4 v1[2] = {acc[ai][0][m][0], acc[ai][0][m][1]}, v2[2] = {acc[ai][1][m][0], acc[ai][1][m][1]};
                if (mode == 2) {
                    float ss = 0.f;
#pragma unroll
                    for (int n = 0; n < 2; ++n)
#pragma unroll
                        for (int e = 0; e < 4; ++e) ss += v1[n][e] * v1[n][e] + v2[n][e] * v2[n][e];
                    ss += __shfl_xor(ss, 16); ss += __shfl_xor(ss, 32);
                    const float ri = __builtin_amdgcn_rsqf(ss * (1.f / 64.f) + EPS);
#pragma unroll
                    for (int n = 0; n < 2; ++n) { v1[n] = (v1[n] * ri) * g1[n]; v2[n] = (v2[n] * ri) * g2[n]; }
                }
                if (mode >= 1) {
                    const int t = row % SEQ;
#pragma unroll
                    for (int n = 0; n < 2; ++n) {
                        const f32x4 c = *(const f32x4*)(cs + t * 32 + 8 * fq + 4 * n), s = *(const f32x4*)(sn + t * 32 + 8 * fq + 4 * n);
                        const f32x4 a = v1[n], b = v2[n];
                        v1[n] = a * c - b * s; v2[n] = b * c + a * s;
                    }
                }
                u32x4 w1, w2;
                w1.x = cvtpk(v1[0][0] * osc, v1[0][1] * osc); w1.y = cvtpk(v1[0][2] * osc, v1[0][3] * osc); w1.z = cvtpk(v1[1][0] * osc, v1[1][1] * osc); w1.w = cvtpk(v1[1][2] * osc, v1[1][3] * osc);
                w2.x = cvtpk(v2[0][0] * osc, v2[0][1] * osc); w2.y = cvtpk(v2[0][2] * osc, v2[0][3] * osc); w2.z = cvtpk(v2[1][0] * osc, v2[1][1] * osc); w2.w = cvtpk(v2[1][2] * osc, v2[1][3] * osc);
                bf16_t* op = P + (size_t)row * NIN + slot * 64 + 8 * fq;
                *(u32x4*)op = w1; *(u32x4*)(op + 32) = w2;
                asm volatile("" ::: "memory");
            }
    }
};
struct EpiResid {
    static constexpr bool PERM = false, AFTER_DRAIN = false;
    const float* base; float* out; const float* gate;
    __device__ __forceinline__ void operator()(const f32x4 (&acc)[2][2][4][2], const Unit& u, int wr, int wc, int fr, int fq) const {
        const int row0 = u.pm * BM + wr * 64 + fr, col0 = u.pn * BM + wc * 32 + 4 * fq;
        const float* gp = gate + (size_t)((u.pm * BM) / SEQ) * 6144 + col0;
        f32x4 gv[2][2];
#pragma unroll
        for (int bj = 0; bj < 2; ++bj)
#pragma unroll
            for (int n = 0; n < 2; ++n) gv[bj][n] = *(const f32x4*)(gp + bj * HALF + n * 16);
#pragma unroll
        for (int ai = 0; ai < 2; ++ai)
#pragma unroll
            for (int m = 0; m < 4; ++m) { const size_t off = (size_t)(row0 + ai * HALF + m * 16) * DM + col0;
#pragma unroll
                for (int bj = 0; bj < 2; ++bj)
#pragma unroll
                    for (int n = 0; n < 2; ++n) { const f32x4 bs = *(const f32x4*)(base + off + bj * HALF + n * 16);
                        *(f32x4*)(out + off + bj * HALF + n * 16) = bs + gv[bj][n] * acc[ai][bj][m][n]; } }
    }
};
struct EpiSwiGLU {
    static constexpr bool PERM = true, AFTER_DRAIN = false;
    bf16_t* ACT;
    __device__ __forceinline__ void operator()(const f32x4 (&acc)[2][2][4][2], const Unit& u, int wr, int wc, int fr, int fq) const {
        const int row0 = u.pm * BM + wr * 64 + fr, col0 = u.pn * HALF + wc * 32 + 8 * fq;
#pragma unroll
        for (int ai = 0; ai < 2; ++ai)
#pragma unroll
            for (int m = 0; m < 4; ++m) {
                float r[8];
#pragma unroll
                for (int n = 0; n < 2; ++n)
#pragma unroll
                    for (int e = 0; e < 4; ++e) { const float g = acc[ai][0][m][n][e], up = acc[ai][1][m][n][e];
                        r[4 * n + e] = g * __builtin_amdgcn_rcpf(1.f + ex2(-g * LOG2E)) * up; }
                u32x4 w; w.x = cvtpk(r[0], r[1]); w.y = cvtpk(r[2], r[3]); w.z = cvtpk(r[4], r[5]); w.w = cvtpk(r[6], r[7]);
                *(u32x4*)(ACT + (size_t)(row0 + ai * HALF + m * 16) * DFF + col0) = w;
            }
    }
};
}

__device__ __forceinline__ void tr_item(const float* W, int ldw, int K, bf16_t* WT, int k0, int drow0, int sc, LAS float* scr, int lane) {
#pragma unroll 8
    for (int i = 0; i < 32; ++i) { const int kk = 2 * i + (lane >> 5); float v = 0.f; if (sc >= 0) v = W[(size_t)(k0 + kk) * ldw + sc]; scr[kk * 33 + (lane & 31)] = v; }
    LDS_WAIT(); asm volatile("" ::: "memory");
    const int c = lane & 7;
#pragma unroll
    for (int j = 0; j < 4; ++j) { const int n = (lane >> 3) + 8 * j; const LAS float* s = scr + (8 * c) * 33 + n;
        u32x4 o; o.x = cvtpk(s[0 * 33], s[1 * 33]); o.y = cvtpk(s[2 * 33], s[3 * 33]); o.z = cvtpk(s[4 * 33], s[5 * 33]); o.w = cvtpk(s[6 * 33], s[7 * 33]);
        *(GAS u32x4*)(WT + (size_t)(drow0 + n) * K + k0 + 8 * c) = o; }
    LDS_WAIT(); asm volatile("" ::: "memory");
}

struct Args { const float* in[17]; float* out; unsigned char* ws; int lo, hi; };

__device__ __forceinline__ void prologue(const Args& a, LAS unsigned char* lds, int tid, int lane, int wave, int G) {
    unsigned char* ws = a.ws;
    const float* w_in = a.in[6]; const float* w_o = a.in[13]; const float* w_gate = a.in[14]; const float* w_up = a.in[15]; const float* w_down = a.in[16];
    LAS float* scr = (LAS float*)(lds + wave * 16384);
    const int gw = blockIdx.x * NWAVES + wave, NGW = G * NWAVES;
    constexpr int I_IN = 16 * 72, I_O = 16 * 32, I_GU = 16 * 176, I_D = 44 * 32, I_L = I_IN + I_O + I_GU + I_D;
    for (int it = gw; it < DEPTH * I_L; it += NGW) {
        const int l = it / I_L; int r = it % I_L;
        bf16_t* wl = (bf16_t*)(ws + WS_W + (size_t)l * W_LAYER);
        if (r < I_IN) {
            const int kb = r / 72, nb = r % 72, np = 32 * nb + (lane & 31), p = np & 255;
            const int slot = (np >> 8) * 4 + ((p & 127) >> 5), dim = 32 * (p >> 7) + (p & 31);
            int sc = slot_col(slot) + dim; if (slot == 11 && dim >= 4) sc = -1;
            tr_item(w_in + (size_t)l * DM * INCOLS, INCOLS, DM, wl + W_IN / 2, 64 * kb, 32 * nb, sc, scr, lane); continue; }
        r -= I_IN;
        if (r < I_O) { const int kb = r / 32, nb = r % 32;
            tr_item(w_o + (size_t)l * DM * DM, DM, DM, wl + W_O / 2, 64 * kb, 32 * nb, 32 * nb + (lane & 31), scr, lane); continue; }
        r -= I_O;
        if (r < I_GU) { const int kb = r / 176, nb = r % 176, d0 = 32 * nb, p0 = d0 & 255;
            const float* src = (p0 < 128 ? w_gate : w_up) + (size_t)l * DM * DFF;
            tr_item(src, DFF, DM, wl + W_GU / 2, 64 * kb, d0, (d0 >> 8) * 128 + (p0 & 127) + (lane & 31), scr, lane); continue; }
        r -= I_GU;
        { const int kb = r / 32, nb = r % 32;
            tr_item(w_down + (size_t)l * DFF * DM, DM, DFF, wl + W_D / 2, 64 * kb, 32 * nb, 32 * nb + (lane & 31), scr, lane); }
    }
    {
        float* cs = (float*)(ws + WS_ROPE); float* sn = cs + SEQ * 32;
        for (int idx = blockIdx.x * 512 + tid; idx < SEQ * 32; idx += G * 512) {
            const int t = idx >> 5, i = idx & 31;
            double inv = 1.0; for (int k = 0; k < i; ++k) inv *= 0.7498942093324559;
            const float ang = (float)t * (float)inv;
            double rv = (double)ang * 0.15915494309189535; rv -= __builtin_floor(rv);
            const float fr = (float)rv;
            cs[idx] = __builtin_amdgcn_cosf(fr); sn[idx] = __builtin_amdgcn_sinf(fr);
        }
    }
    __syncthreads();
    {
        const float* c = a.in[1]; const float* w_mod = a.in[4]; const float* b_mod = a.in[5];
        float* mod = (float*)(ws + WS_MOD);
        LAS float* cact = (LAS float*)lds;
        for (int idx = tid; idx < BATCH * DM; idx += 512) { const int b = idx >> 10, k = idx & 1023; const float v = c[idx]; cact[k * 32 + b] = v * __builtin_amdgcn_rcpf(1.f + ex2(-v * LOG2E)); }
        __syncthreads();
        for (int unit = blockIdx.x; unit < DEPTH * 6144 / 64; unit += G) {
            const int col = unit * 64 + lane, l = col / 6144, j = col % 6144;
            const float* wp = w_mod + (size_t)l * DM * 6144 + j;
            float acc0 = 0.f, acc1 = 0.f, acc2 = 0.f, acc3 = 0.f;
#pragma unroll 8
            for (int k = 0; k < DM; ++k) { const float wv = wp[(size_t)k * 6144]; const f32x4 c4 = *(const LAS f32x4*)(cact + k * 32 + 4 * wave);
                acc0 += c4[0] * wv; acc1 += c4[1] * wv; acc2 += c4[2] * wv; acc3 += c4[3] * wv; }
            const float bm = b_mod[l * 6144 + j];
            float* mo = mod + ((size_t)l * BATCH + 4 * wave) * 6144 + j;
            mo[0] = acc0 + bm; mo[6144] = acc1 + bm; mo[2 * 6144] = acc2 + bm; mo[3 * 6144] = acc3 + bm;
        }
    }
    __syncthreads();
}

__device__ __forceinline__ void norm_phase(const float* x, const float* ln, const float* modl  , int sh_off, bf16_t* H, int lane, int gw, int NGW) {
    for (int m = gw; m < MROWS; m += NGW) {
        const int b = m / SEQ;
        const GAS f32x4* xr = (const GAS f32x4*)(x + (size_t)m * DM) + lane;
        f32x4 v[4]; float s = 0.f;
#pragma unroll
        for (int j = 0; j < 4; ++j) { v[j] = xr[64 * j]; s += (v[j].x * v[j].x + v[j].y * v[j].y) + (v[j].z * v[j].z + v[j].w * v[j].w); }
        const float ri = __builtin_amdgcn_rsqf(wave_sum(s) * (1.f / DM) + EPS);
        const float* mb = modl + (size_t)b * 6144 + sh_off;
        GAS u32x2* o8 = (GAS u32x2*)(H + (size_t)m * DM) + lane;
#pragma unroll
        for (int j = 0; j < 4; ++j) {
            const f32x4 g = *((const GAS f32x4*)ln + lane + 64 * j), shv = *((const GAS f32x4*)mb + lane + 64 * j), scv = *((const GAS f32x4*)(mb + DM) + lane + 64 * j);
            const f32x4 y = ((v[j] * ri) * g) * (scv + 1.f) + shv;
            u32x2 w; w.x = cvtpk(y.x, y.y); w.y = cvtpk(y.z, y.w); o8[64 * j] = w;
        }
    }
}

__device__ __forceinline__ void store_head(const f32x16& o0, const f32x16& o1, float inv, const float* gout, bf16_t* orow, int h) {
    float ss = 0.f;
#pragma unroll
    for (int i = 0; i < 16; ++i) { const float a = o0[i] * inv, b = o1[i] * inv; ss += a * a + b * b; }
    ss += __shfl_xor(ss, 32);
    const float rn = __builtin_amdgcn_rsqf(ss * (1.f / 64.f) + EPS) * inv;
#pragma unroll
    for (int g = 0; g < 4; ++g) {
        const int d0 = 8 * g + 4 * h;
        const f32x4 ga = *(const f32x4*)(gout + d0), gb = *(const f32x4*)(gout + 32 + d0);
        u32x2 wa, wb;
        wa.x = cvtpk(o0[4 * g] * rn * ga[0], o0[4 * g + 1] * rn * ga[1]); wa.y = cvtpk(o0[4 * g + 2] * rn * ga[2], o0[4 * g + 3] * rn * ga[3]);
        wb.x = cvtpk(o1[4 * g] * rn * gb[0], o1[4 * g + 1] * rn * gb[1]); wb.y = cvtpk(o1[4 * g + 2] * rn * gb[2], o1[4 * g + 3] * rn * gb[3]);
        *(GAS u32x2*)(orow + d0) = wa; *(GAS u32x2*)(orow + 32 + d0) = wb;
    }
}

__device__ __forceinline__ void swa_unit(int b, int hc, int qt, const bf16_t* P, const bf16_t* VT, bf16_t* O, float M2, float sink2, const float* gout, int lane) {
    const int r = lane & 31, h = lane >> 5, t0 = qt * 32, kv = hc >> 2;
    const size_t rowbase = (size_t)b * SEQ;
    bf16x8 qf[4];
    { const bf16_t* qp = P + (rowbase + t0 + r) * NIN + (24 + hc) * 64 + 8 * h;
#pragma unroll
      for (int ks = 0; ks < 4; ++ks) qf[ks] = ldg16(qp + 16 * ks); }
    const bf16_t* kbase = P + rowbase * NIN + (32 + kv) * 64 + 8 * h + (size_t)r * NIN;
    const bf16_t* vbase = VT + ((size_t)(b * NVS + 5 + kv) * 64 + r) * SEQ + 8 * h;
    f32x16 o0 = zero16(), o1 = zero16(); float lsum = 0.f;
    const int t = t0 + r;
    const int kt_lo = qt - 4 < 0 ? 0 : qt - 4;
    bf16x8 kf[4];
#pragma unroll
    for (int ks = 0; ks < 4; ++ks) kf[ks] = ldg16(kbase + (size_t)(kt_lo * 32) * NIN + 16 * ks);
    for (int kt = kt_lo; kt <= qt; ++kt) {
        bf16x8 kn[4], vf[2][2];
#pragma unroll
        for (int dt = 0; dt < 2; ++dt)
#pragma unroll
            for (int s = 0; s < 2; ++s) vf[dt][s] = ldg16(vbase + (size_t)(dt * 32) * SEQ + kt * 32 + 16 * s);
        { const bf16_t* kp = kbase + (size_t)((kt < qt ? kt + 1 : kt) * 32) * NIN;
#pragma unroll
          for (int ks = 0; ks < 4; ++ks) kn[ks] = ldg16(kp + 16 * ks); }
        f32x16 sc = zero16();
#pragma unroll
        for (int ks = 0; ks < 4; ++ks) sc = MFMA32(kf[ks], qf[ks], sc);
#pragma unroll
        for (int i = 0; i < 16; ++i) { const int key = kt * 32 + crow(i, h); const bool valid = (unsigned)(t - key) < 128u;
            const float p = valid ? ex2(sc[i] - M2) : 0.f; sc[i] = p; lsum += p; }
        const bf16x8 p0 = pack8(sc, 0), p1 = pack8(sc, 1);
        o0 = MFMA32(vf[0][0], p0, o0); o0 = MFMA32(vf[0][1], p1, o0);
        o1 = MFMA32(vf[1][0], p0, o1); o1 = MFMA32(vf[1][1], p1, o1);
#pragma unroll
        for (int ks = 0; ks < 4; ++ks) kf[ks] = kn[ks];
    }
    lsum += __shfl_xor(lsum, 32); lsum += ex2(sink2 - M2);
    store_head(o0, o1, 1.f / lsum, gout, O + (rowbase + t0 + r) * DM + (8 + hc) * 64, h);
}

__device__ __forceinline__ void sb_unit(int b, int hb, int qt, const bf16_t* P, const bf16_t* VT, bf16_t* O, const float* gout, int lane) {
    const int r = lane & 31, h = lane >> 5, t0 = qt * 32;
    const size_t rowbase = (size_t)b * SEQ;
    bf16x8 qf[4];
    { const bf16_t* qp = P + (rowbase + t0 + r) * NIN + (12 + hb) * 64 + 8 * h;
#pragma unroll
      for (int ks = 0; ks < 4; ++ks) qf[ks] = ldg16(qp + 16 * ks); }
    const bf16_t* kbase = P + rowbase * NIN + (16 + hb) * 64 + 8 * h + (size_t)r * NIN;
    const bf16_t* vbase = VT + ((size_t)(b * NVS + 1 + hb) * 64 + r) * SEQ + 8 * h;
    f32x16 o0 = zero16(), o1 = zero16(); float C = 0.f;
    const int t = t0 + r;
    bf16x8 kf[4];
#pragma unroll
    for (int ks = 0; ks < 4; ++ks) kf[ks] = ldg16(kbase + (size_t)(qt * 32) * NIN + 16 * ks);
    for (int kt = qt; kt >= 0; --kt) {
        bf16x8 kn[4], vf[2][2];
#pragma unroll
        for (int dt = 0; dt < 2; ++dt)
#pragma unroll
            for (int s = 0; s < 2; ++s) vf[dt][s] = ldg16(vbase + (size_t)(dt * 32) * SEQ + kt * 32 + 16 * s);
        { const bf16_t* kp = kbase + (size_t)((kt > 0 ? kt - 1 : 0) * 32) * NIN;
#pragma unroll
          for (int ks = 0; ks < 4; ++ks) kn[ks] = ldg16(kp + 16 * ks); }
        f32x16 z = zero16();
#pragma unroll
        for (int ks = 0; ks < 4; ++ks) z = MFMA32(kf[ks], qf[ks], z);
        float L[16];
#pragma unroll
        for (int i = 0; i < 16; ++i) { const int key = kt * 32 + crow(i, h); const float zz = z[i];
            const float sp = fmaxf(zz, 0.f) + lg2(1.f + ex2(-fabsf(zz)));
            L[i] = (key < t) ? -sp : 0.f; }
        float G4[4], Gp[4], ps[4], aft[4];
#pragma unroll
        for (int g = 0; g < 4; ++g) { G4[g] = (L[4 * g] + L[4 * g + 1]) + (L[4 * g + 2] + L[4 * g + 3]); Gp[g] = __shfl_xor(G4[g], 32); ps[g] = G4[g] + Gp[g]; }
        aft[3] = 0.f; aft[2] = ps[3]; aft[1] = aft[2] + ps[2]; aft[0] = aft[1] + ps[1];
#pragma unroll
        for (int g = 0; g < 4; ++g) {
            const float bg = C + aft[g] + (h == 0 ? Gp[g] : 0.f);
            const float b3 = bg, b2 = b3 + L[4 * g + 3], b1 = b2 + L[4 * g + 2], b0 = b1 + L[4 * g + 1];
            const float bt[4] = {b0, b1, b2, b3};
#pragma unroll
            for (int e = 0; e < 4; ++e) { const int i = 4 * g + e; const int key = kt * 32 + crow(i, h);
                z[i] = (key < t) ? ex2(z[i] + L[i] + bt[e]) : 0.f; }
        }
        C += aft[0] + ps[0];
        const bf16x8 p0 = pack8(z, 0), p1 = pack8(z, 1);
        o0 = MFMA32(vf[0][0], p0, o0); o0 = MFMA32(vf[0][1], p1, o0);
        o1 = MFMA32(vf[1][0], p0, o1); o1 = MFMA32(vf[1][1], p1, o1);
        if (__all(C < -160.f)) break;
#pragma unroll
        for (int ks = 0; ks < 4; ++ks) kf[ks] = kn[ks];
    }
    store_head(o0, o1, 1.f, gout, O + (rowbase + t0 + r) * DM + (4 + hb) * 64, h);
}

__device__ __forceinline__ void dsa_phase(const bf16_t* P, const bf16_t* VT, const float* WI, bf16_t* O, const float* gout  , float M2, unsigned* queue,
                                          LAS unsigned char* lds, int tid, int lane, int wave) {
    LAS float* SC = (LAS float*)(lds + LDS_SC);
    LAS unsigned* MASK = (LAS unsigned*)(lds + LDS_MASK);
    LAS float* LSUM = (LAS float*)(lds + LDS_LSUM);
    LAS float* SSUM = (LAS float*)(lds + LDS_SSUM);
    volatile LAS unsigned* QW = (volatile LAS unsigned*)(lds + LDS_MISC);
    unsigned hint = 0u;
    for (;;) {
        if (tid == 0) QW[0] = __hip_atomic_fetch_add(queue, 1u, __ATOMIC_RELAXED, __HIP_MEMORY_SCOPE_AGENT);
        __syncthreads();
        const int q = (int)QW[0];
        if (q >= BATCH * 128) break;
        const int tau = 127 - (q >> 5), b = q & 31, t0 = 16 * tau;
        const size_t rowbase = (size_t)b * SEQ;
        if (DSA_S & 1) {
            int lane1 = lane; asm volatile("" : "+v"(lane1));
            const int c = lane1 & 15, g = lane1 >> 4;
            bf16x8 qi[4][2];
            const bf16_t* qp = P + (rowbase + t0 + c) * NIN + 4 * 64 + 8 * g;
#pragma unroll
            for (int hh = 0; hh < 4; ++hh) { qi[hh][0] = ldg16(qp + hh * 64); qi[hh][1] = ldg16(qp + hh * 64 + 32); }
            const f32x4 w = *(const GAS f32x4*)(WI + (rowbase + t0 + c) * 4);
            const bf16_t* kp0 = P + (rowbase + c) * NIN + 10 * 64 + 8 * g;
            _Pragma("unroll 1") for (int r1 = 0; r1 < DSA_R1; ++r1) {
            bf16x8 k0 = qi[0][0], k1 = qi[0][1];
            if (wave <= tau) { const bf16_t* kp = kp0 + (size_t)(wave * 16) * NIN; k0 = ldg16(kp); k1 = ldg16(kp + 32); }
            for (int kt = wave; kt <= tau; kt += NWAVES) {
                bf16x8 n0 = k0, n1 = k1;
                if (kt + NWAVES <= tau) { const bf16_t* kp = kp0 + (size_t)((kt + NWAVES) * 16) * NIN; n0 = ldg16(kp); n1 = ldg16(kp + 32); }
                f32x4 sc = {0.f, 0.f, 0.f, 0.f};
#pragma unroll
                for (int hh = 0; hh < 4; ++hh) { f32x4 a = {0.f, 0.f, 0.f, 0.f}; a = MFMA16(k0, qi[hh][0], a); a = MFMA16(k1, qi[hh][1], a);
#pragma unroll
                    for (int j = 0; j < 4; ++j) sc[j] += w[hh] * fmaxf(a[j], 0.f); }
                { LAS float* sp = SC + c * SC_STRIDE + (16 * (kt & 1) + 4 * g) * 64 + (kt >> 1);
                  sp[0] = sc[0]; sp[64] = sc[1]; sp[128] = sc[2]; sp[192] = sc[3]; }
                k0 = n0; k1 = n1;
            }
            }
        }
        __syncthreads();
#pragma unroll 1
        for (int rr = 0; rr < ((DSA_S & 2) ? 2 * DSA_R2 : 0); ++rr) {
            const int r = 2 * wave + (rr & 1), t = t0 + r, n = t + 1;
            const int cv = n - 32 * lane;
            const unsigned A0 = cv >= 32 ? ~0u : (cv <= 0 ? 0u : ((1u << cv) - 1u));
            unsigned S = A0;
            if (n > 256) {
                unsigned P[32];
#pragma unroll
                for (int i = 0; i < 32; ++i) P[i] = __float_as_uint(SC[r * SC_STRIDE + 64 * i + lane]);
#define TSTAGE(J, MSK) _Pragma("unroll") for (int k_ = 0; k_ < 32; ++k_) if ((k_ & (J)) == 0) { const unsigned lo_ = P[k_], hi_ = P[k_ + (J)]; \
                    P[k_] = (lo_ & (MSK)) | ((hi_ << (J)) & ~(MSK)); P[k_ + (J)] = ((lo_ >> (J)) & (MSK)) | (hi_ & ~(MSK)); }
                TSTAGE(16, 0x0000ffffu) TSTAGE(8, 0x00ff00ffu) TSTAGE(4, 0x0f0f0f0fu) TSTAGE(2, 0x33333333u) TSTAGE(1, 0x55555555u)
#undef TSTAGE
#pragma unroll
                for (int bq = 0; bq < 31; ++bq) P[bq] ^= P[31];
                P[31] = ~P[31];
                unsigned A = A0, G = 0u; int cntG = 0, nA = n; bool done = false;
#pragma unroll
                for (int bq = 31; bq >= 0; --bq) {
                    if (!done) {
                        const unsigned X = A & P[bq];
                        const int c = wsum_i(__builtin_popcount(X));
                        if (cntG + c >= 256) { A = X; nA = c; } else { G |= X; cntG += c; A &= ~P[bq]; nA -= c; }
                        done = (cntG + nA == 256);
                    }
                }
                if (!done) {
                    const int need = 256 - cntG, pc = __builtin_popcount(A);
                    int inc = pc;
                    inc += __builtin_amdgcn_update_dpp(0, inc, 0x111, 0xf, 0xf, false);
                    inc += __builtin_amdgcn_update_dpp(0, inc, 0x112, 0xf, 0xf, false);
                    inc += __builtin_amdgcn_update_dpp(0, inc, 0x114, 0xf, 0xf, false);
                    inc += __builtin_amdgcn_update_dpp(0, inc, 0x118, 0xf, 0xf, false);
                    inc += __builtin_amdgcn_update_dpp(0, inc, 0x142, 0xa, 0xf, false);
                    inc += __builtin_amdgcn_update_dpp(0, inc, 0x143, 0xc, 0xf, false);
                    int take = need - (inc - pc); take = take < 0 ? 0 : (take > pc ? pc : take);
                    while (__builtin_popcount(A) > take) A &= ~(0x80000000u >> __builtin_clz(A));
                }
                S = G | A;
            }
            MASK[r * MASK_STRIDE + lane] = S;
        }
        __syncthreads();
        if (DSA_S & 4) {
            int lane3 = lane; asm volatile("" : "+v"(lane3));
            const int r = lane3 & 31, h = lane3 >> 5, c = r & 15;
            bf16x8 qf[2][4];
#pragma unroll
            for (int nt = 0; nt < 2; ++nt) { const bf16_t* qp = P + (rowbase + t0 + c) * NIN + (2 * nt + (r >> 4)) * 64 + 8 * h;
#pragma unroll
                for (int ks = 0; ks < 4; ++ks) qf[nt][ks] = ldg16(qp + 16 * ks); }
            f32x16 o[2][2]; float ls[2];
            _Pragma("unroll 1") for (int r3 = 0; r3 < DSA_R3; ++r3) {
            o[0][0] = zero16(); o[0][1] = zero16(); o[1][0] = zero16(); o[1][1] = zero16(); ls[0] = 0.f; ls[1] = 0.f;
            const bf16_t* kbase = P + (rowbase + r) * NIN + 8 * 64 + 8 * h;
            const bf16_t* vbase = VT + ((size_t)(b * NVS) * 64 + r) * SEQ + 8 * h;
            const int nkt = ((t0 + 15) >> 5) + 1;
            bf16x8 kf[4];
#pragma unroll
            for (int ks = 0; ks < 4; ++ks) kf[ks] = qf[0][ks];
            if (wave < nkt) {
#pragma unroll
                for (int ks = 0; ks < 4; ++ks) kf[ks] = ldg16(kbase + (size_t)(wave * 32) * NIN + 16 * ks); }
            for (int kt = wave; kt < nkt; kt += NWAVES) {
                bf16x8 kn[4], vf[2][2];
#pragma unroll
                for (int dt = 0; dt < 2; ++dt)
#pragma unroll
                    for (int s = 0; s < 2; ++s) vf[dt][s] = ldg16(vbase + (size_t)(dt * 32) * SEQ + kt * 32 + 16 * s);
                { const int kq = (kt + NWAVES < nkt) ? kt + NWAVES : kt; const bf16_t* kp = kbase + (size_t)(kq * 32) * NIN;
#pragma unroll
                  for (int ks = 0; ks < 4; ++ks) kn[ks] = ldg16(kp + 16 * ks); }
                const unsigned mw = MASK[c * MASK_STRIDE + kt];
#pragma unroll
                for (int nt = 0; nt < 2; ++nt) {
                    f32x16 sc = zero16();
#pragma unroll
                    for (int ks = 0; ks < 4; ++ks) sc = MFMA32(kf[ks], qf[nt][ks], sc);
#pragma unroll
                    for (int i = 0; i < 16; ++i) { const float p = ((mw >> crow(i, h)) & 1u) ? ex2(sc[i] - M2) : 0.f; sc[i] = p; ls[nt] += p; }
                    const bf16x8 p0 = pack8(sc, 0), p1 = pack8(sc, 1);
                    o[nt][0] = MFMA32(vf[0][0], p0, o[nt][0]); o[nt][0] = MFMA32(vf[0][1], p1, o[nt][0]);
                    o[nt][1] = MFMA32(vf[1][0], p0, o[nt][1]); o[nt][1] = MFMA32(vf[1][1], p1, o[nt][1]);
                }
#pragma unroll
                for (int ks = 0; ks < 4; ++ks) kf[ks] = kn[ks];
            }
            }
#pragma unroll
            for (int nt = 0; nt < 2; ++nt) {
#pragma unroll
                for (int dt = 0; dt < 2; ++dt)
#pragma unroll
                    for (int i = 0; i < 16; ++i) SC[(wave * 64 + 32 * dt + crow(i, h)) * 64 + 32 * nt + r] = o[nt][dt][i];
                float l2 = ls[nt]; l2 += __shfl_xor(l2, 32);
                if (h == 0) LSUM[wave * 64 + 32 * nt + r] = l2;
            }
        }
        __syncthreads();
        if (DSA_S & 8) {
            int n = lane; asm volatile("" : "+v"(n));
            float l = 0.f;
#pragma unroll
            for (int w = 0; w < NWAVES; ++w) l += LSUM[w * 64 + n];
            const float inv = 1.f / l;
            float ov[8]; float ssp = 0.f;
#pragma unroll
            for (int dd = 0; dd < 8; ++dd) { float a = 0.f;
#pragma unroll
                for (int w = 0; w < NWAVES; ++w) a += SC[(w * 64 + 8 * wave + dd) * 64 + n];
                ov[dd] = a * inv; ssp += ov[dd] * ov[dd]; }
            SSUM[wave * 64 + n] = ssp;
            __syncthreads();
            float ss = 0.f;
#pragma unroll
            for (int w = 0; w < NWAVES; ++w) ss += SSUM[w * 64 + n];
            const float rn = __builtin_amdgcn_rsqf(ss * (1.f / 64.f) + EPS);
            const int head = n >> 4, c = n & 15;
            const f32x4 ga = *(const f32x4*)(gout + head * 64 + 8 * wave), gb = *(const f32x4*)(gout + head * 64 + 8 * wave + 4);
            u32x4 wv; wv.x = cvtpk(ov[0] * rn * ga[0], ov[1] * rn * ga[1]); wv.y = cvtpk(ov[2] * rn * ga[2], ov[3] * rn * ga[3]);
            wv.z = cvtpk(ov[4] * rn * gb[0], ov[5] * rn * gb[1]); wv.w = cvtpk(ov[6] * rn * gb[2], ov[7] * rn * gb[3]);
            *(GAS u32x4*)(O + (rowbase + t0 + c) * DM + head * 64 + 8 * wave) = wv;
        }
        __syncthreads();
    }
}

__global__ void __launch_bounds__(NWAVES * 64, 2) fwd(Args args) {
    extern __shared__ __attribute__((aligned(16))) unsigned char lds_raw[];
    LAS unsigned char* lds = (LAS unsigned char*)lds_raw;
    const int wave = __builtin_amdgcn_readfirstlane(threadIdx.x >> 6);
    const int G = gridDim.x;
    const int gw = blockIdx.x * NWAVES + wave, NGW = G * NWAVES;
    unsigned char* ws = args.ws;
    unsigned* ctl = (unsigned*)(ws + WS_CTL);
    volatile LAS unsigned* MISC = (volatile LAS unsigned*)(lds + LDS_MISC);
    if (threadIdx.x < 16) MISC[threadIdx.x] = 0u;
    __syncthreads();
    XcdBarrier bar; bar.bar = ctl + CW_BAR; bar.x = 0; bar.st = nullptr;
    if (!MK_MULTI) bar = xcd_barrier_post(ctl + CW_BAR, MISC + 4);
    const int lo = args.lo, hi = args.hi;
#define IN(k) (lo <= (k) && (k) < hi)
#define SEAM(k) do { if (IN(k) && IN((k) + 1)) xcd_barrier(bar); } while (0)

    bf16_t* H = (bf16_t*)(ws + WS_H); bf16_t* ACT = (bf16_t*)(ws + WS_ACT); bf16_t* P = (bf16_t*)(ws + WS_P); bf16_t* VT = (bf16_t*)(ws + WS_VT);
    float* WI = (float*)(ws + WS_WI); const float* cs = (const float*)(ws + WS_ROPE); const float* sn = cs + SEQ * 32;
    const float* mod = (const float*)(ws + WS_MOD);
    float* xout = args.out;

#define OPQ() int tid = threadIdx.x; asm volatile("" : "+v"(tid)); const int lane = tid & 63; (void)lane
    if (PH(0) && IN(0)) { OPQ(); prologue(args, lds, tid, lane, wave, G); }
    SEAM(0);

    for (int l = 0; l < DEPTH; ++l) {
        const int s0 = 1 + 7 * l;
        const float* xin = (l == 0) ? args.in[0] : (const float*)xout;
        const float* modl = mod + (size_t)l * BATCH * 6144;
        const bf16_t* wl = (const bf16_t*)(ws + WS_W + (size_t)l * W_LAYER);
        if (PH(1) && IN(s0 + 0)) _Pragma("unroll 1") for (int rep = 0; rep < REP_N; ++rep) { OPQ(); norm_phase(xin, args.in[2] + l * DM, modl, 0, H, lane, gw, NGW); }
        SEAM(s0 + 0);
        if (PH(2) && IN(s0 + 1)) _Pragma("unroll 1") for (int rep = 0; rep < REP_G; ++rep) {
            pg8::Gemm g{H, wl + W_IN / 2, MROWS, NIN, DM}; pg8::StaticOrder S; S.init(MROWS, NIN, G, (int)blockIdx.x);
            pg8::EpiInProj E{P, VT, WI, cs, sn, args.in[7] + l * 64, args.in[8] + l * 64, args.in[9] + l * 64, args.in[10] + l * 64};
            pg8::gemm_phase<pg8::EpiInProj, pg8::StaticOrder, true, true>(lds, g, S, E);
        }
        SEAM(s0 + 1);
        if (PH(3) && IN(s0 + 2)) {
            OPQ();
            const float* gout = args.in[12] + l * 1024;
            const float gqa = wave_max(fabsf(args.in[7][l * 64 + lane])), gka = wave_max(fabsf(args.in[8][l * 64 + lane]));
            const float gqc = wave_max(fabsf(args.in[9][l * 64 + lane])), gkc = wave_max(fabsf(args.in[10][l * 64 + lane]));
            const float M2a = 8.f * gqa * gka * LOG2E, M2c = 8.f * gqc * gkc * LOG2E;
            _Pragma("unroll 1") for (int rep = 0; rep < REP_ATT; ++rep) {
            if (PH(8)) _Pragma("unroll 1") for (int r2 = 0; r2 < REP_SWA; ++r2) for (int u = gw; u < BATCH * 8 * 64; u += NGW) { const int qt = u & 63, hc = (u >> 6) & 7, b = u >> 9;
                swa_unit(b, hc, qt, P, VT, H, M2c, args.in[11][l * 8 + hc] * LOG2E, gout + (8 + hc) * 64, lane); }
            if (PH(9)) _Pragma("unroll 1") for (int r2 = 0; r2 < REP_SB; ++r2) for (int u = gw; u < BATCH * 4 * 64; u += NGW) { const int qt = u & 63, hb = (u >> 6) & 3, b = u >> 8;
                sb_unit(b, hb, qt, P, VT, H, gout + (4 + hb) * 64, lane); }
            if (PH(10)) _Pragma("unroll 1") for (int r2 = 0; r2 < REP_DSA; ++r2) dsa_phase(P, VT, WI, H, gout, M2a, ctl + CW_QUEUE + 64 * l + 16 * rep + 4 * r2, lds, tid, lane, wave);
            }
        }
        SEAM(s0 + 2);
        if (PH(4) && IN(s0 + 3)) _Pragma("unroll 1") for (int rep = 0; rep < REP_G; ++rep) {
            pg8::Gemm g{H, wl + W_O / 2, MROWS, DM, DM}; pg8::StaticOrder S; S.init(MROWS, DM, G, (int)blockIdx.x);
            pg8::EpiResid E{xin, rep ? (float*)(ws + 600 * MiB) : xout, modl + 2 * DM};
            pg8::gemm_phase<pg8::EpiResid, pg8::StaticOrder, true, true>(lds, g, S, E);
        }
        SEAM(s0 + 3);
        if (PH(5) && IN(s0 + 4)) _Pragma("unroll 1") for (int rep = 0; rep < REP_N; ++rep) { OPQ(); norm_phase(xout, args.in[3] + l * DM, modl, 3 * DM, H, lane, gw, NGW); }
        SEAM(s0 + 4);
        if (PH(6) && IN(s0 + 5)) _Pragma("unroll 1") for (int rep = 0; rep < REP_G; ++rep) {
            pg8::Gemm g{H, wl + W_GU / 2, MROWS, NGU, DM}; pg8::StaticOrder S; S.init(MROWS, NGU, G, (int)blockIdx.x);
            pg8::EpiSwiGLU E{ACT};
            pg8::gemm_phase<pg8::EpiSwiGLU, pg8::StaticOrder, true, true>(lds, g, S, E);
        }
        SEAM(s0 + 5);
        if (PH(7) && IN(s0 + 6)) _Pragma("unroll 1") for (int rep = 0; rep < REP_G; ++rep) {
            pg8::Gemm g{ACT, wl + W_D / 2, MROWS, DM, DFF}; pg8::StaticOrder S; S.init(MROWS, DM, G, (int)blockIdx.x);
            pg8::EpiResid E{xout, rep ? (float*)(ws + 600 * MiB) : xout, modl + 5 * DM};
            pg8::gemm_phase<pg8::EpiResid, pg8::StaticOrder, true, true>(lds, g, S, E);
        }
        SEAM(s0 + 6);
    }
#undef IN
#undef SEAM
}

extern "C" void kernel_launch(void* const* d_in, const int* in_sizes, int n_in, void* d_out, int out_size, void* d_ws, size_t ws_size, hipStream_t stream) {
    static int grid = 0;
    if (grid == 0) {
        if (n_in != 17 || in_sizes[0] != MROWS * DM || out_size != MROWS * DM || ws_size < WS_END) {
            fprintf(stderr, "kernel_launch: unexpected problem (n_in %d, in0 %d, out %d, ws %zu); nothing launched\n", n_in, n_in > 0 ? in_sizes[0] : -1, out_size, ws_size); grid = -1; return; }
        int dev = 0, cus = 0, per_cu = 0;
        if (hipGetDevice(&dev) != hipSuccess || hipDeviceGetAttribute(&cus, hipDeviceAttributeMultiprocessorCount, dev) != hipSuccess) { grid = -1; return; }
        if (hipFuncSetAttribute((const void*)fwd, hipFuncAttributeMaxDynamicSharedMemorySize, LDS_BYTES) != hipSuccess) { fprintf(stderr, "kernel_launch: hipFuncSetAttribute failed\n"); grid = -1; return; }
        if (hipOccupancyMaxActiveBlocksPerMultiprocessor(&per_cu, (const void*)fwd, NWAVES * 64, LDS_BYTES) != hipSuccess || per_cu < 1) {
            fprintf(stderr, "kernel_launch: occupancy query reports %d workgroups per CU\n", per_cu); per_cu = 1; }
        (void)hipGetLastError();
        grid = cus;
    }
    if (grid < 0) return;
    if (hipMemsetAsync((char*)d_ws + WS_CTL, 0, CTL_BYTES, stream) != hipSuccess) return;
    Args a{};
    for (int i = 0; i < 17; ++i) a.in[i] = (const float*)d_in[i];
    a.out = (float*)d_out; a.ws = (unsigned char*)d_ws;
#if MK_MULTI
    for (int s = 0; s < NSTEPS; ++s) { a.lo = s; a.hi = s + 1; hipLaunchKernelGGL(fwd, dim3(grid), dim3(NWAVES * 64), LDS_BYTES, stream, a); }
#else
    a.lo = 0; a.hi = NSTEPS;
    hipLaunchKernelGGL(fwd, dim3(grid), dim3(NWAVES * 64), LDS_BYTES, stream, a);
#endif
}
```

```cpp
#include <hip/hip_runtime.h>
#include <cstdio>
#include <cstdint>

#ifndef MK_MULTI
#define MK_MULTI 0
#endif

#define LAS __attribute__((address_space(3)))
#define GAS __attribute__((address_space(1)))
namespace pg8 {
#define PG8_LAS __attribute__((address_space(3)))
typedef unsigned short bf16_t;
typedef short bf16x8 __attribute__((ext_vector_type(8)));
typedef float f32x4 __attribute__((ext_vector_type(4)));
typedef unsigned u32x4 __attribute__((ext_vector_type(4)));
constexpr int BM = 256, BK = 64, HALF = 128, HTB = HALF * BK * 2  , STAGE_BYTES = 8 * HTB, NXCD = 8, WGM = 8;

__host__ __device__ __forceinline__ int lds_byte(int r, int c) { const int st = (r >> 4) * 2 + (c >> 5), rr = r & 15, cc = c & 31, ob = rr * 64 + cc * 2; return st * 1024 + (ob ^ (((ob >> 9) & 1) << 5)); }
__host__ __device__ __forceinline__ void stage_rc(int b, int& R, int& C) { const int st = b / 1024, sb = b % 1024, swz = sb ^ (((sb >> 9) & 1) << 5); R = (st >> 1) * 16 + swz / 64; C = (st & 1) * 32 + (swz % 64) / 2; }
__host__ __device__ __forceinline__ int perm32(int rho) { const int n = rho >> 4, i = rho & 15; return 8 * (i >> 2) + 4 * n + (i & 3); }

struct Unit { int pm, pn; };
struct Gemm { const bf16_t* A; const bf16_t* Bt; int M, N, K; };

struct StaticOrder {
    int nM, nN, nwg, G, c;
    __host__ __device__ void init(int M, int N, int G_, int c_) { nM = M / BM; nN = N / BM; nwg = nM * nN; G = G_; c = c_; }
    __host__ __device__ bool next(int i, Unit& u) const {
        const long L = (long)i * G + c; if (L >= nwg) return false;
        int wgid = (int)L; { const int q = nwg / NXCD, r = nwg % NXCD, xcd = wgid % NXCD, off = wgid / NXCD; wgid = (xcd < r ? xcd * (q + 1) : r * (q + 1) + (xcd - r) * q) + off; }
        const int nig = WGM * nN, gid = wgid / nig, fm = gid * WGM, gsz = (nM - fm) < WGM ? (nM - fm) : WGM;
        u.pm = fm + ((wgid % nig) % gsz); u.pn = (wgid % nig) / gsz; return true;
    }
    __device__ __forceinline__ void a_ready(const Unit&) const {}
    __device__ __forceinline__ void done(const Unit&) const {}
};
template <class Epi, class Sched, bool ALIGN_EPI = false, bool SP2 = false>
__device__ __forceinline__ void gemm_phase(PG8_LAS unsigned char* lds, const Gemm g, const Sched& S, const Epi& E) {
    int tid_o = threadIdx.x; asm volatile("" : "+v"(tid_o));
    const int tid = tid_o, wid = __builtin_amdgcn_readfirstlane(tid >> 6), lane = tid & 63, wr = wid >> 2, wc = wid & 3, fr = lane & 15, fq = lane >> 4;
    const int K = g.K, nt = K / BK;
    unsigned voffA[2], voffB[2];
#pragma unroll
    for (int i = 0; i < 2; ++i) { int R, C; stage_rc(tid * 16 + i * 8192, R, C); const int Rb = Epi::PERM ? ((R & ~31) + perm32(R & 31)) : R;
        voffA[i] = (unsigned)(R * K + C) * 2u; voffB[i] = (unsigned)(Rb * K + C) * 2u; }
    const size_t kstep = (size_t)(BK * 2);
    const size_t hstep = (size_t)HALF * K * 2;
    const size_t tstep = 2 * hstep;
    const unsigned ldsw = (unsigned)wid * 1024u;
    const int aoff = lds_byte(wr * 64 + fr, fq * 8), boff = lds_byte(wc * 32 + fr, fq * 8);
#define PG8_SA(b, h) (((b) * 2 + (h)) * HTB)
#define PG8_SB(b, h) ((4 + (b) * 2 + (h)) * HTB)
#define PG8_STAGE(bufoff, gbase, voff) do { _Pragma("unroll") for (int _i = 0; _i < 2; ++_i) \
        __builtin_amdgcn_global_load_lds((const unsigned*)((const char*)(gbase) + (voff)[_i]), (PG8_LAS unsigned*)(lds + (bufoff) + ldsw + _i * 8192), 16, 0, 0); } while (0)
#define PG8_LDA(dst, b, h) do { _Pragma("unroll") for (int m = 0; m < 4; ++m) _Pragma("unroll") for (int k = 0; k < 2; ++k) dst[m][k] = *(const PG8_LAS bf16x8*)(lds + PG8_SA(b, h) + aoff + m * 2048 + k * 1024); } while (0)
#define PG8_LDB(dst, b, h) do { _Pragma("unroll") for (int n = 0; n < 2; ++n) _Pragma("unroll") for (int k = 0; k < 2; ++k) dst[n][k] = *(const PG8_LAS bf16x8*)(lds + PG8_SB(b, h) + boff + n * 2048 + k * 1024); } while (0)
#define PG8_MMA(ai, bj, At, Bt) do { __builtin_amdgcn_s_setprio(1); _Pragma("unroll") for (int m = 0; m < 4; ++m) _Pragma("unroll") for (int n = 0; n < 2; ++n) _Pragma("unroll") for (int k = 0; k < 2; ++k) \
        acc[ai][bj][m][n] = __builtin_amdgcn_mfma_f32_16x16x32_bf16(Bt[n][k], At[m][k], acc[ai][bj][m][n], 0, 0, 0); __builtin_amdgcn_s_setprio(0); } while (0)
#define PG8_WAIT_V(n) asm volatile("s_waitcnt vmcnt(" #n ")" ::: "memory")
#define PG8_WAIT_L(n) asm volatile("s_waitcnt lgkmcnt(" #n ")" ::: "memory")
#define PG8_BAR __builtin_amdgcn_s_barrier()
#define PG8_SCHED __builtin_amdgcn_sched_barrier(0)
    Unit cur, nxt; int ui = 0;
    if (!S.next(0, cur)) return;
    f32x4 acc[2][2][4][2];
#pragma unroll
    for (int a = 0; a < 2; ++a)
#pragma unroll
        for (int b = 0; b < 2; ++b)
#pragma unroll
            for (int m = 0; m < 4; ++m)
#pragma unroll
                for (int n = 0; n < 2; ++n) acc[a][b][m][n] = (f32x4){0.f, 0.f, 0.f, 0.f};
    bf16x8 At[4][2], B0[2][2], B1[2][2];
    const char* cA = (const char*)g.A + (size_t)cur.pm * tstep; const char* cB = (const char*)g.Bt + (size_t)cur.pn * tstep;
    S.a_ready(cur);
    if constexpr (SP2) {
        PG8_STAGE(PG8_SB(0, 0), cB, voffB); PG8_STAGE(PG8_SB(0, 1), cB + hstep, voffB); PG8_STAGE(PG8_SA(0, 0), cA, voffA); PG8_STAGE(PG8_SA(0, 1), cA + hstep, voffA);
        if (wr == 1) PG8_BAR;
        PG8_WAIT_V(2); PG8_BAR;
        PG8_STAGE(PG8_SB(1, 0), cB + kstep, voffB); PG8_STAGE(PG8_SA(1, 0), cA + kstep, voffA); PG8_STAGE(PG8_SB(1, 1), cB + hstep + kstep, voffB);
        PG8_WAIT_V(6); PG8_BAR;
    } else {
        PG8_STAGE(PG8_SB(0, 0), cB, voffB); PG8_STAGE(PG8_SA(0, 0), cA, voffA); PG8_STAGE(PG8_SB(0, 1), cB + hstep, voffB); PG8_STAGE(PG8_SA(0, 1), cA + hstep, voffA);
        if (wr == 1) PG8_BAR;
        PG8_WAIT_V(4); PG8_BAR;
        PG8_STAGE(PG8_SB(1, 0), cB + kstep, voffB); PG8_STAGE(PG8_SA(1, 0), cA + kstep, voffA); PG8_STAGE(PG8_SB(1, 1), cB + hstep + kstep, voffB);
        PG8_WAIT_V(6); PG8_BAR;
    }
    for (;;) {
        const bool has_next = S.next(ui + 1, nxt);
        const char* nA = has_next ? (const char*)g.A + (size_t)nxt.pm * tstep : cA; const char* nB = has_next ? (const char*)g.Bt + (size_t)nxt.pn * tstep : cB;
        for (int t = 0; t < nt; t += 2) {
            const bool last = (t == nt - 2);
            const char* a1 = cA + (size_t)(t + 1) * kstep;
            const char* a2 = last ? nA : cA + (size_t)(t + 2) * kstep; const char* b2 = last ? nB : cB + (size_t)(t + 2) * kstep;
            const char* a3 = a2 + kstep; const char* b3 = b2 + kstep;
            if (last && has_next) S.a_ready(nxt);
            if constexpr (SP2) {
            PG8_LDB(B0, 0, 0); PG8_LDB(B1, 0, 1); PG8_SCHED; PG8_LDA(At, 0, 0); PG8_STAGE(PG8_SA(1, 1), a1 + hstep, voffA);
            PG8_WAIT_V(8); PG8_WAIT_L(0); PG8_BAR; PG8_MMA(0, 0, At, B0); PG8_MMA(0, 1, At, B1); PG8_BAR; PG8_SCHED;
            PG8_LDA(At, 0, 1); PG8_STAGE(PG8_SB(0, 0), b2, voffB); PG8_STAGE(PG8_SB(0, 1), b2 + hstep, voffB); PG8_STAGE(PG8_SA(0, 0), a2, voffA);
            PG8_WAIT_V(8); PG8_WAIT_L(0); PG8_BAR; PG8_MMA(1, 0, At, B0); PG8_MMA(1, 1, At, B1); PG8_BAR; PG8_SCHED;
            PG8_LDB(B0, 1, 0); PG8_LDB(B1, 1, 1); PG8_SCHED; PG8_LDA(At, 1, 0); PG8_STAGE(PG8_SA(0, 1), a2 + hstep, voffA);
            PG8_WAIT_V(8); PG8_WAIT_L(0); PG8_BAR; PG8_MMA(0, 0, At, B0); PG8_MMA(0, 1, At, B1); PG8_BAR; PG8_SCHED;
            PG8_LDA(At, 1, 1); PG8_STAGE(PG8_SB(1, 0), b3, voffB); PG8_STAGE(PG8_SB(1, 1), b3 + hstep, voffB); PG8_STAGE(PG8_SA(1, 0), a3, voffA);
            PG8_WAIT_V(8); PG8_WAIT_L(0); PG8_BAR; PG8_MMA(1, 0, At, B0); PG8_MMA(1, 1, At, B1); PG8_BAR; PG8_SCHED;
            } else {
            PG8_LDB(B0, 0, 0); PG8_SCHED; PG8_LDA(At, 0, 0); PG8_STAGE(PG8_SA(1, 1), a1 + hstep, voffA);
            PG8_WAIT_L(8); PG8_BAR; PG8_WAIT_L(0); PG8_MMA(0, 0, At, B0); PG8_BAR; PG8_SCHED;
            PG8_LDB(B1, 0, 1); PG8_STAGE(PG8_SB(0, 0), b2, voffB);
            PG8_BAR; PG8_WAIT_L(0); PG8_MMA(0, 1, At, B1); PG8_BAR;
            PG8_LDA(At, 0, 1); PG8_STAGE(PG8_SA(0, 0), a2, voffA);
            PG8_BAR; PG8_WAIT_L(0); PG8_MMA(1, 0, At, B0); PG8_BAR; PG8_SCHED;
            PG8_STAGE(PG8_SB(0, 1), b2 + hstep, voffB);
            PG8_WAIT_V(6); PG8_BAR; PG8_MMA(1, 1, At, B1); PG8_BAR;
            PG8_LDB(B0, 1, 0); PG8_SCHED; PG8_LDA(At, 1, 0); PG8_STAGE(PG8_SA(0, 1), a2 + hstep, voffA);
            PG8_WAIT_L(8); PG8_BAR; PG8_WAIT_L(0); PG8_MMA(0, 0, At, B0); PG8_BAR; PG8_SCHED;
            PG8_LDB(B1, 1, 1); PG8_STAGE(PG8_SB(1, 0), b3, voffB);
            PG8_BAR; PG8_WAIT_L(0); PG8_MMA(0, 1, At, B1); PG8_BAR;
            PG8_LDA(At, 1, 1); PG8_STAGE(PG8_SA(1, 0), a3, voffA);
            PG8_BAR; PG8_WAIT_L(0); PG8_MMA(1, 0, At, B0); PG8_BAR; PG8_SCHED;
            PG8_STAGE(PG8_SB(1, 1), b3 + hstep, voffB);
            PG8_WAIT_V(6); PG8_BAR; PG8_MMA(1, 1, At, B1); PG8_BAR;
            }
        }
        if constexpr (ALIGN_EPI) { if (wr == 0) PG8_BAR; }
        if constexpr (!Epi::AFTER_DRAIN) { E(acc, cur, wr, wc, fr, fq); S.done(cur); }
        if (!has_next) break;
#pragma unroll
        for (int a = 0; a < 2; ++a)
#pragma unroll
            for (int b = 0; b < 2; ++b)
#pragma unroll
                for (int m = 0; m < 4; ++m)
#pragma unroll
                    for (int n = 0; n < 2; ++n) acc[a][b][m][n] = (f32x4){0.f, 0.f, 0.f, 0.f};
        cur = nxt; cA = nA; cB = nB; ++ui;
        if constexpr (ALIGN_EPI) { if (wr == 1) PG8_BAR; }
    }
    PG8_WAIT_V(0);
    if constexpr (!ALIGN_EPI) { if (wr == 0) PG8_BAR; }
    PG8_BAR;
    if constexpr (Epi::AFTER_DRAIN) { E.fused(acc, cur, wr, wc, fr, fq, lds, wid, lane); S.done(cur); }
#undef PG8_SA
#undef PG8_SB
#undef PG8_STAGE
#undef PG8_LDA
#undef PG8_LDB
#undef PG8_MMA
#undef PG8_WAIT_V
#undef PG8_WAIT_L
#undef PG8_BAR
#undef PG8_SCHED
}
}

#define XB_TMO      128
#define XB_XCNT(j)  (256  + 64 * (j))
#define XB_XSUB(j)  (1280 + 64 * (j))
#define XB_XGEN(j)  (2304 + 64 * (j))
#define XB_TOP      3328
#define XB_TOPGEN   3392
#define XCD_BAR_WORDS 3456
#define XB_SPIN_CAP (1u << 24)

__device__ __forceinline__ unsigned xb_ld(unsigned* p)              { return __hip_atomic_load(p, __ATOMIC_RELAXED, __HIP_MEMORY_SCOPE_AGENT); }
__device__ __forceinline__ unsigned xb_add(unsigned* p, unsigned v) { return __hip_atomic_fetch_add(p, v, __ATOMIC_RELAXED, __HIP_MEMORY_SCOPE_AGENT); }
__device__ __forceinline__ unsigned xb_xcc_id() { return (unsigned)__builtin_amdgcn_s_getreg((3 << 11) | 20) & 0xFu; }
#define XB_SPIN(cond, bar) do { unsigned _sp = 0; while (cond) { __builtin_amdgcn_s_sleep(1); \
    if ((++_sp & 255u) == 0u) { if (xb_ld(&(bar)[XB_TMO])) break; if (_sp > XB_SPIN_CAP) { atomicAdd(&(bar)[XB_TMO], 1u); break; } } } } while (0)

struct XcdBarrier {
    unsigned* bar; unsigned x;
    volatile LAS unsigned* st;
};

__device__ __forceinline__ XcdBarrier xcd_barrier_post(unsigned* bar, volatile LAS unsigned* st) {
    XcdBarrier b; b.bar = bar; b.x = xb_xcc_id(); b.st = st;
    if (threadIdx.x == 0) (void)xb_add(&bar[XB_XCNT(b.x)], 1u);
    return b;
}
__device__ __forceinline__ void xcd_barrier_complete(unsigned* bar, unsigned x, unsigned& nloc, unsigned& nx) {
    const unsigned G = gridDim.x * gridDim.y * gridDim.z;
    unsigned sum, cnt, mine, sp = 0u;
    for (;;) {
        sum = 0u; cnt = 0u; mine = 0u;
#pragma unroll
        for (unsigned j = 0; j < 16; ++j) { const unsigned c = xb_ld(&bar[XB_XCNT(j)]); sum += c; cnt += (c > 0u) ? 1u : 0u; mine = (j == x) ? c : mine; }
        if (sum == G) break;
        __builtin_amdgcn_s_sleep(1);
        if ((++sp & 255u) == 0u) { if (xb_ld(&bar[XB_TMO])) break; if (sp > XB_SPIN_CAP) { atomicAdd(&bar[XB_TMO], 1u); break; } }
    }
    nloc = mine > 0u ? mine : 1u; nx = cnt > 0u ? cnt : 1u;
}

__device__ __forceinline__ void xcd_barrier(const XcdBarrier& b) {
    asm volatile("s_waitcnt vmcnt(0)" ::: "memory");
    __syncthreads();
    if (threadIdx.x == 0) {
        unsigned* bar = b.bar;
        __builtin_amdgcn_s_waitcnt(0);
        unsigned nloc = b.st[0], nx = b.st[1];
        if (nloc == 0u) { xcd_barrier_complete(bar, b.x, nloc, nx); b.st[0] = nloc; b.st[1] = nx; }
        const unsigned old = xb_add(&bar[XB_XSUB(b.x)], 1u);
        const unsigned gen = old / nloc;
        if (old + 1u == (gen + 1u) * nloc) {
            __builtin_amdgcn_fence(__ATOMIC_RELEASE, "agent");
            asm volatile("s_waitcnt vmcnt(0)" ::: "memory");
            const unsigned og = xb_add(&bar[XB_TOP], 1u);
            const unsigned tg = og / nx;
            if (og + 1u == (tg + 1u) * nx) xb_add(&bar[XB_TOPGEN], 1u);
            else XB_SPIN(xb_ld(&bar[XB_TOPGEN]) == tg, bar);
            __builtin_amdgcn_fence(__ATOMIC_ACQUIRE, "agent");
            xb_add(&bar[XB_XGEN(b.x)], 1u);
            asm volatile("s_waitcnt vmcnt(0)" ::: "memory");
        } else {
            XB_SPIN(xb_ld(&bar[XB_XGEN(b.x)]) == gen, bar);
            __builtin_amdgcn_fence(__ATOMIC_ACQUIRE, "agent");
            asm volatile("s_waitcnt vmcnt(0)" ::: "memory");
        }
    }
    __syncthreads();
}

#define LAS __attribute__((address_space(3)))
#define GAS __attribute__((address_space(1)))
typedef unsigned short bf16_t;
typedef short bf16x8 __attribute__((ext_vector_type(8)));
typedef float f32x4 __attribute__((ext_vector_type(4)));
typedef float f32x2 __attribute__((ext_vector_type(2)));
typedef float f32x16 __attribute__((ext_vector_type(16)));
typedef unsigned u32x4 __attribute__((ext_vector_type(4)));
typedef unsigned u32x2 __attribute__((ext_vector_type(2)));
typedef __bf16 bf16x2v __attribute__((ext_vector_type(2)));

constexpr int NWAVES = 8;
constexpr int BATCH = 32, SEQ = 2048, DM = 1024, DEPTH = 4, MROWS = BATCH * SEQ;
constexpr int NIN = 2304, INCOLS = 2244, DFF = 2816, NGU = 2 * DFF, NVS = 7;
constexpr float EPS = 1e-6f, LOG2E = 1.4426950408889634f, C2 = 0.18033688011112042f;
constexpr int NSTEPS = 2 + 5 * DEPTH;
#ifndef PHMASK
#define PHMASK 0xffff
#endif
#define PH(i) ((PHMASK >> (i)) & 1)
#ifndef DSA_S
#define DSA_S 15
#endif
#ifndef REP_ATT
#define REP_ATT 1
#endif
#ifndef REP_SWA
#define REP_SWA 1
#endif
#ifndef REP_SB
#define REP_SB 1
#endif
#ifndef REP_DSA
#define REP_DSA 1
#endif
#ifndef DSA_R1
#define DSA_R1 1
#endif
#ifndef DSA_R2
#define DSA_R2 1
#endif
#ifndef DSA_R3
#define DSA_R3 1
#endif
#ifndef REP_BIS
#define REP_BIS 1
#endif
#ifndef REP_PA
#define REP_PA 1
#endif
#ifndef REP_PB
#define REP_PB 1
#endif
#ifndef REP_G
#define REP_G 1
#endif
#ifndef REP_G2
#define REP_G2 REP_G
#endif
#ifndef REP_G4
#define REP_G4 REP_G
#endif
#ifndef REP_G6
#define REP_G6 REP_G
#endif
#ifndef REP_G7
#define REP_G7 REP_G
#endif
#ifndef REP_N
#define REP_N 1
#endif

constexpr size_t MiB = 1u << 20;
constexpr size_t WS_CTL = 0, CTL_BYTES = MiB;
constexpr size_t WS_ROPE = 1 * MiB;
constexpr size_t WS_MOD = 2 * MiB;
constexpr size_t WS_WI = 5 * MiB;
constexpr size_t WS_W = 8 * MiB, W_LAYER = 23 * MiB;
constexpr size_t W_IN = 0, W_O = 4608 * 1024, W_GU = W_O + 2 * MiB, W_D = W_GU + 11 * MiB;
constexpr size_t WS_H = 104 * MiB;
constexpr size_t WS_ACT = 232 * MiB;
constexpr size_t WS_P = WS_ACT;
constexpr size_t WS_VT = WS_ACT + 288 * MiB;
constexpr size_t WS_O = 584 * MiB;
constexpr size_t WS_SS = 712 * MiB;
constexpr size_t WS_B1 = 716 * MiB;
constexpr size_t WS_BG = 718 * MiB, WS_BU = 720 * MiB;
constexpr size_t WS_END = 722 * MiB, WS_DUMMY = 740 * MiB;
static_assert(W_D + (size_t)DM * DFF * 2 <= W_LAYER && WS_W + DEPTH * W_LAYER <= WS_H && WS_VT + (size_t)BATCH * NVS * 64 * SEQ * 2 <= WS_END, "ws map");
static_assert((size_t)MROWS * NIN * 2 == 288 * MiB && (size_t)MROWS * DFF * 2 == 352 * MiB, "ws map 2");

constexpr int CW_BAR = 4096, CW_QUEUE = 8192;

constexpr int SC_STRIDE = 2052;
constexpr int LDS_SC = 0;
constexpr int LDS_MASK = 131328, MASK_STRIDE = 66;
constexpr int LDS_LSUM = LDS_MASK + 16 * MASK_STRIDE * 4;
constexpr int LDS_SSUM = LDS_LSUM + 2048;
constexpr int LDS_MISC = LDS_SSUM + 2048;
constexpr int LDS_BYTES = 147456;
static_assert(LDS_MISC + 64 <= LDS_BYTES && 16 * SC_STRIDE * 4 == LDS_MASK && 8 * 64 * 64 * 4 <= LDS_MASK && (LDS_MISC % 16) == 0, "lds map");

#define LDS_WAIT() asm volatile("s_waitcnt lgkmcnt(0)" ::: "memory")
__device__ __forceinline__ unsigned cvtpk(float lo, float hi) { f32x2 v = {lo, hi}; bf16x2v b = __builtin_convertvector(v, bf16x2v); return __builtin_bit_cast(unsigned, b); }
__device__ __forceinline__ bf16x8 ldg16(const bf16_t* p) { return *(const GAS bf16x8*)p; }
__device__ __forceinline__ float ex2(float x) { return __builtin_amdgcn_exp2f(x); }
__device__ __forceinline__ float lg2(float x) { return __builtin_amdgcn_logf(x); }
__device__ __forceinline__ int crow(int i, int h) { return (i & 3) + 8 * (i >> 2) + 4 * h; }
#define MFMA32(a, b, c) __builtin_amdgcn_mfma_f32_32x32x16_bf16((a), (b), (c), 0, 0, 0)
#define MFMA16(a, b, c) __builtin_amdgcn_mfma_f32_16x16x32_bf16((a), (b), (c), 0, 0, 0)
__device__ __forceinline__ bf16x8 pack8(const f32x16& x, int s) {
    u32x4 p; p.x = cvtpk(x[8 * s], x[8 * s + 1]); p.y = cvtpk(x[8 * s + 2], x[8 * s + 3]); p.z = cvtpk(x[8 * s + 4], x[8 * s + 5]); p.w = cvtpk(x[8 * s + 6], x[8 * s + 7]);
    return __builtin_bit_cast(bf16x8, p);
}
__device__ __forceinline__ f32x16 zero16() { f32x16 z; for (int i = 0; i < 16; ++i) z[i] = 0.f; return z; }
__device__ __forceinline__ int wsum_i(int v) {
    v += __builtin_amdgcn_update_dpp(0, v, 0x111, 0xf, 0xf, false);
    v += __builtin_amdgcn_update_dpp(0, v, 0x112, 0xf, 0xf, false);
    v += __builtin_amdgcn_update_dpp(0, v, 0x114, 0xf, 0xf, false);
    v += __builtin_amdgcn_update_dpp(0, v, 0x118, 0xf, 0xf, false);
    v += __builtin_amdgcn_update_dpp(0, v, 0x142, 0xa, 0xf, false);
    v += __builtin_amdgcn_update_dpp(0, v, 0x143, 0xc, 0xf, false);
    return __builtin_amdgcn_readlane(v, 63);
}
__device__ __forceinline__ float wave_max(float v) {
#pragma unroll
    for (int o = 1; o < 64; o <<= 1) v = fmaxf(v, __shfl_xor(v, o));
    return v;
}
__device__ __forceinline__ float wave_sum(float v) {
#pragma unroll
    for (int o = 1; o < 64; o <<= 1) v += __shfl_xor(v, o);
    return v;
}

__device__ __forceinline__ int slot_col(int s) {
    if (s < 4) return 64 * s;
    if (s < 8) return 384 + 64 * (s - 4);
    if (s == 8) return 256;
    if (s == 9) return 320;
    if (s == 10) return 640;
    if (s == 11) return 704;
    if (s < 16) return 708 + 64 * (s - 12);
    if (s < 20) return 964 + 64 * (s - 16);
    if (s < 24) return 1220 + 64 * (s - 20);
    if (s < 32) return 1476 + 64 * (s - 24);
    if (s < 34) return 1988 + 64 * (s - 32);
    return 2116 + 64 * (s - 34);
}

namespace pg8 {
struct EpiInProj {
    static constexpr bool PERM = true, AFTER_DRAIN = false;
    bf16_t* P; bf16_t* VT; float* WI; const float* cs; const float* sn; const float* qn_a; const float* kn_a; const float* qn_c; const float* kn_c;
    const float* SS; const float* bias;
    __device__ __forceinline__ void operator()(const f32x4 (&acc)[2][2][4][2], const Unit& u, int wr, int wc, int fr, int fq) const {
        const int slot = u.pn * 4 + wc;
        int mode = 0; const float* gain = nullptr; float osc = 1.f; int vslot = 0;
        if (slot < 4) { mode = 2; gain = qn_a; osc = C2; }
        else if (slot < 8) { mode = 1; }
        else if (slot == 8) { mode = 2; gain = kn_a; }
        else if (slot == 9) { mode = 3; vslot = 0; }
        else if (slot == 10) { mode = 1; }
        else if (slot == 11) { mode = 4; }
        else if (slot < 16) { mode = 0; osc = C2; }
        else if (slot < 20) { mode = 0; }
        else if (slot < 24) { mode = 3; vslot = 1 + (slot - 20); }
        else if (slot < 32) { mode = 2; gain = qn_c; osc = C2; }
        else if (slot < 34) { mode = 2; gain = kn_c; }
        else { mode = 3; vslot = 5 + (slot - 34); }
        const int rowt = u.pm * BM + wr * 64 + fr;
        const float* bp = bias + (size_t)((u.pm * BM) / SEQ) * NIN + slot_col(slot) + 8 * fq;
        const int b = rowt / SEQ; const int tt = rowt % SEQ;
        const int pfr = (fr & 3) | ((fr & 4) << 1) | ((fr & 8) >> 1);
        bf16_t* vb = VT + ((size_t)(b * NVS + vslot) * 64) * SEQ;
        float rsv[2][4];
        { f32x4 p4[2][4];
#pragma unroll
          for (int ai = 0; ai < 2; ++ai)
#pragma unroll
              for (int m = 0; m < 4; ++m) p4[ai][m] = *(const f32x4*)(SS + (size_t)(rowt + ai * HALF + m * 16) * 16 + 4 * fq);
#pragma unroll
          for (int ai = 0; ai < 2; ++ai)
#pragma unroll
              for (int m = 0; m < 4; ++m) { float sq = (p4[ai][m][0] + p4[ai][m][1]) + (p4[ai][m][2] + p4[ai][m][3]); sq += __shfl_xor(sq, 16); sq += __shfl_xor(sq, 32);
                  rsv[ai][m] = __builtin_amdgcn_rsqf(sq * (1.f / DM) + EPS); } }
        asm volatile("" ::: "memory");
#pragma unroll
        for (int ai = 0; ai < 2; ++ai)
#pragma unroll
            for (int m = 0; m < 4; ++m) {
                const int row = rowt + ai * HALF + m * 16;
                const float rs = rsv[ai][m];
                const f32x4 b00 = *(const f32x4*)(bp), b01 = *(const f32x4*)(bp + 4), b10 = *(const f32x4*)(bp + 32), b11 = *(const f32x4*)(bp + 36);
                f32x4 v1[2] = {acc[ai][0][m][0] * rs + b00, acc[ai][0][m][1] * rs + b01}, v2[2] = {acc[ai][1][m][0] * rs + b10, acc[ai][1][m][1] * rs + b11};
                if (mode == 3) {
                    const unsigned voff = (unsigned)(8 * fq * SEQ + (((tt + ai * HALF + m * 16) & ~15) + pfr));
#pragma unroll
                    for (int n = 0; n < 2; ++n)
#pragma unroll
                        for (int e = 0; e < 4; ++e) {
                            (vb + (4 * n + e) * SEQ)[voff] = (bf16_t)(cvtpk(v1[n][e], 0.f) & 0xffffu);
                            (vb + (32 + 4 * n + e) * SEQ)[voff] = (bf16_t)(cvtpk(v2[n][e], 0.f) & 0xffffu); }
                } else if (mode == 4) {
                    if (fq == 0) *(f32x4*)(WI + (size_t)row * 4) = v1[0];
                } else {
                    if (mode == 2) {
                        float ss = 0.f;
#pragma unroll
                        for (int n = 0; n < 2; ++n)
#pragma unroll
                            for (int e = 0; e < 4; ++e) ss += v1[n][e] * v1[n][e] + v2[n][e] * v2[n][e];
                        ss += __shfl_xor(ss, 16); ss += __shfl_xor(ss, 32);
                        const float ri = __builtin_amdgcn_rsqf(ss * (1.f / 64.f) + EPS);
#pragma unroll
                        for (int n = 0; n < 2; ++n) { v1[n] = (v1[n] * ri) * *(const f32x4*)(gain + 8 * fq + 4 * n); v2[n] = (v2[n] * ri) * *(const f32x4*)(gain + 32 + 8 * fq + 4 * n); }
                    }
                    if (mode >= 1) {
                        const int t = row % SEQ;
#pragma unroll
                        for (int n = 0; n < 2; ++n) {
                            const f32x4 c = *(const f32x4*)(cs + t * 32 + 8 * fq + 4 * n), sv = *(const f32x4*)(sn + t * 32 + 8 * fq + 4 * n);
                            const f32x4 xa = v1[n], xb = v2[n];
                            v1[n] = xa * c - xb * sv; v2[n] = xb * c + xa * sv;
                        }
                    }
                    u32x4 w1, w2;
                    w1.x = cvtpk(v1[0][0] * osc, v1[0][1] * osc); w1.y = cvtpk(v1[0][2] * osc, v1[0][3] * osc); w1.z = cvtpk(v1[1][0] * osc, v1[1][1] * osc); w1.w = cvtpk(v1[1][2] * osc, v1[1][3] * osc);
                    w2.x = cvtpk(v2[0][0] * osc, v2[0][1] * osc); w2.y = cvtpk(v2[0][2] * osc, v2[0][3] * osc); w2.z = cvtpk(v2[1][0] * osc, v2[1][1] * osc); w2.w = cvtpk(v2[1][2] * osc, v2[1][3] * osc);
                    bf16_t* op = P + (size_t)row * NIN + slot * 64 + 8 * fq;
                    *(u32x4*)op = w1; *(u32x4*)(op + 32) = w2;
                }
                asm volatile("" ::: "memory");
            }
    }
};
struct EpiResid {
    static constexpr bool PERM = true, AFTER_DRAIN = false;
    const float* base; float* out; const float* gate;
    bf16_t* Hn; const float* lnn; const float* scn; float* SS; int do_next;
    __device__ __forceinline__ void operator()(const f32x4 (&acc)[2][2][4][2], const Unit& u, int wr, int wc, int fr, int fq) const {
        const int row0 = u.pm * BM + wr * 64 + fr, col0 = u.pn * BM + wc * 32 + 8 * fq;
        const size_t bo = (size_t)((u.pm * BM) / SEQ) * 6144 + col0;
        f32x4 gv[2][2], vv[2][2];
#pragma unroll
        for (int bj = 0; bj < 2; ++bj)
#pragma unroll
            for (int n = 0; n < 2; ++n) { gv[bj][n] = *(const f32x4*)(gate + bo + bj * HALF + 4 * n);
                if (do_next) vv[bj][n] = *(const f32x4*)(lnn + col0 + bj * HALF + 4 * n) * (*(const f32x4*)(scn + bo + bj * HALF + 4 * n) + 1.f); }
#pragma unroll
        for (int ai = 0; ai < 2; ++ai)
#pragma unroll
        for (int mh = 0; mh < 2; ++mh) {
            f32x4 bs[2][2][2];
#pragma unroll
            for (int mm = 0; mm < 2; ++mm) { const size_t off = (size_t)(row0 + ai * HALF + (2 * mh + mm) * 16) * DM + col0;
#pragma unroll
                for (int bj = 0; bj < 2; ++bj) { bs[mm][bj][0] = *(const f32x4*)(base + off + bj * HALF); bs[mm][bj][1] = *(const f32x4*)(base + off + bj * HALF + 4); } }
#pragma unroll
            for (int mm = 0; mm < 2; ++mm) { const int m = 2 * mh + mm; const int row = row0 + ai * HALF + m * 16; const size_t off = (size_t)row * DM + col0; float ss = 0.f;
#pragma unroll
                for (int bj = 0; bj < 2; ++bj) {
                    const f32x4 x0 = bs[mm][bj][0] + gv[bj][0] * acc[ai][bj][m][0], x1 = bs[mm][bj][1] + gv[bj][1] * acc[ai][bj][m][1];
                    *(f32x4*)(out + off + bj * HALF) = x0; *(f32x4*)(out + off + bj * HALF + 4) = x1;
                    if (do_next) {
                        ss += (x0[0] * x0[0] + x0[1] * x0[1]) + (x0[2] * x0[2] + x0[3] * x0[3]) + (x1[0] * x1[0] + x1[1] * x1[1]) + (x1[2] * x1[2] + x1[3] * x1[3]);
                        const f32x4 a0 = x0 * vv[bj][0], a1 = x1 * vv[bj][1];
                        u32x4 w; w.x = cvtpk(a0[0], a0[1]); w.y = cvtpk(a0[2], a0[3]); w.z = cvtpk(a1[0], a1[1]); w.w = cvtpk(a1[2], a1[3]);
                        *(u32x4*)(Hn + off + bj * HALF) = w; }
                }
                if (do_next) { ss += __shfl_xor(ss, 16); ss += __shfl_xor(ss, 32); if (fq == 0) SS[(size_t)row * 16 + u.pn * 4 + wc] = ss; }
            }
            asm volatile("" ::: "memory");
        }
    }
};
struct EpiSwiGLU {
    static constexpr bool PERM = true, AFTER_DRAIN = false;
    bf16_t* ACT; const float* SS; const float* bg; const float* bu;
    __device__ __forceinline__ void operator()(const f32x4 (&acc)[2][2][4][2], const Unit& u, int wr, int wc, int fr, int fq) const {
        const int row0 = u.pm * BM + wr * 64 + fr, col0 = u.pn * HALF + wc * 32 + 8 * fq;
        const size_t bo = (size_t)((u.pm * BM) / SEQ) * DFF + col0;
        const f32x4 g0 = *(const f32x4*)(bg + bo), g1 = *(const f32x4*)(bg + bo + 4), u0 = *(const f32x4*)(bu + bo), u1 = *(const f32x4*)(bu + bo + 4);
        float rsv[2][4];
        { f32x4 p4[2][4];
#pragma unroll
          for (int ai = 0; ai < 2; ++ai)
#pragma unroll
              for (int m = 0; m < 4; ++m) p4[ai][m] = *(const f32x4*)(SS + (size_t)(row0 + ai * HALF + m * 16) * 16 + 4 * fq);
#pragma unroll
          for (int ai = 0; ai < 2; ++ai)
#pragma unroll
              for (int m = 0; m < 4; ++m) { float sq = (p4[ai][m][0] + p4[ai][m][1]) + (p4[ai][m][2] + p4[ai][m][3]); sq += __shfl_xor(sq, 16); sq += __shfl_xor(sq, 32);
                  rsv[ai][m] = __builtin_amdgcn_rsqf(sq * (1.f / DM) + EPS); } }
#pragma unroll
        for (int ai = 0; ai < 2; ++ai)
#pragma unroll
            for (int m = 0; m < 4; ++m) {
                const int row = row0 + ai * HALF + m * 16;
                const float rs = rsv[ai][m];
                const f32x4 ga[2] = {acc[ai][0][m][0] * rs + g0, acc[ai][0][m][1] * rs + g1}, ua[2] = {acc[ai][1][m][0] * rs + u0, acc[ai][1][m][1] * rs + u1};
                float r[8];
#pragma unroll
                for (int n = 0; n < 2; ++n)
#pragma unroll
                    for (int e = 0; e < 4; ++e) { const float g = ga[n][e]; r[4 * n + e] = g * __builtin_amdgcn_rcpf(1.f + ex2(-g * LOG2E)) * ua[n][e]; }
                u32x4 w; w.x = cvtpk(r[0], r[1]); w.y = cvtpk(r[2], r[3]); w.z = cvtpk(r[4], r[5]); w.w = cvtpk(r[6], r[7]);
                *(u32x4*)(ACT + (size_t)row * DFF + col0) = w;
            }
    }
};
}

__device__ __forceinline__ void tr_item(const float* W, int ldw, int K, bf16_t* WT, int k0, int drow0, int sc, LAS float* scr, int lane) {
#pragma unroll 8
    for (int i = 0; i < 32; ++i) { const int kk = 2 * i + (lane >> 5); float v = 0.f; if (sc >= 0) v = W[(size_t)(k0 + kk) * ldw + sc]; scr[kk * 33 + (lane & 31)] = v; }
    LDS_WAIT(); asm volatile("" ::: "memory");
    const int c = lane & 7;
#pragma unroll
    for (int j = 0; j < 4; ++j) { const int n = (lane >> 3) + 8 * j; const LAS float* s = scr + (8 * c) * 33 + n;
        u32x4 o; o.x = cvtpk(s[0 * 33], s[1 * 33]); o.y = cvtpk(s[2 * 33], s[3 * 33]); o.z = cvtpk(s[4 * 33], s[5 * 33]); o.w = cvtpk(s[6 * 33], s[7 * 33]);
        *(GAS u32x4*)(WT + (size_t)(drow0 + n) * K + k0 + 8 * c) = o; }
    LDS_WAIT(); asm volatile("" ::: "memory");
}

struct Args { const float* in[17]; float* out; unsigned char* ws; int lo, hi; };

__device__ __forceinline__ void prologue(const Args& a, LAS unsigned char* lds, int tid, int lane, int wave, int G) {
    unsigned char* ws = a.ws;
    const float* w_in = a.in[6]; const float* w_o = a.in[13]; const float* w_gate = a.in[14]; const float* w_up = a.in[15]; const float* w_down = a.in[16];
    LAS float* scr = (LAS float*)(lds + wave * 16384);
    const int gw = blockIdx.x * NWAVES + wave, NGW = G * NWAVES;
    constexpr int I_IN = 16 * 72, I_O = 16 * 32, I_GU = 16 * 176, I_D = 44 * 32, I_L = I_IN + I_O + I_GU + I_D;
    for (int it = gw; it < DEPTH * I_L; it += NGW) {
        const int l = it / I_L; int r = it % I_L;
        bf16_t* wl = (bf16_t*)(ws + WS_W + (size_t)l * W_LAYER);
        if (r < I_IN) {
            const int kb = r / 72, nb = r % 72, np = 32 * nb + (lane & 31), p = np & 255;
            const int slot = (np >> 8) * 4 + ((p & 127) >> 5), dim = 32 * (p >> 7) + (p & 31);
            int sc = slot_col(slot) + dim; if (slot == 11 && dim >= 4) sc = -1;
            tr_item(w_in + (size_t)l * DM * INCOLS, INCOLS, DM, wl + W_IN / 2, 64 * kb, 32 * nb, sc, scr, lane); continue; }
        r -= I_IN;
        if (r < I_O) { const int kb = r / 32, nb = r % 32;
            tr_item(w_o + (size_t)l * DM * DM, DM, DM, wl + W_O / 2, 64 * kb, 32 * nb, 32 * nb + (lane & 31), scr, lane); continue; }
        r -= I_O;
        if (r < I_GU) { const int kb = r / 176, nb = r % 176, d0 = 32 * nb, p0 = d0 & 255;
            const float* src = (p0 < 128 ? w_gate : w_up) + (size_t)l * DM * DFF;
            tr_item(src, DFF, DM, wl + W_GU / 2, 64 * kb, d0, (d0 >> 8) * 128 + (p0 & 127) + (lane & 31), scr, lane); continue; }
        r -= I_GU;
        { const int kb = r / 32, nb = r % 32;
            tr_item(w_down + (size_t)l * DFF * DM, DM, DFF, wl + W_D / 2, 64 * kb, 32 * nb, 32 * nb + (lane & 31), scr, lane); }
    }
    {
        float* cs = (float*)(ws + WS_ROPE); float* sn = cs + SEQ * 32;
        for (int idx = blockIdx.x * 512 + tid; idx < SEQ * 32; idx += G * 512) {
            const int t = idx >> 5, i = idx & 31;
            double inv = 1.0; for (int k = 0; k < i; ++k) inv *= 0.7498942093324559;
            const float ang = (float)t * (float)inv;
            double rv = (double)ang * 0.15915494309189535; rv -= __builtin_floor(rv);
            const float fr = (float)rv;
            cs[idx] = __builtin_amdgcn_cosf(fr); sn[idx] = __builtin_amdgcn_sinf(fr);
        }
    }
    __syncthreads();
    {
        const float* c = a.in[1]; const float* w_mod = a.in[4]; const float* b_mod = a.in[5];
        float* mod = (float*)(ws + WS_MOD);
        LAS float* cact = (LAS float*)lds;
        for (int idx = tid; idx < BATCH * DM; idx += 512) { const int b = idx >> 10, k = idx & 1023; const float v = c[idx]; cact[k * 32 + b] = v * __builtin_amdgcn_rcpf(1.f + ex2(-v * LOG2E)); }
        __syncthreads();
        for (int unit = blockIdx.x; unit < DEPTH * 6144 / 64; unit += G) {
            const int col = unit * 64 + lane, l = col / 6144, j = col % 6144;
            const float* wp = w_mod + (size_t)l * DM * 6144 + j;
            float acc0 = 0.f, acc1 = 0.f, acc2 = 0.f, acc3 = 0.f;
#pragma unroll 32
            for (int k = 0; k < DM; ++k) { const float wv = wp[(size_t)k * 6144]; const f32x4 c4 = *(const LAS f32x4*)(cact + k * 32 + 4 * wave);
                acc0 += c4[0] * wv; acc1 += c4[1] * wv; acc2 += c4[2] * wv; acc3 += c4[3] * wv; }
            const float bm = b_mod[l * 6144 + j];
            float* mo = mod + ((size_t)l * BATCH + 4 * wave) * 6144 + j;
            mo[0] = acc0 + bm; mo[6144] = acc1 + bm; mo[2 * 6144] = acc2 + bm; mo[3 * 6144] = acc3 + bm;
        }
    }
    __syncthreads();
}

__device__ __forceinline__ void prologue_b(const Args& a, LAS unsigned char* lds, int tid, int lane, int wave, int G) {
    unsigned char* ws = a.ws;
    const float* mod = (const float*)(ws + WS_MOD);
    LAS float* cact = (LAS float*)lds;
    constexpr int U_IN = (INCOLS + 63) / 64, U_FF = DFF / 64, U_L = U_IN + 2 * U_FF;
    for (int un = blockIdx.x; un < DEPTH * U_L; un += G) {
        const int l = un / U_L; int r = un % U_L; int type = 0; if (r >= U_IN) { r -= U_IN; type = 1; if (r >= U_FF) { r -= U_FF; type = 2; } }
        const float* shp = mod + (size_t)l * BATCH * 6144 + (type == 0 ? 0 : 3 * DM);
        for (int idx = tid; idx < BATCH * DM; idx += 512) { const int b = idx >> 10, k = idx & 1023; cact[k * 32 + b] = shp[(size_t)b * 6144 + k]; }
        __syncthreads();
        const int ncols = type == 0 ? INCOLS : DFF;
        const float* W = type == 0 ? a.in[6] + (size_t)l * DM * INCOLS : (type == 1 ? a.in[14] : a.in[15]) + (size_t)l * DM * DFF;
        const int col = r * 64 + lane, cc = col < ncols ? col : ncols - 1;
        const float* wp = W + cc;
        float acc0 = 0.f, acc1 = 0.f, acc2 = 0.f, acc3 = 0.f;
#pragma unroll 32
        for (int k = 0; k < DM; ++k) { const float wv = wp[(size_t)k * ncols]; const f32x4 c4 = *(const LAS f32x4*)(cact + k * 32 + 4 * wave);
            acc0 += c4[0] * wv; acc1 += c4[1] * wv; acc2 += c4[2] * wv; acc3 += c4[3] * wv; }
        if (col < ncols) {
            const int ldb = type == 0 ? NIN : DFF;
            float* bo = (float*)(ws + (type == 0 ? WS_B1 : (type == 1 ? WS_BG : WS_BU))) + ((size_t)l * BATCH + 4 * wave) * ldb + col;
            bo[0] = acc0; bo[ldb] = acc1; bo[2 * ldb] = acc2; bo[3 * ldb] = acc3;
        }
        __syncthreads();
    }
}

__device__ __forceinline__ void pre_phase(const float* x, const float* ln, const float* modl  , bf16_t* H, float* SS, int lane, int gw, int NGW) {
    for (int m = gw; m < MROWS; m += NGW) {
        const int b = m / SEQ;
        const GAS f32x4* xr = (const GAS f32x4*)(x + (size_t)m * DM) + lane;
        f32x4 v[4]; float s = 0.f;
#pragma unroll
        for (int j = 0; j < 4; ++j) { v[j] = xr[64 * j]; s += (v[j].x * v[j].x + v[j].y * v[j].y) + (v[j].z * v[j].z + v[j].w * v[j].w); }
        s = wave_sum(s);
        if (lane < 16) SS[(size_t)m * 16 + lane] = (lane == 0) ? s : 0.f;
        const float* mb = modl + (size_t)b * 6144;
        GAS u32x2* o8 = (GAS u32x2*)(H + (size_t)m * DM) + lane;
#pragma unroll
        for (int j = 0; j < 4; ++j) {
            const f32x4 g = *((const GAS f32x4*)ln + lane + 64 * j), scv = *((const GAS f32x4*)(mb + DM) + lane + 64 * j);
            const f32x4 y = v[j] * (g * (scv + 1.f));
            u32x2 w; w.x = cvtpk(y.x, y.y); w.y = cvtpk(y.z, y.w); o8[64 * j] = w;
        }
    }
}

__device__ __forceinline__ void store_head(const f32x16& o0, const f32x16& o1, float inv, const float* gout, bf16_t* orow, int h) {
    float ss = 0.f;
#pragma unroll
    for (int i = 0; i < 16; ++i) { const float a = o0[i] * inv, b = o1[i] * inv; ss += a * a + b * b; }
    ss += __shfl_xor(ss, 32);
    const float rn = __builtin_amdgcn_rsqf(ss * (1.f / 64.f) + EPS) * inv;
#pragma unroll
    for (int g = 0; g < 4; ++g) {
        const int d0 = 8 * g + 4 * h;
        const f32x4 ga = *(const f32x4*)(gout + d0), gb = *(const f32x4*)(gout + 32 + d0);
        u32x2 wa, wb;
        wa.x = cvtpk(o0[4 * g] * rn * ga[0], o0[4 * g + 1] * rn * ga[1]); wa.y = cvtpk(o0[4 * g + 2] * rn * ga[2], o0[4 * g + 3] * rn * ga[3]);
        wb.x = cvtpk(o1[4 * g] * rn * gb[0], o1[4 * g + 1] * rn * gb[1]); wb.y = cvtpk(o1[4 * g + 2] * rn * gb[2], o1[4 * g + 3] * rn * gb[3]);
        *(GAS u32x2*)(orow + d0) = wa; *(GAS u32x2*)(orow + 32 + d0) = wb;
    }
}

__device__ __forceinline__ void swa_unit(int b, int hc, int qt, const bf16_t* P, const bf16_t* VT, bf16_t* O, float M2, float sink2, const float* gout, int lane) {
    const int r = lane & 31, h = lane >> 5, t0 = qt * 32, kv = hc >> 2;
    const size_t rowbase = (size_t)b * SEQ;
    bf16x8 qf[4];
    { const bf16_t* qp = P + (rowbase + t0 + r) * NIN + (24 + hc) * 64 + 8 * h;
#pragma unroll
      for (int ks = 0; ks < 4; ++ks) qf[ks] = ldg16(qp + 16 * ks); }
    const bf16_t* kbase = P + rowbase * NIN + (32 + kv) * 64 + 8 * h + (size_t)r * NIN;
    const bf16_t* vbase = VT + ((size_t)(b * NVS + 5 + kv) * 64 + r) * SEQ + 8 * h;
    f32x16 o0 = zero16(), o1 = zero16(); float lsum = 0.f;
    const int t = t0 + r;
    const int kt_lo = qt - 4 < 0 ? 0 : qt - 4;
    bf16x8 kf[4];
#pragma unroll
    for (int ks = 0; ks < 4; ++ks) kf[ks] = ldg16(kbase + (size_t)(kt_lo * 32) * NIN + 16 * ks);
    for (int kt = kt_lo; kt <= qt; ++kt) {
        bf16x8 kn[4], vf[2][2];
#pragma unroll
        for (int dt = 0; dt < 2; ++dt)
#pragma unroll
            for (int s = 0; s < 2; ++s) vf[dt][s] = ldg16(vbase + (size_t)(dt * 32) * SEQ + kt * 32 + 16 * s);
        { const bf16_t* kp = kbase + (size_t)((kt < qt ? kt + 1 : kt) * 32) * NIN;
#pragma unroll
          for (int ks = 0; ks < 4; ++ks) kn[ks] = ldg16(kp + 16 * ks); }
        f32x16 sc = zero16();
#pragma unroll
        for (int ks = 0; ks < 4; ++ks) sc = MFMA32(kf[ks], qf[ks], sc);
#pragma unroll
        for (int i = 0; i < 16; ++i) { const int key = kt * 32 + crow(i, h); const bool valid = (unsigned)(t - key) < 128u;
            const float p = valid ? ex2(sc[i] - M2) : 0.f; sc[i] = p; lsum += p; }
        const bf16x8 p0 = pack8(sc, 0), p1 = pack8(sc, 1);
        o0 = MFMA32(vf[0][0], p0, o0); o0 = MFMA32(vf[0][1], p1, o0);
        o1 = MFMA32(vf[1][0], p0, o1); o1 = MFMA32(vf[1][1], p1, o1);
#pragma unroll
        for (int ks = 0; ks < 4; ++ks) kf[ks] = kn[ks];
    }
    lsum += __shfl_xor(lsum, 32); lsum += ex2(sink2 - M2);
    store_head(o0, o1, 1.f / lsum, gout, O + (rowbase + t0 + r) * DM + (8 + hc) * 64, h);
}

__device__ __forceinline__ void sb_unit(int b, int hb, int qt, const bf16_t* P, const bf16_t* VT, bf16_t* O, const float* gout, int lane) {
    const int r = lane & 31, h = lane >> 5, t0 = qt * 32;
    const size_t rowbase = (size_t)b * SEQ;
    bf16x8 qf[4];
    { const bf16_t* qp = P + (rowbase + t0 + r) * NIN + (12 + hb) * 64 + 8 * h;
#pragma unroll
      for (int ks = 0; ks < 4; ++ks) qf[ks] = ldg16(qp + 16 * ks); }
    const bf16_t* kbase = P + rowbase * NIN + (16 + hb) * 64 + 8 * h + (size_t)r * NIN;
    const bf16_t* vbase = VT + ((size_t)(b * NVS + 1 + hb) * 64 + r) * SEQ + 8 * h;
    f32x16 o0 = zero16(), o1 = zero16(); float C = 0.f;
    const int t = t0 + r;
    bf16x8 kf[4];
#pragma unroll
    for (int ks = 0; ks < 4; ++ks) kf[ks] = ldg16(kbase + (size_t)(qt * 32) * NIN + 16 * ks);
    for (int kt = qt; kt >= 0; --kt) {
        bf16x8 kn[4], vf[2][2];
#pragma unroll
        for (int dt = 0; dt < 2; ++dt)
#pragma unroll
            for (int s = 0; s < 2; ++s) vf[dt][s] = ldg16(vbase + (size_t)(dt * 32) * SEQ + kt * 32 + 16 * s);
        { const bf16_t* kp = kbase + (size_t)((kt > 0 ? kt - 1 : 0) * 32) * NIN;
#pragma unroll
          for (int ks = 0; ks < 4; ++ks) kn[ks] = ldg16(kp + 16 * ks); }
        f32x16 z = zero16();
#pragma unroll
        for (int ks = 0; ks < 4; ++ks) z = MFMA32(kf[ks], qf[ks], z);
        float L[16];
#pragma unroll
        for (int i = 0; i < 16; ++i) { const int key = kt * 32 + crow(i, h); const float zz = z[i];
            const float sp = fmaxf(zz, 0.f) + lg2(1.f + ex2(-fabsf(zz)));
            L[i] = (key < t) ? -sp : 0.f; }
        float G4[4], Gp[4], ps[4], aft[4];
#pragma unroll
        for (int g = 0; g < 4; ++g) { G4[g] = (L[4 * g] + L[4 * g + 1]) + (L[4 * g + 2] + L[4 * g + 3]); Gp[g] = __shfl_xor(G4[g], 32); ps[g] = G4[g] + Gp[g]; }
        aft[3] = 0.f; aft[2] = ps[3]; aft[1] = aft[2] + ps[2]; aft[0] = aft[1] + ps[1];
#pragma unroll
        for (int g = 0; g < 4; ++g) {
            const float bg = C + aft[g] + (h == 0 ? Gp[g] : 0.f);
            const float b3 = bg, b2 = b3 + L[4 * g + 3], b1 = b2 + L[4 * g + 2], b0 = b1 + L[4 * g + 1];
            const float bt[4] = {b0, b1, b2, b3};
#pragma unroll
            for (int e = 0; e < 4; ++e) { const int i = 4 * g + e; const int key = kt * 32 + crow(i, h);
                z[i] = (key < t) ? ex2(z[i] + L[i] + bt[e]) : 0.f; }
        }
        C += aft[0] + ps[0];
        const bf16x8 p0 = pack8(z, 0), p1 = pack8(z, 1);
        o0 = MFMA32(vf[0][0], p0, o0); o0 = MFMA32(vf[0][1], p1, o0);
        o1 = MFMA32(vf[1][0], p0, o1); o1 = MFMA32(vf[1][1], p1, o1);
        if (__all(C < -160.f)) break;
#pragma unroll
        for (int ks = 0; ks < 4; ++ks) kf[ks] = kn[ks];
    }
    store_head(o0, o1, 1.f, gout, O + (rowbase + t0 + r) * DM + (4 + hb) * 64, h);
}

__device__ __forceinline__ void dsa_phase(const bf16_t* P, const bf16_t* VT, const float* WI, bf16_t* O, const float* gout  , float M2, unsigned* queue,
                                          LAS unsigned char* lds, int tid, int lane, int wave) {
    LAS float* SC = (LAS float*)(lds + LDS_SC);
    LAS unsigned* MASK = (LAS unsigned*)(lds + LDS_MASK);
    LAS float* LSUM = (LAS float*)(lds + LDS_LSUM);
    LAS float* SSUM = (LAS float*)(lds + LDS_SSUM);
    volatile LAS unsigned* QW = (volatile LAS unsigned*)(lds + LDS_MISC);
    unsigned hint = 0u;
    for (;;) {
        if (tid == 0) QW[0] = __hip_atomic_fetch_add(queue, 1u, __ATOMIC_RELAXED, __HIP_MEMORY_SCOPE_AGENT);
        __syncthreads();
        const int q = (int)QW[0];
        if (q >= BATCH * 128) break;
        const int tau = 127 - (q >> 5), b = q & 31, t0 = 16 * tau;
        const size_t rowbase = (size_t)b * SEQ;
        if (DSA_S & 1) {
            int lane1 = lane; asm volatile("" : "+v"(lane1));
            const int c = lane1 & 15, g = lane1 >> 4;
            bf16x8 qi[4][2];
            const bf16_t* qp = P + (rowbase + t0 + c) * NIN + 4 * 64 + 8 * g;
#pragma unroll
            for (int hh = 0; hh < 4; ++hh) { qi[hh][0] = ldg16(qp + hh * 64); qi[hh][1] = ldg16(qp + hh * 64 + 32); }
            const f32x4 w = *(const GAS f32x4*)(WI + (rowbase + t0 + c) * 4);
            const bf16_t* kp0 = P + (rowbase + c) * NIN + 10 * 64 + 8 * g;
            _Pragma("unroll 1") for (int r1 = 0; r1 < DSA_R1; ++r1) {
            bf16x8 k0 = qi[0][0], k1 = qi[0][1];
            if (wave <= tau) { const bf16_t* kp = kp0 + (size_t)(wave * 16) * NIN; k0 = ldg16(kp); k1 = ldg16(kp + 32); }
            for (int kt = wave; kt <= tau; kt += NWAVES) {
                bf16x8 n0 = k0, n1 = k1;
                if (kt + NWAVES <= tau) { const bf16_t* kp = kp0 + (size_t)((kt + NWAVES) * 16) * NIN; n0 = ldg16(kp); n1 = ldg16(kp + 32); }
                f32x4 sc = {0.f, 0.f, 0.f, 0.f};
#pragma unroll
                for (int hh = 0; hh < 4; ++hh) { f32x4 a = {0.f, 0.f, 0.f, 0.f}; a = MFMA16(k0, qi[hh][0], a); a = MFMA16(k1, qi[hh][1], a);
#pragma unroll
                    for (int j = 0; j < 4; ++j) sc[j] += w[hh] * fmaxf(a[j], 0.f); }
                { LAS float* sp = SC + c * SC_STRIDE + (16 * (kt & 1) + 4 * g) * 64 + (kt >> 1);
                  sp[0] = sc[0]; sp[64] = sc[1]; sp[128] = sc[2]; sp[192] = sc[3]; }
                k0 = n0; k1 = n1;
            }
            }
        }
        __syncthreads();
#pragma unroll 1
        for (int rr = 0; rr < ((DSA_S & 2) ? 2 * DSA_R2 : 0); ++rr) {
            const int r = 2 * wave + (rr & 1), t = t0 + r, n = t + 1;
            const int cv = n - 32 * lane;
            const unsigned A0 = cv >= 32 ? ~0u : (cv <= 0 ? 0u : ((1u << cv) - 1u));
            unsigned S = A0;
            if (n > 256) {
                unsigned P[32];
#pragma unroll
                for (int i = 0; i < 32; ++i) P[i] = __float_as_uint(SC[r * SC_STRIDE + 64 * i + lane]);
#define TSTAGE(J, MSK) _Pragma("unroll") for (int k_ = 0; k_ < 32; ++k_) if ((k_ & (J)) == 0) { const unsigned lo_ = P[k_], hi_ = P[k_ + (J)]; \
                    P[k_] = (lo_ & (MSK)) | ((hi_ << (J)) & ~(MSK)); P[k_ + (J)] = ((lo_ >> (J)) & (MSK)) | (hi_ & ~(MSK)); }
                TSTAGE(16, 0x0000ffffu) TSTAGE(8, 0x00ff00ffu) TSTAGE(4, 0x0f0f0f0fu) TSTAGE(2, 0x33333333u) TSTAGE(1, 0x55555555u)
#undef TSTAGE
#pragma unroll
                for (int bq = 0; bq < 31; ++bq) P[bq] ^= P[31];
                P[31] = ~P[31];
                unsigned A = A0, G = 0u; int cntG = 0, nA = n; bool done = false;
#pragma unroll
                for (int bq = 31; bq >= 0; --bq) {
                    if (!done) {
                        const unsigned X = A & P[bq];
                        const int c = wsum_i(__builtin_popcount(X));
                        if (cntG + c >= 256) { A = X; nA = c; } else { G |= X; cntG += c; A &= ~P[bq]; nA -= c; }
                        done = (cntG + nA == 256);
                    }
                }
                if (!done) {
                    const int need = 256 - cntG, pc = __builtin_popcount(A);
                    int inc = pc;
                    inc += __builtin_amdgcn_update_dpp(0, inc, 0x111, 0xf, 0xf, false);
                    inc += __builtin_amdgcn_update_dpp(0, inc, 0x112, 0xf, 0xf, false);
                    inc += __builtin_amdgcn_update_dpp(0, inc, 0x114, 0xf, 0xf, false);
                    inc += __builtin_amdgcn_update_dpp(0, inc, 0x118, 0xf, 0xf, false);
                    inc += __builtin_amdgcn_update_dpp(0, inc, 0x142, 0xa, 0xf, false);
                    inc += __builtin_amdgcn_update_dpp(0, inc, 0x143, 0xc, 0xf, false);
                    int take = need - (inc - pc); take = take < 0 ? 0 : (take > pc ? pc : take);
                    while (__builtin_popcount(A) > take) A &= ~(0x80000000u >> __builtin_clz(A));
                }
                S = G | A;
            }
            MASK[r * MASK_STRIDE + lane] = S;
        }
        __syncthreads();
        if (DSA_S & 4) {
            int lane3 = lane; asm volatile("" : "+v"(lane3));
            const int r = lane3 & 31, h = lane3 >> 5, c = r & 15;
            bf16x8 qf[2][4];
#pragma unroll
            for (int nt = 0; nt < 2; ++nt) { const bf16_t* qp = P + (rowbase + t0 + c) * NIN + (2 * nt + (r >> 4)) * 64 + 8 * h;
#pragma unroll
                for (int ks = 0; ks < 4; ++ks) qf[nt][ks] = ldg16(qp + 16 * ks); }
            f32x16 o[2][2]; float ls[2];
            _Pragma("unroll 1") for (int r3 = 0; r3 < DSA_R3; ++r3) {
            o[0][0] = zero16(); o[0][1] = zero16(); o[1][0] = zero16(); o[1][1] = zero16(); ls[0] = 0.f; ls[1] = 0.f;
            const bf16_t* kbase = P + (rowbase + r) * NIN + 8 * 64 + 8 * h;
            const bf16_t* vbase = VT + ((size_t)(b * NVS) * 64 + r) * SEQ + 8 * h;
            const int nkt = ((t0 + 15) >> 5) + 1;
            bf16x8 kf[4];
#pragma unroll
            for (int ks = 0; ks < 4; ++ks) kf[ks] = qf[0][ks];
            if (wave < nkt) {
#pragma unroll
                for (int ks = 0; ks < 4; ++ks) kf[ks] = ldg16(kbase + (size_t)(wave * 32) * NIN + 16 * ks); }
            for (int kt = wave; kt < nkt; kt += NWAVES) {
                bf16x8 kn[4], vf[2][2];
#pragma unroll
                for (int dt = 0; dt < 2; ++dt)
#pragma unroll
                    for (int s = 0; s < 2; ++s) vf[dt][s] = ldg16(vbase + (size_t)(dt * 32) * SEQ + kt * 32 + 16 * s);
                { const int kq = (kt + NWAVES < nkt) ? kt + NWAVES : kt; const bf16_t* kp = kbase + (size_t)(kq * 32) * NIN;
#pragma unroll
                  for (int ks = 0; ks < 4; ++ks) kn[ks] = ldg16(kp + 16 * ks); }
                const unsigned mw = MASK[c * MASK_STRIDE + kt];
#pragma unroll
                for (int nt = 0; nt < 2; ++nt) {
                    f32x16 sc = zero16();
#pragma unroll
                    for (int ks = 0; ks < 4; ++ks) sc = MFMA32(kf[ks], qf[nt][ks], sc);
#pragma unroll
                    for (int i = 0; i < 16; ++i) { const float p = ((mw >> crow(i, h)) & 1u) ? ex2(sc[i] - M2) : 0.f; sc[i] = p; ls[nt] += p; }
                    const bf16x8 p0 = pack8(sc, 0), p1 = pack8(sc, 1);
                    o[nt][0] = MFMA32(vf[0][0], p0, o[nt][0]); o[nt][0] = MFMA32(vf[0][1], p1, o[nt][0]);
                    o[nt][1] = MFMA32(vf[1][0], p0, o[nt][1]); o[nt][1] = MFMA32(vf[1][1], p1, o[nt][1]);
                }
#pragma unroll
                for (int ks = 0; ks < 4; ++ks) kf[ks] = kn[ks];
            }
            }
#pragma unroll
            for (int nt = 0; nt < 2; ++nt) {
#pragma unroll
                for (int dt = 0; dt < 2; ++dt)
#pragma unroll
                    for (int i = 0; i < 16; ++i) SC[(wave * 64 + 32 * dt + crow(i, h)) * 64 + 32 * nt + r] = o[nt][dt][i];
                float l2 = ls[nt]; l2 += __shfl_xor(l2, 32);
                if (h == 0) LSUM[wave * 64 + 32 * nt + r] = l2;
            }
        }
        __syncthreads();
        if (DSA_S & 8) {
            int n = lane; asm volatile("" : "+v"(n));
            float l = 0.f;
#pragma unroll
            for (int w = 0; w < NWAVES; ++w) l += LSUM[w * 64 + n];
            const float inv = 1.f / l;
            float ov[8]; float ssp = 0.f;
#pragma unroll
            for (int dd = 0; dd < 8; ++dd) { float a = 0.f;
#pragma unroll
                for (int w = 0; w < NWAVES; ++w) a += SC[(w * 64 + 8 * wave + dd) * 64 + n];
                ov[dd] = a * inv; ssp += ov[dd] * ov[dd]; }
            SSUM[wave * 64 + n] = ssp;
            __syncthreads();
            float ss = 0.f;
#pragma unroll
            for (int w = 0; w < NWAVES; ++w) ss += SSUM[w * 64 + n];
            const float rn = __builtin_amdgcn_rsqf(ss * (1.f / 64.f) + EPS);
            const int head = n >> 4, c = n & 15;
            const f32x4 ga = *(const f32x4*)(gout + head * 64 + 8 * wave), gb = *(const f32x4*)(gout + head * 64 + 8 * wave + 4);
            u32x4 wv; wv.x = cvtpk(ov[0] * rn * ga[0], ov[1] * rn * ga[1]); wv.y = cvtpk(ov[2] * rn * ga[2], ov[3] * rn * ga[3]);
            wv.z = cvtpk(ov[4] * rn * gb[0], ov[5] * rn * gb[1]); wv.w = cvtpk(ov[6] * rn * gb[2], ov[7] * rn * gb[3]);
            *(GAS u32x4*)(O + (rowbase + t0 + c) * DM + head * 64 + 8 * wave) = wv;
        }
        __syncthreads();
    }
}

__global__ void __launch_bounds__(NWAVES * 64, 2) fwd(Args args) {
    extern __shared__ __attribute__((aligned(16))) unsigned char lds_raw[];
    LAS unsigned char* lds = (LAS unsigned char*)lds_raw;
    const int wave = __builtin_amdgcn_readfirstlane(threadIdx.x >> 6);
    const int G = gridDim.x;
    const int gw = blockIdx.x * NWAVES + wave, NGW = G * NWAVES;
    unsigned char* ws = args.ws;
    unsigned* ctl = (unsigned*)(ws + WS_CTL);
    volatile LAS unsigned* MISC = (volatile LAS unsigned*)(lds + LDS_MISC);
    if (threadIdx.x < 16) MISC[threadIdx.x] = 0u;
    __syncthreads();
    XcdBarrier bar; bar.bar = ctl + CW_BAR; bar.x = 0; bar.st = nullptr;
    if (!MK_MULTI) bar = xcd_barrier_post(ctl + CW_BAR, MISC + 4);
    const int lo = args.lo, hi = args.hi;
#define IN(k) (lo <= (k) && (k) < hi)
#define SEAM(k) do { if (IN(k) && IN((k) + 1)) xcd_barrier(bar); } while (0)

    bf16_t* H = (bf16_t*)(ws + WS_H); bf16_t* ACT = (bf16_t*)(ws + WS_ACT); bf16_t* P = (bf16_t*)(ws + WS_P); bf16_t* VT = (bf16_t*)(ws + WS_VT);
    float* WI = (float*)(ws + WS_WI); const float* cs = (const float*)(ws + WS_ROPE); const float* sn = cs + SEQ * 32;
    const float* mod = (const float*)(ws + WS_MOD);
    float* xout = args.out;

#define OPQ() int tid = threadIdx.x; asm volatile("" : "+v"(tid)); const int lane = tid & 63; (void)lane
    bf16_t* OB = (bf16_t*)(ws + WS_O); float* SS = (float*)(ws + WS_SS);
    const float* B1 = (const float*)(ws + WS_B1); const float* BG = (const float*)(ws + WS_BG); const float* BU = (const float*)(ws + WS_BU);
    if (PH(0) && IN(0)) _Pragma("unroll 1") for (int rep = 0; rep < REP_PA; ++rep) { OPQ(); prologue(args, lds, tid, lane, wave, G); }
    SEAM(0);
    if (PH(0) && IN(1)) _Pragma("unroll 1") for (int rep = 0; rep < REP_PB; ++rep) { OPQ(); prologue_b(args, lds, tid, lane, wave, G); }
    if (PH(1) && IN(1)) _Pragma("unroll 1") for (int rep = 0; rep < REP_N; ++rep) { OPQ(); pre_phase(args.in[0], args.in[2], mod, H, SS, lane, gw, NGW); }
    SEAM(1);

    for (int l = 0; l < DEPTH; ++l) {
        const int s0 = 1 + 5 * l;
        const float* xin = (l == 0) ? args.in[0] : (const float*)xout;
        const float* modl = mod + (size_t)l * BATCH * 6144;
        const bf16_t* wl = (const bf16_t*)(ws + WS_W + (size_t)l * W_LAYER);
        if (PH(2) && IN(s0 + 1)) _Pragma("unroll 1") for (int rep = 0; rep < REP_G2; ++rep) {
            pg8::Gemm g{H, wl + W_IN / 2, MROWS, NIN, DM}; pg8::StaticOrder S; S.init(MROWS, NIN, G, (int)blockIdx.x);
            pg8::EpiInProj E{P, VT, WI, cs, sn, args.in[7] + l * 64, args.in[8] + l * 64, args.in[9] + l * 64, args.in[10] + l * 64, SS, B1 + (size_t)l * BATCH * NIN};
            pg8::gemm_phase<pg8::EpiInProj, pg8::StaticOrder, true, true>(lds, g, S, E);
        }
        SEAM(s0 + 1);
        if (PH(3) && IN(s0 + 2)) {
            OPQ();
            const float* gout = args.in[12] + l * 1024;
            const float gqa = wave_max(fabsf(args.in[7][l * 64 + lane])), gka = wave_max(fabsf(args.in[8][l * 64 + lane]));
            const float gqc = wave_max(fabsf(args.in[9][l * 64 + lane])), gkc = wave_max(fabsf(args.in[10][l * 64 + lane]));
            const float M2a = 8.f * gqa * gka * LOG2E, M2c = 8.f * gqc * gkc * LOG2E;
            _Pragma("unroll 1") for (int rep = 0; rep < REP_ATT; ++rep) {
            if (PH(8)) _Pragma("unroll 1") for (int r2 = 0; r2 < REP_SWA; ++r2) for (int u = gw; u < BATCH * 8 * 64; u += NGW) { const int qt = u & 63, hc = (u >> 6) & 7, b = u >> 9;
                swa_unit(b, hc, qt, P, VT, OB, M2c, args.in[11][l * 8 + hc] * LOG2E, gout + (8 + hc) * 64, lane); }
            if (PH(9)) _Pragma("unroll 1") for (int r2 = 0; r2 < REP_SB; ++r2) for (int u = gw; u < BATCH * 4 * 64; u += NGW) { const int qt = u & 63, hb = (u >> 6) & 3, b = u >> 8;
                sb_unit(b, hb, qt, P, VT, OB, gout + (4 + hb) * 64, lane); }
            if (PH(10)) _Pragma("unroll 1") for (int r2 = 0; r2 < REP_DSA; ++r2) dsa_phase(P, VT, WI, OB, gout, M2a, ctl + CW_QUEUE + 64 * l + 16 * rep + 4 * r2, lds, tid, lane, wave);
            }
        }
        SEAM(s0 + 2);
        if (PH(4) && IN(s0 + 3)) _Pragma("unroll 1") for (int rep = 0; rep < REP_G4; ++rep) {
            pg8::Gemm g{OB, wl + W_O / 2, MROWS, DM, DM}; pg8::StaticOrder S; S.init(MROWS, DM, G, (int)blockIdx.x);
            pg8::EpiResid E{xin, rep ? (float*)(ws + WS_DUMMY) : xout, modl + 2 * DM, rep ? (bf16_t*)(ws + WS_DUMMY) : H, args.in[3] + l * DM, modl + 4 * DM, rep ? (float*)(ws + WS_DUMMY) : SS, 1};
            pg8::gemm_phase<pg8::EpiResid, pg8::StaticOrder, true, true>(lds, g, S, E);
        }
        SEAM(s0 + 3);
        if (PH(6) && IN(s0 + 4)) _Pragma("unroll 1") for (int rep = 0; rep < REP_G6; ++rep) {
            pg8::Gemm g{H, wl + W_GU / 2, MROWS, NGU, DM}; pg8::StaticOrder S; S.init(MROWS, NGU, G, (int)blockIdx.x);
            pg8::EpiSwiGLU E{ACT, SS, BG + (size_t)l * BATCH * DFF, BU + (size_t)l * BATCH * DFF};
            pg8::gemm_phase<pg8::EpiSwiGLU, pg8::StaticOrder, true, true>(lds, g, S, E);
        }
        SEAM(s0 + 4);
        if (PH(7) && IN(s0 + 5)) _Pragma("unroll 1") for (int rep = 0; rep < REP_G7; ++rep) {
            pg8::Gemm g{ACT, wl + W_D / 2, MROWS, DM, DFF}; pg8::StaticOrder S; S.init(MROWS, DM, G, (int)blockIdx.x);
            const int ln = (l + 1 < DEPTH) ? l + 1 : l;
            pg8::EpiResid E{xout, rep ? (float*)(ws + WS_DUMMY) : xout, modl + 5 * DM, rep ? (bf16_t*)(ws + WS_DUMMY) : H, args.in[2] + ln * DM, mod + (size_t)ln * BATCH * 6144 + DM, rep ? (float*)(ws + WS_DUMMY) : SS, (l + 1 < DEPTH) ? 1 : 0};
            pg8::gemm_phase<pg8::EpiResid, pg8::StaticOrder, true, true>(lds, g, S, E);
        }
        SEAM(s0 + 5);
    }
#undef IN
#undef SEAM
}

extern "C" void kernel_launch(void* const* d_in, const int* in_sizes, int n_in, void* d_out, int out_size, void* d_ws, size_t ws_size, hipStream_t stream) {
    static int grid = 0;
    if (grid == 0) {
        if (n_in != 17 || in_sizes[0] != MROWS * DM || out_size != MROWS * DM || ws_size < WS_END) {
            fprintf(stderr, "kernel_launch: unexpected problem (n_in %d, in0 %d, out %d, ws %zu); nothing launched\n", n_in, n_in > 0 ? in_sizes[0] : -1, out_size, ws_size); grid = -1; return; }
        int dev = 0, cus = 0, per_cu = 0;
        if (hipGetDevice(&dev) != hipSuccess || hipDeviceGetAttribute(&cus, hipDeviceAttributeMultiprocessorCount, dev) != hipSuccess) { grid = -1; return; }
        if (hipFuncSetAttribute((const void*)fwd, hipFuncAttributeMaxDynamicSharedMemorySize, LDS_BYTES) != hipSuccess) { fprintf(stderr, "kernel_launch: hipFuncSetAttribute failed\n"); grid = -1; return; }
        if (hipOccupancyMaxActiveBlocksPerMultiprocessor(&per_cu, (const void*)fwd, NWAVES * 64, LDS_BYTES) != hipSuccess || per_cu < 1) {
            fprintf(stderr, "kernel_launch: occupancy query reports %d workgroups per CU\n", per_cu); per_cu = 1; }
        (void)hipGetLastError();
        grid = cus;
    }
    if (grid < 0) return;
    if (hipMemsetAsync((char*)d_ws + WS_CTL, 0, CTL_BYTES, stream) != hipSuccess) return;
    Args a{};
    for (int i = 0; i < 17; ++i) a.in[i] = (const float*)d_in[i];
    a.out = (float*)d_out; a.ws = (unsigned char*)d_ws;
#if MK_MULTI
    for (int s = 0; s < NSTEPS; ++s) { a.lo = s; a.hi = s + 1; hipLaunchKernelGGL(fwd, dim3(grid), dim3(NWAVES * 64), LDS_BYTES, stream, a); }
#else
    a.lo = 0; a.hi = NSTEPS;
    hipLaunchKernelGGL(fwd, dim3(grid), dim3(NWAVES * 64), LDS_BYTES, stream, a);
#endif
}
```

```cpp
#include <hip/hip_runtime.h>
#include <cstdio>
#include <cstdint>

#ifndef MK_MULTI
#define MK_MULTI 0
#endif

#define LAS __attribute__((address_space(3)))
#define GAS __attribute__((address_space(1)))
namespace pg8 {
#define PG8_LAS __attribute__((address_space(3)))
typedef unsigned short bf16_t;
typedef short bf16x8 __attribute__((ext_vector_type(8)));
typedef float f32x4 __attribute__((ext_vector_type(4)));
typedef unsigned u32x4 __attribute__((ext_vector_type(4)));
constexpr int BM = 256, BK = 64, HALF = 128, HTB = HALF * BK * 2  , STAGE_BYTES = 8 * HTB, NXCD = 8, WGM = 8;

__host__ __device__ __forceinline__ int lds_byte(int r, int c) { const int st = (r >> 4) * 2 + (c >> 5), rr = r & 15, cc = c & 31, ob = rr * 64 + cc * 2; return st * 1024 + (ob ^ (((ob >> 9) & 1) << 5)); }
__host__ __device__ __forceinline__ void stage_rc(int b, int& R, int& C) { const int st = b / 1024, sb = b % 1024, swz = sb ^ (((sb >> 9) & 1) << 5); R = (st >> 1) * 16 + swz / 64; C = (st & 1) * 32 + (swz % 64) / 2; }
__host__ __device__ __forceinline__ int perm32(int rho) { const int n = rho >> 4, i = rho & 15; return 8 * (i >> 2) + 4 * n + (i & 3); }

struct Unit { int pm, pn; };
struct Gemm { const bf16_t* A; const bf16_t* Bt; int M, N, K; };

struct StaticOrder {
    int nM, nN, nwg, G, c;
    __host__ __device__ void init(int M, int N, int G_, int c_) { nM = M / BM; nN = N / BM; nwg = nM * nN; G = G_; c = c_; }
    __host__ __device__ bool next(int i, Unit& u) const {
        const long L = (long)i * G + c; if (L >= nwg) return false;
        int wgid = (int)L; { const int q = nwg / NXCD, r = nwg % NXCD, xcd = wgid % NXCD, off = wgid / NXCD; wgid = (xcd < r ? xcd * (q + 1) : r * (q + 1) + (xcd - r) * q) + off; }
        const int nig = WGM * nN, gid = wgid / nig, fm = gid * WGM, gsz = (nM - fm) < WGM ? (nM - fm) : WGM;
        u.pm = fm + ((wgid % nig) % gsz); u.pn = (wgid % nig) / gsz; return true;
    }
    __device__ __forceinline__ void a_ready(const Unit&) const {}
    __device__ __forceinline__ void done(const Unit&) const {}
};
#ifndef RELAX_V
#define RELAX_V 1
#endif
template <class Epi, class Sched, bool ALIGN_EPI = false, bool SP2 = false>
__device__ __forceinline__ void gemm_phase(PG8_LAS unsigned char* lds, const Gemm g, const Sched& S, const Epi& E) {
    int tid_o = threadIdx.x; asm volatile("" : "+v"(tid_o));
    const int tid = tid_o, wid = __builtin_amdgcn_readfirstlane(tid >> 6), lane = tid & 63, wr = wid >> 2, wc = wid & 3, fr = lane & 15, fq = lane >> 4;
    const int K = g.K, nt = K / BK;
    unsigned voffA[2], voffB[2];
#pragma unroll
    for (int i = 0; i < 2; ++i) { int R, C; stage_rc(tid * 16 + i * 8192, R, C); const int Rb = Epi::PERM ? ((R & ~31) + perm32(R & 31)) : R;
        voffA[i] = (unsigned)(R * K + C) * 2u; voffB[i] = (unsigned)(Rb * K + C) * 2u; }
    const size_t kstep = (size_t)(BK * 2);
    const size_t hstep = (size_t)HALF * K * 2;
    const size_t tstep = 2 * hstep;
    const unsigned ldsw = (unsigned)wid * 1024u;
    const int aoff = lds_byte(wr * 64 + fr, fq * 8), boff = lds_byte(wc * 32 + fr, fq * 8);
#define PG8_SA(b, h) (((b) * 2 + (h)) * HTB)
#define PG8_SB(b, h) ((4 + (b) * 2 + (h)) * HTB)
#define PG8_STAGE(bufoff, gbase, voff) do { _Pragma("unroll") for (int _i = 0; _i < 2; ++_i) \
        __builtin_amdgcn_global_load_lds((const unsigned*)((const char*)(gbase) + (voff)[_i]), (PG8_LAS unsigned*)(lds + (bufoff) + ldsw + _i * 8192), 16, 0, 0); } while (0)
#define PG8_LDA(dst, b, h) do { _Pragma("unroll") for (int m = 0; m < 4; ++m) _Pragma("unroll") for (int k = 0; k < 2; ++k) dst[m][k] = *(const PG8_LAS bf16x8*)(lds + PG8_SA(b, h) + aoff + m * 2048 + k * 1024); } while (0)
#define PG8_LDB(dst, b, h) do { _Pragma("unroll") for (int n = 0; n < 2; ++n) _Pragma("unroll") for (int k = 0; k < 2; ++k) dst[n][k] = *(const PG8_LAS bf16x8*)(lds + PG8_SB(b, h) + boff + n * 2048 + k * 1024); } while (0)
#define PG8_MMA(ai, bj, At, Bt) do { __builtin_amdgcn_s_setprio(1); _Pragma("unroll") for (int m = 0; m < 4; ++m) _Pragma("unroll") for (int n = 0; n < 2; ++n) _Pragma("unroll") for (int k = 0; k < 2; ++k) \
        acc[ai][bj][m][n] = __builtin_amdgcn_mfma_f32_16x16x32_bf16(Bt[n][k], At[m][k], acc[ai][bj][m][n], 0, 0, 0); __builtin_amdgcn_s_setprio(0); } while (0)
#define PG8_WAIT_V(n) asm volatile("s_waitcnt vmcnt(" #n ")" ::: "memory")
#define PG8_WAIT_L(n) asm volatile("s_waitcnt lgkmcnt(" #n ")" ::: "memory")
#define PG8_BAR __builtin_amdgcn_s_barrier()
#define PG8_SCHED __builtin_amdgcn_sched_barrier(0)
    Unit cur, nxt; int ui = 0;
    if (!S.next(0, cur)) return;
    f32x4 acc[2][2][4][2];
#pragma unroll
    for (int a = 0; a < 2; ++a)
#pragma unroll
        for (int b = 0; b < 2; ++b)
#pragma unroll
            for (int m = 0; m < 4; ++m)
#pragma unroll
                for (int n = 0; n < 2; ++n) acc[a][b][m][n] = (f32x4){0.f, 0.f, 0.f, 0.f};
    bf16x8 At[4][2], B0[2][2], B1[2][2];
    const char* cA = (const char*)g.A + (size_t)cur.pm * tstep; const char* cB = (const char*)g.Bt + (size_t)cur.pn * tstep;
    S.a_ready(cur);
    if constexpr (SP2) {
        PG8_STAGE(PG8_SB(0, 0), cB, voffB); PG8_STAGE(PG8_SB(0, 1), cB + hstep, voffB); PG8_STAGE(PG8_SA(0, 0), cA, voffA); PG8_STAGE(PG8_SA(0, 1), cA + hstep, voffA);
        if (wr == 1) PG8_BAR;
        PG8_WAIT_V(2); PG8_BAR;
        PG8_STAGE(PG8_SB(1, 0), cB + kstep, voffB); PG8_STAGE(PG8_SA(1, 0), cA + kstep, voffA); PG8_STAGE(PG8_SB(1, 1), cB + hstep + kstep, voffB);
        PG8_WAIT_V(6); PG8_BAR;
    } else {
        PG8_STAGE(PG8_SB(0, 0), cB, voffB); PG8_STAGE(PG8_SA(0, 0), cA, voffA); PG8_STAGE(PG8_SB(0, 1), cB + hstep, voffB); PG8_STAGE(PG8_SA(0, 1), cA + hstep, voffA);
        if (wr == 1) PG8_BAR;
        PG8_WAIT_V(4); PG8_BAR;
        PG8_STAGE(PG8_SB(1, 0), cB + kstep, voffB); PG8_STAGE(PG8_SA(1, 0), cA + kstep, voffA); PG8_STAGE(PG8_SB(1, 1), cB + hstep + kstep, voffB);
        PG8_WAIT_V(6); PG8_BAR;
    }
    for (;;) {
        const bool has_next = S.next(ui + 1, nxt);
        const char* nA = has_next ? (const char*)g.A + (size_t)nxt.pm * tstep : cA; const char* nB = has_next ? (const char*)g.Bt + (size_t)nxt.pn * tstep : cB;
        for (int t = 0; t < nt; t += 2) {
            const bool last = (t == nt - 2);
            const char* a1 = cA + (size_t)(t + 1) * kstep;
            const char* a2 = last ? nA : cA + (size_t)(t + 2) * kstep; const char* b2 = last ? nB : cB + (size_t)(t + 2) * kstep;
            const char* a3 = a2 + kstep; const char* b3 = b2 + kstep;
            if (last && has_next) S.a_ready(nxt);
            if constexpr (SP2) {
            PG8_LDB(B0, 0, 0); PG8_LDB(B1, 0, 1); PG8_SCHED; PG8_LDA(At, 0, 0); PG8_STAGE(PG8_SA(1, 1), a1 + hstep, voffA);
            if constexpr (RELAX_V != 0) { const int rlx = __builtin_amdgcn_readfirstlane((t == 0 && ui > 0) ? 1 : 0);
                asm volatile("s_cmp_lg_u32 %0, 0\n\ts_cbranch_scc1 .Lrlx%=\n\ts_waitcnt vmcnt(8)\n.Lrlx%=:\n\ts_waitcnt vmcnt(%1)" :: "s"(rlx), "n"(8 + Epi::NVM) : "memory", "scc"); }
            else PG8_WAIT_V(8);
            PG8_WAIT_L(0); PG8_BAR; PG8_MMA(0, 0, At, B0); PG8_MMA(0, 1, At, B1); PG8_BAR; PG8_SCHED;
            PG8_LDA(At, 0, 1); PG8_STAGE(PG8_SB(0, 0), b2, voffB); PG8_STAGE(PG8_SB(0, 1), b2 + hstep, voffB); PG8_STAGE(PG8_SA(0, 0), a2, voffA);
            PG8_WAIT_V(8); PG8_WAIT_L(0); PG8_BAR; PG8_MMA(1, 0, At, B0); PG8_MMA(1, 1, At, B1); PG8_BAR; PG8_SCHED;
            PG8_LDB(B0, 1, 0); PG8_LDB(B1, 1, 1); PG8_SCHED; PG8_LDA(At, 1, 0); PG8_STAGE(PG8_SA(0, 1), a2 + hstep, voffA);
            PG8_WAIT_V(8); PG8_WAIT_L(0); PG8_BAR; PG8_MMA(0, 0, At, B0); PG8_MMA(0, 1, At, B1); PG8_BAR; PG8_SCHED;
            PG8_LDA(At, 1, 1); PG8_STAGE(PG8_SB(1, 0), b3, voffB); PG8_STAGE(PG8_SB(1, 1), b3 + hstep, voffB); PG8_STAGE(PG8_SA(1, 0), a3, voffA);
            PG8_WAIT_V(8); PG8_WAIT_L(0); PG8_BAR; PG8_MMA(1, 0, At, B0); PG8_MMA(1, 1, At, B1); PG8_BAR; PG8_SCHED;
            } else {
            PG8_LDB(B0, 0, 0); PG8_SCHED; PG8_LDA(At, 0, 0); PG8_STAGE(PG8_SA(1, 1), a1 + hstep, voffA);
            PG8_WAIT_L(8); PG8_BAR; PG8_WAIT_L(0); PG8_MMA(0, 0, At, B0); PG8_BAR; PG8_SCHED;
            PG8_LDB(B1, 0, 1); PG8_STAGE(PG8_SB(0, 0), b2, voffB);
            PG8_BAR; PG8_WAIT_L(0); PG8_MMA(0, 1, At, B1); PG8_BAR;
            PG8_LDA(At, 0, 1); PG8_STAGE(PG8_SA(0, 0), a2, voffA);
            PG8_BAR; PG8_WAIT_L(0); PG8_MMA(1, 0, At, B0); PG8_BAR; PG8_SCHED;
            PG8_STAGE(PG8_SB(0, 1), b2 + hstep, voffB);
            PG8_WAIT_V(6); PG8_BAR; PG8_MMA(1, 1, At, B1); PG8_BAR;
            PG8_LDB(B0, 1, 0); PG8_SCHED; PG8_LDA(At, 1, 0); PG8_STAGE(PG8_SA(0, 1), a2 + hstep, voffA);
            PG8_WAIT_L(8); PG8_BAR; PG8_WAIT_L(0); PG8_MMA(0, 0, At, B0); PG8_BAR; PG8_SCHED;
            PG8_LDB(B1, 1, 1); PG8_STAGE(PG8_SB(1, 0), b3, voffB);
            PG8_BAR; PG8_WAIT_L(0); PG8_MMA(0, 1, At, B1); PG8_BAR;
            PG8_LDA(At, 1, 1); PG8_STAGE(PG8_SA(1, 0), a3, voffA);
            PG8_BAR; PG8_WAIT_L(0); PG8_MMA(1, 0, At, B0); PG8_BAR; PG8_SCHED;
            PG8_STAGE(PG8_SB(1, 1), b3 + hstep, voffB);
            PG8_WAIT_V(6); PG8_BAR; PG8_MMA(1, 1, At, B1); PG8_BAR;
            }
        }
        if constexpr (ALIGN_EPI) { if (wr == 0) PG8_BAR; }
        if constexpr (!Epi::AFTER_DRAIN) { E(acc, cur, wr, wc, fr, fq); S.done(cur); }
        if (!has_next) break;
#pragma unroll
        for (int a = 0; a < 2; ++a)
#pragma unroll
            for (int b = 0; b < 2; ++b)
#pragma unroll
                for (int m = 0; m < 4; ++m)
#pragma unroll
                    for (int n = 0; n < 2; ++n) acc[a][b][m][n] = (f32x4){0.f, 0.f, 0.f, 0.f};
        cur = nxt; cA = nA; cB = nB; ++ui;
        if constexpr (ALIGN_EPI) { if (wr == 1) PG8_BAR; }
    }
    PG8_WAIT_V(0);
    if constexpr (!ALIGN_EPI) { if (wr == 0) PG8_BAR; }
    PG8_BAR;
    if constexpr (Epi::AFTER_DRAIN) { E.fused(acc, cur, wr, wc, fr, fq, lds, wid, lane); S.done(cur); }
#undef PG8_SA
#undef PG8_SB
#undef PG8_STAGE
#undef PG8_LDA
#undef PG8_LDB
#undef PG8_MMA
#undef PG8_WAIT_V
#undef PG8_WAIT_L
#undef PG8_BAR
#undef PG8_SCHED
}
}

#define XB_TMO      128
#define XB_XCNT(j)  (256  + 64 * (j))
#define XB_XSUB(j)  (1280 + 64 * (j))
#define XB_XGEN(j)  (2304 + 64 * (j))
#define XB_TOP      3328
#define XB_TOPGEN   3392
#define XCD_BAR_WORDS 3456
#define XB_SPIN_CAP (1u << 24)

__device__ __forceinline__ unsigned xb_ld(unsigned* p)              { return __hip_atomic_load(p, __ATOMIC_RELAXED, __HIP_MEMORY_SCOPE_AGENT); }
__device__ __forceinline__ unsigned xb_add(unsigned* p, unsigned v) { return __hip_atomic_fetch_add(p, v, __ATOMIC_RELAXED, __HIP_MEMORY_SCOPE_AGENT); }
__device__ __forceinline__ unsigned xb_xcc_id() { return (unsigned)__builtin_amdgcn_s_getreg((3 << 11) | 20) & 0xFu; }
#define XB_SPIN(cond, bar) do { unsigned _sp = 0; while (cond) { __builtin_amdgcn_s_sleep(1); \
    if ((++_sp & 255u) == 0u) { if (xb_ld(&(bar)[XB_TMO])) break; if (_sp > XB_SPIN_CAP) { atomicAdd(&(bar)[XB_TMO], 1u); break; } } } } while (0)

struct XcdBarrier {
    unsigned* bar; unsigned x;
    volatile LAS unsigned* st;
};

__device__ __forceinline__ XcdBarrier xcd_barrier_post(unsigned* bar, volatile LAS unsigned* st) {
    XcdBarrier b; b.bar = bar; b.x = xb_xcc_id(); b.st = st;
    if (threadIdx.x == 0) (void)xb_add(&bar[XB_XCNT(b.x)], 1u);
    return b;
}
__device__ __forceinline__ void xcd_barrier_complete(unsigned* bar, unsigned x, unsigned& nloc, unsigned& nx) {
    const unsigned G = gridDim.x * gridDim.y * gridDim.z;
    unsigned sum, cnt, mine, sp = 0u;
    for (;;) {
        sum = 0u; cnt = 0u; mine = 0u;
#pragma unroll
        for (unsigned j = 0; j < 16; ++j) { const unsigned c = xb_ld(&bar[XB_XCNT(j)]); sum += c; cnt += (c > 0u) ? 1u : 0u; mine = (j == x) ? c : mine; }
        if (sum == G) break;
        __builtin_amdgcn_s_sleep(1);
        if ((++sp & 255u) == 0u) { if (xb_ld(&bar[XB_TMO])) break; if (sp > XB_SPIN_CAP) { atomicAdd(&bar[XB_TMO], 1u); break; } }
    }
    nloc = mine > 0u ? mine : 1u; nx = cnt > 0u ? cnt : 1u;
}

__device__ __forceinline__ void xcd_barrier(const XcdBarrier& b) {
    asm volatile("s_waitcnt vmcnt(0)" ::: "memory");
    __syncthreads();
    if (threadIdx.x == 0) {
        unsigned* bar = b.bar;
        __builtin_amdgcn_s_waitcnt(0);
        unsigned nloc = b.st[0], nx = b.st[1];
        if (nloc == 0u) { xcd_barrier_complete(bar, b.x, nloc, nx); b.st[0] = nloc; b.st[1] = nx; }
        const unsigned old = xb_add(&bar[XB_XSUB(b.x)], 1u);
        const unsigned gen = old / nloc;
        if (old + 1u == (gen + 1u) * nloc) {
            __builtin_amdgcn_fence(__ATOMIC_RELEASE, "agent");
            asm volatile("s_waitcnt vmcnt(0)" ::: "memory");
            const unsigned og = xb_add(&bar[XB_TOP], 1u);
            const unsigned tg = og / nx;
            if (og + 1u == (tg + 1u) * nx) xb_add(&bar[XB_TOPGEN], 1u);
            else XB_SPIN(xb_ld(&bar[XB_TOPGEN]) == tg, bar);
            __builtin_amdgcn_fence(__ATOMIC_ACQUIRE, "agent");
            xb_add(&bar[XB_XGEN(b.x)], 1u);
            asm volatile("s_waitcnt vmcnt(0)" ::: "memory");
        } else {
            XB_SPIN(xb_ld(&bar[XB_XGEN(b.x)]) == gen, bar);
            __builtin_amdgcn_fence(__ATOMIC_ACQUIRE, "agent");
            asm volatile("s_waitcnt vmcnt(0)" ::: "memory");
        }
    }
    __syncthreads();
}

#define LAS __attribute__((address_space(3)))
#define GAS __attribute__((address_space(1)))
typedef unsigned short bf16_t;
typedef short bf16x8 __attribute__((ext_vector_type(8)));
typedef float f32x4 __attribute__((ext_vector_type(4)));
typedef float f32x2 __attribute__((ext_vector_type(2)));
typedef float f32x16 __attribute__((ext_vector_type(16)));
typedef unsigned u32x4 __attribute__((ext_vector_type(4)));
typedef unsigned u32x2 __attribute__((ext_vector_type(2)));
typedef __bf16 bf16x2v __attribute__((ext_vector_type(2)));

constexpr int NWAVES = 8;
constexpr int BATCH = 32, SEQ = 2048, DM = 1024, DEPTH = 4, MROWS = BATCH * SEQ;
constexpr int NIN = 2304, INCOLS = 2244, DFF = 2816, NGU = 2 * DFF, NVS = 7;
constexpr float EPS = 1e-6f, LOG2E = 1.4426950408889634f, C2 = 0.18033688011112042f;
constexpr int NSTEPS = 2 + 5 * DEPTH;
#ifndef PHMASK
#define PHMASK 0xffff
#endif
#define PH(i) ((PHMASK >> (i)) & 1)
#ifndef DSA_S
#define DSA_S 15
#endif
#ifndef REP_ATT
#define REP_ATT 1
#endif
#ifndef REP_SWA
#define REP_SWA 1
#endif
#ifndef REP_SB
#define REP_SB 1
#endif
#ifndef REP_DSA
#define REP_DSA 1
#endif
#ifndef DSA_R1
#define DSA_R1 1
#endif
#ifndef DSA_R2
#define DSA_R2 1
#endif
#ifndef DSA_R3
#define DSA_R3 1
#endif
#ifndef REP_BIS
#define REP_BIS 1
#endif
#ifndef REP_PA
#define REP_PA 1
#endif
#ifndef REP_PB
#define REP_PB 1
#endif
#ifndef TEST_SELN
#define TEST_SELN 2
#endif
#ifndef STAG_O
#define STAG_O 0
#endif
#ifndef STAG_D
#define STAG_D 0
#endif
#ifndef STAG_I
#define STAG_I 0
#endif
#ifndef REP_G
#define REP_G 1
#endif
#ifndef REP_G2
#define REP_G2 REP_G
#endif
#ifndef REP_G4
#define REP_G4 REP_G
#endif
#ifndef REP_G6
#define REP_G6 REP_G
#endif
#ifndef REP_G7
#define REP_G7 REP_G
#endif
#ifndef REP_N
#define REP_N 1
#endif

constexpr size_t MiB = 1u << 20;
constexpr size_t WS_CTL = 0, CTL_BYTES = MiB;
constexpr size_t WS_ROPE = 1 * MiB;
constexpr size_t WS_MOD = 2 * MiB;
constexpr size_t WS_WI = 5 * MiB;
constexpr size_t WS_W = 8 * MiB, W_LAYER = 23 * MiB;
constexpr size_t W_IN = 0, W_O = 4608 * 1024, W_GU = W_O + 2 * MiB, W_D = W_GU + 11 * MiB;
constexpr size_t WS_H = 104 * MiB;
constexpr size_t WS_ACT = 232 * MiB;
constexpr size_t WS_P = WS_ACT;
constexpr size_t WS_VT = WS_ACT + 288 * MiB;
constexpr size_t WS_O = 584 * MiB;
constexpr size_t WS_SS = 712 * MiB;
constexpr size_t WS_B1 = 716 * MiB;
constexpr size_t WS_BG = 718 * MiB, WS_BU = 720 * MiB;
constexpr size_t WS_X16 = 724 * MiB;
constexpr size_t WS_END = 852 * MiB, WS_DUMMY = 852 * MiB;
static_assert(W_D + (size_t)DM * DFF * 2 <= W_LAYER && WS_W + DEPTH * W_LAYER <= WS_H && WS_VT + (size_t)BATCH * NVS * 64 * SEQ * 2 <= WS_END, "ws map");
static_assert((size_t)MROWS * NIN * 2 == 288 * MiB && (size_t)MROWS * DFF * 2 == 352 * MiB, "ws map 2");

constexpr int CW_BAR = 4096, CW_QUEUE = 8192;

constexpr int SC_STRIDE = 2052;
constexpr int SCH = 2056;
constexpr int G2_SC = 0;
constexpr int G2_MASK = 16 * SCH * 2, MASK_STRIDE = 66;
constexpr int G2_LSUM = G2_MASK + 16 * MASK_STRIDE * 4;
constexpr int G2_SSUM = G2_LSUM + 1024;
constexpr int G2_BYTES = G2_SSUM + 1024;
constexpr int LDS_MISC = 2 * G2_BYTES;
constexpr int LDS_BYTES = 147456;
static_assert(LDS_MISC + 64 <= LDS_BYTES && 4 * 64 * 64 * 4 <= G2_MASK && (G2_BYTES % 16) == 0 && LDS_MISC >= 131072 + 4096, "lds map");

#define LDS_WAIT() asm volatile("s_waitcnt lgkmcnt(0)" ::: "memory")
__device__ __forceinline__ unsigned cvtpk(float lo, float hi) { f32x2 v = {lo, hi}; bf16x2v b = __builtin_convertvector(v, bf16x2v); return __builtin_bit_cast(unsigned, b); }
__device__ __forceinline__ bf16x8 ldg16(const bf16_t* p) { return *(const GAS bf16x8*)p; }
__device__ __forceinline__ float ex2(float x) { return __builtin_amdgcn_exp2f(x); }
__device__ __forceinline__ float lg2(float x) { return __builtin_amdgcn_logf(x); }
__device__ __forceinline__ int crow(int i, int h) { return (i & 3) + 8 * (i >> 2) + 4 * h; }
#define MFMA32(a, b, c) __builtin_amdgcn_mfma_f32_32x32x16_bf16((a), (b), (c), 0, 0, 0)
#define MFMA16(a, b, c) __builtin_amdgcn_mfma_f32_16x16x32_bf16((a), (b), (c), 0, 0, 0)
__device__ __forceinline__ bf16x8 pack8(const f32x16& x, int s) {
    u32x4 p; p.x = cvtpk(x[8 * s], x[8 * s + 1]); p.y = cvtpk(x[8 * s + 2], x[8 * s + 3]); p.z = cvtpk(x[8 * s + 4], x[8 * s + 5]); p.w = cvtpk(x[8 * s + 6], x[8 * s + 7]);
    return __builtin_bit_cast(bf16x8, p);
}
__device__ __forceinline__ f32x16 zero16() { f32x16 z; for (int i = 0; i < 16; ++i) z[i] = 0.f; return z; }
__device__ __forceinline__ int wsum_i(int v) {
    v += __builtin_amdgcn_update_dpp(0, v, 0x111, 0xf, 0xf, false);
    v += __builtin_amdgcn_update_dpp(0, v, 0x112, 0xf, 0xf, false);
    v += __builtin_amdgcn_update_dpp(0, v, 0x114, 0xf, 0xf, false);
    v += __builtin_amdgcn_update_dpp(0, v, 0x118, 0xf, 0xf, false);
    v += __builtin_amdgcn_update_dpp(0, v, 0x142, 0xa, 0xf, false);
    v += __builtin_amdgcn_update_dpp(0, v, 0x143, 0xc, 0xf, false);
    return __builtin_amdgcn_readlane(v, 63);
}
__device__ __forceinline__ void stagger(unsigned ticks) {
    const unsigned g = blockIdx.x & 3u;
    if (ticks && g) { const unsigned long long t0 = __builtin_amdgcn_s_memrealtime(); while (__builtin_amdgcn_s_memrealtime() - t0 < (unsigned long long)(g * ticks)) __builtin_amdgcn_s_sleep(8); }
}
__device__ __forceinline__ float wave_max(float v) {
#pragma unroll
    for (int o = 1; o < 64; o <<= 1) v = fmaxf(v, __shfl_xor(v, o));
    return v;
}
__device__ __forceinline__ float wave_sum(float v) {
#pragma unroll
    for (int o = 1; o < 64; o <<= 1) v += __shfl_xor(v, o);
    return v;
}

__device__ __forceinline__ int slot_col(int s) {
    if (s < 4) return 64 * s;
    if (s < 8) return 384 + 64 * (s - 4);
    if (s == 8) return 256;
    if (s == 9) return 320;
    if (s == 10) return 640;
    if (s == 11) return 704;
    if (s < 16) return 708 + 64 * (s - 12);
    if (s < 20) return 964 + 64 * (s - 16);
    if (s < 24) return 1220 + 64 * (s - 20);
    if (s < 32) return 1476 + 64 * (s - 24);
    if (s < 34) return 1988 + 64 * (s - 32);
    return 2116 + 64 * (s - 34);
}

namespace pg8 {
struct EpiInProj {
    static constexpr bool PERM = true, AFTER_DRAIN = false;
    static constexpr int NVM = 16;
    bf16_t* P; bf16_t* VT; float* WI; const float* cs; const float* sn; const float* qn_a; const float* kn_a; const float* qn_c; const float* kn_c;
    const float* SS; const float* bias;
    LAS float* xl;
    __device__ __forceinline__ void operator()(const f32x4 (&acc)[2][2][4][2], const Unit& u, int wr, int wc, int fr, int fq) const {
        const int slot = u.pn * 4 + wc;
        int mode = 0; const float* gain = nullptr; float osc = 1.f; int vslot = 0;
        if (slot < 4) { mode = 2; gain = qn_a; osc = C2; }
        else if (slot < 8) { mode = 1; }
        else if (slot == 8) { mode = 2; gain = kn_a; }
        else if (slot == 9) { mode = 3; vslot = 0; }
        else if (slot == 10) { mode = 1; }
        else if (slot == 11) { mode = 4; }
        else if (slot < 16) { mode = 0; osc = C2; }
        else if (slot < 20) { mode = 0; }
        else if (slot < 24) { mode = 3; vslot = 1 + (slot - 20); }
        else if (slot < 32) { mode = 2; gain = qn_c; osc = C2; }
        else if (slot < 34) { mode = 2; gain = kn_c; }
        else { mode = 3; vslot = 5 + (slot - 34); }
        const int rowt = u.pm * BM + wr * 64 + fr;
        const int b = rowt / SEQ; const int tt = rowt % SEQ;
        const int pfr = (fr & 3) | ((fr & 4) << 1) | ((fr & 8) >> 1);
        bf16_t* vb = VT + ((size_t)(b * NVS + vslot) * 64) * SEQ;
        float rsv[2][4];
        LAS float* wl = xl + (wr * 4 + wc) * 128;
        LAS float* wb = wl + 8 * fq; LAS float* wg = wl + 64 + 8 * fq;
        f32x4 rc[2], rsn[2];
        { f32x4 p4[2][4];
#pragma unroll
          for (int ai = 0; ai < 2; ++ai)
#pragma unroll
              for (int m = 0; m < 4; ++m) p4[ai][m] = *(const f32x4*)(SS + (size_t)(rowt + ai * HALF + m * 16) * 16 + 4 * fq);
          const int l64 = fr + 16 * fq;
          const float bval = bias[(size_t)((u.pm * BM) / SEQ) * NIN + slot_col(slot) + l64], gval = (mode == 2) ? gain[l64] : 1.f;
          if (mode == 1 || mode == 2) { const int t = rowt % SEQ;
#pragma unroll
              for (int n = 0; n < 2; ++n) { rc[n] = *(const f32x4*)(cs + t * 32 + 8 * fq + 4 * n); rsn[n] = *(const f32x4*)(sn + t * 32 + 8 * fq + 4 * n); } }
          wl[l64] = bval; wl[64 + l64] = gval;
#pragma unroll
          for (int ai = 0; ai < 2; ++ai)
#pragma unroll
              for (int m = 0; m < 4; ++m) { float sq = (p4[ai][m][0] + p4[ai][m][1]) + (p4[ai][m][2] + p4[ai][m][3]); sq += __shfl_xor(sq, 16); sq += __shfl_xor(sq, 32);
                  rsv[ai][m] = __builtin_amdgcn_rsqf(sq * (1.f / DM) + EPS); } }
        asm volatile("" ::: "memory");
#define ADJ_ROW(AI, M) const float rs = rsv[AI][M]; \
                f32x4 v1[2] = {acc[AI][0][M][0] * rs + *(LAS f32x4*)(wb), acc[AI][0][M][1] * rs + *(LAS f32x4*)(wb + 4)}, v2[2] = {acc[AI][1][M][0] * rs + *(LAS f32x4*)(wb + 32), acc[AI][1][M][1] * rs + *(LAS f32x4*)(wb + 36)}
#define STORE_ROW(ROW) do { u32x4 w1, w2; \
                w1.x = cvtpk(v1[0][0] * osc, v1[0][1] * osc); w1.y = cvtpk(v1[0][2] * osc, v1[0][3] * osc); w1.z = cvtpk(v1[1][0] * osc, v1[1][1] * osc); w1.w = cvtpk(v1[1][2] * osc, v1[1][3] * osc); \
                w2.x = cvtpk(v2[0][0] * osc, v2[0][1] * osc); w2.y = cvtpk(v2[0][2] * osc, v2[0][3] * osc); w2.z = cvtpk(v2[1][0] * osc, v2[1][1] * osc); w2.w = cvtpk(v2[1][2] * osc, v2[1][3] * osc); \
                bf16_t* op = P + (size_t)(ROW) * NIN + slot * 64 + 8 * fq; *(u32x4*)op = w1; *(u32x4*)(op + 32) = w2; } while (0)
        if (mode == 3) {
#pragma unroll
            for (int ai = 0; ai < 2; ++ai)
#pragma unroll
                for (int m = 0; m < 4; ++m) { ADJ_ROW(ai, m);
                    const unsigned voff = (unsigned)(8 * fq * SEQ + (((tt + ai * HALF + m * 16) & ~15) + pfr));
#pragma unroll
                    for (int n = 0; n < 2; ++n)
#pragma unroll
                        for (int e = 0; e < 4; ++e) {
                            (vb + (4 * n + e) * SEQ)[voff] = (bf16_t)(cvtpk(v1[n][e], 0.f) & 0xffffu);
                            (vb + (32 + 4 * n + e) * SEQ)[voff] = (bf16_t)(cvtpk(v2[n][e], 0.f) & 0xffffu); }
                    asm volatile("" ::: "memory"); }
        } else if (mode == 4) {
#pragma unroll
            for (int ai = 0; ai < 2; ++ai)
#pragma unroll
                for (int m = 0; m < 4; ++m) { ADJ_ROW(ai, m); (void)v2; if (fq == 0) *(f32x4*)(WI + (size_t)(rowt + ai * HALF + m * 16) * 4) = v1[0]; asm volatile("" ::: "memory"); }
        } else if (mode == 0) {
#pragma unroll
            for (int ai = 0; ai < 2; ++ai)
#pragma unroll
                for (int m = 0; m < 4; ++m) { ADJ_ROW(ai, m); STORE_ROW(rowt + ai * HALF + m * 16); asm volatile("" ::: "memory"); }
        } else {
#pragma unroll
            for (int ai = 0; ai < 2; ++ai)
#pragma unroll
                for (int m = 0; m < 4; ++m) {
                    f32x4 nc[2], ns[2];
                    if ((ai * 4 + m) < 7) { const int k1 = ai * 4 + m + 1; const int t = (rowt + (k1 >> 2) * HALF + (k1 & 3) * 16) % SEQ;
#pragma unroll
                        for (int n = 0; n < 2; ++n) { nc[n] = *(const f32x4*)(cs + t * 32 + 8 * fq + 4 * n); ns[n] = *(const f32x4*)(sn + t * 32 + 8 * fq + 4 * n); } }
                    ADJ_ROW(ai, m);
                    if (mode == 2) {
                        float ss = 0.f;
#pragma unroll
                        for (int n = 0; n < 2; ++n)
#pragma unroll
                            for (int e = 0; e < 4; ++e) ss += v1[n][e] * v1[n][e] + v2[n][e] * v2[n][e];
                        ss += __shfl_xor(ss, 16); ss += __shfl_xor(ss, 32);
                        const float ri = __builtin_amdgcn_rsqf(ss * (1.f / 64.f) + EPS);
#pragma unroll
                        for (int n = 0; n < 2; ++n) { v1[n] = (v1[n] * ri) * *(LAS f32x4*)(wg + 4 * n); v2[n] = (v2[n] * ri) * *(LAS f32x4*)(wg + 32 + 4 * n); }
                    }
#pragma unroll
                    for (int n = 0; n < 2; ++n) { const f32x4 xa = v1[n], xb = v2[n]; v1[n] = xa * rc[n] - xb * rsn[n]; v2[n] = xb * rc[n] + xa * rsn[n]; }
                    STORE_ROW(rowt + ai * HALF + m * 16);
                    if ((ai * 4 + m) < 7) { rc[0] = nc[0]; rc[1] = nc[1]; rsn[0] = ns[0]; rsn[1] = ns[1]; }
                    asm volatile("" ::: "memory");
                }
        }
#undef ADJ_ROW
#undef STORE_ROW
    }
};
typedef _Float16 h16x8 __attribute__((ext_vector_type(8)));
typedef float f32x8 __attribute__((ext_vector_type(8)));
struct EpiResid {
    static constexpr bool PERM = true, AFTER_DRAIN = false;
    static constexpr int NVM = 36;
    const void* base; void* out; const float* gate;
    bf16_t* Hn; const float* lnn; const float* scn; float* SS; int do_next;
    int base_f32, out_f32;
    __device__ __forceinline__ void operator()(const f32x4 (&acc)[2][2][4][2], const Unit& u, int wr, int wc, int fr, int fq) const {
        const int row0 = u.pm * BM + wr * 64 + fr, col0 = u.pn * BM + wc * 32 + 8 * fq;
        const size_t bo = (size_t)((u.pm * BM) / SEQ) * 6144 + col0;
        f32x4 gv[2][2], vv[2][2];
#pragma unroll
        for (int bj = 0; bj < 2; ++bj)
#pragma unroll
            for (int n = 0; n < 2; ++n) { gv[bj][n] = *(const f32x4*)(gate + bo + bj * HALF + 4 * n);
                if (do_next) vv[bj][n] = *(const f32x4*)(lnn + col0 + bj * HALF + 4 * n) * (*(const f32x4*)(scn + bo + bj * HALF + 4 * n) + 1.f); }
#define RESID_ROW(AI, M, X0, X1, BJ) do { const int row_ = row0 + (AI) * HALF + (M) * 16; const size_t off_ = (size_t)row_ * DM + col0 + (BJ) * HALF; \
            if (out_f32) { *(f32x4*)((float*)out + off_) = X0; *(f32x4*)((float*)out + off_ + 4) = X1; } \
            else { f32x8 xx_; xx_[0] = X0[0]; xx_[1] = X0[1]; xx_[2] = X0[2]; xx_[3] = X0[3]; xx_[4] = X1[0]; xx_[5] = X1[1]; xx_[6] = X1[2]; xx_[7] = X1[3]; \
                   *(h16x8*)((_Float16*)out + off_) = __builtin_convertvector(xx_, h16x8); } \
            if (do_next) { ss += (X0[0] * X0[0] + X0[1] * X0[1]) + (X0[2] * X0[2] + X0[3] * X0[3]) + (X1[0] * X1[0] + X1[1] * X1[1]) + (X1[2] * X1[2] + X1[3] * X1[3]); \
                const f32x4 a0_ = X0 * vv[BJ][0], a1_ = X1 * vv[BJ][1]; \
                u32x4 w_; w_.x = cvtpk(a0_[0], a0_[1]); w_.y = cvtpk(a0_[2], a0_[3]); w_.z = cvtpk(a1_[0], a1_[1]); w_.w = cvtpk(a1_[2], a1_[3]); \
                *(u32x4*)(Hn + off_) = w_; } } while (0)
        if (base_f32) {
#pragma unroll
            for (int ai = 0; ai < 2; ++ai)
#pragma unroll
            for (int mh = 0; mh < 2; ++mh) {
                f32x4 bs[2][2][2];
#pragma unroll
                for (int mm = 0; mm < 2; ++mm) { const size_t off = (size_t)(row0 + ai * HALF + (2 * mh + mm) * 16) * DM + col0;
#pragma unroll
                    for (int bj = 0; bj < 2; ++bj) { bs[mm][bj][0] = *(const f32x4*)((const float*)base + off + bj * HALF); bs[mm][bj][1] = *(const f32x4*)((const float*)base + off + bj * HALF + 4); } }
#pragma unroll
                for (int mm = 0; mm < 2; ++mm) { const int m = 2 * mh + mm; float ss = 0.f;
#pragma unroll
                    for (int bj = 0; bj < 2; ++bj) { const f32x4 x0 = bs[mm][bj][0] + gv[bj][0] * acc[ai][bj][m][0], x1 = bs[mm][bj][1] + gv[bj][1] * acc[ai][bj][m][1]; RESID_ROW(ai, m, x0, x1, bj); }
                    if (do_next) { ss += __shfl_xor(ss, 16); ss += __shfl_xor(ss, 32); if (fq == 0) SS[(size_t)(row0 + ai * HALF + m * 16) * 16 + u.pn * 4 + wc] = ss; } }
                asm volatile("" ::: "memory");
            }
        } else {
#pragma unroll
            for (int ai = 0; ai < 2; ++ai) {
                h16x8 bh[4][2];
#pragma unroll
                for (int m = 0; m < 4; ++m) { const size_t off = (size_t)(row0 + ai * HALF + m * 16) * DM + col0;
#pragma unroll
                    for (int bj = 0; bj < 2; ++bj) bh[m][bj] = *(const h16x8*)((const _Float16*)base + off + bj * HALF); }
#pragma unroll
                for (int m = 0; m < 4; ++m) { float ss = 0.f;
#pragma unroll
                    for (int bj = 0; bj < 2; ++bj) { const f32x8 bf = __builtin_convertvector(bh[m][bj], f32x8);
                        const f32x4 x0 = (f32x4){bf[0], bf[1], bf[2], bf[3]} + gv[bj][0] * acc[ai][bj][m][0], x1 = (f32x4){bf[4], bf[5], bf[6], bf[7]} + gv[bj][1] * acc[ai][bj][m][1];
                        RESID_ROW(ai, m, x0, x1, bj); }
                    if (do_next) { ss += __shfl_xor(ss, 16); ss += __shfl_xor(ss, 32); if (fq == 0) SS[(size_t)(row0 + ai * HALF + m * 16) * 16 + u.pn * 4 + wc] = ss; } }
                asm volatile("" ::: "memory");
            }
        }
#undef RESID_ROW
    }
};
struct EpiSwiGLU {
    static constexpr bool PERM = true, AFTER_DRAIN = false;
    static constexpr int NVM = 20;
    bf16_t* ACT; const float* SS; const float* bg; const float* bu;
    __device__ __forceinline__ void operator()(const f32x4 (&acc)[2][2][4][2], const Unit& u, int wr, int wc, int fr, int fq) const {
        const int row0 = u.pm * BM + wr * 64 + fr, col0 = u.pn * HALF + wc * 32 + 8 * fq;
        const size_t bo = (size_t)((u.pm * BM) / SEQ) * DFF + col0;
        const f32x4 g0 = *(const f32x4*)(bg + bo), g1 = *(const f32x4*)(bg + bo + 4), u0 = *(const f32x4*)(bu + bo), u1 = *(const f32x4*)(bu + bo + 4);
        float rsv[2][4];
        { f32x4 p4[2][4];
#pragma unroll
          for (int ai = 0; ai < 2; ++ai)
#pragma unroll
              for (int m = 0; m < 4; ++m) p4[ai][m] = *(const f32x4*)(SS + (size_t)(row0 + ai * HALF + m * 16) * 16 + 4 * fq);
#pragma unroll
          for (int ai = 0; ai < 2; ++ai)
#pragma unroll
              for (int m = 0; m < 4; ++m) { float sq = (p4[ai][m][0] + p4[ai][m][1]) + (p4[ai][m][2] + p4[ai][m][3]); sq += __shfl_xor(sq, 16); sq += __shfl_xor(sq, 32);
                  rsv[ai][m] = __builtin_amdgcn_rsqf(sq * (1.f / DM) + EPS); } }
#pragma unroll
        for (int ai = 0; ai < 2; ++ai)
#pragma unroll
            for (int m = 0; m < 4; ++m) {
                const int row = row0 + ai * HALF + m * 16;
                const float rs = rsv[ai][m];
                const f32x4 ga[2] = {acc[ai][0][m][0] * rs + g0, acc[ai][0][m][1] * rs + g1}, ua[2] = {acc[ai][1][m][0] * rs + u0, acc[ai][1][m][1] * rs + u1};
                float r[8];
#pragma unroll
                for (int n = 0; n < 2; ++n)
#pragma unroll
                    for (int e = 0; e < 4; ++e) { const float g = ga[n][e]; r[4 * n + e] = g * __builtin_amdgcn_rcpf(1.f + ex2(-g * LOG2E)) * ua[n][e]; }
                u32x4 w; w.x = cvtpk(r[0], r[1]); w.y = cvtpk(r[2], r[3]); w.z = cvtpk(r[4], r[5]); w.w = cvtpk(r[6], r[7]);
                *(u32x4*)(ACT + (size_t)row * DFF + col0) = w;
            }
    }
};
}

__device__ __forceinline__ void tr_item(const float* W, int ldw, int K, bf16_t* WT, int k0, int drow0, int sc, LAS float* scr, int lane) {
    float tv[32];
#pragma unroll
    for (int i = 0; i < 32; ++i) { const int kk = 2 * i + (lane >> 5); tv[i] = 0.f; if (sc >= 0) tv[i] = W[(size_t)(k0 + kk) * ldw + sc]; }
#pragma unroll
    for (int i = 0; i < 32; ++i) { const int kk = 2 * i + (lane >> 5); scr[kk * 33 + (lane & 31)] = tv[i]; }
    LDS_WAIT(); asm volatile("" ::: "memory");
    const int c = lane & 7;
#pragma unroll
    for (int j = 0; j < 4; ++j) { const int n = (lane >> 3) + 8 * j; const LAS float* s = scr + (8 * c) * 33 + n;
        u32x4 o; o.x = cvtpk(s[0 * 33], s[1 * 33]); o.y = cvtpk(s[2 * 33], s[3 * 33]); o.z = cvtpk(s[4 * 33], s[5 * 33]); o.w = cvtpk(s[6 * 33], s[7 * 33]);
        *(GAS u32x4*)(WT + (size_t)(drow0 + n) * K + k0 + 8 * c) = o; }
    LDS_WAIT(); asm volatile("" ::: "memory");
}

struct Args { const float* in[17]; float* out; unsigned char* ws; int lo, hi; };

__device__ __forceinline__ void prologue(const Args& a, LAS unsigned char* lds, int tid, int lane, int wave, int G) {
    unsigned char* ws = a.ws;
    const float* w_in = a.in[6]; const float* w_o = a.in[13]; const float* w_gate = a.in[14]; const float* w_up = a.in[15]; const float* w_down = a.in[16];
    LAS float* scr = (LAS float*)(lds + wave * 16384);
    const int gw = blockIdx.x * NWAVES + wave, NGW = G * NWAVES;
    constexpr int I_IN = 16 * 72, I_O = 16 * 32, I_GU = 16 * 176, I_D = 44 * 32, I_L = I_IN + I_O + I_GU + I_D;
    for (int it = gw; it < DEPTH * I_L; it += NGW) {
        const int l = it / I_L; int r = it % I_L;
        bf16_t* wl = (bf16_t*)(ws + WS_W + (size_t)l * W_LAYER);
        if (r < I_IN) {
            const int kb = r / 72, nb = r % 72, np = 32 * nb + (lane & 31), p = np & 255;
            const int slot = (np >> 8) * 4 + ((p & 127) >> 5), dim = 32 * (p >> 7) + (p & 31);
            int sc = slot_col(slot) + dim; if (slot == 11 && dim >= 4) sc = -1;
            tr_item(w_in + (size_t)l * DM * INCOLS, INCOLS, DM, wl + W_IN / 2, 64 * kb, 32 * nb, sc, scr, lane); continue; }
        r -= I_IN;
        if (r < I_O) { const int kb = r / 32, nb = r % 32;
            tr_item(w_o + (size_t)l * DM * DM, DM, DM, wl + W_O / 2, 64 * kb, 32 * nb, 32 * nb + (lane & 31), scr, lane); continue; }
        r -= I_O;
        if (r < I_GU) { const int kb = r / 176, nb = r % 176, d0 = 32 * nb, p0 = d0 & 255;
            const float* src = (p0 < 128 ? w_gate : w_up) + (size_t)l * DM * DFF;
            tr_item(src, DFF, DM, wl + W_GU / 2, 64 * kb, d0, (d0 >> 8) * 128 + (p0 & 127) + (lane & 31), scr, lane); continue; }
        r -= I_GU;
        { const int kb = r / 32, nb = r % 32;
            tr_item(w_down + (size_t)l * DFF * DM, DM, DFF, wl + W_D / 2, 64 * kb, 32 * nb, 32 * nb + (lane & 31), scr, lane); }
    }
    {
        float* cs = (float*)(ws + WS_ROPE); float* sn = cs + SEQ * 32;
        for (int idx = blockIdx.x * 512 + tid; idx < SEQ * 32; idx += G * 512) {
            const int t = idx >> 5, i = idx & 31;
            double inv = 1.0; for (int k = 0; k < i; ++k) inv *= 0.7498942093324559;
            const float ang = (float)t * (float)inv;
            double rv = (double)ang * 0.15915494309189535; rv -= __builtin_floor(rv);
            const float fr = (float)rv;
            cs[idx] = __builtin_amdgcn_cosf(fr); sn[idx] = __builtin_amdgcn_sinf(fr);
        }
    }
    __syncthreads();
    {
        const float* c = a.in[1]; const float* w_mod = a.in[4]; const float* b_mod = a.in[5];
        float* mod = (float*)(ws + WS_MOD);
        LAS float* cact = (LAS float*)lds;
        for (int idx = tid; idx < BATCH * DM; idx += 512) { const int b = idx >> 10, k = idx & 1023; const float v = c[idx]; cact[k * 32 + b] = v * __builtin_amdgcn_rcpf(1.f + ex2(-v * LOG2E)); }
        __syncthreads();
        for (int unit = blockIdx.x; unit < DEPTH * 6144 / 64; unit += G) {
            const int col = unit * 64 + lane, l = col / 6144, j = col % 6144;
            const float* wp = w_mod + (size_t)l * DM * 6144 + j;
            float acc0 = 0.f, acc1 = 0.f, acc2 = 0.f, acc3 = 0.f;
#pragma unroll 32
            for (int k = 0; k < DM; ++k) { const float wv = wp[(size_t)k * 6144]; const f32x4 c4 = *(const LAS f32x4*)(cact + k * 32 + 4 * wave);
                acc0 += c4[0] * wv; acc1 += c4[1] * wv; acc2 += c4[2] * wv; acc3 += c4[3] * wv; }
            const float bm = b_mod[l * 6144 + j];
            float* mo = mod + ((size_t)l * BATCH + 4 * wave) * 6144 + j;
            mo[0] = acc0 + bm; mo[6144] = acc1 + bm; mo[2 * 6144] = acc2 + bm; mo[3 * 6144] = acc3 + bm;
        }
    }
    __syncthreads();
}

__device__ __forceinline__ void prologue_b(const Args& a, LAS unsigned char* lds, int tid, int lane, int wave, int G) {
    unsigned char* ws = a.ws;
    const float* mod = (const float*)(ws + WS_MOD);
    LAS float* cact = (LAS float*)lds;
    constexpr int U_IN = (INCOLS + 63) / 64, U_FF = DFF / 64, U_L = U_IN + 2 * U_FF;
    for (int un = blockIdx.x; un < DEPTH * U_L; un += G) {
        const int l = un / U_L; int r = un % U_L; int type = 0; if (r >= U_IN) { r -= U_IN; type = 1; if (r >= U_FF) { r -= U_FF; type = 2; } }
        const float* shp = mod + (size_t)l * BATCH * 6144 + (type == 0 ? 0 : 3 * DM);
        for (int idx = tid; idx < BATCH * DM; idx += 512) { const int b = idx >> 10, k = idx & 1023; cact[k * 32 + b] = shp[(size_t)b * 6144 + k]; }
        __syncthreads();
        const int ncols = type == 0 ? INCOLS : DFF;
        const float* W = type == 0 ? a.in[6] + (size_t)l * DM * INCOLS : (type == 1 ? a.in[14] : a.in[15]) + (size_t)l * DM * DFF;
        const int col = r * 64 + lane, cc = col < ncols ? col : ncols - 1;
        const float* wp = W + cc;
        float acc0 = 0.f, acc1 = 0.f, acc2 = 0.f, acc3 = 0.f;
#pragma unroll 32
        for (int k = 0; k < DM; ++k) { const float wv = wp[(size_t)k * ncols]; const f32x4 c4 = *(const LAS f32x4*)(cact + k * 32 + 4 * wave);
            acc0 += c4[0] * wv; acc1 += c4[1] * wv; acc2 += c4[2] * wv; acc3 += c4[3] * wv; }
        if (col < ncols) {
            const int ldb = type == 0 ? NIN : DFF;
            float* bo = (float*)(ws + (type == 0 ? WS_B1 : (type == 1 ? WS_BG : WS_BU))) + ((size_t)l * BATCH + 4 * wave) * ldb + col;
            bo[0] = acc0; bo[ldb] = acc1; bo[2 * ldb] = acc2; bo[3 * ldb] = acc3;
        }
        __syncthreads();
    }
}

__device__ __forceinline__ float wsum_f(float v) {
#define DPP_ADD(CTRL, RM) v += __uint_as_float((unsigned)__builtin_amdgcn_update_dpp(0, (int)__float_as_uint(v), CTRL, RM, 0xf, false))
    DPP_ADD(0x111, 0xf); DPP_ADD(0x112, 0xf); DPP_ADD(0x114, 0xf); DPP_ADD(0x118, 0xf); DPP_ADD(0x142, 0xa); DPP_ADD(0x143, 0xc);
#undef DPP_ADD
    return __uint_as_float((unsigned)__builtin_amdgcn_readlane((int)__float_as_uint(v), 63));
}
__device__ __forceinline__ void pre_phase(const float* x, const float* ln, const float* modl  , bf16_t* H, float* SS, int lane, int gw, int NGW) {
    for (int m0 = 4 * gw; m0 < MROWS; m0 += 4 * NGW) {
        f32x4 v[4][4]; float s[4];
#pragma unroll
        for (int rr = 0; rr < 4; ++rr) { const GAS f32x4* xr = (const GAS f32x4*)(x + (size_t)(m0 + rr) * DM) + lane;
#pragma unroll
            for (int j = 0; j < 4; ++j) v[rr][j] = xr[64 * j]; }
#pragma unroll
        for (int rr = 0; rr < 4; ++rr) { float a = 0.f;
#pragma unroll
            for (int j = 0; j < 4; ++j) a += (v[rr][j].x * v[rr][j].x + v[rr][j].y * v[rr][j].y) + (v[rr][j].z * v[rr][j].z + v[rr][j].w * v[rr][j].w);
            s[rr] = wsum_f(a); }
        const int b = m0 / SEQ;
        const float* mb = modl + (size_t)b * 6144;
        f32x4 gv[4];
#pragma unroll
        for (int j = 0; j < 4; ++j) gv[j] = *((const GAS f32x4*)ln + lane + 64 * j) * (*((const GAS f32x4*)(mb + DM) + lane + 64 * j) + 1.f);
#pragma unroll
        for (int rr = 0; rr < 4; ++rr) {
            if (lane < 16) SS[(size_t)(m0 + rr) * 16 + lane] = (lane == 0) ? s[rr] : 0.f;
            GAS u32x2* o8 = (GAS u32x2*)(H + (size_t)(m0 + rr) * DM) + lane;
#pragma unroll
            for (int j = 0; j < 4; ++j) { const f32x4 y = v[rr][j] * gv[j]; u32x2 w; w.x = cvtpk(y.x, y.y); w.y = cvtpk(y.z, y.w); o8[64 * j] = w; }
        }
    }
}

__device__ __forceinline__ void store_head(const f32x16& o0, const f32x16& o1, float inv, const float* gout, bf16_t* orow, int h) {
    float ss = 0.f;
#pragma unroll
    for (int i = 0; i < 16; ++i) { const float a = o0[i] * inv, b = o1[i] * inv; ss += a * a + b * b; }
    ss += __shfl_xor(ss, 32);
    const float rn = __builtin_amdgcn_rsqf(ss * (1.f / 64.f) + EPS) * inv;
#pragma unroll
    for (int g = 0; g < 4; ++g) {
        const int d0 = 8 * g + 4 * h;
        const f32x4 ga = *(const f32x4*)(gout + d0), gb = *(const f32x4*)(gout + 32 + d0);
        u32x2 wa, wb;
        wa.x = cvtpk(o0[4 * g] * rn * ga[0], o0[4 * g + 1] * rn * ga[1]); wa.y = cvtpk(o0[4 * g + 2] * rn * ga[2], o0[4 * g + 3] * rn * ga[3]);
        wb.x = cvtpk(o1[4 * g] * rn * gb[0], o1[4 * g + 1] * rn * gb[1]); wb.y = cvtpk(o1[4 * g + 2] * rn * gb[2], o1[4 * g + 3] * rn * gb[3]);
        *(GAS u32x2*)(orow + d0) = wa; *(GAS u32x2*)(orow + 32 + d0) = wb;
    }
}

__device__ __forceinline__ void swa_unit(int b, int hc, int qt, const bf16_t* P, const bf16_t* VT, bf16_t* O, float M2, float sink2, const float* gout, int lane) {
    const int r = lane & 31, h = lane >> 5, t0 = qt * 32, kv = hc >> 2;
    const size_t rowbase = (size_t)b * SEQ;
    bf16x8 qf[4];
    { const bf16_t* qp = P + (rowbase + t0 + r) * NIN + (24 + hc) * 64 + 8 * h;
#pragma unroll
      for (int ks = 0; ks < 4; ++ks) qf[ks] = ldg16(qp + 16 * ks); }
    const bf16_t* kbase = P + rowbase * NIN + (32 + kv) * 64 + 8 * h + (size_t)r * NIN;
    const bf16_t* vbase = VT + ((size_t)(b * NVS + 5 + kv) * 64 + r) * SEQ + 8 * h;
    f32x16 o0 = zero16(), o1 = zero16(); float lsum = 0.f;
    const int t = t0 + r;
    const int kt_lo = qt - 4 < 0 ? 0 : qt - 4;
    bf16x8 kf[4];
#pragma unroll
    for (int ks = 0; ks < 4; ++ks) kf[ks] = ldg16(kbase + (size_t)(kt_lo * 32) * NIN + 16 * ks);
    for (int kt = kt_lo; kt <= qt; ++kt) {
        bf16x8 kn[4], vf[2][2];
#pragma unroll
        for (int dt = 0; dt < 2; ++dt)
#pragma unroll
            for (int s = 0; s < 2; ++s) vf[dt][s] = ldg16(vbase + (size_t)(dt * 32) * SEQ + kt * 32 + 16 * s);
        { const bf16_t* kp = kbase + (size_t)((kt < qt ? kt + 1 : kt) * 32) * NIN;
#pragma unroll
          for (int ks = 0; ks < 4; ++ks) kn[ks] = ldg16(kp + 16 * ks); }
        f32x16 sc = zero16();
#pragma unroll
        for (int ks = 0; ks < 4; ++ks) sc = MFMA32(kf[ks], qf[ks], sc);
#pragma unroll
        for (int i = 0; i < 16; ++i) { const int key = kt * 32 + crow(i, h); const bool valid = (unsigned)(t - key) < 128u;
            const float p = valid ? ex2(sc[i] - M2) : 0.f; sc[i] = p; lsum += p; }
        const bf16x8 p0 = pack8(sc, 0), p1 = pack8(sc, 1);
        o0 = MFMA32(vf[0][0], p0, o0); o0 = MFMA32(vf[0][1], p1, o0);
        o1 = MFMA32(vf[1][0], p0, o1); o1 = MFMA32(vf[1][1], p1, o1);
#pragma unroll
        for (int ks = 0; ks < 4; ++ks) kf[ks] = kn[ks];
    }
    lsum += __shfl_xor(lsum, 32); lsum += ex2(sink2 - M2);
    store_head(o0, o1, 1.f / lsum, gout, O + (rowbase + t0 + r) * DM + (8 + hc) * 64, h);
}

__device__ __forceinline__ void sb_unit(int b, int hb, int qt, const bf16_t* P, const bf16_t* VT, bf16_t* O, const float* gout, int lane) {
    const int r = lane & 31, h = lane >> 5, t0 = qt * 32;
    const size_t rowbase = (size_t)b * SEQ;
    bf16x8 qf[4];
    { const bf16_t* qp = P + (rowbase + t0 + r) * NIN + (12 + hb) * 64 + 8 * h;
#pragma unroll
      for (int ks = 0; ks < 4; ++ks) qf[ks] = ldg16(qp + 16 * ks); }
    const bf16_t* kbase = P + rowbase * NIN + (16 + hb) * 64 + 8 * h + (size_t)r * NIN;
    const bf16_t* vbase = VT + ((size_t)(b * NVS + 1 + hb) * 64 + r) * SEQ + 8 * h;
    f32x16 o0 = zero16(), o1 = zero16(); float C = 0.f;
    const int t = t0 + r;
    bf16x8 kf[4];
#pragma unroll
    for (int ks = 0; ks < 4; ++ks) kf[ks] = ldg16(kbase + (size_t)(qt * 32) * NIN + 16 * ks);
    for (int kt = qt; kt >= 0; --kt) {
        bf16x8 kn[4], vf[2][2];
#pragma unroll
        for (int dt = 0; dt < 2; ++dt)
#pragma unroll
            for (int s = 0; s < 2; ++s) vf[dt][s] = ldg16(vbase + (size_t)(dt * 32) * SEQ + kt * 32 + 16 * s);
        { const bf16_t* kp = kbase + (size_t)((kt > 0 ? kt - 1 : 0) * 32) * NIN;
#pragma unroll
          for (int ks = 0; ks < 4; ++ks) kn[ks] = ldg16(kp + 16 * ks); }
        f32x16 z = zero16();
#pragma unroll
        for (int ks = 0; ks < 4; ++ks) z = MFMA32(kf[ks], qf[ks], z);
        float L[16];
#pragma unroll
        for (int i = 0; i < 16; ++i) { const int key = kt * 32 + crow(i, h); const float zz = z[i];
            const float sp = fmaxf(zz, 0.f) + lg2(1.f + ex2(-fabsf(zz)));
            L[i] = (key < t) ? -sp : 0.f; }
        float G4[4], Gp[4], ps[4], aft[4];
#pragma unroll
        for (int g = 0; g < 4; ++g) { G4[g] = (L[4 * g] + L[4 * g + 1]) + (L[4 * g + 2] + L[4 * g + 3]); Gp[g] = __shfl_xor(G4[g], 32); ps[g] = G4[g] + Gp[g]; }
        aft[3] = 0.f; aft[2] = ps[3]; aft[1] = aft[2] + ps[2]; aft[0] = aft[1] + ps[1];
#pragma unroll
        for (int g = 0; g < 4; ++g) {
            const float bg = C + aft[g] + (h == 0 ? Gp[g] : 0.f);
            const float b3 = bg, b2 = b3 + L[4 * g + 3], b1 = b2 + L[4 * g + 2], b0 = b1 + L[4 * g + 1];
            const float bt[4] = {b0, b1, b2, b3};
#pragma unroll
            for (int e = 0; e < 4; ++e) { const int i = 4 * g + e; const int key = kt * 32 + crow(i, h);
                z[i] = (key < t) ? ex2(z[i] + L[i] + bt[e]) : 0.f; }
        }
        C += aft[0] + ps[0];
        const bf16x8 p0 = pack8(z, 0), p1 = pack8(z, 1);
        o0 = MFMA32(vf[0][0], p0, o0); o0 = MFMA32(vf[0][1], p1, o0);
        o1 = MFMA32(vf[1][0], p0, o1); o1 = MFMA32(vf[1][1], p1, o1);
        if (__all(C < -160.f)) break;
#pragma unroll
        for (int ks = 0; ks < 4; ++ks) kf[ks] = kn[ks];
    }
    store_head(o0, o1, 1.f, gout, O + (rowbase + t0 + r) * DM + (4 + hb) * 64, h);
}

template <int NROWS, int VCH>
__device__ __forceinline__ void stage_kv(LAS unsigned char* ldsK, LAS unsigned char* ldsV, const bf16_t* kg  , const bf16_t* vg  , int tk0  , int tid) {
    constexpr int KCH = NROWS * 8 / 512, NTC = NROWS / 8, VCHT = 64 * NTC / 512;
    const int first_row = tk0 < 0 ? -tk0 : 0;
    const unsigned char* kb = (const unsigned char*)(kg + (size_t)(tk0 + first_row) * NIN);
    const unsigned char* vb = (const unsigned char*)(vg + (tk0 + first_row));
    u32x4 kr[KCH], vr[VCHT];
#pragma unroll
    for (int i = 0; i < KCH; ++i) { const int q = tid + 512 * i, row = q >> 3, c = q & 7; kr[i] = (u32x4){0u, 0u, 0u, 0u};
        if (row >= first_row) kr[i] = *(const GAS u32x4*)(kb + (unsigned)((row - first_row) * (NIN * 2) + 16 * c)); }
#pragma unroll
    for (int i = 0; i < VCHT; ++i) { const int q = tid + 512 * i, d = q / NTC, c = q % NTC; vr[i] = (u32x4){0u, 0u, 0u, 0u};
        if (8 * c >= first_row) vr[i] = *(const GAS u32x4*)(vb + (unsigned)(d * (SEQ * 2) + (8 * c - first_row) * 2)); }
#pragma unroll
    for (int i = 0; i < KCH; ++i) { const int q = tid + 512 * i, row = q >> 3, c = q & 7; *(LAS u32x4*)(ldsK + row * 128 + ((c ^ ((row >> 1) & 7)) << 4)) = kr[i]; }
#pragma unroll
    for (int i = 0; i < VCHT; ++i) { const int q = tid + 512 * i, d = q / NTC, c = q % NTC; *(LAS u32x4*)(ldsV + d * (VCH * 16) + ((c ^ (d & 15)) << 4)) = vr[i]; }
    asm volatile("" ::: "memory");
}
__device__ __forceinline__ bf16x8 lds_kfrag(LAS unsigned char* ldsK, int row, int ch) { return *(const LAS bf16x8*)(ldsK + row * 128 + ((ch ^ ((row >> 1) & 7)) << 4)); }
template <int VCH> __device__ __forceinline__ bf16x8 lds_vfrag(LAS unsigned char* ldsV, int d, int ch) { return *(const LAS bf16x8*)(ldsV + d * (VCH * 16) + ((ch ^ (d & 15)) << 4)); }

__device__ __forceinline__ void swa_block(int b, int kv, int qb, const bf16_t* P, const bf16_t* VT, bf16_t* O, float M2, const float* sinks  , const float* gout  ,
                                          LAS unsigned char* lds, int tid, int lane, int wave) {
    LAS unsigned char* ldsK = lds; LAS unsigned char* ldsV = lds + 32768;
    const int t0 = qb * 128, tk0 = t0 - 128;
    const size_t rowbase = (size_t)b * SEQ;
    const int r = lane & 31, h = lane >> 5, j = wave & 3, hc0 = kv * 4 + 2 * (wave >> 2), t0q = t0 + 32 * j;
    bf16x8 qf[2][4];
#pragma unroll
    for (int hd = 0; hd < 2; ++hd) { const bf16_t* qp = P + (rowbase + t0q + r) * NIN + (24 + hc0 + hd) * 64 + 8 * h;
#pragma unroll
        for (int ks = 0; ks < 4; ++ks) qf[hd][ks] = ldg16(qp + 16 * ks); }
    stage_kv<256, 32>(ldsK, ldsV, P + rowbase * NIN + (32 + kv) * 64, VT + ((size_t)(b * NVS + 5 + kv) * 64) * SEQ, tk0, tid);
    __syncthreads();
    f32x16 o[2][2]; o[0][0] = zero16(); o[0][1] = zero16(); o[1][0] = zero16(); o[1][1] = zero16();
    float ls[2] = {0.f, 0.f};
    const int t = t0q + r;
    for (int i = (tk0 < 0 && j < 4) ? (4 > j ? 4 : j) : j; i <= j + 4; ++i) {
        bf16x8 kf[4], vf[2][2];
#pragma unroll
        for (int ks = 0; ks < 4; ++ks) kf[ks] = lds_kfrag(ldsK, 32 * i + r, 2 * ks + h);
#pragma unroll
        for (int dt = 0; dt < 2; ++dt)
#pragma unroll
            for (int s2 = 0; s2 < 2; ++s2) vf[dt][s2] = lds_vfrag<32>(ldsV, 32 * dt + r, 4 * i + 2 * s2 + h);
#pragma unroll
        for (int hd = 0; hd < 2; ++hd) {
            f32x16 sc;
#pragma unroll
            for (int e = 0; e < 16; ++e) sc[e] = -M2;
#pragma unroll
            for (int ks = 0; ks < 4; ++ks) sc = MFMA32(kf[ks], qf[hd][ks], sc);
            if (i == j || i == j + 4) {
#pragma unroll
                for (int e = 0; e < 16; ++e) { const int key = tk0 + 32 * i + crow(e, h); const bool valid = (unsigned)(t - key) < 128u;
                    const float p = valid ? ex2(sc[e]) : 0.f; sc[e] = p; ls[hd] += p; }
            } else {
#pragma unroll
                for (int e = 0; e < 16; ++e) { const float p = ex2(sc[e]); sc[e] = p; ls[hd] += p; }
            }
            const bf16x8 p0 = pack8(sc, 0), p1 = pack8(sc, 1);
            o[hd][0] = MFMA32(vf[0][0], p0, o[hd][0]); o[hd][0] = MFMA32(vf[0][1], p1, o[hd][0]);
            o[hd][1] = MFMA32(vf[1][0], p0, o[hd][1]); o[hd][1] = MFMA32(vf[1][1], p1, o[hd][1]);
        }
    }
#pragma unroll
    for (int hd = 0; hd < 2; ++hd) {
        float l2 = ls[hd]; l2 += __shfl_xor(l2, 32); l2 += ex2(sinks[hc0 + hd] * LOG2E - M2);
        store_head(o[hd][0], o[hd][1], 1.f / l2, gout + (8 + hc0 + hd) * 64, O + (rowbase + t0q + r) * DM + (8 + hc0 + hd) * 64, h);
    }
    __syncthreads();
}

__device__ __forceinline__ void sb_block(int b, int hb, int qb, const bf16_t* P, const bf16_t* VT, bf16_t* O, const float* gout  , LAS unsigned char* lds, int tid, int lane, int wave) {
    LAS unsigned char* ldsK = lds; LAS unsigned char* ldsV = lds + 57344;
    const int t0 = qb * 256, tk0 = t0 - 192;
    const size_t rowbase = (size_t)b * SEQ;
    const int r = lane & 31, h = lane >> 5, t0q = t0 + 32 * wave;
    bf16x8 qf[4];
    { const bf16_t* qp = P + (rowbase + t0q + r) * NIN + (12 + hb) * 64 + 8 * h;
#pragma unroll
      for (int ks = 0; ks < 4; ++ks) qf[ks] = ldg16(qp + 16 * ks); }
    const bf16_t* kg = P + rowbase * NIN + (16 + hb) * 64;
    const bf16_t* vg = VT + ((size_t)(b * NVS + 1 + hb) * 64) * SEQ;
    stage_kv<448, 64>(ldsK, ldsV, kg, vg, tk0, tid);
    __syncthreads();
    f32x16 o0 = zero16(), o1 = zero16(); float C = 0.f;
    const int t = t0q + r;
#pragma unroll 1
    for (int kt = t0q >> 5; kt >= 0; --kt) {
        bf16x8 kf[4], vf[2][2];
        const int i = kt - (tk0 >> 5);
        if (i >= 0) {
#pragma unroll
            for (int ks = 0; ks < 4; ++ks) kf[ks] = lds_kfrag(ldsK, 32 * i + r, 2 * ks + h);
#pragma unroll
            for (int dt = 0; dt < 2; ++dt)
#pragma unroll
                for (int s2 = 0; s2 < 2; ++s2) vf[dt][s2] = lds_vfrag<64>(ldsV, 32 * dt + r, 4 * i + 2 * s2 + h);
        } else {
            const bf16_t* kp = kg + (size_t)(kt * 32 + r) * NIN + 8 * h;
#pragma unroll
            for (int ks = 0; ks < 4; ++ks) kf[ks] = ldg16(kp + 16 * ks);
#pragma unroll
            for (int dt = 0; dt < 2; ++dt)
#pragma unroll
                for (int s2 = 0; s2 < 2; ++s2) vf[dt][s2] = ldg16(vg + (size_t)(dt * 32 + r) * SEQ + kt * 32 + 16 * s2 + 8 * h);
        }
        f32x16 z = zero16();
#pragma unroll
        for (int ks = 0; ks < 4; ++ks) z = MFMA32(kf[ks], qf[ks], z);
        float L[16];
        const bool diag = (kt == (t0q >> 5));
#pragma unroll
        for (int e = 0; e < 16; ++e) { const float zz = z[e];
            L[e] = -(fmaxf(zz, 0.f) + lg2(1.f + ex2(-fabsf(zz)))); }
        if (diag) {
#pragma unroll
            for (int e = 0; e < 16; ++e) { const int key = kt * 32 + crow(e, h); L[e] = (key < t) ? L[e] : 0.f; }
        }
        float G4[4], Gp[4], ps[4], aft[4];
#pragma unroll
        for (int g = 0; g < 4; ++g) { G4[g] = (L[4 * g] + L[4 * g + 1]) + (L[4 * g + 2] + L[4 * g + 3]); Gp[g] = __shfl_xor(G4[g], 32); ps[g] = G4[g] + Gp[g]; }
        aft[3] = 0.f; aft[2] = ps[3]; aft[1] = aft[2] + ps[2]; aft[0] = aft[1] + ps[1];
#pragma unroll
        for (int g = 0; g < 4; ++g) {
            const float bg = C + aft[g] + (h == 0 ? Gp[g] : 0.f);
            const float b3 = bg, b2 = b3 + L[4 * g + 3], b1 = b2 + L[4 * g + 2], b0 = b1 + L[4 * g + 1];
            const float bt[4] = {b0, b1, b2, b3};
#pragma unroll
            for (int e = 0; e < 4; ++e) { const int ii = 4 * g + e; z[ii] = ex2(z[ii] + L[ii] + bt[e]); }
        }
        C += aft[0] + ps[0];
        if (diag) {
#pragma unroll
            for (int e = 0; e < 16; ++e) { const int key = kt * 32 + crow(e, h); z[e] = (key < t) ? z[e] : 0.f; }
        }
        const bf16x8 p0 = pack8(z, 0), p1 = pack8(z, 1);
        o0 = MFMA32(vf[0][0], p0, o0); o0 = MFMA32(vf[0][1], p1, o0);
        o1 = MFMA32(vf[1][0], p0, o1); o1 = MFMA32(vf[1][1], p1, o1);
        if (__all(C < -160.f)) break;
    }
    store_head(o0, o1, 1.f, gout + (4 + hb) * 64, O + (rowbase + t0q + r) * DM + (4 + hb) * 64, h);
    __syncthreads();
}

__device__ __forceinline__ void group_sync(volatile LAS unsigned* cnt, unsigned& target, int lane) {
    asm volatile("s_waitcnt vmcnt(0) lgkmcnt(0)" ::: "memory");
    target += 4u;
    if (lane == 0) __hip_atomic_fetch_add((LAS unsigned*)cnt, 1u, __ATOMIC_RELAXED, __HIP_MEMORY_SCOPE_WORKGROUP);
    while (*cnt - (target - 4u) < 4u) __builtin_amdgcn_s_sleep(1);
    asm volatile("" ::: "memory");
}
__device__ __forceinline__ void dsa_phase(const bf16_t* P, const bf16_t* VT, const float* WI, bf16_t* O, const float* gout  , float M2, unsigned* queue,
                                          LAS unsigned char* lds, int tid, int lane, int wave) {
    const int grp = wave >> 2, gwv = wave & 3;
    LAS unsigned char* gl = lds + grp * G2_BYTES;
    LAS _Float16* SC = (LAS _Float16*)(gl + G2_SC);
    LAS float* PART = (LAS float*)(gl + G2_SC);
    LAS unsigned* MASK = (LAS unsigned*)(gl + G2_MASK);
    LAS float* LSUM = (LAS float*)(gl + G2_LSUM);
    LAS float* SSUM = (LAS float*)(gl + G2_SSUM);
    volatile LAS unsigned* QW = (volatile LAS unsigned*)(lds + LDS_MISC) + 2 * grp;
    volatile LAS unsigned* GC = (volatile LAS unsigned*)(lds + LDS_MISC) + 8 + grp;
    unsigned gtarget = *GC;
    __syncthreads();
#define GSYNC() group_sync(GC, gtarget, lane)
    constexpr int NU = BATCH * 128, NUX = NU / 8;
    const unsigned xq = xb_xcc_id() & 7u;
#define FETCH_UNIT(DST) do { unsigned got_ = (unsigned)NU; \
        for (unsigned k_ = 0; k_ < 8u; ++k_) { const unsigned x_ = (xq + k_) & 7u; \
            if (__hip_atomic_load(queue + 16 * x_, __ATOMIC_RELAXED, __HIP_MEMORY_SCOPE_AGENT) >= (unsigned)NUX) continue; \
            const unsigned i_ = __hip_atomic_fetch_add(queue + 16 * x_, 1u, __ATOMIC_RELAXED, __HIP_MEMORY_SCOPE_AGENT); \
            if (i_ < (unsigned)NUX) { got_ = x_ * NUX + i_; break; } } \
        DST = got_; } while (0)
#define UNIT_B(Q) (4 * ((Q) / NUX) + (((Q) % NUX) & 3))
#define UNIT_TAU(Q) (127 - (((Q) % NUX) >> 2))
    if (gwv == 0 && lane == 0) FETCH_UNIT(QW[0]);
    GSYNC();
    int q = (int)QW[0], par = 0;
    bf16x8 qi[4][2]; f32x4 wq;
    { const int c = lane & 15, g = lane >> 4; const int qq = q < NU ? q : 0; const size_t row = (size_t)UNIT_B(qq) * SEQ + 16 * UNIT_TAU(qq) + c;
      const bf16_t* qp = P + row * NIN + 4 * 64 + 8 * g;
#pragma unroll
      for (int hh = 0; hh < 4; ++hh) { qi[hh][0] = ldg16(qp + hh * 64); qi[hh][1] = ldg16(qp + hh * 64 + 32); }
      wq = *(const GAS f32x4*)(WI + row * 4); }
    while (q < NU) {
        const int tau = UNIT_TAU(q), b = UNIT_B(q), t0 = 16 * tau;
        const size_t rowbase = (size_t)b * SEQ;
        if (gwv == 0 && lane == 0) FETCH_UNIT(QW[par ^ 1]);
        {
            int lane1 = lane; asm volatile("" : "+v"(lane1));
            const int c = lane1 & 15, g = lane1 >> 4;
            const bf16_t* kp0 = P + (rowbase + c) * NIN + 10 * 64 + 8 * g;
#define IDX_TILE(KT, K0, K1) do { f32x4 sc_ = {0.f, 0.f, 0.f, 0.f}; \
                _Pragma("unroll") for (int hh = 0; hh < 4; ++hh) { f32x4 a_ = {0.f, 0.f, 0.f, 0.f}; a_ = MFMA16(K0, qi[hh][0], a_); a_ = MFMA16(K1, qi[hh][1], a_); \
                    _Pragma("unroll") for (int j = 0; j < 4; ++j) sc_[j] += wq[hh] * fmaxf(a_[j], 0.f); } \
                LAS _Float16* sp_ = SC + c * SCH + (16 * ((KT) & 1) + 4 * g) * 64 + ((KT) >> 1);     \
                sp_[0] = (_Float16)sc_[0]; sp_[64] = (_Float16)sc_[1]; sp_[128] = (_Float16)sc_[2]; sp_[192] = (_Float16)sc_[3]; } while (0)
            bf16x8 ka0 = qi[0][0], ka1 = qi[0][1], kb0 = qi[0][0], kb1 = qi[0][1];
            if (gwv <= tau) { const bf16_t* kp = kp0 + (size_t)(gwv * 16) * NIN; ka0 = ldg16(kp); ka1 = ldg16(kp + 32); }
            if (gwv + 4 <= tau) { const bf16_t* kp = kp0 + (size_t)((gwv + 4) * 16) * NIN; kb0 = ldg16(kp); kb1 = ldg16(kp + 32); }
            for (int kt = gwv; kt <= tau; kt += 8) {
                bf16x8 na0 = ka0, na1 = ka1, nb0 = kb0, nb1 = kb1;
                if (kt + 8 <= tau) { const bf16_t* kp = kp0 + (size_t)((kt + 8) * 16) * NIN; na0 = ldg16(kp); na1 = ldg16(kp + 32); }
                if (kt + 12 <= tau) { const bf16_t* kp = kp0 + (size_t)((kt + 12) * 16) * NIN; nb0 = ldg16(kp); nb1 = ldg16(kp + 32); }
                IDX_TILE(kt, ka0, ka1);
                if (kt + 4 <= tau) IDX_TILE(kt + 4, kb0, kb1);
                ka0 = na0; ka1 = na1; kb0 = nb0; kb1 = nb1;
            }
#undef IDX_TILE
        }
        bf16x8 qf[2][4];
        { const int r = lane & 31, h = lane >> 5, c = r & 15;
#pragma unroll
          for (int nt = 0; nt < 2; ++nt) { const bf16_t* qp = P + (rowbase + t0 + c) * NIN + (2 * nt + (r >> 4)) * 64 + 8 * h;
#pragma unroll
              for (int ks = 0; ks < 4; ++ks) qf[nt][ks] = ldg16(qp + 16 * ks); } }
        GSYNC();
#define SEL_LOAD(PL, R) do { _Pragma("unroll") for (int i = 0; i < 16; ++i) { \
                const unsigned lo_ = (unsigned)__builtin_bit_cast(unsigned short, SC[(R) * SCH + 64 * i + lane]), hi_ = (unsigned)__builtin_bit_cast(unsigned short, SC[(R) * SCH + 64 * (i + 16) + lane]); \
                PL[i] = lo_ | (hi_ << 16); } } while (0)
#define TSTAGE(PL, J, MSK) _Pragma("unroll") for (int k_ = 0; k_ < 16; ++k_) if ((k_ & (J)) == 0) { const unsigned lo_ = PL[k_], hi_ = PL[k_ + (J)]; \
                PL[k_] = (lo_ & (MSK)) | ((hi_ << (J)) & ~(MSK)); PL[k_ + (J)] = ((lo_ >> (J)) & (MSK)) | (hi_ & ~(MSK)); }
#define SEL_PLANES(PL) do { TSTAGE(PL, 8, 0x00ff00ffu) TSTAGE(PL, 4, 0x0f0f0f0fu) TSTAGE(PL, 2, 0x33333333u) TSTAGE(PL, 1, 0x55555555u) \
                _Pragma("unroll") for (int bq = 0; bq < 15; ++bq) PL[bq] ^= PL[15]; PL[15] = ~PL[15]; } while (0)
#define SEL_STEP(PL, X, C, A, G, CNTG, NA, DONE) do { if (!DONE) { if (CNTG + C >= 256) { A = X; NA = C; } else { G |= X; CNTG += C; A &= ~PL; NA -= C; } DONE = (CNTG + NA == 256); } } while (0)
#define SEL_TIES(A, CNTG) do { const int need_ = 256 - CNTG, pc_ = __builtin_popcount(A); int inc_ = pc_; \
                inc_ += __builtin_amdgcn_update_dpp(0, inc_, 0x111, 0xf, 0xf, false); inc_ += __builtin_amdgcn_update_dpp(0, inc_, 0x112, 0xf, 0xf, false); \
                inc_ += __builtin_amdgcn_update_dpp(0, inc_, 0x114, 0xf, 0xf, false); inc_ += __builtin_amdgcn_update_dpp(0, inc_, 0x118, 0xf, 0xf, false); \
                inc_ += __builtin_amdgcn_update_dpp(0, inc_, 0x142, 0xa, 0xf, false); inc_ += __builtin_amdgcn_update_dpp(0, inc_, 0x143, 0xc, 0xf, false); \
                int take_ = need_ - (inc_ - pc_); take_ = take_ < 0 ? 0 : (take_ > pc_ ? pc_ : take_); \
                while (__builtin_popcount(A) > take_) A &= ~(0x80000000u >> __builtin_clz(A)); } while (0)
#pragma unroll 1
        for (int rp = 0; rp < 2; ++rp) {
            const int ra = 4 * gwv + 2 * rp, rb = ra + 1, na = t0 + ra + 1, nb = na + 1;
            const int cva = na - 32 * lane, cvb = nb - 32 * lane;
            unsigned Aa = cva >= 32 ? ~0u : (cva <= 0 ? 0u : ((1u << cva) - 1u)), Ab = cvb >= 32 ? ~0u : (cvb <= 0 ? 0u : ((1u << cvb) - 1u));
            unsigned Ga = 0u, Gb = 0u; int cntGa = 0, cntGb = 0, nAa = na, nAb = nb;
            bool donea = (na <= 256), doneb = (nb <= 256);
            if (!(donea && doneb)) {
                unsigned PA[16], PB[16];
                SEL_LOAD(PA, ra); SEL_LOAD(PB, rb);
                SEL_PLANES(PA); SEL_PLANES(PB);
#pragma unroll
                for (int bq = 15; bq >= 0; --bq) {
                    if (!(donea && doneb)) {
                        const unsigned Xa = Aa & PA[bq], Xb = Ab & PB[bq];
                        const int ca = wsum_i(__builtin_popcount(Xa)), cb = wsum_i(__builtin_popcount(Xb));
                        SEL_STEP(PA[bq], Xa, ca, Aa, Ga, cntGa, nAa, donea);
                        SEL_STEP(PB[bq], Xb, cb, Ab, Gb, cntGb, nAb, doneb);
                    }
                }
                if (!donea) SEL_TIES(Aa, cntGa);
                if (!doneb) SEL_TIES(Ab, cntGb);
            }
            MASK[ra * MASK_STRIDE + lane] = Ga | Aa;
            MASK[rb * MASK_STRIDE + lane] = Gb | Ab;
        }
#undef SEL_LOAD
#undef TSTAGE
#undef SEL_PLANES
#undef SEL_STEP
#undef SEL_TIES
        GSYNC();
        {
            int lane3 = lane; asm volatile("" : "+v"(lane3));
            const int r = lane3 & 31, h = lane3 >> 5, c = r & 15;
            f32x16 o[2][2]; float ls[2];
            o[0][0] = zero16(); o[0][1] = zero16(); o[1][0] = zero16(); o[1][1] = zero16(); ls[0] = 0.f; ls[1] = 0.f;
            const int nkt = ((t0 + 15) >> 5) + 1;
#define ATT_TILE(KT, KF, VF) do { const unsigned mw_ = MASK[c * MASK_STRIDE + (KT)]; \
                _Pragma("unroll") for (int nt = 0; nt < 2; ++nt) { \
                    f32x16 sc_; _Pragma("unroll") for (int i = 0; i < 16; ++i) sc_[i] = -M2; \
                    _Pragma("unroll") for (int ks = 0; ks < 4; ++ks) sc_ = MFMA32(KF[ks], qf[nt][ks], sc_); \
                    _Pragma("unroll") for (int i = 0; i < 16; ++i) { const float p_ = ((mw_ >> crow(i, h)) & 1u) ? ex2(sc_[i]) : 0.f; sc_[i] = p_; ls[nt] += p_; } \
                    const bf16x8 p0_ = pack8(sc_, 0), p1_ = pack8(sc_, 1); \
                    o[nt][0] = MFMA32(VF[0][0], p0_, o[nt][0]); o[nt][0] = MFMA32(VF[0][1], p1_, o[nt][0]); \
                    o[nt][1] = MFMA32(VF[1][0], p0_, o[nt][1]); o[nt][1] = MFMA32(VF[1][1], p1_, o[nt][1]); } } while (0)
            LAS unsigned char* const wslot = (LAS unsigned char*)PART + gwv * 16384;
            const unsigned char* const kgb = (const unsigned char*)(P + rowbase * NIN + 8 * 64);
            const unsigned char* const vgb = (const unsigned char*)(VT + ((size_t)(b * NVS) * 64) * SEQ);
            unsigned koff[4], voff[4];
#pragma unroll
            for (int i = 0; i < 4; ++i) { const int row = 8 * i + (lane3 >> 3), ch = (lane3 & 7) ^ ((row >> 1) & 7); koff[i] = (unsigned)(row * (NIN * 2) + 16 * ch);
                const int d = 16 * i + (lane3 >> 2), cv = (lane3 & 3) ^ ((d >> 2) & 3); voff[i] = (unsigned)(d * (SEQ * 2) + 16 * cv); }
#define DMA_TILE(KT, SLOT) do { const unsigned char* kt_ = kgb + (size_t)((KT) * 32) * (NIN * 2); const unsigned char* vt_ = vgb + (size_t)(KT) * 64; \
                _Pragma("unroll") for (int i = 0; i < 4; ++i) __builtin_amdgcn_global_load_lds((const unsigned*)(kt_ + koff[i]), (LAS unsigned*)(wslot + (SLOT) * 8192 + 1024 * i), 16, 0, 0); \
                _Pragma("unroll") for (int i = 0; i < 4; ++i) __builtin_amdgcn_global_load_lds((const unsigned*)(vt_ + voff[i]), (LAS unsigned*)(wslot + (SLOT) * 8192 + 4096 + 1024 * i), 16, 0, 0); } while (0)
            const int ntl = gwv < nkt ? (nkt - gwv + 3) >> 2 : 0;
            if (ntl > 0) DMA_TILE(gwv, 0);
            if (ntl > 1) DMA_TILE(gwv + 4, 1);
            for (int j = 0; j < ntl; ++j) {
                const int kt = gwv + 4 * j;
                if (j + 1 < ntl) asm volatile("s_waitcnt vmcnt(8)" ::: "memory"); else asm volatile("s_waitcnt vmcnt(0)" ::: "memory");
                LAS unsigned char* const sl = wslot + (j & 1) * 8192;
                bf16x8 kf[4], vf[2][2];
#pragma unroll
                for (int ks = 0; ks < 4; ++ks) kf[ks] = *(const LAS bf16x8*)(sl + r * 128 + (((2 * ks + h) ^ ((r >> 1) & 7)) << 4));
#pragma unroll
                for (int dt = 0; dt < 2; ++dt)
#pragma unroll
                    for (int s2 = 0; s2 < 2; ++s2) { const int d = 32 * dt + r; vf[dt][s2] = *(const LAS bf16x8*)(sl + 4096 + d * 64 + (((2 * s2 + h) ^ ((d >> 2) & 3)) << 4)); }
                asm volatile("s_waitcnt lgkmcnt(0)" ::: "memory");
                if (j + 2 < ntl) DMA_TILE(kt + 8, j & 1);
                ATT_TILE(kt, kf, vf);
            }
            asm volatile("s_waitcnt vmcnt(0) lgkmcnt(0)" ::: "memory");
#undef DMA_TILE
#undef ATT_TILE
#pragma unroll
            for (int nt = 0; nt < 2; ++nt) {
#pragma unroll
                for (int dt = 0; dt < 2; ++dt)
#pragma unroll
                    for (int i = 0; i < 16; ++i) PART[(gwv * 64 + 32 * dt + crow(i, h)) * 64 + 32 * nt + r] = o[nt][dt][i];
                float l2 = ls[nt]; l2 += __shfl_xor(l2, 32);
                if (h == 0) LSUM[gwv * 64 + 32 * nt + r] = l2;
            }
        }
        const int qn = (int)QW[par ^ 1];
        { const int c = lane & 15, g = lane >> 4; const int qq = qn < NU ? qn : 0; const size_t row = (size_t)UNIT_B(qq) * SEQ + 16 * UNIT_TAU(qq) + c;
          const bf16_t* qp = P + row * NIN + 4 * 64 + 8 * g;
#pragma unroll
          for (int hh = 0; hh < 4; ++hh) { qi[hh][0] = ldg16(qp + hh * 64); qi[hh][1] = ldg16(qp + hh * 64 + 32); }
          wq = *(const GAS f32x4*)(WI + row * 4); }
        GSYNC();
        {
            int n = lane; asm volatile("" : "+v"(n));
            float l = 0.f;
#pragma unroll
            for (int w = 0; w < 4; ++w) l += LSUM[w * 64 + n];
            const float inv = 1.f / l;
            float ov[16]; float ssp = 0.f;
#pragma unroll
            for (int dd = 0; dd < 16; ++dd) { float a = 0.f;
#pragma unroll
                for (int w = 0; w < 4; ++w) a += PART[(w * 64 + 16 * gwv + dd) * 64 + n];
                ov[dd] = a * inv; ssp += ov[dd] * ov[dd]; }
            SSUM[gwv * 64 + n] = ssp;
            GSYNC();
            float ss = 0.f;
#pragma unroll
            for (int w = 0; w < 4; ++w) ss += SSUM[w * 64 + n];
            const float rn = __builtin_amdgcn_rsqf(ss * (1.f / 64.f) + EPS);
            const int head = n >> 4, c = n & 15;
            bf16_t* op = O + (rowbase + t0 + c) * DM + head * 64 + 16 * gwv;
#pragma unroll
            for (int hf = 0; hf < 2; ++hf) {
                const f32x4 ga = *(const f32x4*)(gout + head * 64 + 16 * gwv + 8 * hf), gb = *(const f32x4*)(gout + head * 64 + 16 * gwv + 8 * hf + 4);
                u32x4 wv; wv.x = cvtpk(ov[8 * hf] * rn * ga[0], ov[8 * hf + 1] * rn * ga[1]); wv.y = cvtpk(ov[8 * hf + 2] * rn * ga[2], ov[8 * hf + 3] * rn * ga[3]);
                wv.z = cvtpk(ov[8 * hf + 4] * rn * gb[0], ov[8 * hf + 5] * rn * gb[1]); wv.w = cvtpk(ov[8 * hf + 6] * rn * gb[2], ov[8 * hf + 7] * rn * gb[3]);
                *(GAS u32x4*)(op + 8 * hf) = wv; }
        }
        GSYNC();
        q = qn; par ^= 1;
    }
#undef GSYNC
#undef FETCH_UNIT
#undef UNIT_B
#undef UNIT_TAU
}

typedef const __attribute__((address_space(4))) char* kargp_t;
#define KP() kargp_t kp_ = (kargp_t)__builtin_amdgcn_kernarg_segment_ptr(); asm volatile("" : "+s"(kp_)); unsigned char* const ws = *(unsigned char* const __attribute__((address_space(4)))*)(kp_ + 144); (void)ws
#define AIN(k) (*(const float* const __attribute__((address_space(4)))*)(kp_ + 8 * (k)))
#define AOUT() (*(float* const __attribute__((address_space(4)))*)(kp_ + 136))
static_assert(sizeof(Args) == 160, "Args layout: in[17] | out | ws | lo | hi");
__global__ void __launch_bounds__(NWAVES * 64, 2) fwd(Args args) {
    extern __shared__ __attribute__((aligned(16))) unsigned char lds_raw[];
    LAS unsigned char* lds = (LAS unsigned char*)lds_raw;
    const int wave = __builtin_amdgcn_readfirstlane(threadIdx.x >> 6);
    const int G = gridDim.x;
    const int gw = blockIdx.x * NWAVES + wave, NGW = G * NWAVES;
    volatile LAS unsigned* MISC = (volatile LAS unsigned*)(lds + LDS_MISC);
    if (threadIdx.x < 16) MISC[threadIdx.x] = 0u;
    __syncthreads();
    XcdBarrier bar; bar.bar = (unsigned*)(args.ws + WS_CTL) + CW_BAR; bar.x = 0; bar.st = nullptr;
    if (!MK_MULTI) bar = xcd_barrier_post((unsigned*)(args.ws + WS_CTL) + CW_BAR, MISC + 4);
    const int lo = args.lo, hi = args.hi;
#define IN(k) (lo <= (k) && (k) < hi)
#define SEAM(k) do { if (IN(k) && IN((k) + 1)) xcd_barrier(bar); } while (0)
#define OPQ() int tid = threadIdx.x; asm volatile("" : "+v"(tid)); const int lane = tid & 63; (void)lane
    if (PH(0) && IN(0)) _Pragma("unroll 1") for (int rep = 0; rep < REP_PA; ++rep) { OPQ(); prologue(args, lds, tid, lane, wave, G); }
    SEAM(0);
    if (PH(0) && IN(1)) _Pragma("unroll 1") for (int rep = 0; rep < REP_PB; ++rep) { OPQ(); prologue_b(args, lds, tid, lane, wave, G); }
    if (PH(1) && IN(1)) _Pragma("unroll 1") for (int rep = 0; rep < REP_N; ++rep) { OPQ(); KP();
        pre_phase(AIN(0), AIN(2), (const float*)(ws + WS_MOD), (bf16_t*)(ws + WS_H), (float*)(ws + WS_SS), lane, gw, NGW); }
    SEAM(1);

    for (int l = 0; l < DEPTH; ++l) {
        const int s0 = 1 + 5 * l;
        if (PH(2) && IN(s0 + 1)) _Pragma("unroll 1") for (int rep = 0; rep < REP_G2; ++rep) {
            KP(); stagger(STAG_I);
            const bf16_t* wl = (const bf16_t*)(ws + WS_W + (size_t)l * W_LAYER);
            pg8::Gemm g{(const bf16_t*)(ws + WS_H), wl + W_IN / 2, MROWS, NIN, DM}; pg8::StaticOrder S; S.init(MROWS, NIN, G, (int)blockIdx.x);
            pg8::EpiInProj E{(bf16_t*)(ws + WS_P), (bf16_t*)(ws + WS_VT), (float*)(ws + WS_WI), (const float*)(ws + WS_ROPE), (const float*)(ws + WS_ROPE) + SEQ * 32,
                             AIN(7) + l * 64, AIN(8) + l * 64, AIN(9) + l * 64, AIN(10) + l * 64, (const float*)(ws + WS_SS), (const float*)(ws + WS_B1) + (size_t)l * BATCH * NIN, (LAS float*)(lds + 131072)};
            pg8::gemm_phase<pg8::EpiInProj, pg8::StaticOrder, true, true>(lds, g, S, E);
        }
        SEAM(s0 + 1);
        if (PH(3) && IN(s0 + 2)) {
            OPQ(); KP();
            const bf16_t* P = (const bf16_t*)(ws + WS_P); const bf16_t* VT = (const bf16_t*)(ws + WS_VT); bf16_t* OB = (bf16_t*)(ws + WS_O);
            const float* gout = AIN(12) + l * 1024;
            const float gqa = wave_max(fabsf(AIN(7)[l * 64 + lane])), gka = wave_max(fabsf(AIN(8)[l * 64 + lane]));
            const float gqc = wave_max(fabsf(AIN(9)[l * 64 + lane])), gkc = wave_max(fabsf(AIN(10)[l * 64 + lane]));
            const float M2a = 8.f * gqa * gka * LOG2E, M2c = 8.f * gqc * gkc * LOG2E;
            _Pragma("unroll 1") for (int rep = 0; rep < REP_ATT; ++rep) {
            const int xs = (G % 8 == 0) ? (int)(blockIdx.x & 7) : 0, js = (G % 8 == 0) ? (int)(blockIdx.x >> 3) : (int)blockIdx.x, njs = (G % 8 == 0) ? G / 8 : G, nvs = (G % 8 == 0) ? 128 : 1024;
            if (PH(8)) _Pragma("unroll 1") for (int r2 = 0; r2 < REP_SWA; ++r2) for (int v = js; v < nvs; v += njs) { const int b = 4 * xs + (v >> 5), kv = (v >> 4) & 1, qb = v & 15;
                swa_block(b, kv, qb, P, VT, OB, M2c, AIN(11) + l * 8, gout, lds, tid, lane, wave); }
            if (PH(9)) _Pragma("unroll 1") for (int r2 = 0; r2 < REP_SB; ++r2) for (int v = js; v < nvs; v += njs) { const int b = 4 * xs + (v >> 5), hb = (v >> 3) & 3, qb = v & 7;
                sb_block(b, hb, qb, P, VT, OB, gout, lds, tid, lane, wave); }
            if (PH(10)) _Pragma("unroll 1") for (int r2 = 0; r2 < REP_DSA; ++r2) dsa_phase(P, VT, (const float*)(ws + WS_WI), OB, gout, M2a, (unsigned*)(ws + WS_CTL) + CW_QUEUE + 1024 * l + 256 * rep + 128 * r2, lds, tid, lane, wave);
            }
        }
        SEAM(s0 + 2);
        if (PH(4) && IN(s0 + 3)) _Pragma("unroll 1") for (int rep = 0; rep < REP_G4; ++rep) {
            KP(); stagger(STAG_O);
            const bf16_t* wl = (const bf16_t*)(ws + WS_W + (size_t)l * W_LAYER); const float* modl = (const float*)(ws + WS_MOD) + (size_t)l * BATCH * 6144;
            pg8::Gemm g{(const bf16_t*)(ws + WS_O), wl + W_O / 2, MROWS, DM, DM}; pg8::StaticOrder S; S.init(MROWS, DM, G, (int)blockIdx.x);
            pg8::EpiResid E{l == 0 ? (const void*)AIN(0) : (const void*)(ws + WS_X16), rep ? (void*)(ws + WS_DUMMY) : (void*)(ws + WS_X16), modl + 2 * DM, rep ? (bf16_t*)(ws + WS_DUMMY) : (bf16_t*)(ws + WS_H),
                            AIN(3) + l * DM, modl + 4 * DM, rep ? (float*)(ws + WS_DUMMY) : (float*)(ws + WS_SS), 1, l == 0 ? 1 : 0, 0};
            pg8::gemm_phase<pg8::EpiResid, pg8::StaticOrder, true, true>(lds, g, S, E);
        }
        SEAM(s0 + 3);
        if (PH(6) && IN(s0 + 4)) _Pragma("unroll 1") for (int rep = 0; rep < REP_G6; ++rep) {
            KP();
            const bf16_t* wl = (const bf16_t*)(ws + WS_W + (size_t)l * W_LAYER);
            pg8::Gemm g{(const bf16_t*)(ws + WS_H), wl + W_GU / 2, MROWS, NGU, DM}; pg8::StaticOrder S; S.init(MROWS, NGU, G, (int)blockIdx.x);
            pg8::EpiSwiGLU E{(bf16_t*)(ws + WS_ACT), (const float*)(ws + WS_SS), (const float*)(ws + WS_BG) + (size_t)l * BATCH * DFF, (const float*)(ws + WS_BU) + (size_t)l * BATCH * DFF};
            pg8::gemm_phase<pg8::EpiSwiGLU, pg8::StaticOrder, true, true>(lds, g, S, E);
        }
        SEAM(s0 + 4);
        if (PH(7) && IN(s0 + 5)) _Pragma("unroll 1") for (int rep = 0; rep < REP_G7; ++rep) {
            KP(); stagger(STAG_D);
            const bf16_t* wl = (const bf16_t*)(ws + WS_W + (size_t)l * W_LAYER); const float* mod = (const float*)(ws + WS_MOD); const float* modl = mod + (size_t)l * BATCH * 6144;
            pg8::Gemm g{(const bf16_t*)(ws + WS_ACT), wl + W_D / 2, MROWS, DM, DFF}; pg8::StaticOrder S; S.init(MROWS, DM, G, (int)blockIdx.x);
            const int ln = (l + 1 < DEPTH) ? l + 1 : l;
            const int last = (l + 1 == DEPTH);
            pg8::EpiResid E{(const void*)(ws + WS_X16), rep ? (void*)(ws + WS_DUMMY) : (last ? (void*)AOUT() : (void*)(ws + WS_X16)), modl + 5 * DM, rep ? (bf16_t*)(ws + WS_DUMMY) : (bf16_t*)(ws + WS_H),
                            AIN(2) + ln * DM, mod + (size_t)ln * BATCH * 6144 + DM, rep ? (float*)(ws + WS_DUMMY) : (float*)(ws + WS_SS), last ? 0 : 1, 0, (last && !rep) ? 1 : 0};
            pg8::gemm_phase<pg8::EpiResid, pg8::StaticOrder, true, true>(lds, g, S, E);
        }
        SEAM(s0 + 5);
    }
#undef IN
#undef SEAM
}

extern "C" void kernel_launch(void* const* d_in, const int* in_sizes, int n_in, void* d_out, int out_size, void* d_ws, size_t ws_size, hipStream_t stream) {
    static int grid = 0;
    if (grid == 0) {
        if (n_in != 17 || in_sizes[0] != MROWS * DM || out_size != MROWS * DM || ws_size < WS_END) {
            fprintf(stderr, "kernel_launch: unexpected problem (n_in %d, in0 %d, out %d, ws %zu); nothing launched\n", n_in, n_in > 0 ? in_sizes[0] : -1, out_size, ws_size); grid = -1; return; }
        int dev = 0, cus = 0, per_cu = 0;
        if (hipGetDevice(&dev) != hipSuccess || hipDeviceGetAttribute(&cus, hipDeviceAttributeMultiprocessorCount, dev) != hipSuccess) { grid = -1; return; }
        if (hipFuncSetAttribute((const void*)fwd, hipFuncAttributeMaxDynamicSharedMemorySize, LDS_BYTES) != hipSuccess) { fprintf(stderr, "kernel_launch: hipFuncSetAttribute failed\n"); grid = -1; return; }
        if (hipOccupancyMaxActiveBlocksPerMultiprocessor(&per_cu, (const void*)fwd, NWAVES * 64, LDS_BYTES) != hipSuccess || per_cu < 1) {
            fprintf(stderr, "kernel_launch: occupancy query reports %d workgroups per CU\n", per_cu); per_cu = 1; }
        (void)hipGetLastError();
        grid = cus;
    }
    if (grid < 0) return;
    if (hipMemsetAsync((char*)d_ws + WS_CTL, 0, CTL_BYTES, stream) != hipSuccess) return;
    Args a{};
    for (int i = 0; i < 17; ++i) a.in[i] = (const float*)d_in[i];
    a.out = (float*)d_out; a.ws = (unsigned char*)d_ws;
#if MK_MULTI
    for (int s = 0; s < NSTEPS; ++s) { a.lo = s; a.hi = s + 1; hipLaunchKernelGGL(fwd, dim3(grid), dim3(NWAVES * 64), LDS_BYTES, stream, a); }
#else
    a.lo = 0; a.hi = NSTEPS;
    hipLaunchKernelGGL(fwd, dim3(grid), dim3(NWAVES * 64), LDS_BYTES, stream, a);
#endif
}
```

```cpp
#include <hip/hip_runtime.h>
#include <cstdio>
#include <cstdint>

#ifndef MK_MULTI
#define MK_MULTI 0
#endif

#define LAS __attribute__((address_space(3)))
#define GAS __attribute__((address_space(1)))
__device__ __forceinline__ int lane_id_v() { int l; asm volatile("v_mbcnt_lo_u32_b32 %0, -1, 0\n\tv_mbcnt_hi_u32_b32 %0, -1, %0" : "=v"(l)); return l; }
namespace pg8 {
#define PG8_LAS __attribute__((address_space(3)))
typedef unsigned short bf16_t;
typedef short bf16x8 __attribute__((ext_vector_type(8)));
typedef float f32x4 __attribute__((ext_vector_type(4)));
typedef unsigned u32x4 __attribute__((ext_vector_type(4)));
constexpr int BM = 256, BK = 64, HALF = 128, HTB = HALF * BK * 2  , STAGE_BYTES = 8 * HTB, NXCD = 8, WGM = 8;

__host__ __device__ __forceinline__ int lds_byte(int r, int c) { const int st = (r >> 4) * 2 + (c >> 5), rr = r & 15, cc = c & 31, ob = rr * 64 + cc * 2; return st * 1024 + (ob ^ (((ob >> 9) & 1) << 5)); }
__host__ __device__ __forceinline__ void stage_rc(int b, int& R, int& C) { const int st = b / 1024, sb = b % 1024, swz = sb ^ (((sb >> 9) & 1) << 5); R = (st >> 1) * 16 + swz / 64; C = (st & 1) * 32 + (swz % 64) / 2; }
__host__ __device__ __forceinline__ int perm32(int rho) { const int n = rho >> 4, i = rho & 15; return 8 * (i >> 2) + 4 * n + (i & 3); }

struct Unit { int pm, pn; };
struct Gemm { const bf16_t* A; const bf16_t* Bt; int M, N, K; };

struct StaticOrder {
    int nM, nN, nwg, G, c;
    __host__ __device__ void init(int M, int N, int G_, int c_) { nM = M / BM; nN = N / BM; nwg = nM * nN; G = G_; c = c_; }
    __host__ __device__ bool next(int i, Unit& u) const {
        const long L = (long)i * G + c; if (L >= nwg) return false;
        int wgid = (int)L; { const int q = nwg / NXCD, r = nwg % NXCD, xcd = wgid % NXCD, off = wgid / NXCD; wgid = (xcd < r ? xcd * (q + 1) : r * (q + 1) + (xcd - r) * q) + off; }
        const int nig = WGM * nN, gid = wgid / nig, fm = gid * WGM, gsz = (nM - fm) < WGM ? (nM - fm) : WGM;
        u.pm = fm + ((wgid % nig) % gsz); u.pn = (wgid % nig) / gsz; return true;
    }
    __device__ __forceinline__ void a_ready(const Unit&) const {}
    __device__ __forceinline__ void done(const Unit&) const {}
};
#ifndef RELAX_V
#define RELAX_V 0
#endif
template <class Epi, class Sched, bool ALIGN_EPI = false, bool SP2 = false>
__device__ __forceinline__ void gemm_phase(PG8_LAS unsigned char* lds, const Gemm g, const Sched& S, const Epi& E, int wave_) {
    int tid_o = wave_ * 64 + lane_id_v(); asm volatile("" : "+v"(tid_o));
    const int tid = tid_o, wid = __builtin_amdgcn_readfirstlane(tid >> 6), lane = tid & 63, wr = wid >> 2, wc = wid & 3, fr = lane & 15, fq = lane >> 4;
    const int K = g.K, nt = K / BK;
    unsigned voffA[2], voffB[2];
#pragma unroll
    for (int i = 0; i < 2; ++i) { int R, C; stage_rc(tid * 16 + i * 8192, R, C); const int Rb = Epi::PERM ? ((R & ~31) + perm32(R & 31)) : R;
        voffA[i] = (unsigned)(R * K + C) * 2u; voffB[i] = (unsigned)(Rb * K + C) * 2u; }
    const size_t kstep = (size_t)(BK * 2);
    const size_t hstep = (size_t)HALF * K * 2;
    const size_t tstep = 2 * hstep;
    const unsigned ldsw = (unsigned)wid * 1024u;
    const int aoff = lds_byte(wr * 64 + fr, fq * 8), boff = lds_byte(wc * 32 + fr, fq * 8);
#define PG8_SA(b, h) (((b) * 2 + (h)) * HTB)
#define PG8_SB(b, h) ((4 + (b) * 2 + (h)) * HTB)
#define PG8_STAGE(bufoff, gbase, voff) do { _Pragma("unroll") for (int _i = 0; _i < 2; ++_i) \
        __builtin_amdgcn_global_load_lds((const unsigned*)((const char*)(gbase) + (voff)[_i]), (PG8_LAS unsigned*)(lds + (bufoff) + ldsw + _i * 8192), 16, 0, 0); } while (0)
#define PG8_LDA(dst, b, h) do { _Pragma("unroll") for (int m = 0; m < 4; ++m) _Pragma("unroll") for (int k = 0; k < 2; ++k) dst[m][k] = *(const PG8_LAS bf16x8*)(lds + PG8_SA(b, h) + aoff + m * 2048 + k * 1024); } while (0)
#define PG8_LDB(dst, b, h) do { _Pragma("unroll") for (int n = 0; n < 2; ++n) _Pragma("unroll") for (int k = 0; k < 2; ++k) dst[n][k] = *(const PG8_LAS bf16x8*)(lds + PG8_SB(b, h) + boff + n * 2048 + k * 1024); } while (0)
#define PG8_MMA(ai, bj, At, Bt) do { __builtin_amdgcn_s_setprio(1); _Pragma("unroll") for (int m = 0; m < 4; ++m) _Pragma("unroll") for (int n = 0; n < 2; ++n) _Pragma("unroll") for (int k = 0; k < 2; ++k) \
        acc[ai][bj][m][n] = __builtin_amdgcn_mfma_f32_16x16x32_bf16(Bt[n][k], At[m][k], acc[ai][bj][m][n], 0, 0, 0); __builtin_amdgcn_s_setprio(0); } while (0)
#define PG8_WAIT_V(n) asm volatile("s_waitcnt vmcnt(" #n ")" ::: "memory")
#define PG8_WAIT_L(n) asm volatile("s_waitcnt lgkmcnt(" #n ")" ::: "memory")
#define PG8_BAR __builtin_amdgcn_s_barrier()
#define PG8_SCHED __builtin_amdgcn_sched_barrier(0)
    Unit cur, nxt; int ui = 0;
    if (!S.next(0, cur)) return;
    f32x4 acc[2][2][4][2];
#pragma unroll
    for (int a = 0; a < 2; ++a)
#pragma unroll
        for (int b = 0; b < 2; ++b)
#pragma unroll
            for (int m = 0; m < 4; ++m)
#pragma unroll
                for (int n = 0; n < 2; ++n) acc[a][b][m][n] = (f32x4){0.f, 0.f, 0.f, 0.f};
    bf16x8 At[4][2], B0[2][2], B1[2][2];
    const char* cA = (const char*)g.A + (size_t)cur.pm * tstep; const char* cB = (const char*)g.Bt + (size_t)cur.pn * tstep;
    S.a_ready(cur);
    if constexpr (SP2) {
        PG8_STAGE(PG8_SB(0, 0), cB, voffB); PG8_STAGE(PG8_SB(0, 1), cB + hstep, voffB); PG8_STAGE(PG8_SA(0, 0), cA, voffA); PG8_STAGE(PG8_SA(0, 1), cA + hstep, voffA);
        if (wr == 1) PG8_BAR;
        PG8_WAIT_V(2); PG8_BAR;
        PG8_STAGE(PG8_SB(1, 0), cB + kstep, voffB); PG8_STAGE(PG8_SA(1, 0), cA + kstep, voffA); PG8_STAGE(PG8_SB(1, 1), cB + hstep + kstep, voffB);
        PG8_WAIT_V(6); PG8_BAR;
    } else {
        PG8_STAGE(PG8_SB(0, 0), cB, voffB); PG8_STAGE(PG8_SA(0, 0), cA, voffA); PG8_STAGE(PG8_SB(0, 1), cB + hstep, voffB); PG8_STAGE(PG8_SA(0, 1), cA + hstep, voffA);
        if (wr == 1) PG8_BAR;
        PG8_WAIT_V(4); PG8_BAR;
        PG8_STAGE(PG8_SB(1, 0), cB + kstep, voffB); PG8_STAGE(PG8_SA(1, 0), cA + kstep, voffA); PG8_STAGE(PG8_SB(1, 1), cB + hstep + kstep, voffB);
        PG8_WAIT_V(6); PG8_BAR;
    }
    for (;;) {
        const bool has_next = S.next(ui + 1, nxt);
        const char* nA = has_next ? (const char*)g.A + (size_t)nxt.pm * tstep : cA; const char* nB = has_next ? (const char*)g.Bt + (size_t)nxt.pn * tstep : cB;
#ifdef KREP_PROBE
        _Pragma("unroll 1") for (int kr = 0; kr < Epi::KREP; ++kr) {
        if (kr > 0) {
            _Pragma("unroll") for (int a = 0; a < 2; ++a) _Pragma("unroll") for (int b = 0; b < 2; ++b) _Pragma("unroll") for (int m = 0; m < 4; ++m) _Pragma("unroll") for (int n = 0; n < 2; ++n) acc[a][b][m][n] = (f32x4){0.f, 0.f, 0.f, 0.f};
        }
        const bool lastrep = (kr == Epi::KREP - 1);
#else
        const bool lastrep = true;
#endif
        for (int t = 0; t < nt; t += 2) {
            const bool last = (t == nt - 2);
            const char* a1 = cA + (size_t)(t + 1) * kstep;
            const char* a2 = last ? (lastrep ? nA : cA) : cA + (size_t)(t + 2) * kstep; const char* b2 = last ? (lastrep ? nB : cB) : cB + (size_t)(t + 2) * kstep;
            const char* a3 = a2 + kstep; const char* b3 = b2 + kstep;
            if (last && has_next) S.a_ready(nxt);
            if constexpr (SP2) {
            PG8_LDB(B0, 0, 0); PG8_LDB(B1, 0, 1); PG8_SCHED; PG8_LDA(At, 0, 0); PG8_STAGE(PG8_SA(1, 1), a1 + hstep, voffA);
            if constexpr (RELAX_V != 0) { const int rlx = __builtin_amdgcn_readfirstlane((t == 0 && ui > 0) ? 1 : 0);
                asm volatile("s_cmp_lg_u32 %0, 0\n\ts_cbranch_scc1 .Lrlx%=\n\ts_waitcnt vmcnt(8)\n.Lrlx%=:\n\ts_waitcnt vmcnt(%1)" :: "s"(rlx), "n"(8 + Epi::NVM) : "memory", "scc"); }
            else PG8_WAIT_V(8);
            PG8_WAIT_L(0); PG8_BAR; PG8_MMA(0, 0, At, B0); PG8_MMA(0, 1, At, B1); PG8_BAR; PG8_SCHED;
            PG8_LDA(At, 0, 1); PG8_STAGE(PG8_SB(0, 0), b2, voffB); PG8_STAGE(PG8_SB(0, 1), b2 + hstep, voffB); PG8_STAGE(PG8_SA(0, 0), a2, voffA);
            PG8_WAIT_V(8); PG8_WAIT_L(0); PG8_BAR; PG8_MMA(1, 0, At, B0); PG8_MMA(1, 1, At, B1); PG8_BAR; PG8_SCHED;
            PG8_LDB(B0, 1, 0); PG8_LDB(B1, 1, 1); PG8_SCHED; PG8_LDA(At, 1, 0); PG8_STAGE(PG8_SA(0, 1), a2 + hstep, voffA);
            PG8_WAIT_V(8); PG8_WAIT_L(0); PG8_BAR; PG8_MMA(0, 0, At, B0); PG8_MMA(0, 1, At, B1); PG8_BAR; PG8_SCHED;
            PG8_LDA(At, 1, 1); PG8_STAGE(PG8_SB(1, 0), b3, voffB); PG8_STAGE(PG8_SB(1, 1), b3 + hstep, voffB); PG8_STAGE(PG8_SA(1, 0), a3, voffA);
            PG8_WAIT_V(8); PG8_WAIT_L(0); PG8_BAR; PG8_MMA(1, 0, At, B0); PG8_MMA(1, 1, At, B1); PG8_BAR; PG8_SCHED;
            } else {
            PG8_LDB(B0, 0, 0); PG8_SCHED; PG8_LDA(At, 0, 0); PG8_STAGE(PG8_SA(1, 1), a1 + hstep, voffA);
            PG8_WAIT_L(8); PG8_BAR; PG8_WAIT_L(0); PG8_MMA(0, 0, At, B0); PG8_BAR; PG8_SCHED;
            PG8_LDB(B1, 0, 1); PG8_STAGE(PG8_SB(0, 0), b2, voffB);
            PG8_BAR; PG8_WAIT_L(0); PG8_MMA(0, 1, At, B1); PG8_BAR;
            PG8_LDA(At, 0, 1); PG8_STAGE(PG8_SA(0, 0), a2, voffA);
            PG8_BAR; PG8_WAIT_L(0); PG8_MMA(1, 0, At, B0); PG8_BAR; PG8_SCHED;
            PG8_STAGE(PG8_SB(0, 1), b2 + hstep, voffB);
            PG8_WAIT_V(6); PG8_BAR; PG8_MMA(1, 1, At, B1); PG8_BAR;
            PG8_LDB(B0, 1, 0); PG8_SCHED; PG8_LDA(At, 1, 0); PG8_STAGE(PG8_SA(0, 1), a2 + hstep, voffA);
            PG8_WAIT_L(8); PG8_BAR; PG8_WAIT_L(0); PG8_MMA(0, 0, At, B0); PG8_BAR; PG8_SCHED;
            PG8_LDB(B1, 1, 1); PG8_STAGE(PG8_SB(1, 0), b3, voffB);
            PG8_BAR; PG8_WAIT_L(0); PG8_MMA(0, 1, At, B1); PG8_BAR;
            PG8_LDA(At, 1, 1); PG8_STAGE(PG8_SA(1, 0), a3, voffA);
            PG8_BAR; PG8_WAIT_L(0); PG8_MMA(1, 0, At, B0); PG8_BAR; PG8_SCHED;
            PG8_STAGE(PG8_SB(1, 1), b3 + hstep, voffB);
            PG8_WAIT_V(6); PG8_BAR; PG8_MMA(1, 1, At, B1); PG8_BAR;
            }
        }
#ifdef KREP_PROBE
        }
#endif
        if constexpr (ALIGN_EPI) { if (wr == 0) PG8_BAR; }
#ifdef KREP_PROBE
        if constexpr (Epi::EREP > 1) { _Pragma("unroll 1") for (int er = 1; er < Epi::EREP; ++er) { int fr2 = fr, fq2 = fq; asm volatile("" : "+v"(fr2), "+v"(fq2)); E(acc, cur, wr, wc, fr2, fq2); asm volatile("" ::: "memory"); } }
#endif
        if constexpr (!Epi::AFTER_DRAIN) { E(acc, cur, wr, wc, fr, fq); S.done(cur); }
        if (!has_next) break;
#pragma unroll
        for (int a = 0; a < 2; ++a)
#pragma unroll
            for (int b = 0; b < 2; ++b)
#pragma unroll
                for (int m = 0; m < 4; ++m)
#pragma unroll
                    for (int n = 0; n < 2; ++n) acc[a][b][m][n] = (f32x4){0.f, 0.f, 0.f, 0.f};
        cur = nxt; cA = nA; cB = nB; ++ui;
        if constexpr (ALIGN_EPI) { if (wr == 1) PG8_BAR; }
    }
    PG8_WAIT_V(0);
    if constexpr (!ALIGN_EPI) { if (wr == 0) PG8_BAR; }
    PG8_BAR;
    if constexpr (Epi::AFTER_DRAIN) { E.fused(acc, cur, wr, wc, fr, fq, lds, wid, lane); S.done(cur); }
#undef PG8_SA
#undef PG8_SB
#undef PG8_STAGE
#undef PG8_LDA
#undef PG8_LDB
#undef PG8_MMA
#undef PG8_WAIT_V
#undef PG8_WAIT_L
#undef PG8_BAR
#undef PG8_SCHED
}
}

#define XB_TMO      128
#define XB_XCNT(j)  (256  + 64 * (j))
#define XB_XSUB(j)  (1280 + 64 * (j))
#define XB_XGEN(j)  (2304 + 64 * (j))
#define XB_TOP      3328
#define XB_TOPGEN   3392
#define XCD_BAR_WORDS 3456
#define XB_SPIN_CAP (1u << 24)

__device__ __forceinline__ unsigned xb_ld(unsigned* p)              { return __hip_atomic_load(p, __ATOMIC_RELAXED, __HIP_MEMORY_SCOPE_AGENT); }
__device__ __forceinline__ unsigned xb_add(unsigned* p, unsigned v) { return __hip_atomic_fetch_add(p, v, __ATOMIC_RELAXED, __HIP_MEMORY_SCOPE_AGENT); }
__device__ __forceinline__ unsigned xb_xcc_id() { return (unsigned)__builtin_amdgcn_s_getreg((3 << 11) | 20) & 0xFu; }
#define XB_SPIN(cond, bar) do { unsigned _sp = 0; while (cond) { __builtin_amdgcn_s_sleep(1); \
    if ((++_sp & 255u) == 0u) { if (xb_ld(&(bar)[XB_TMO])) break; if (_sp > XB_SPIN_CAP) { atomicAdd(&(bar)[XB_TMO], 1u); break; } } } } while (0)

struct XcdBarrier {
    unsigned* bar; unsigned x; int w;
    volatile LAS unsigned* st;
};

#define XB_THREAD0(w) ((w) == 0 && lane_id_v() == 0)
__device__ __forceinline__ XcdBarrier xcd_barrier_post(unsigned* bar, volatile LAS unsigned* st, int w) {
    XcdBarrier b; b.bar = bar; b.x = xb_xcc_id(); b.st = st; b.w = w;
    if (XB_THREAD0(w)) (void)xb_add(&bar[XB_XCNT(b.x)], 1u);
    return b;
}
__device__ __forceinline__ void xcd_barrier_complete(unsigned* bar, unsigned x, unsigned& nloc, unsigned& nx) {
    const unsigned G = gridDim.x * gridDim.y * gridDim.z;
    unsigned sum, cnt, mine, sp = 0u;
    for (;;) {
        sum = 0u; cnt = 0u; mine = 0u;
#pragma unroll
        for (unsigned j = 0; j < 16; ++j) { const unsigned c = xb_ld(&bar[XB_XCNT(j)]); sum += c; cnt += (c > 0u) ? 1u : 0u; mine = (j == x) ? c : mine; }
        if (sum == G) break;
        __builtin_amdgcn_s_sleep(1);
        if ((++sp & 255u) == 0u) { if (xb_ld(&bar[XB_TMO])) break; if (sp > XB_SPIN_CAP) { atomicAdd(&bar[XB_TMO], 1u); break; } }
    }
    nloc = mine > 0u ? mine : 1u; nx = cnt > 0u ? cnt : 1u;
}

__device__ __forceinline__ void xcd_barrier(const XcdBarrier& b) {
    asm volatile("s_waitcnt vmcnt(0)" ::: "memory");
    __syncthreads();
    if (XB_THREAD0(b.w)) {
        unsigned* bar = b.bar;
        __builtin_amdgcn_s_waitcnt(0);
        unsigned nloc = b.st[0], nx = b.st[1];
        if (nloc == 0u) { xcd_barrier_complete(bar, b.x, nloc, nx); b.st[0] = nloc; b.st[1] = nx; }
        const unsigned old = xb_add(&bar[XB_XSUB(b.x)], 1u);
        const unsigned gen = old / nloc;
        if (old + 1u == (gen + 1u) * nloc) {
            __builtin_amdgcn_fence(__ATOMIC_RELEASE, "agent");
            asm volatile("s_waitcnt vmcnt(0)" ::: "memory");
            const unsigned og = xb_add(&bar[XB_TOP], 1u);
            const unsigned tg = og / nx;
            if (og + 1u == (tg + 1u) * nx) xb_add(&bar[XB_TOPGEN], 1u);
            else XB_SPIN(xb_ld(&bar[XB_TOPGEN]) == tg, bar);
            __builtin_amdgcn_fence(__ATOMIC_ACQUIRE, "agent");
            xb_add(&bar[XB_XGEN(b.x)], 1u);
            asm volatile("s_waitcnt vmcnt(0)" ::: "memory");
        } else {
            XB_SPIN(xb_ld(&bar[XB_XGEN(b.x)]) == gen, bar);
            __builtin_amdgcn_fence(__ATOMIC_ACQUIRE, "agent");
            asm volatile("s_waitcnt vmcnt(0)" ::: "memory");
        }
    }
    __syncthreads();
}

#define LAS __attribute__((address_space(3)))
#define GAS __attribute__((address_space(1)))
typedef unsigned short bf16_t;
typedef short bf16x8 __attribute__((ext_vector_type(8)));
typedef float f32x4 __attribute__((ext_vector_type(4)));
typedef float f32x2 __attribute__((ext_vector_type(2)));
typedef float f32x16 __attribute__((ext_vector_type(16)));
typedef unsigned u32x4 __attribute__((ext_vector_type(4)));
typedef unsigned u32x2 __attribute__((ext_vector_type(2)));
typedef __bf16 bf16x2v __attribute__((ext_vector_type(2)));

constexpr int NWAVES = 8;
constexpr int BATCH = 32, SEQ = 2048, DM = 1024, DEPTH = 4, MROWS = BATCH * SEQ;
constexpr int NIN = 2304, INCOLS = 2244, DFF = 2816, NGU = 2 * DFF, NVS = 7;
constexpr float EPS = 1e-6f, LOG2E = 1.4426950408889634f, C2 = 0.18033688011112042f;
constexpr int NSTEPS = 2 + 5 * DEPTH;
#ifndef IDX_QD
#define IDX_QD 6
#endif
#ifndef PHMASK
#define PHMASK 0xffff
#endif
#define PH(i) ((PHMASK >> (i)) & 1)
#ifndef DSA_S
#define DSA_S 15
#endif
#ifndef REP_ATT
#define REP_ATT 1
#endif
#ifndef REP_SWA
#define REP_SWA 1
#endif
#ifndef REP_SB
#define REP_SB 1
#endif
#ifndef REP_DSA
#define REP_DSA 1
#endif
#ifndef DSA_R1
#define DSA_R1 1
#endif
#ifndef DSA_R2
#define DSA_R2 1
#endif
#ifndef DSA_R3
#define DSA_R3 1
#endif
#ifndef REP_BIS
#define REP_BIS 1
#endif
#ifndef REP_PA
#define REP_PA 1
#endif
#ifndef REP_PB
#define REP_PB 1
#endif
#ifndef TEST_SELN
#define TEST_SELN 2
#endif
#ifndef STAG_O
#define STAG_O 0
#endif
#ifndef STAG_D
#define STAG_D 0
#endif
#ifndef STAG_I
#define STAG_I 0
#endif
#ifndef REP_G
#define REP_G 1
#endif
#ifndef REP_G2
#define REP_G2 REP_G
#endif
#ifndef REP_G4
#define REP_G4 REP_G
#endif
#ifndef REP_G6
#define REP_G6 REP_G
#endif
#ifndef REP_G7
#define REP_G7 REP_G
#endif
#ifndef REP_N
#define REP_N 1
#endif

constexpr size_t MiB = 1u << 20;
constexpr size_t WS_CTL = 0, CTL_BYTES = MiB;
constexpr size_t WS_ROPE = 1 * MiB;
constexpr size_t WS_MOD = 2 * MiB;
constexpr size_t WS_WI = 5 * MiB;
constexpr size_t WS_W = 8 * MiB, W_LAYER = 23 * MiB;
constexpr size_t W_IN = 0, W_O = 4608 * 1024, W_GU = W_O + 2 * MiB, W_D = W_GU + 11 * MiB;
constexpr size_t WS_H = 104 * MiB;
constexpr size_t WS_ACT = 232 * MiB;
constexpr size_t WS_P = WS_ACT;
constexpr size_t WS_VT = WS_ACT + 288 * MiB;
constexpr size_t WS_O = 584 * MiB;
constexpr size_t WS_SS = 712 * MiB;
constexpr size_t WS_B1 = 716 * MiB;
constexpr size_t WS_BG = 718 * MiB, WS_BU = 720 * MiB;
constexpr size_t WS_X16 = 724 * MiB;
constexpr size_t WS_END = 852 * MiB, WS_DUMMY = 852 * MiB;
static_assert(W_D + (size_t)DM * DFF * 2 <= W_LAYER && WS_W + DEPTH * W_LAYER <= WS_H && WS_VT + (size_t)BATCH * NVS * 64 * SEQ * 2 <= WS_END, "ws map");
static_assert((size_t)MROWS * NIN * 2 == 288 * MiB && (size_t)MROWS * DFF * 2 == 352 * MiB, "ws map 2");

constexpr int CW_BAR = 4096, CW_QUEUE = 8192;

constexpr int SC_STRIDE = 2052;
constexpr int SCH = 2056;
constexpr int G2_SC = 0;
constexpr int G2_MASK = 16 * SCH * 2, MASK_STRIDE = 66;
constexpr int G2_LSUM = G2_MASK + 16 * MASK_STRIDE * 4;
constexpr int G2_SSUM = G2_LSUM + 1024;
constexpr int G2_BYTES = G2_SSUM + 1024;
constexpr int LDS_MISC = 2 * G2_BYTES;
constexpr int LDS_BYTES = 147456;
static_assert(LDS_MISC + 64 <= LDS_BYTES && 4 * 64 * 64 * 4 <= G2_MASK && (G2_BYTES % 16) == 0 && LDS_MISC >= 131072 + 4096, "lds map");

#define LDS_WAIT() asm volatile("s_waitcnt lgkmcnt(0)" ::: "memory")
__device__ __forceinline__ unsigned cvtpk(float lo, float hi) { f32x2 v = {lo, hi}; bf16x2v b = __builtin_convertvector(v, bf16x2v); return __builtin_bit_cast(unsigned, b); }
__device__ __forceinline__ bf16x8 ldg16(const bf16_t* p) { return *(const GAS bf16x8*)p; }
#define RELU(x) __builtin_amdgcn_fmed3f((x), 0.f, __builtin_fabsf(x))
__device__ __forceinline__ float ex2(float x) { return __builtin_amdgcn_exp2f(x); }
__device__ __forceinline__ float lg2(float x) { return __builtin_amdgcn_logf(x); }
__device__ __forceinline__ int crow(int i, int h) { return (i & 3) + 8 * (i >> 2) + 4 * h; }
#define MFMA32(a, b, c) __builtin_amdgcn_mfma_f32_32x32x16_bf16((a), (b), (c), 0, 0, 0)
#define MFMA16(a, b, c) __builtin_amdgcn_mfma_f32_16x16x32_bf16((a), (b), (c), 0, 0, 0)
__device__ __forceinline__ bf16x8 pack8(const f32x16& x, int s) {
    u32x4 p; p.x = cvtpk(x[8 * s], x[8 * s + 1]); p.y = cvtpk(x[8 * s + 2], x[8 * s + 3]); p.z = cvtpk(x[8 * s + 4], x[8 * s + 5]); p.w = cvtpk(x[8 * s + 6], x[8 * s + 7]);
    return __builtin_bit_cast(bf16x8, p);
}
__device__ __forceinline__ f32x16 zero16() { f32x16 z; for (int i = 0; i < 16; ++i) z[i] = 0.f; return z; }
__device__ __forceinline__ int wsum_i(int v) {
    v += __builtin_amdgcn_update_dpp(0, v, 0x111, 0xf, 0xf, false);
    v += __builtin_amdgcn_update_dpp(0, v, 0x112, 0xf, 0xf, false);
    v += __builtin_amdgcn_update_dpp(0, v, 0x114, 0xf, 0xf, false);
    v += __builtin_amdgcn_update_dpp(0, v, 0x118, 0xf, 0xf, false);
    v += __builtin_amdgcn_update_dpp(0, v, 0x142, 0xa, 0xf, false);
    v += __builtin_amdgcn_update_dpp(0, v, 0x143, 0xc, 0xf, false);
    return __builtin_amdgcn_readlane(v, 63);
}
__device__ __forceinline__ void stagger(unsigned ticks) {
    const unsigned g = blockIdx.x & 3u;
    if (ticks && g) { const unsigned long long t0 = __builtin_amdgcn_s_memrealtime(); while (__builtin_amdgcn_s_memrealtime() - t0 < (unsigned long long)(g * ticks)) __builtin_amdgcn_s_sleep(8); }
}
__device__ __forceinline__ float wave_max(float v) {
#pragma unroll
    for (int o = 1; o < 64; o <<= 1) v = fmaxf(v, __shfl_xor(v, o));
    return v;
}
__device__ __forceinline__ float wave_sum(float v) {
#pragma unroll
    for (int o = 1; o < 64; o <<= 1) v += __shfl_xor(v, o);
    return v;
}

__device__ __forceinline__ int slot_col(int s) {
    if (s < 4) return 64 * s;
    if (s < 8) return 384 + 64 * (s - 4);
    if (s == 8) return 256;
    if (s == 9) return 320;
    if (s == 10) return 640;
    if (s == 11) return 704;
    if (s < 16) return 708 + 64 * (s - 12);
    if (s < 20) return 964 + 64 * (s - 16);
    if (s < 24) return 1220 + 64 * (s - 20);
    if (s < 32) return 1476 + 64 * (s - 24);
    if (s < 34) return 1988 + 64 * (s - 32);
    return 2116 + 64 * (s - 34);
}

namespace pg8 {
struct EpiInProj {
    static constexpr bool PERM = true, AFTER_DRAIN = false;
#ifndef KREP_I
#define KREP_I 1
#endif
#ifndef KREP_R
#define KREP_R 1
#endif
#ifndef KREP_S
#define KREP_S 1
#endif
#ifndef EREP_I
#define EREP_I 1
#endif
#ifndef EREP_R
#define EREP_R 1
#endif
#ifndef EREP_S
#define EREP_S 1
#endif
    static constexpr int KREP = KREP_I, EREP = EREP_I;
    static constexpr int NVM = 16;
    bf16_t* P; bf16_t* VT; float* WI; const float* cs; const float* sn; const float* qn_a; const float* kn_a; const float* qn_c; const float* kn_c;
    const float* SS; const float* bias;
    LAS float* xl;
    __device__ __forceinline__ void operator()(const f32x4 (&acc)[2][2][4][2], const Unit& u, int wr, int wc, int fr, int fq) const {
        const int slot = u.pn * 4 + wc;
        int mode = 0; const float* gain = nullptr; float osc = 1.f; int vslot = 0;
        if (slot < 4) { mode = 2; gain = qn_a; osc = C2; }
        else if (slot < 8) { mode = 1; }
        else if (slot == 8) { mode = 2; gain = kn_a; }
        else if (slot == 9) { mode = 3; vslot = 0; }
        else if (slot == 10) { mode = 1; }
        else if (slot == 11) { mode = 4; }
        else if (slot < 16) { mode = 0; osc = C2; }
        else if (slot < 20) { mode = 0; }
        else if (slot < 24) { mode = 3; vslot = 1 + (slot - 20); }
        else if (slot < 32) { mode = 2; gain = qn_c; osc = C2; }
        else if (slot < 34) { mode = 2; gain = kn_c; }
        else { mode = 3; vslot = 5 + (slot - 34); }
        const int rowt = u.pm * BM + wr * 64 + fr;
        const int b = rowt / SEQ; const int tt = rowt % SEQ;
        const int pfr = (fr & 3) | ((fr & 4) << 1) | ((fr & 8) >> 1);
        bf16_t* vb = VT + ((size_t)(b * NVS + vslot) * 64) * SEQ;
        float rsv[2][4];
        LAS float* wl = xl + (wr * 4 + wc) * 128;
        LAS float* wb = wl + 8 * fq; LAS float* wg = wl + 64 + 8 * fq;
        f32x4 rc[2], rsn[2];
        { f32x4 p4[2][4];
#pragma unroll
          for (int ai = 0; ai < 2; ++ai)
#pragma unroll
              for (int m = 0; m < 4; ++m) p4[ai][m] = *(const f32x4*)(SS + (size_t)(rowt + ai * HALF + m * 16) * 16 + 4 * fq);
          const int l64 = fr + 16 * fq;
          const float bval = bias[(size_t)((u.pm * BM) / SEQ) * NIN + slot_col(slot) + l64], gval = (mode == 2) ? gain[l64] : 1.f;
          if (mode == 1 || mode == 2) { const int t = rowt % SEQ;
#pragma unroll
              for (int n = 0; n < 2; ++n) { rc[n] = *(const f32x4*)(cs + t * 32 + 8 * fq + 4 * n); rsn[n] = *(const f32x4*)(sn + t * 32 + 8 * fq + 4 * n); } }
          wl[l64] = bval; wl[64 + l64] = gval;
#pragma unroll
          for (int ai = 0; ai < 2; ++ai)
#pragma unroll
              for (int m = 0; m < 4; ++m) { float sq = (p4[ai][m][0] + p4[ai][m][1]) + (p4[ai][m][2] + p4[ai][m][3]); sq += __shfl_xor(sq, 16); sq += __shfl_xor(sq, 32);
                  rsv[ai][m] = __builtin_amdgcn_rsqf(sq * (1.f / DM) + EPS); } }
        asm volatile("" ::: "memory");
#define ADJ_ROW(AI, M) const float rs = rsv[AI][M]; \
                f32x4 v1[2] = {acc[AI][0][M][0] * rs + *(LAS f32x4*)(wb), acc[AI][0][M][1] * rs + *(LAS f32x4*)(wb + 4)}, v2[2] = {acc[AI][1][M][0] * rs + *(LAS f32x4*)(wb + 32), acc[AI][1][M][1] * rs + *(LAS f32x4*)(wb + 36)}
#define STORE_ROW(ROW) do { u32x4 w1, w2; \
                w1.x = cvtpk(v1[0][0] * osc, v1[0][1] * osc); w1.y = cvtpk(v1[0][2] * osc, v1[0][3] * osc); w1.z = cvtpk(v1[1][0] * osc, v1[1][1] * osc); w1.w = cvtpk(v1[1][2] * osc, v1[1][3] * osc); \
                w2.x = cvtpk(v2[0][0] * osc, v2[0][1] * osc); w2.y = cvtpk(v2[0][2] * osc, v2[0][3] * osc); w2.z = cvtpk(v2[1][0] * osc, v2[1][1] * osc); w2.w = cvtpk(v2[1][2] * osc, v2[1][3] * osc); \
                bf16_t* op = P + (size_t)(ROW) * NIN + slot * 64 + 8 * fq; *(u32x4*)op = w1; *(u32x4*)(op + 32) = w2; } while (0)
        if (mode == 3) {
            LAS unsigned short* vt = (LAS unsigned short*)(xl + 1024) + (wr * 4 + wc) * 512;
            const int l64 = fr + 16 * fq;
            LAS unsigned short* vw = vt + 128 * fq + pfr;
            const LAS u32x4* vr = (const LAS u32x4*)(vt + 8 * l64);
            const unsigned gofs = (unsigned)((l64 >> 1) * SEQ + 8 * (l64 & 1));
            bf16_t* vgb = vb + (u.pm * BM + wr * 64) % SEQ;
#pragma unroll
            for (int ai = 0; ai < 2; ++ai)
#pragma unroll
                for (int m = 0; m < 4; ++m) { ADJ_ROW(ai, m);
#pragma unroll
                    for (int n = 0; n < 2; ++n)
#pragma unroll
                        for (int e = 0; e < 4; e += 2) { const unsigned w = cvtpk(v1[n][e], v1[n][e + 1]); vw[(4 * n + e) * 16] = (unsigned short)(w & 0xffffu); vw[(4 * n + e + 1) * 16] = (unsigned short)(w >> 16); }
                    const u32x4 r1 = *vr;
                    asm volatile("" ::: "memory");
#pragma unroll
                    for (int n = 0; n < 2; ++n)
#pragma unroll
                        for (int e = 0; e < 4; e += 2) { const unsigned w = cvtpk(v2[n][e], v2[n][e + 1]); vw[(4 * n + e) * 16] = (unsigned short)(w & 0xffffu); vw[(4 * n + e + 1) * 16] = (unsigned short)(w >> 16); }
                    const u32x4 r2 = *vr;
                    *(u32x4*)(vgb + (ai * HALF + m * 16) + gofs) = r1; *(u32x4*)(vgb + (32 * SEQ + ai * HALF + m * 16) + gofs) = r2;
                    asm volatile("" ::: "memory"); }
        } else if (mode == 4) {
#pragma unroll
            for (int ai = 0; ai < 2; ++ai)
#pragma unroll
                for (int m = 0; m < 4; ++m) { ADJ_ROW(ai, m); (void)v2; if (fq == 0) *(f32x4*)(WI + (size_t)(rowt + ai * HALF + m * 16) * 4) = v1[0]; asm volatile("" ::: "memory"); }
        } else if (mode == 0) {
#pragma unroll
            for (int ai = 0; ai < 2; ++ai)
#pragma unroll
                for (int m = 0; m < 4; ++m) { ADJ_ROW(ai, m); STORE_ROW(rowt + ai * HALF + m * 16); asm volatile("" ::: "memory"); }
        } else {
#pragma unroll
            for (int ai = 0; ai < 2; ++ai)
#pragma unroll
                for (int m = 0; m < 4; ++m) {
                    f32x4 nc[2], ns[2];
                    if ((ai * 4 + m) < 7) { const int k1 = ai * 4 + m + 1; const int t = (rowt + (k1 >> 2) * HALF + (k1 & 3) * 16) % SEQ;
#pragma unroll
                        for (int n = 0; n < 2; ++n) { nc[n] = *(const f32x4*)(cs + t * 32 + 8 * fq + 4 * n); ns[n] = *(const f32x4*)(sn + t * 32 + 8 * fq + 4 * n); } }
                    ADJ_ROW(ai, m);
                    if (mode == 2) {
                        float ss = 0.f;
#pragma unroll
                        for (int n = 0; n < 2; ++n)
#pragma unroll
                            for (int e = 0; e < 4; ++e) ss += v1[n][e] * v1[n][e] + v2[n][e] * v2[n][e];
                        ss += __shfl_xor(ss, 16); ss += __shfl_xor(ss, 32);
                        const float ri = __builtin_amdgcn_rsqf(ss * (1.f / 64.f) + EPS);
#pragma unroll
                        for (int n = 0; n < 2; ++n) { v1[n] = (v1[n] * ri) * *(LAS f32x4*)(wg + 4 * n); v2[n] = (v2[n] * ri) * *(LAS f32x4*)(wg + 32 + 4 * n); }
                    }
#pragma unroll
                    for (int n = 0; n < 2; ++n) { const f32x4 xa = v1[n], xb = v2[n]; v1[n] = xa * rc[n] - xb * rsn[n]; v2[n] = xb * rc[n] + xa * rsn[n]; }
                    STORE_ROW(rowt + ai * HALF + m * 16);
                    if ((ai * 4 + m) < 7) { rc[0] = nc[0]; rc[1] = nc[1]; rsn[0] = ns[0]; rsn[1] = ns[1]; }
                    asm volatile("" ::: "memory");
                }
        }
#undef ADJ_ROW
#undef STORE_ROW
    }
};
typedef _Float16 h16x8 __attribute__((ext_vector_type(8)));
typedef float f32x8 __attribute__((ext_vector_type(8)));
struct EpiResid {
    static constexpr bool PERM = true, AFTER_DRAIN = false;
    static constexpr int KREP = KREP_R, EREP = EREP_R;
    static constexpr int NVM = 36;
    const void* base; void* out; const float* gate;
    bf16_t* Hn; const float* lnn; const float* scn; float* SS; int do_next;
    int base_f32, out_f32;
    __device__ __forceinline__ void operator()(const f32x4 (&acc)[2][2][4][2], const Unit& u, int wr, int wc, int fr, int fq) const {
        const int row0 = u.pm * BM + wr * 64 + fr, col0 = u.pn * BM + wc * 32 + 8 * fq;
        const size_t bo = (size_t)((u.pm * BM) / SEQ) * 6144 + col0;
        f32x4 gv[2][2], vv[2][2];
#pragma unroll
        for (int bj = 0; bj < 2; ++bj)
#pragma unroll
            for (int n = 0; n < 2; ++n) { gv[bj][n] = *(const f32x4*)(gate + bo + bj * HALF + 4 * n);
                if (do_next) vv[bj][n] = *(const f32x4*)(lnn + col0 + bj * HALF + 4 * n) * (*(const f32x4*)(scn + bo + bj * HALF + 4 * n) + 1.f); }
#define RESID_ROW(AI, M, X0, X1, BJ) do { const int row_ = row0 + (AI) * HALF + (M) * 16; const size_t off_ = (size_t)row_ * DM + col0 + (BJ) * HALF; \
            if (out_f32) { *(f32x4*)((float*)out + off_) = X0; *(f32x4*)((float*)out + off_ + 4) = X1; } \
            else { f32x8 xx_; xx_[0] = X0[0]; xx_[1] = X0[1]; xx_[2] = X0[2]; xx_[3] = X0[3]; xx_[4] = X1[0]; xx_[5] = X1[1]; xx_[6] = X1[2]; xx_[7] = X1[3]; \
                   *(h16x8*)((_Float16*)out + off_) = __builtin_convertvector(xx_, h16x8); } \
            if (do_next) { ss += (X0[0] * X0[0] + X0[1] * X0[1]) + (X0[2] * X0[2] + X0[3] * X0[3]) + (X1[0] * X1[0] + X1[1] * X1[1]) + (X1[2] * X1[2] + X1[3] * X1[3]); \
                const f32x4 a0_ = X0 * vv[BJ][0], a1_ = X1 * vv[BJ][1]; \
                u32x4 w_; w_.x = cvtpk(a0_[0], a0_[1]); w_.y = cvtpk(a0_[2], a0_[3]); w_.z = cvtpk(a1_[0], a1_[1]); w_.w = cvtpk(a1_[2], a1_[3]); \
                *(u32x4*)(Hn + off_) = w_; } } while (0)
        if (base_f32) {
#pragma unroll
            for (int ai = 0; ai < 2; ++ai)
#pragma unroll
            for (int mh = 0; mh < 2; ++mh) {
                f32x4 bs[2][2][2];
#pragma unroll
                for (int mm = 0; mm < 2; ++mm) { const size_t off = (size_t)(row0 + ai * HALF + (2 * mh + mm) * 16) * DM + col0;
#pragma unroll
                    for (int bj = 0; bj < 2; ++bj) { bs[mm][bj][0] = *(const f32x4*)((const float*)base + off + bj * HALF); bs[mm][bj][1] = *(const f32x4*)((const float*)base + off + bj * HALF + 4); } }
#pragma unroll
                for (int mm = 0; mm < 2; ++mm) { const int m = 2 * mh + mm; float ss = 0.f;
#pragma unroll
                    for (int bj = 0; bj < 2; ++bj) { const f32x4 x0 = bs[mm][bj][0] + gv[bj][0] * acc[ai][bj][m][0], x1 = bs[mm][bj][1] + gv[bj][1] * acc[ai][bj][m][1]; RESID_ROW(ai, m, x0, x1, bj); }
                    if (do_next) { ss += __shfl_xor(ss, 16); ss += __shfl_xor(ss, 32); if (fq == 0) SS[(size_t)(row0 + ai * HALF + m * 16) * 16 + u.pn * 4 + wc] = ss; } }
                asm volatile("" ::: "memory");
            }
        } else {
#pragma unroll
            for (int ai = 0; ai < 2; ++ai) {
                h16x8 bh[4][2];
#pragma unroll
                for (int m = 0; m < 4; ++m) { const size_t off = (size_t)(row0 + ai * HALF + m * 16) * DM + col0;
#pragma unroll
                    for (int bj = 0; bj < 2; ++bj) bh[m][bj] = *(const h16x8*)((const _Float16*)base + off + bj * HALF); }
#pragma unroll
                for (int m = 0; m < 4; ++m) { float ss = 0.f;
#pragma unroll
                    for (int bj = 0; bj < 2; ++bj) { const f32x8 bf = __builtin_convertvector(bh[m][bj], f32x8);
                        const f32x4 x0 = (f32x4){bf[0], bf[1], bf[2], bf[3]} + gv[bj][0] * acc[ai][bj][m][0], x1 = (f32x4){bf[4], bf[5], bf[6], bf[7]} + gv[bj][1] * acc[ai][bj][m][1];
                        RESID_ROW(ai, m, x0, x1, bj); }
                    if (do_next) { ss += __shfl_xor(ss, 16); ss += __shfl_xor(ss, 32); if (fq == 0) SS[(size_t)(row0 + ai * HALF + m * 16) * 16 + u.pn * 4 + wc] = ss; } }
                asm volatile("" ::: "memory");
            }
        }
#undef RESID_ROW
    }
};
struct EpiSwiGLU {
    static constexpr bool PERM = true, AFTER_DRAIN = false;
    static constexpr int KREP = KREP_S, EREP = EREP_S;
    static constexpr int NVM = 20;
    bf16_t* ACT; const float* SS; const float* bg; const float* bu;
    __device__ __forceinline__ void operator()(const f32x4 (&acc)[2][2][4][2], const Unit& u, int wr, int wc, int fr, int fq) const {
        const int row0 = u.pm * BM + wr * 64 + fr, col0 = u.pn * HALF + wc * 32 + 8 * fq;
        const size_t bo = (size_t)((u.pm * BM) / SEQ) * DFF + col0;
        const f32x4 g0 = *(const f32x4*)(bg + bo), g1 = *(const f32x4*)(bg + bo + 4), u0 = *(const f32x4*)(bu + bo), u1 = *(const f32x4*)(bu + bo + 4);
        float rsv[2][4];
        { f32x4 p4[2][4];
#pragma unroll
          for (int ai = 0; ai < 2; ++ai)
#pragma unroll
              for (int m = 0; m < 4; ++m) p4[ai][m] = *(const f32x4*)(SS + (size_t)(row0 + ai * HALF + m * 16) * 16 + 4 * fq);
#pragma unroll
          for (int ai = 0; ai < 2; ++ai)
#pragma unroll
              for (int m = 0; m < 4; ++m) { float sq = (p4[ai][m][0] + p4[ai][m][1]) + (p4[ai][m][2] + p4[ai][m][3]); sq += __shfl_xor(sq, 16); sq += __shfl_xor(sq, 32);
                  rsv[ai][m] = __builtin_amdgcn_rsqf(sq * (1.f / DM) + EPS); } }
#pragma unroll
        for (int ai = 0; ai < 2; ++ai)
#pragma unroll
            for (int m = 0; m < 4; ++m) {
                const int row = row0 + ai * HALF + m * 16;
                const float rs = rsv[ai][m];
                const f32x4 ga[2] = {acc[ai][0][m][0] * rs + g0, acc[ai][0][m][1] * rs + g1}, ua[2] = {acc[ai][1][m][0] * rs + u0, acc[ai][1][m][1] * rs + u1};
                float r[8];
#pragma unroll
                for (int n = 0; n < 2; ++n)
#pragma unroll
                    for (int e = 0; e < 4; ++e) { const float g = ga[n][e]; r[4 * n + e] = g * __builtin_amdgcn_rcpf(1.f + ex2(-g * LOG2E)) * ua[n][e]; }
                u32x4 w; w.x = cvtpk(r[0], r[1]); w.y = cvtpk(r[2], r[3]); w.z = cvtpk(r[4], r[5]); w.w = cvtpk(r[6], r[7]);
                *(u32x4*)(ACT + (size_t)row * DFF + col0) = w;
            }
    }
};
}

__device__ __forceinline__ void tr_item(const float* W, int ldw, int K, bf16_t* WT, int k0, int drow0, int sc, LAS float* scr, int lane) {
    float tv[32];
#pragma unroll
    for (int i = 0; i < 32; ++i) { const int kk = 2 * i + (lane >> 5); tv[i] = 0.f; if (sc >= 0) tv[i] = W[(size_t)(k0 + kk) * ldw + sc]; }
#pragma unroll
    for (int i = 0; i < 32; ++i) { const int kk = 2 * i + (lane >> 5); scr[kk * 33 + (lane & 31)] = tv[i]; }
    LDS_WAIT(); asm volatile("" ::: "memory");
    const int c = lane & 7;
#pragma unroll
    for (int j = 0; j < 4; ++j) { const int n = (lane >> 3) + 8 * j; const LAS float* s = scr + (8 * c) * 33 + n;
        u32x4 o; o.x = cvtpk(s[0 * 33], s[1 * 33]); o.y = cvtpk(s[2 * 33], s[3 * 33]); o.z = cvtpk(s[4 * 33], s[5 * 33]); o.w = cvtpk(s[6 * 33], s[7 * 33]);
        *(GAS u32x4*)(WT + (size_t)(drow0 + n) * K + k0 + 8 * c) = o; }
    LDS_WAIT(); asm volatile("" ::: "memory");
}

struct Args { const float* in[17]; float* out; unsigned char* ws; int lo, hi; };

__device__ __forceinline__ void prologue(const Args& a, LAS unsigned char* lds, int tid, int lane, int wave, int G) {
    unsigned char* ws = a.ws;
    const float* w_in = a.in[6]; const float* w_o = a.in[13]; const float* w_gate = a.in[14]; const float* w_up = a.in[15]; const float* w_down = a.in[16];
    LAS float* scr = (LAS float*)(lds + wave * 16384);
    const int gw = blockIdx.x * NWAVES + wave, NGW = G * NWAVES;
    constexpr int I_IN = 16 * 72, I_O = 16 * 32, I_GU = 16 * 176, I_D = 44 * 32, I_L = I_IN + I_O + I_GU + I_D;
    for (int it = gw; it < DEPTH * I_L; it += NGW) {
        const int l = it / I_L; int r = it % I_L;
        bf16_t* wl = (bf16_t*)(ws + WS_W + (size_t)l * W_LAYER);
        if (r < I_IN) {
            const int kb = r / 72, nb = r % 72, np = 32 * nb + (lane & 31), p = np & 255;
            const int slot = (np >> 8) * 4 + ((p & 127) >> 5), dim = 32 * (p >> 7) + (p & 31);
            int sc = slot_col(slot) + dim; if (slot == 11 && dim >= 4) sc = -1;
            tr_item(w_in + (size_t)l * DM * INCOLS, INCOLS, DM, wl + W_IN / 2, 64 * kb, 32 * nb, sc, scr, lane); continue; }
        r -= I_IN;
        if (r < I_O) { const int kb = r / 32, nb = r % 32;
            tr_item(w_o + (size_t)l * DM * DM, DM, DM, wl + W_O / 2, 64 * kb, 32 * nb, 32 * nb + (lane & 31), scr, lane); continue; }
        r -= I_O;
        if (r < I_GU) { const int kb = r / 176, nb = r % 176, d0 = 32 * nb, p0 = d0 & 255;
            const float* src = (p0 < 128 ? w_gate : w_up) + (size_t)l * DM * DFF;
            tr_item(src, DFF, DM, wl + W_GU / 2, 64 * kb, d0, (d0 >> 8) * 128 + (p0 & 127) + (lane & 31), scr, lane); continue; }
        r -= I_GU;
        { const int kb = r / 32, nb = r % 32;
            tr_item(w_down + (size_t)l * DFF * DM, DM, DFF, wl + W_D / 2, 64 * kb, 32 * nb, 32 * nb + (lane & 31), scr, lane); }
    }
    {
        float* cs = (float*)(ws + WS_ROPE); float* sn = cs + SEQ * 32;
        for (int idx = blockIdx.x * 512 + tid; idx < SEQ * 32; idx += G * 512) {
            const int t = idx >> 5, i = idx & 31;
            double inv = 1.0; for (int k = 0; k < i; ++k) inv *= 0.7498942093324559;
            const float ang = (float)t * (float)inv;
            double rv = (double)ang * 0.15915494309189535; rv -= __builtin_floor(rv);
            const float fr = (float)rv;
            cs[idx] = __builtin_amdgcn_cosf(fr); sn[idx] = __builtin_amdgcn_sinf(fr);
        }
    }
    __syncthreads();
    {
        const float* c = a.in[1]; const float* w_mod = a.in[4]; const float* b_mod = a.in[5];
        float* mod = (float*)(ws + WS_MOD);
        LAS float* cact = (LAS float*)lds;
        for (int idx = tid; idx < BATCH * DM; idx += 512) { const int b = idx >> 10, k = idx & 1023; const float v = c[idx]; cact[k * 32 + b] = v * __builtin_amdgcn_rcpf(1.f + ex2(-v * LOG2E)); }
        __syncthreads();
        for (int unit = blockIdx.x; unit < DEPTH * 6144 / 64; unit += G) {
            const int col = unit * 64 + lane, l = col / 6144, j = col % 6144;
            const float* wp = w_mod + (size_t)l * DM * 6144 + j;
            float acc0 = 0.f, acc1 = 0.f, acc2 = 0.f, acc3 = 0.f;
#pragma unroll 32
            for (int k = 0; k < DM; ++k) { const float wv = wp[(size_t)k * 6144]; const f32x4 c4 = *(const LAS f32x4*)(cact + k * 32 + 4 * wave);
                acc0 += c4[0] * wv; acc1 += c4[1] * wv; acc2 += c4[2] * wv; acc3 += c4[3] * wv; }
            const float bm = b_mod[l * 6144 + j];
            float* mo = mod + ((size_t)l * BATCH + 4 * wave) * 6144 + j;
            mo[0] = acc0 + bm; mo[6144] = acc1 + bm; mo[2 * 6144] = acc2 + bm; mo[3 * 6144] = acc3 + bm;
        }
    }
    __syncthreads();
}

__device__ __forceinline__ void prologue_b(const Args& a, LAS unsigned char* lds, int tid, int lane, int wave, int G) {
    unsigned char* ws = a.ws;
    const float* mod = (const float*)(ws + WS_MOD);
    LAS float* cact = (LAS float*)lds;
    constexpr int U_IN = (INCOLS + 63) / 64, U_FF = DFF / 64, U_L = U_IN + 2 * U_FF;
    for (int un = blockIdx.x; un < DEPTH * U_L; un += G) {
        const int l = un / U_L; int r = un % U_L; int type = 0; if (r >= U_IN) { r -= U_IN; type = 1; if (r >= U_FF) { r -= U_FF; type = 2; } }
        const float* shp = mod + (size_t)l * BATCH * 6144 + (type == 0 ? 0 : 3 * DM);
        for (int idx = tid; idx < BATCH * DM; idx += 512) { const int b = idx >> 10, k = idx & 1023; cact[k * 32 + b] = shp[(size_t)b * 6144 + k]; }
        __syncthreads();
        const int ncols = type == 0 ? INCOLS : DFF;
        const float* W = type == 0 ? a.in[6] + (size_t)l * DM * INCOLS : (type == 1 ? a.in[14] : a.in[15]) + (size_t)l * DM * DFF;
        const int col = r * 64 + lane, cc = col < ncols ? col : ncols - 1;
        const float* wp = W + cc;
        float acc0 = 0.f, acc1 = 0.f, acc2 = 0.f, acc3 = 0.f;
#pragma unroll 32
        for (int k = 0; k < DM; ++k) { const float wv = wp[(size_t)k * ncols]; const f32x4 c4 = *(const LAS f32x4*)(cact + k * 32 + 4 * wave);
            acc0 += c4[0] * wv; acc1 += c4[1] * wv; acc2 += c4[2] * wv; acc3 += c4[3] * wv; }
        if (col < ncols) {
            const int ldb = type == 0 ? NIN : DFF;
            float* bo = (float*)(ws + (type == 0 ? WS_B1 : (type == 1 ? WS_BG : WS_BU))) + ((size_t)l * BATCH + 4 * wave) * ldb + col;
            bo[0] = acc0; bo[ldb] = acc1; bo[2 * ldb] = acc2; bo[3 * ldb] = acc3;
        }
        __syncthreads();
    }
}

__device__ __forceinline__ float wsum_f(float v) {
#define DPP_ADD(CTRL, RM) v += __uint_as_float((unsigned)__builtin_amdgcn_update_dpp(0, (int)__float_as_uint(v), CTRL, RM, 0xf, false))
    DPP_ADD(0x111, 0xf); DPP_ADD(0x112, 0xf); DPP_ADD(0x114, 0xf); DPP_ADD(0x118, 0xf); DPP_ADD(0x142, 0xa); DPP_ADD(0x143, 0xc);
#undef DPP_ADD
    return __uint_as_float((unsigned)__builtin_amdgcn_readlane((int)__float_as_uint(v), 63));
}
__device__ __forceinline__ void pre_phase(const float* x, const float* ln, const float* modl  , bf16_t* H, float* SS, int lane, int gw, int NGW) {
    for (int m0 = 4 * gw; m0 < MROWS; m0 += 4 * NGW) {
        f32x4 v[4][4]; float s[4];
#pragma unroll
        for (int rr = 0; rr < 4; ++rr) { const GAS f32x4* xr = (const GAS f32x4*)(x + (size_t)(m0 + rr) * DM) + lane;
#pragma unroll
            for (int j = 0; j < 4; ++j) v[rr][j] = xr[64 * j]; }
#pragma unroll
        for (int rr = 0; rr < 4; ++rr) { float a = 0.f;
#pragma unroll
            for (int j = 0; j < 4; ++j) a += (v[rr][j].x * v[rr][j].x + v[rr][j].y * v[rr][j].y) + (v[rr][j].z * v[rr][j].z + v[rr][j].w * v[rr][j].w);
            s[rr] = wsum_f(a); }
        const int b = m0 / SEQ;
        const float* mb = modl + (size_t)b * 6144;
        f32x4 gv[4];
#pragma unroll
        for (int j = 0; j < 4; ++j) gv[j] = *((const GAS f32x4*)ln + lane + 64 * j) * (*((const GAS f32x4*)(mb + DM) + lane + 64 * j) + 1.f);
#pragma unroll
        for (int rr = 0; rr < 4; ++rr) {
            if (lane < 16) SS[(size_t)(m0 + rr) * 16 + lane] = (lane == 0) ? s[rr] : 0.f;
            GAS u32x2* o8 = (GAS u32x2*)(H + (size_t)(m0 + rr) * DM) + lane;
#pragma unroll
            for (int j = 0; j < 4; ++j) { const f32x4 y = v[rr][j] * gv[j]; u32x2 w; w.x = cvtpk(y.x, y.y); w.y = cvtpk(y.z, y.w); o8[64 * j] = w; }
        }
    }
}

__device__ __forceinline__ void store_head(const f32x16& o0, const f32x16& o1, float inv, const float* gout, bf16_t* orow, int h) {
    float ss = 0.f;
#pragma unroll
    for (int i = 0; i < 16; ++i) { const float a = o0[i] * inv, b = o1[i] * inv; ss += a * a + b * b; }
    ss += __shfl_xor(ss, 32);
    const float rn = __builtin_amdgcn_rsqf(ss * (1.f / 64.f) + EPS) * inv;
#pragma unroll
    for (int g = 0; g < 4; ++g) {
        const int d0 = 8 * g + 4 * h;
        const f32x4 ga = *(const f32x4*)(gout + d0), gb = *(const f32x4*)(gout + 32 + d0);
        u32x2 wa, wb;
        wa.x = cvtpk(o0[4 * g] * rn * ga[0], o0[4 * g + 1] * rn * ga[1]); wa.y = cvtpk(o0[4 * g + 2] * rn * ga[2], o0[4 * g + 3] * rn * ga[3]);
        wb.x = cvtpk(o1[4 * g] * rn * gb[0], o1[4 * g + 1] * rn * gb[1]); wb.y = cvtpk(o1[4 * g + 2] * rn * gb[2], o1[4 * g + 3] * rn * gb[3]);
        *(GAS u32x2*)(orow + d0) = wa; *(GAS u32x2*)(orow + 32 + d0) = wb;
    }
}

__device__ __forceinline__ void swa_unit(int b, int hc, int qt, const bf16_t* P, const bf16_t* VT, bf16_t* O, float M2, float sink2, const float* gout, int lane) {
    const int r = lane & 31, h = lane >> 5, t0 = qt * 32, kv = hc >> 2;
    const size_t rowbase = (size_t)b * SEQ;
    bf16x8 qf[4];
    { const bf16_t* qp = P + (rowbase + t0 + r) * NIN + (24 + hc) * 64 + 8 * h;
#pragma unroll
      for (int ks = 0; ks < 4; ++ks) qf[ks] = ldg16(qp + 16 * ks); }
    const bf16_t* kbase = P + rowbase * NIN + (32 + kv) * 64 + 8 * h + (size_t)r * NIN;
    const bf16_t* vbase = VT + ((size_t)(b * NVS + 5 + kv) * 64 + r) * SEQ + 8 * h;
    f32x16 o0 = zero16(), o1 = zero16(); float lsum = 0.f;
    const int t = t0 + r;
    const int kt_lo = qt - 4 < 0 ? 0 : qt - 4;
    bf16x8 kf[4];
#pragma unroll
    for (int ks = 0; ks < 4; ++ks) kf[ks] = ldg16(kbase + (size_t)(kt_lo * 32) * NIN + 16 * ks);
    for (int kt = kt_lo; kt <= qt; ++kt) {
        bf16x8 kn[4], vf[2][2];
#pragma unroll
        for (int dt = 0; dt < 2; ++dt)
#pragma unroll
            for (int s = 0; s < 2; ++s) vf[dt][s] = ldg16(vbase + (size_t)(dt * 32) * SEQ + kt * 32 + 16 * s);
        { const bf16_t* kp = kbase + (size_t)((kt < qt ? kt + 1 : kt) * 32) * NIN;
#pragma unroll
          for (int ks = 0; ks < 4; ++ks) kn[ks] = ldg16(kp + 16 * ks); }
        f32x16 sc = zero16();
#pragma unroll
        for (int ks = 0; ks < 4; ++ks) sc = MFMA32(kf[ks], qf[ks], sc);
#pragma unroll
        for (int i = 0; i < 16; ++i) { const int key = kt * 32 + crow(i, h); const bool valid = (unsigned)(t - key) < 128u;
            const float p = valid ? ex2(sc[i] - M2) : 0.f; sc[i] = p; lsum += p; }
        const bf16x8 p0 = pack8(sc, 0), p1 = pack8(sc, 1);
        o0 = MFMA32(vf[0][0], p0, o0); o0 = MFMA32(vf[0][1], p1, o0);
        o1 = MFMA32(vf[1][0], p0, o1); o1 = MFMA32(vf[1][1], p1, o1);
#pragma unroll
        for (int ks = 0; ks < 4; ++ks) kf[ks] = kn[ks];
    }
    lsum += __shfl_xor(lsum, 32); lsum += ex2(sink2 - M2);
    store_head(o0, o1, 1.f / lsum, gout, O + (rowbase + t0 + r) * DM + (8 + hc) * 64, h);
}

__device__ __forceinline__ void sb_unit(int b, int hb, int qt, const bf16_t* P, const bf16_t* VT, bf16_t* O, const float* gout, int lane) {
    const int r = lane & 31, h = lane >> 5, t0 = qt * 32;
    const size_t rowbase = (size_t)b * SEQ;
    bf16x8 qf[4];
    { const bf16_t* qp = P + (rowbase + t0 + r) * NIN + (12 + hb) * 64 + 8 * h;
#pragma unroll
      for (int ks = 0; ks < 4; ++ks) qf[ks] = ldg16(qp + 16 * ks); }
    const bf16_t* kbase = P + rowbase * NIN + (16 + hb) * 64 + 8 * h + (size_t)r * NIN;
    const bf16_t* vbase = VT + ((size_t)(b * NVS + 1 + hb) * 64 + r) * SEQ + 8 * h;
    f32x16 o0 = zero16(), o1 = zero16(); float C = 0.f;
    const int t = t0 + r;
    bf16x8 kf[4];
#pragma unroll
    for (int ks = 0; ks < 4; ++ks) kf[ks] = ldg16(kbase + (size_t)(qt * 32) * NIN + 16 * ks);
    for (int kt = qt; kt >= 0; --kt) {
        bf16x8 kn[4], vf[2][2];
#pragma unroll
        for (int dt = 0; dt < 2; ++dt)
#pragma unroll
            for (int s = 0; s < 2; ++s) vf[dt][s] = ldg16(vbase + (size_t)(dt * 32) * SEQ + kt * 32 + 16 * s);
        { const bf16_t* kp = kbase + (size_t)((kt > 0 ? kt - 1 : 0) * 32) * NIN;
#pragma unroll
          for (int ks = 0; ks < 4; ++ks) kn[ks] = ldg16(kp + 16 * ks); }
        f32x16 z = zero16();
#pragma unroll
        for (int ks = 0; ks < 4; ++ks) z = MFMA32(kf[ks], qf[ks], z);
        float L[16];
#pragma unroll
        for (int i = 0; i < 16; ++i) { const int key = kt * 32 + crow(i, h); const float zz = z[i];
            const float sp = RELU(zz) + lg2(1.f + ex2(-fabsf(zz)));
            L[i] = (key < t) ? -sp : 0.f; }
        float G4[4], Gp[4], ps[4], aft[4];
#pragma unroll
        for (int g = 0; g < 4; ++g) { G4[g] = (L[4 * g] + L[4 * g + 1]) + (L[4 * g + 2] + L[4 * g + 3]); Gp[g] = __shfl_xor(G4[g], 32); ps[g] = G4[g] + Gp[g]; }
        aft[3] = 0.f; aft[2] = ps[3]; aft[1] = aft[2] + ps[2]; aft[0] = aft[1] + ps[1];
#pragma unroll
        for (int g = 0; g < 4; ++g) {
            const float bg = C + aft[g] + (h == 0 ? Gp[g] : 0.f);
            const float b3 = bg, b2 = b3 + L[4 * g + 3], b1 = b2 + L[4 * g + 2], b0 = b1 + L[4 * g + 1];
            const float bt[4] = {b0, b1, b2, b3};
#pragma unroll
            for (int e = 0; e < 4; ++e) { const int i = 4 * g + e; const int key = kt * 32 + crow(i, h);
                z[i] = (key < t) ? ex2(z[i] + L[i] + bt[e]) : 0.f; }
        }
        C += aft[0] + ps[0];
        const bf16x8 p0 = pack8(z, 0), p1 = pack8(z, 1);
        o0 = MFMA32(vf[0][0], p0, o0); o0 = MFMA32(vf[0][1], p1, o0);
        o1 = MFMA32(vf[1][0], p0, o1); o1 = MFMA32(vf[1][1], p1, o1);
        if (__all(C < -160.f)) break;
#pragma unroll
        for (int ks = 0; ks < 4; ++ks) kf[ks] = kn[ks];
    }
    store_head(o0, o1, 1.f, gout, O + (rowbase + t0 + r) * DM + (4 + hb) * 64, h);
}

template <int NROWS, int VCH>
__device__ __forceinline__ void stage_kv(LAS unsigned char* ldsK, LAS unsigned char* ldsV, const bf16_t* kg  , const bf16_t* vg  , int tk0  , int tid) {
    constexpr int KCH = NROWS * 8 / 512, NTC = NROWS / 8, VCHT = 64 * NTC / 512;
    const int first_row = tk0 < 0 ? -tk0 : 0;
    const unsigned char* kb = (const unsigned char*)(kg + (size_t)(tk0 + first_row) * NIN);
    const unsigned char* vb = (const unsigned char*)(vg + (tk0 + first_row));
    u32x4 kr[KCH], vr[VCHT];
#pragma unroll
    for (int i = 0; i < KCH; ++i) { const int q = tid + 512 * i, row = q >> 3, c = q & 7; kr[i] = (u32x4){0u, 0u, 0u, 0u};
        if (row >= first_row) kr[i] = *(const GAS u32x4*)(kb + (unsigned)((row - first_row) * (NIN * 2) + 16 * c)); }
#pragma unroll
    for (int i = 0; i < VCHT; ++i) { const int q = tid + 512 * i, d = q / NTC, c = q % NTC; vr[i] = (u32x4){0u, 0u, 0u, 0u};
        if (8 * c >= first_row) vr[i] = *(const GAS u32x4*)(vb + (unsigned)(d * (SEQ * 2) + (8 * c - first_row) * 2)); }
#pragma unroll
    for (int i = 0; i < KCH; ++i) { const int q = tid + 512 * i, row = q >> 3, c = q & 7; *(LAS u32x4*)(ldsK + row * 128 + ((c ^ ((row >> 1) & 7)) << 4)) = kr[i]; }
#pragma unroll
    for (int i = 0; i < VCHT; ++i) { const int q = tid + 512 * i, d = q / NTC, c = q % NTC; *(LAS u32x4*)(ldsV + d * (VCH * 16) + ((c ^ (d & 15)) << 4)) = vr[i]; }
    asm volatile("" ::: "memory");
}
__device__ __forceinline__ bf16x8 lds_kfrag(LAS unsigned char* ldsK, int row, int ch) { return *(const LAS bf16x8*)(ldsK + row * 128 + ((ch ^ ((row >> 1) & 7)) << 4)); }
template <int VCH> __device__ __forceinline__ bf16x8 lds_vfrag(LAS unsigned char* ldsV, int d, int ch) { return *(const LAS bf16x8*)(ldsV + d * (VCH * 16) + ((ch ^ (d & 15)) << 4)); }

#ifdef TPROBE
#define DTB(cls) do { if ((TPROBE >> (cls)) & 1) { if (threadIdx.x == 0) ((volatile LAS unsigned*)(lds + LDS_MISC))[13] = (unsigned)__builtin_amdgcn_s_memrealtime(); } } while (0)
#define DTE(cls) do { if ((TPROBE >> (cls)) & 1) { if (threadIdx.x == 0) { volatile LAS unsigned* m_ = (volatile LAS unsigned*)(lds + LDS_MISC); m_[12] = m_[12] + ((unsigned)__builtin_amdgcn_s_memrealtime() - m_[13]); } } } while (0)
#else
#define DTB(cls) do { } while (0)
#define DTE(cls) do { } while (0)
#endif
__device__ __forceinline__ void swa_block(int b, int kv, int qb, const bf16_t* P, const bf16_t* VT, bf16_t* O, float M2, const float* sinks  , const float* gout  ,
                                          LAS unsigned char* lds, int tid, int lane, int wave) {
    LAS unsigned char* ldsK = lds; LAS unsigned char* ldsV = lds + 32768;
    DTB(16);
    const int t0 = qb * 128, tk0 = t0 - 128;
    const size_t rowbase = (size_t)b * SEQ;
    const int r = lane & 31, h = lane >> 5, j = wave & 3, hc0 = kv * 4 + 2 * (wave >> 2), t0q = t0 + 32 * j;
    bf16x8 qf[2][4];
#pragma unroll
    for (int hd = 0; hd < 2; ++hd) { const bf16_t* qp = P + (rowbase + t0q + r) * NIN + (24 + hc0 + hd) * 64 + 8 * h;
#pragma unroll
        for (int ks = 0; ks < 4; ++ks) qf[hd][ks] = ldg16(qp + 16 * ks); }
    stage_kv<256, 32>(ldsK, ldsV, P + rowbase * NIN + (32 + kv) * 64, VT + ((size_t)(b * NVS + 5 + kv) * 64) * SEQ, tk0, tid);
    __syncthreads();
    f32x16 o[2][2]; o[0][0] = zero16(); o[0][1] = zero16(); o[1][0] = zero16(); o[1][1] = zero16();
    float ls[2] = {0.f, 0.f};
    const int t = t0q + r;
    for (int i = (tk0 < 0 && j < 4) ? (4 > j ? 4 : j) : j; i <= j + 4; ++i) {
        bf16x8 kf[4], vf[2][2];
#pragma unroll
        for (int ks = 0; ks < 4; ++ks) kf[ks] = lds_kfrag(ldsK, 32 * i + r, 2 * ks + h);
#pragma unroll
        for (int dt = 0; dt < 2; ++dt)
#pragma unroll
            for (int s2 = 0; s2 < 2; ++s2) vf[dt][s2] = lds_vfrag<32>(ldsV, 32 * dt + r, 4 * i + 2 * s2 + h);
#pragma unroll
        for (int hd = 0; hd < 2; ++hd) {
            f32x16 sc;
#pragma unroll
            for (int e = 0; e < 16; ++e) sc[e] = -M2;
#pragma unroll
            for (int ks = 0; ks < 4; ++ks) sc = MFMA32(kf[ks], qf[hd][ks], sc);
            if (i == j || i == j + 4) {
#pragma unroll
                for (int e = 0; e < 16; ++e) { const int key = tk0 + 32 * i + crow(e, h); const bool valid = (unsigned)(t - key) < 128u;
                    const float p = valid ? ex2(sc[e]) : 0.f; sc[e] = p; ls[hd] += p; }
            } else {
#pragma unroll
                for (int e = 0; e < 16; ++e) { const float p = ex2(sc[e]); sc[e] = p; ls[hd] += p; }
            }
            const bf16x8 p0 = pack8(sc, 0), p1 = pack8(sc, 1);
            o[hd][0] = MFMA32(vf[0][0], p0, o[hd][0]); o[hd][0] = MFMA32(vf[0][1], p1, o[hd][0]);
            o[hd][1] = MFMA32(vf[1][0], p0, o[hd][1]); o[hd][1] = MFMA32(vf[1][1], p1, o[hd][1]);
        }
    }
#pragma unroll
    for (int hd = 0; hd < 2; ++hd) {
        float l2 = ls[hd]; l2 += __shfl_xor(l2, 32); l2 += ex2(sinks[hc0 + hd] * LOG2E - M2);
        store_head(o[hd][0], o[hd][1], 1.f / l2, gout + (8 + hc0 + hd) * 64, O + (rowbase + t0q + r) * DM + (8 + hc0 + hd) * 64, h);
    }
    __syncthreads();
    DTE(16);
}

__device__ __forceinline__ void sb_block(int b, int hb, int qb, const bf16_t* P, const bf16_t* VT, bf16_t* O, const float* gout  , LAS unsigned char* lds, int tid, int lane, int wave) {
    LAS unsigned char* ldsK = lds; LAS unsigned char* ldsV = lds + 57344;
    const int t0 = qb * 256, tk0 = t0 - 192;
    const size_t rowbase = (size_t)b * SEQ;
    const int r = lane & 31, h = lane >> 5, t0q = t0 + 32 * wave;
    bf16x8 qf[4];
    { const bf16_t* qp = P + (rowbase + t0q + r) * NIN + (12 + hb) * 64 + 8 * h;
#pragma unroll
      for (int ks = 0; ks < 4; ++ks) qf[ks] = ldg16(qp + 16 * ks); }
    const bf16_t* kg = P + rowbase * NIN + (16 + hb) * 64;
    const bf16_t* vg = VT + ((size_t)(b * NVS + 1 + hb) * 64) * SEQ;
    stage_kv<448, 64>(ldsK, ldsV, kg, vg, tk0, tid);
    __syncthreads();
    f32x16 o0 = zero16(), o1 = zero16(); float C = 0.f;
    const int t = t0q + r;
#pragma unroll 1
    for (int kt = t0q >> 5; kt >= 0; --kt) {
        bf16x8 kf[4], vf[2][2];
        const int i = kt - (tk0 >> 5);
        if (i >= 0) {
#pragma unroll
            for (int ks = 0; ks < 4; ++ks) kf[ks] = lds_kfrag(ldsK, 32 * i + r, 2 * ks + h);
#pragma unroll
            for (int dt = 0; dt < 2; ++dt)
#pragma unroll
                for (int s2 = 0; s2 < 2; ++s2) vf[dt][s2] = lds_vfrag<64>(ldsV, 32 * dt + r, 4 * i + 2 * s2 + h);
        } else {
            const bf16_t* kp = kg + (size_t)(kt * 32 + r) * NIN + 8 * h;
#pragma unroll
            for (int ks = 0; ks < 4; ++ks) kf[ks] = ldg16(kp + 16 * ks);
#pragma unroll
            for (int dt = 0; dt < 2; ++dt)
#pragma unroll
                for (int s2 = 0; s2 < 2; ++s2) vf[dt][s2] = ldg16(vg + (size_t)(dt * 32 + r) * SEQ + kt * 32 + 16 * s2 + 8 * h);
        }
        f32x16 z = zero16();
#pragma unroll
        for (int ks = 0; ks < 4; ++ks) z = MFMA32(kf[ks], qf[ks], z);
        float L[16];
        const bool diag = (kt == (t0q >> 5));
#pragma unroll
        for (int e = 0; e < 16; ++e) { const float zz = z[e];
            L[e] = -(RELU(zz) + lg2(1.f + ex2(-fabsf(zz)))); }
        if (diag) {
#pragma unroll
            for (int e = 0; e < 16; ++e) { const int key = kt * 32 + crow(e, h); L[e] = (key < t) ? L[e] : 0.f; }
        }
        float G4[4], Gp[4], ps[4], aft[4];
#pragma unroll
        for (int g = 0; g < 4; ++g) { G4[g] = (L[4 * g] + L[4 * g + 1]) + (L[4 * g + 2] + L[4 * g + 3]); Gp[g] = __shfl_xor(G4[g], 32); ps[g] = G4[g] + Gp[g]; }
        aft[3] = 0.f; aft[2] = ps[3]; aft[1] = aft[2] + ps[2]; aft[0] = aft[1] + ps[1];
#pragma unroll
        for (int g = 0; g < 4; ++g) {
            const float bg = C + aft[g] + (h == 0 ? Gp[g] : 0.f);
            const float b3 = bg, b2 = b3 + L[4 * g + 3], b1 = b2 + L[4 * g + 2], b0 = b1 + L[4 * g + 1];
            const float bt[4] = {b0, b1, b2, b3};
#pragma unroll
            for (int e = 0; e < 4; ++e) { const int ii = 4 * g + e; z[ii] = ex2(z[ii] + L[ii] + bt[e]); }
        }
        C += aft[0] + ps[0];
        if (diag) {
#pragma unroll
            for (int e = 0; e < 16; ++e) { const int key = kt * 32 + crow(e, h); z[e] = (key < t) ? z[e] : 0.f; }
        }
        const bf16x8 p0 = pack8(z, 0), p1 = pack8(z, 1);
        o0 = MFMA32(vf[0][0], p0, o0); o0 = MFMA32(vf[0][1], p1, o0);
        o1 = MFMA32(vf[1][0], p0, o1); o1 = MFMA32(vf[1][1], p1, o1);
        if (__all(C < -160.f)) break;
    }
    store_head(o0, o1, 1.f, gout + (4 + hb) * 64, O + (rowbase + t0q + r) * DM + (4 + hb) * 64, h);
    __syncthreads();
}

__device__ __forceinline__ void group_sync(volatile LAS unsigned* cnt, unsigned& target, int lane) {
    asm volatile("s_waitcnt lgkmcnt(0)" ::: "memory");
    target += 4u;
    if (lane == 0) __hip_atomic_fetch_add((LAS unsigned*)cnt, 1u, __ATOMIC_RELAXED, __HIP_MEMORY_SCOPE_WORKGROUP);
    while (*cnt - (target - 4u) < 4u) __builtin_amdgcn_s_sleep(1);
    asm volatile("" ::: "memory");
}
__device__ __forceinline__ void dsa_phase(const bf16_t* P, const bf16_t* VT, const float* WI, bf16_t* O, const float* gout  , float M2, unsigned* queue,
                                          LAS unsigned char* lds, int tid, int lane, int wave) {
    const int grp = wave >> 2, gwv = wave & 3;
    LAS unsigned char* gl = lds + grp * G2_BYTES;
    LAS _Float16* SC = (LAS _Float16*)(gl + G2_SC);
    LAS float* PART = (LAS float*)(gl + G2_SC);
    LAS unsigned* MASK = (LAS unsigned*)(gl + G2_MASK);
    LAS float* LSUM = (LAS float*)(gl + G2_LSUM);
    LAS float* SSUM = (LAS float*)(gl + G2_SSUM);
    volatile LAS unsigned* QW = (volatile LAS unsigned*)(lds + LDS_MISC) + 2 * grp;
    volatile LAS unsigned* GC = (volatile LAS unsigned*)(lds + LDS_MISC) + 8 + grp;
    unsigned gtarget = *GC;
    __syncthreads();
#define GSYNC() group_sync(GC, gtarget, lane)
    constexpr int NU = BATCH * 128, NUX = NU / 8;
    const unsigned xq = xb_xcc_id() & 7u;
#define FETCH_UNIT(DST) do { unsigned got_ = (unsigned)NU; \
        for (unsigned k_ = 0; k_ < 8u; ++k_) { const unsigned x_ = (xq + k_) & 7u; \
            if (__hip_atomic_load(queue + 16 * x_, __ATOMIC_RELAXED, __HIP_MEMORY_SCOPE_AGENT) >= (unsigned)NUX) continue; \
            const unsigned i_ = __hip_atomic_fetch_add(queue + 16 * x_, 1u, __ATOMIC_RELAXED, __HIP_MEMORY_SCOPE_AGENT); \
            if (i_ < (unsigned)NUX) { got_ = x_ * NUX + i_; break; } } \
        DST = got_; } while (0)
#define FETCH_EARLY() __hip_atomic_fetch_add(queue + 16 * xq, 1u, __ATOMIC_RELAXED, __HIP_MEMORY_SCOPE_AGENT)
#define FETCH_LATE(DST, I0) do { unsigned got_ = (unsigned)NU; \
        if ((I0) < (unsigned)NUX) got_ = xq * NUX + (I0); \
        else for (unsigned k_ = 1; k_ < 8u; ++k_) { const unsigned x_ = (xq + k_) & 7u; \
            if (__hip_atomic_load(queue + 16 * x_, __ATOMIC_RELAXED, __HIP_MEMORY_SCOPE_AGENT) >= (unsigned)NUX) continue; \
            const unsigned i_ = __hip_atomic_fetch_add(queue + 16 * x_, 1u, __ATOMIC_RELAXED, __HIP_MEMORY_SCOPE_AGENT); \
            if (i_ < (unsigned)NUX) { got_ = x_ * NUX + i_; break; } } \
        DST = got_; } while (0)
#define UNIT_B(Q) (4 * ((Q) / NUX) + (((Q) % NUX) & 3))
#define UNIT_TAU(Q) (127 - (((Q) % NUX) >> 2))
    if (gwv == 0 && lane == 0) FETCH_UNIT(QW[0]);
    GSYNC();
    int q = (int)QW[0], par = 0;
    bf16x8 qi[4][2]; f32x4 wq;
    { const int c = lane & 15, g = lane >> 4; const int qq = q < NU ? q : 0; const size_t row = (size_t)UNIT_B(qq) * SEQ + 16 * UNIT_TAU(qq) + c;
      const bf16_t* qp = P + row * NIN + 4 * 64 + 8 * g;
#pragma unroll
      for (int hh = 0; hh < 4; ++hh) { qi[hh][0] = ldg16(qp + hh * 64); qi[hh][1] = ldg16(qp + hh * 64 + 32); }
      wq = *(const GAS f32x4*)(WI + row * 4); }
    while (q < NU) {
        const int tau = UNIT_TAU(q), b = UNIT_B(q), t0 = 16 * tau;
        const size_t rowbase = (size_t)b * SEQ;
        DTB(12);
        unsigned fu0 = 0u;
        if (gwv == 0 && lane == 0) fu0 = FETCH_EARLY();
        {
            int lane1 = lane; asm volatile("" : "+v"(lane1));
            const int c = lane1 & 15, g = lane1 >> 4;
            const bf16_t* kp0 = P + (rowbase + c) * NIN + 10 * 64 + 8 * g;
#define IDX_TILE(KT, K0, K1) do { f32x4 sc_ = {0.f, 0.f, 0.f, 0.f}; \
                _Pragma("unroll") for (int hh = 0; hh < 4; ++hh) { f32x4 a_ = {0.f, 0.f, 0.f, 0.f}; a_ = MFMA16(K0, qi[hh][0], a_); a_ = MFMA16(K1, qi[hh][1], a_); \
                    _Pragma("unroll") for (int j = 0; j < 4; ++j) sc_[j] += wq[hh] * RELU(a_[j]); } \
                LAS _Float16* sp_ = SC + c * SCH + (16 * ((KT) & 1) + 4 * g) * 64 + ((KT) >> 1);     \
                sp_[0] = (_Float16)sc_[0]; sp_[64] = (_Float16)sc_[1]; sp_[128] = (_Float16)sc_[2]; sp_[192] = (_Float16)sc_[3]; } while (0)
            bf16x8 ka0 = qi[0][0], ka1 = qi[0][1], kb0 = qi[0][0], kb1 = qi[0][1];
            if (gwv <= tau) { const bf16_t* kp = kp0 + (size_t)(gwv * 16) * NIN; ka0 = ldg16(kp); ka1 = ldg16(kp + 32); }
            if (gwv + 4 <= tau) { const bf16_t* kp = kp0 + (size_t)((gwv + 4) * 16) * NIN; kb0 = ldg16(kp); kb1 = ldg16(kp + 32); }
            for (int kt = gwv; kt <= tau; kt += 8) {
                bf16x8 na0 = ka0, na1 = ka1, nb0 = kb0, nb1 = kb1;
                if (kt + 8 <= tau) { const bf16_t* kp = kp0 + (size_t)((kt + 8) * 16) * NIN; na0 = ldg16(kp); na1 = ldg16(kp + 32); }
                if (kt + 12 <= tau) { const bf16_t* kp = kp0 + (size_t)((kt + 12) * 16) * NIN; nb0 = ldg16(kp); nb1 = ldg16(kp + 32); }
                IDX_TILE(kt, ka0, ka1);
                if (kt + 4 <= tau) IDX_TILE(kt + 4, kb0, kb1);
                ka0 = na0; ka1 = na1; kb0 = nb0; kb1 = nb1;
            }
#undef IDX_TILE
        }
        bf16x8 qf[2][4];
        { int lane2 = lane; asm volatile("" : "+v"(lane2));
          const int r = lane2 & 31, h = lane2 >> 5, c = r & 15;
#pragma unroll
          for (int nt = 0; nt < 2; ++nt) { const bf16_t* qp = P + (rowbase + t0 + c) * NIN + (2 * nt + (r >> 4)) * 64 + 8 * h;
#pragma unroll
              for (int ks = 0; ks < 4; ++ks) qf[nt][ks] = ldg16(qp + 16 * ks); } }
        GSYNC();
        DTE(12); DTB(13);
#define SEL_LOAD(PL, R) do { _Pragma("unroll") for (int i = 0; i < 16; ++i) { \
                const unsigned lo_ = (unsigned)__builtin_bit_cast(unsigned short, SC[(R) * SCH + 64 * i + lane]), hi_ = (unsigned)__builtin_bit_cast(unsigned short, SC[(R) * SCH + 64 * (i + 16) + lane]); \
                PL[i] = lo_ | (hi_ << 16); } } while (0)
#define TSTAGE(PL, J, MSK) _Pragma("unroll") for (int k_ = 0; k_ < 16; ++k_) if ((k_ & (J)) == 0) { const unsigned lo_ = PL[k_], hi_ = PL[k_ + (J)]; \
                PL[k_] = (lo_ & (MSK)) | ((hi_ << (J)) & ~(MSK)); PL[k_ + (J)] = ((lo_ >> (J)) & (MSK)) | (hi_ & ~(MSK)); }
#define SEL_PLANES(PL) do { TSTAGE(PL, 8, 0x00ff00ffu) TSTAGE(PL, 4, 0x0f0f0f0fu) TSTAGE(PL, 2, 0x33333333u) TSTAGE(PL, 1, 0x55555555u) \
                _Pragma("unroll") for (int bq = 0; bq < 15; ++bq) PL[bq] ^= PL[15]; PL[15] = ~PL[15]; } while (0)
#define SEL_STEP(PL, X, C, A, G, CNTG, NA, DONE) do { if (!DONE) { if (CNTG + C >= 256) { A = X; NA = C; } else { G |= X; CNTG += C; A &= ~PL; NA -= C; } DONE = (CNTG + NA == 256); } } while (0)
#define SEL_TIES(A, CNTG) do { const int need_ = 256 - CNTG, pc_ = __builtin_popcount(A); int inc_ = pc_; \
                inc_ += __builtin_amdgcn_update_dpp(0, inc_, 0x111, 0xf, 0xf, false); inc_ += __builtin_amdgcn_update_dpp(0, inc_, 0x112, 0xf, 0xf, false); \
                inc_ += __builtin_amdgcn_update_dpp(0, inc_, 0x114, 0xf, 0xf, false); inc_ += __builtin_amdgcn_update_dpp(0, inc_, 0x118, 0xf, 0xf, false); \
                inc_ += __builtin_amdgcn_update_dpp(0, inc_, 0x142, 0xa, 0xf, false); inc_ += __builtin_amdgcn_update_dpp(0, inc_, 0x143, 0xc, 0xf, false); \
                int take_ = need_ - (inc_ - pc_); take_ = take_ < 0 ? 0 : (take_ > pc_ ? pc_ : take_); \
                while (__builtin_popcount(A) > take_) A &= ~(0x80000000u >> __builtin_clz(A)); } while (0)
#pragma unroll 1
        for (int rp = 0; rp < 2; ++rp) {
            const int ra = 4 * gwv + 2 * rp, rb = ra + 1, na = t0 + ra + 1, nb = na + 1;
            const int cva = na - 32 * lane, cvb = nb - 32 * lane;
            unsigned Aa = cva >= 32 ? ~0u : (cva <= 0 ? 0u : ((1u << cva) - 1u)), Ab = cvb >= 32 ? ~0u : (cvb <= 0 ? 0u : ((1u << cvb) - 1u));
            unsigned Ga = 0u, Gb = 0u; int cntGa = 0, cntGb = 0, nAa = na, nAb = nb;
            bool donea = (na <= 256), doneb = (nb <= 256);
            if (!(donea && doneb)) {
                unsigned PA[16], PB[16];
                SEL_LOAD(PA, ra); SEL_LOAD(PB, rb);
                SEL_PLANES(PA); SEL_PLANES(PB);
#pragma unroll
                for (int bq = 15; bq >= 0; --bq) {
                    if (!(donea && doneb)) {
                        const unsigned Xa = Aa & PA[bq], Xb = Ab & PB[bq];
                        const int ca = wsum_i(__builtin_popcount(Xa)), cb = wsum_i(__builtin_popcount(Xb));
                        SEL_STEP(PA[bq], Xa, ca, Aa, Ga, cntGa, nAa, donea);
                        SEL_STEP(PB[bq], Xb, cb, Ab, Gb, cntGb, nAb, doneb);
                    }
                }
                if (!donea) SEL_TIES(Aa, cntGa);
                if (!doneb) SEL_TIES(Ab, cntGb);
            }
            MASK[ra * MASK_STRIDE + lane] = Ga | Aa;
            MASK[rb * MASK_STRIDE + lane] = Gb | Ab;
        }
#undef SEL_LOAD
#undef TSTAGE
#undef SEL_PLANES
#undef SEL_STEP
#undef SEL_TIES
        if (gwv == 0 && lane == 0) FETCH_LATE(QW[par ^ 1], fu0);
        GSYNC();
        DTE(13); DTB(14);
        {
            int lane3 = lane; asm volatile("" : "+v"(lane3));
            const int r = lane3 & 31, h = lane3 >> 5, c = r & 15;
            f32x16 o[2][2]; float ls[2];
            o[0][0] = zero16(); o[0][1] = zero16(); o[1][0] = zero16(); o[1][1] = zero16(); ls[0] = 0.f; ls[1] = 0.f;
            const int nkt = ((t0 + 15) >> 5) + 1;
#define ATT_TILE(KT, KF, VF) do { const unsigned mw_ = MASK[c * MASK_STRIDE + (KT)]; \
                _Pragma("unroll") for (int nt = 0; nt < 2; ++nt) { \
                    f32x16 sc_; _Pragma("unroll") for (int i = 0; i < 16; ++i) sc_[i] = -M2; \
                    _Pragma("unroll") for (int ks = 0; ks < 4; ++ks) sc_ = MFMA32(KF[ks], qf[nt][ks], sc_); \
                    _Pragma("unroll") for (int i = 0; i < 16; ++i) { const float p_ = ((mw_ >> crow(i, h)) & 1u) ? ex2(sc_[i]) : 0.f; sc_[i] = p_; ls[nt] += p_; } \
                    const bf16x8 p0_ = pack8(sc_, 0), p1_ = pack8(sc_, 1); \
                    o[nt][0] = MFMA32(VF[0][0], p0_, o[nt][0]); o[nt][0] = MFMA32(VF[0][1], p1_, o[nt][0]); \
                    o[nt][1] = MFMA32(VF[1][0], p0_, o[nt][1]); o[nt][1] = MFMA32(VF[1][1], p1_, o[nt][1]); } } while (0)
            LAS unsigned char* const wslot = (LAS unsigned char*)PART + gwv * 16384;
            const unsigned char* const kgb = (const unsigned char*)(P + rowbase * NIN + 8 * 64);
            const unsigned char* const vgb = (const unsigned char*)(VT + ((size_t)(b * NVS) * 64) * SEQ);
            unsigned koff[4], voff[4];
#pragma unroll
            for (int i = 0; i < 4; ++i) { const int row = 8 * i + (lane3 >> 3), ch = (lane3 & 7) ^ ((row >> 1) & 7); koff[i] = (unsigned)(row * (NIN * 2) + 16 * ch);
                const int d = 16 * i + (lane3 >> 2), cv = (lane3 & 3) ^ ((d >> 2) & 3); voff[i] = (unsigned)(d * (SEQ * 2) + 16 * cv); }
#define DMA_TILE(KT, SLOT) do { const unsigned char* kt_ = kgb + (size_t)((KT) * 32) * (NIN * 2); const unsigned char* vt_ = vgb + (size_t)(KT) * 64; \
                _Pragma("unroll") for (int i = 0; i < 4; ++i) __builtin_amdgcn_global_load_lds((const unsigned*)(kt_ + koff[i]), (LAS unsigned*)(wslot + (SLOT) * 8192 + 1024 * i), 16, 0, 0); \
                _Pragma("unroll") for (int i = 0; i < 4; ++i) __builtin_amdgcn_global_load_lds((const unsigned*)(vt_ + voff[i]), (LAS unsigned*)(wslot + (SLOT) * 8192 + 4096 + 1024 * i), 16, 0, 0); } while (0)
            const int ntl = gwv < nkt ? (nkt - gwv + 3) >> 2 : 0;
            if (ntl > 0) DMA_TILE(gwv, 0);
            if (ntl > 1) DMA_TILE(gwv + 4, 1);
            for (int j = 0; j < ntl; ++j) {
                const int kt = gwv + 4 * j;
                if (j + 1 < ntl) asm volatile("s_waitcnt vmcnt(8)" ::: "memory"); else asm volatile("s_waitcnt vmcnt(0)" ::: "memory");
                LAS unsigned char* const sl = wslot + (j & 1) * 8192;
                bf16x8 kf[4], vf[2][2];
#pragma unroll
                for (int ks = 0; ks < 4; ++ks) kf[ks] = *(const LAS bf16x8*)(sl + r * 128 + (((2 * ks + h) ^ ((r >> 1) & 7)) << 4));
#pragma unroll
                for (int dt = 0; dt < 2; ++dt)
#pragma unroll
                    for (int s2 = 0; s2 < 2; ++s2) { const int d = 32 * dt + r; vf[dt][s2] = *(const LAS bf16x8*)(sl + 4096 + d * 64 + (((2 * s2 + h) ^ ((d >> 2) & 3)) << 4)); }
                asm volatile("s_waitcnt lgkmcnt(0)" ::: "memory");
                if (j + 2 < ntl) DMA_TILE(kt + 8, j & 1);
                ATT_TILE(kt, kf, vf);
            }
            asm volatile("s_waitcnt vmcnt(0) lgkmcnt(0)" ::: "memory");
#undef DMA_TILE
#undef ATT_TILE
#pragma unroll
            for (int nt = 0; nt < 2; ++nt) {
#pragma unroll
                for (int dt = 0; dt < 2; ++dt)
#pragma unroll
                    for (int i = 0; i < 16; ++i) PART[(gwv * 64 + 32 * dt + crow(i, h)) * 64 + 32 * nt + r] = o[nt][dt][i];
                float l2 = ls[nt]; l2 += __shfl_xor(l2, 32);
                if (h == 0) LSUM[gwv * 64 + 32 * nt + r] = l2;
            }
        }
        const int qn = (int)QW[par ^ 1];
        { int lane4 = lane; asm volatile("" : "+v"(lane4));
          const int c = lane4 & 15, g = lane4 >> 4; const int qq = qn < NU ? qn : 0; const size_t row = (size_t)UNIT_B(qq) * SEQ + 16 * UNIT_TAU(qq) + c;
          const bf16_t* qp = P + row * NIN + 4 * 64 + 8 * g;
#pragma unroll
          for (int hh = 0; hh < 4; ++hh) { qi[hh][0] = ldg16(qp + hh * 64); qi[hh][1] = ldg16(qp + hh * 64 + 32); }
          wq = *(const GAS f32x4*)(WI + row * 4); }
        GSYNC();
        DTE(14); DTB(15);
        {
            int n = lane; asm volatile("" : "+v"(n));
            float l = 0.f;
#pragma unroll
            for (int w = 0; w < 4; ++w) l += LSUM[w * 64 + n];
            const float inv = 1.f / l;
            float ov[16]; float ssp = 0.f;
#pragma unroll
            for (int dd = 0; dd < 16; ++dd) { float a = 0.f;
#pragma unroll
                for (int w = 0; w < 4; ++w) a += PART[(w * 64 + 16 * gwv + dd) * 64 + n];
                ov[dd] = a * inv; ssp += ov[dd] * ov[dd]; }
            SSUM[gwv * 64 + n] = ssp;
            GSYNC();
            float ss = 0.f;
#pragma unroll
            for (int w = 0; w < 4; ++w) ss += SSUM[w * 64 + n];
            const float rn = __builtin_amdgcn_rsqf(ss * (1.f / 64.f) + EPS);
            const int head = n >> 4, c = n & 15;
            bf16_t* op = O + (rowbase + t0 + c) * DM + head * 64 + 16 * gwv;
#pragma unroll
            for (int hf = 0; hf < 2; ++hf) {
                const f32x4 ga = *(const f32x4*)(gout + head * 64 + 16 * gwv + 8 * hf), gb = *(const f32x4*)(gout + head * 64 + 16 * gwv + 8 * hf + 4);
                u32x4 wv; wv.x = cvtpk(ov[8 * hf] * rn * ga[0], ov[8 * hf + 1] * rn * ga[1]); wv.y = cvtpk(ov[8 * hf + 2] * rn * ga[2], ov[8 * hf + 3] * rn * ga[3]);
                wv.z = cvtpk(ov[8 * hf + 4] * rn * gb[0], ov[8 * hf + 5] * rn * gb[1]); wv.w = cvtpk(ov[8 * hf + 6] * rn * gb[2], ov[8 * hf + 7] * rn * gb[3]);
                *(GAS u32x4*)(op + 8 * hf) = wv; }
        }
        GSYNC();
        DTE(15);
        q = qn; par ^= 1;
    }
#undef GSYNC
#undef FETCH_UNIT
#undef FETCH_EARLY
#undef FETCH_LATE
#undef UNIT_B
#undef UNIT_TAU
}

typedef const __attribute__((address_space(4))) char* kargp_t;
#define KP() kargp_t kp_ = (kargp_t)__builtin_amdgcn_kernarg_segment_ptr(); asm volatile("" : "+s"(kp_)); unsigned char* const ws = *(unsigned char* const __attribute__((address_space(4)))*)(kp_ + 144); (void)ws
#define AIN(k) (*(const float* const __attribute__((address_space(4)))*)(kp_ + 8 * (k)))
#define AOUT() (*(float* const __attribute__((address_space(4)))*)(kp_ + 136))
static_assert(sizeof(Args) == 160, "Args layout: in[17] | out | ws | lo | hi");
__global__ void __launch_bounds__(NWAVES * 64, 2) fwd(Args args) {
    extern __shared__ __attribute__((aligned(16))) unsigned char lds_raw[];
    LAS unsigned char* lds = (LAS unsigned char*)lds_raw;
    const int wave = __builtin_amdgcn_readfirstlane(threadIdx.x >> 6);
    const int G = gridDim.x;
    const int gw = blockIdx.x * NWAVES + wave, NGW = G * NWAVES;
    volatile LAS unsigned* MISC = (volatile LAS unsigned*)(lds + LDS_MISC);
    if (threadIdx.x < 16) MISC[threadIdx.x] = 0u;
    __syncthreads();
    XcdBarrier bar; bar.bar = (unsigned*)(args.ws + WS_CTL) + CW_BAR; bar.x = 0; bar.st = nullptr; bar.w = wave;
    if (!MK_MULTI) bar = xcd_barrier_post((unsigned*)(args.ws + WS_CTL) + CW_BAR, MISC + 4, wave);
    const int lo = args.lo, hi = args.hi;
#define IN(k) (lo <= (k) && (k) < hi)
#define SEAM(k) do { if (IN(k) && IN((k) + 1)) xcd_barrier(bar); } while (0)
#define OPQ() int tid = wave * 64 + lane_id_v(); asm volatile("" : "+v"(tid)); const int lane = tid & 63; (void)lane
#ifdef TPROBE
#define TBEG(cls) do { if ((TPROBE >> (cls)) & 1) { if (threadIdx.x == 0) MISC[13] = (unsigned)__builtin_amdgcn_s_memrealtime(); } } while (0)
#define TEND(cls) do { if ((TPROBE >> (cls)) & 1) { if (threadIdx.x == 0) MISC[12] = MISC[12] + ((unsigned)__builtin_amdgcn_s_memrealtime() - MISC[13]); } } while (0)
#else
#define TBEG(cls) do { } while (0)
#define TEND(cls) do { } while (0)
#endif
#ifdef TPROBE_BODY
#define TENDB(cls) TEND(cls)
#define TENDS(cls) do { } while (0)
#else
#define TENDB(cls) do { } while (0)
#define TENDS(cls) TEND(cls)
#endif
    TBEG(0);
    if (PH(0) && IN(0)) _Pragma("unroll 1") for (int rep = 0; rep < REP_PA; ++rep) { OPQ(); prologue(args, lds, tid, lane, wave, G); }
    TENDB(0); SEAM(0); TENDS(0);
    TBEG(1);
    if (PH(0) && IN(1)) _Pragma("unroll 1") for (int rep = 0; rep < REP_PB; ++rep) { OPQ(); prologue_b(args, lds, tid, lane, wave, G); }
    if (PH(1) && IN(1)) _Pragma("unroll 1") for (int rep = 0; rep < REP_N; ++rep) { OPQ(); KP();
        pre_phase(AIN(0), AIN(2), (const float*)(ws + WS_MOD), (bf16_t*)(ws + WS_H), (float*)(ws + WS_SS), lane, gw, NGW); }
    TENDB(1); SEAM(1); TENDS(1);

    for (int l = 0; l < DEPTH; ++l) {
        const int s0 = 1 + 5 * l;
        TBEG(2);
        if (PH(2) && IN(s0 + 1)) _Pragma("unroll 1") for (int rep = 0; rep < REP_G2; ++rep) {
            KP(); stagger(STAG_I);
            const bf16_t* wl = (const bf16_t*)(ws + WS_W + (size_t)l * W_LAYER);
            pg8::Gemm g{(const bf16_t*)(ws + WS_H), wl + W_IN / 2, MROWS, NIN, DM}; pg8::StaticOrder S; S.init(MROWS, NIN, G, (int)blockIdx.x);
            pg8::EpiInProj E{(bf16_t*)(ws + WS_P), (bf16_t*)(ws + WS_VT), (float*)(ws + WS_WI), (const float*)(ws + WS_ROPE), (const float*)(ws + WS_ROPE) + SEQ * 32,
                             AIN(7) + l * 64, AIN(8) + l * 64, AIN(9) + l * 64, AIN(10) + l * 64, (const float*)(ws + WS_SS), (const float*)(ws + WS_B1) + (size_t)l * BATCH * NIN, (LAS float*)(lds + 131072)};
            pg8::gemm_phase<pg8::EpiInProj, pg8::StaticOrder, true, true>(lds, g, S, E, wave);
        }
        TENDB(2); SEAM(s0 + 1); TENDS(2); TBEG(3);
        if (PH(3) && IN(s0 + 2)) {
            OPQ(); KP();
            const bf16_t* P = (const bf16_t*)(ws + WS_P); const bf16_t* VT = (const bf16_t*)(ws + WS_VT); bf16_t* OB = (bf16_t*)(ws + WS_O);
            const float* gout = AIN(12) + l * 1024;
            const float gqa = wave_max(fabsf(AIN(7)[l * 64 + lane])), gka = wave_max(fabsf(AIN(8)[l * 64 + lane]));
            const float gqc = wave_max(fabsf(AIN(9)[l * 64 + lane])), gkc = wave_max(fabsf(AIN(10)[l * 64 + lane]));
            const float M2a = 8.f * gqa * gka * LOG2E, M2c = 8.f * gqc * gkc * LOG2E;
            _Pragma("unroll 1") for (int rep = 0; rep < REP_ATT; ++rep) {
            const int xs = (G % 8 == 0) ? (int)(blockIdx.x & 7) : 0, js = (G % 8 == 0) ? (int)(blockIdx.x >> 3) : (int)blockIdx.x, njs = (G % 8 == 0) ? G / 8 : G, nvs = (G % 8 == 0) ? 128 : 1024;
            TBEG(8); TBEG(11);
            if (PH(8)) _Pragma("unroll 1") for (int r2 = 0; r2 < REP_SWA; ++r2) for (int v = js; v < nvs; v += njs) { const int b = 4 * xs + (v >> 5), kv = (v >> 4) & 1, qb = v & 15;
                swa_block(b, kv, qb, P, VT, OB, M2c, AIN(11) + l * 8, gout, lds, tid, lane, wave); }
            TEND(8); TBEG(9);
            if (PH(9)) _Pragma("unroll 1") for (int r2 = 0; r2 < REP_SB; ++r2) for (int v = js; v < nvs; v += njs) { const int b = 4 * xs + (v >> 5), hb = (v >> 3) & 3, qb = v & 7;
                sb_block(b, hb, qb, P, VT, OB, gout, lds, tid, lane, wave); }
            TEND(9); TEND(11); TBEG(10);
            if (PH(10)) _Pragma("unroll 1") for (int r2 = 0; r2 < REP_DSA; ++r2) dsa_phase(P, VT, (const float*)(ws + WS_WI), OB, gout, M2a, (unsigned*)(ws + WS_CTL) + CW_QUEUE + 1024 * l + 256 * rep + 128 * r2, lds, tid, lane, wave);
            TEND(10);
            }
        }
        TENDB(3); SEAM(s0 + 2); TENDS(3); TBEG(4);
        if (PH(4) && IN(s0 + 3)) _Pragma("unroll 1") for (int rep = 0; rep < REP_G4; ++rep) {
            KP(); stagger(STAG_O);
            const bf16_t* wl = (const bf16_t*)(ws + WS_W + (size_t)l * W_LAYER); const float* modl = (const float*)(ws + WS_MOD) + (size_t)l * BATCH * 6144;
            pg8::Gemm g{(const bf16_t*)(ws + WS_O), wl + W_O / 2, MROWS, DM, DM}; pg8::StaticOrder S; S.init(MROWS, DM, G, (int)blockIdx.x);
            pg8::EpiResid E{l == 0 ? (const void*)AIN(0) : (const void*)(ws + WS_X16), rep ? (void*)(ws + WS_DUMMY) : (void*)(ws + WS_X16), modl + 2 * DM, rep ? (bf16_t*)(ws + WS_DUMMY) : (bf16_t*)(ws + WS_H),
                            AIN(3) + l * DM, modl + 4 * DM, rep ? (float*)(ws + WS_DUMMY) : (float*)(ws + WS_SS), 1, l == 0 ? 1 : 0, 0};
            pg8::gemm_phase<pg8::EpiResid, pg8::StaticOrder, true, true>(lds, g, S, E, wave);
        }
        TENDB(4); SEAM(s0 + 3); TENDS(4); TBEG(5);
        if (PH(6) && IN(s0 + 4)) _Pragma("unroll 1") for (int rep = 0; rep < REP_G6; ++rep) {
            KP();
            const bf16_t* wl = (const bf16_t*)(ws + WS_W + (size_t)l * W_LAYER);
            pg8::Gemm g{(const bf16_t*)(ws + WS_H), wl + W_GU / 2, MROWS, NGU, DM}; pg8::StaticOrder S; S.init(MROWS, NGU, G, (int)blockIdx.x);
            pg8::EpiSwiGLU E{(bf16_t*)(ws + WS_ACT), (const float*)(ws + WS_SS), (const float*)(ws + WS_BG) + (size_t)l * BATCH * DFF, (const float*)(ws + WS_BU) + (size_t)l * BATCH * DFF};
            pg8::gemm_phase<pg8::EpiSwiGLU, pg8::StaticOrder, true, true>(lds, g, S, E, wave);
        }
        TENDB(5); SEAM(s0 + 4); TENDS(5); TBEG(6);
        if (PH(7) && IN(s0 + 5)) _Pragma("unroll 1") for (int rep = 0; rep < REP_G7; ++rep) {
            KP(); stagger(STAG_D);
            const bf16_t* wl = (const bf16_t*)(ws + WS_W + (size_t)l * W_LAYER); const float* mod = (const float*)(ws + WS_MOD); const float* modl = mod + (size_t)l * BATCH * 6144;
            pg8::Gemm g{(const bf16_t*)(ws + WS_ACT), wl + W_D / 2, MROWS, DM, DFF}; pg8::StaticOrder S; S.init(MROWS, DM, G, (int)blockIdx.x);
            const int ln = (l + 1 < DEPTH) ? l + 1 : l;
            const int last = (l + 1 == DEPTH);
            pg8::EpiResid E{(const void*)(ws + WS_X16), rep ? (void*)(ws + WS_DUMMY) : (last ? (void*)AOUT() : (void*)(ws + WS_X16)), modl + 5 * DM, rep ? (bf16_t*)(ws + WS_DUMMY) : (bf16_t*)(ws + WS_H),
                            AIN(2) + ln * DM, mod + (size_t)ln * BATCH * 6144 + DM, rep ? (float*)(ws + WS_DUMMY) : (float*)(ws + WS_SS), last ? 0 : 1, 0, (last && !rep) ? 1 : 0};
            pg8::gemm_phase<pg8::EpiResid, pg8::StaticOrder, true, true>(lds, g, S, E, wave);
        }
        TENDB(6); SEAM(s0 + 5); TENDS(6);
    }
#ifdef TPROBE
    __syncthreads();
    { unsigned tacc = MISC[12];
#ifdef TPROBE_BLK
      if ((int)blockIdx.x != (TPROBE_BLK)) tacc = 0u;
#endif
      const unsigned tend = (unsigned)__builtin_amdgcn_s_memrealtime(), span = tacc * (unsigned)(TPROBE_K);
      while ((unsigned)__builtin_amdgcn_s_memrealtime() - tend < span) __builtin_amdgcn_s_sleep(8); }
#endif
#undef IN
#undef SEAM
}

extern "C" void kernel_launch(void* const* d_in, const int* in_sizes, int n_in, void* d_out, int out_size, void* d_ws, size_t ws_size, hipStream_t stream) {
    static int grid = 0;
    if (grid == 0) {
        if (n_in != 17 || in_sizes[0] != MROWS * DM || out_size != MROWS * DM || ws_size < WS_END) {
            fprintf(stderr, "kernel_launch: unexpected problem (n_in %d, in0 %d, out %d, ws %zu); nothing launched\n", n_in, n_in > 0 ? in_sizes[0] : -1, out_size, ws_size); grid = -1; return; }
        int dev = 0, cus = 0, per_cu = 0;
        if (hipGetDevice(&dev) != hipSuccess || hipDeviceGetAttribute(&cus, hipDeviceAttributeMultiprocessorCount, dev) != hipSuccess) { grid = -1; return; }
        if (hipFuncSetAttribute((const void*)fwd, hipFuncAttributeMaxDynamicSharedMemorySize, LDS_BYTES) != hipSuccess) { fprintf(stderr, "kernel_launch: hipFuncSetAttribute failed\n"); grid = -1; return; }
        if (hipOccupancyMaxActiveBlocksPerMultiprocessor(&per_cu, (const void*)fwd, NWAVES * 64, LDS_BYTES) != hipSuccess || per_cu < 1) {
            fprintf(stderr, "kernel_launch: occupancy query reports %d workgroups per CU\n", per_cu); per_cu = 1; }
        (void)hipGetLastError();
        grid = cus;
    }
    if (grid < 0) return;
    if (hipMemsetAsync((char*)d_ws + WS_CTL, 0, CTL_BYTES, stream) != hipSuccess) return;
    Args a{};
    for (int i = 0; i < 17; ++i) a.in[i] = (const float*)d_in[i];
    a.out = (float*)d_out; a.ws = (unsigned char*)d_ws;
#if MK_MULTI
    for (int s = 0; s < NSTEPS; ++s) { a.lo = s; a.hi = s + 1; hipLaunchKernelGGL(fwd, dim3(grid), dim3(NWAVES * 64), LDS_BYTES, stream, a); }
#else
    a.lo = 0; a.hi = NSTEPS;
    hipLaunchKernelGGL(fwd, dim3(grid), dim3(NWAVES * 64), LDS_BYTES, stream, a);
#endif
}
```

```cpp
#include <hip/hip_runtime.h>
#include <cstdio>
#include <cstdint>

#ifndef MK_MULTI
#define MK_MULTI 0
#endif

#define LAS __attribute__((address_space(3)))
#define GAS __attribute__((address_space(1)))
__device__ __forceinline__ int lane_id_v() { int l; asm volatile("v_mbcnt_lo_u32_b32 %0, -1, 0\n\tv_mbcnt_hi_u32_b32 %0, -1, %0" : "=v"(l)); return l; }
namespace pg8 {
#define PG8_LAS __attribute__((address_space(3)))
typedef unsigned short bf16_t;
typedef short bf16x8 __attribute__((ext_vector_type(8)));
typedef float f32x4 __attribute__((ext_vector_type(4)));
typedef unsigned u32x4 __attribute__((ext_vector_type(4)));
constexpr int BM = 256, BK = 64, HALF = 128, HTB = HALF * BK * 2  , STAGE_BYTES = 8 * HTB, NXCD = 8, WGM = 8;

__host__ __device__ __forceinline__ int lds_byte(int r, int c) { const int st = (r >> 4) * 2 + (c >> 5), rr = r & 15, cc = c & 31, ob = rr * 64 + cc * 2; return st * 1024 + (ob ^ (((ob >> 9) & 1) << 5)); }
__host__ __device__ __forceinline__ void stage_rc(int b, int& R, int& C) { const int st = b / 1024, sb = b % 1024, swz = sb ^ (((sb >> 9) & 1) << 5); R = (st >> 1) * 16 + swz / 64; C = (st & 1) * 32 + (swz % 64) / 2; }
__host__ __device__ __forceinline__ int perm32(int rho) { const int n = rho >> 4, i = rho & 15; return 8 * (i >> 2) + 4 * n + (i & 3); }

struct Unit { int pm, pn; };
struct Gemm { const bf16_t* A; const bf16_t* Bt; int M, N, K; };

struct StaticOrder {
    int nM, nN, nwg, G, c;
    __host__ __device__ void init(int M, int N, int G_, int c_) { nM = M / BM; nN = N / BM; nwg = nM * nN; G = G_; c = c_; }
    __host__ __device__ bool next(int i, Unit& u) const {
        const long L = (long)i * G + c; if (L >= nwg) return false;
        int wgid = (int)L; { const int q = nwg / NXCD, r = nwg % NXCD, xcd = wgid % NXCD, off = wgid / NXCD; wgid = (xcd < r ? xcd * (q + 1) : r * (q + 1) + (xcd - r) * q) + off; }
        const int nig = WGM * nN, gid = wgid / nig, fm = gid * WGM, gsz = (nM - fm) < WGM ? (nM - fm) : WGM;
        u.pm = fm + ((wgid % nig) % gsz); u.pn = (wgid % nig) / gsz; return true;
    }
    __device__ __forceinline__ void a_ready(const Unit&) const {}
    __device__ __forceinline__ void done(const Unit&) const {}
};
#ifndef RELAX_V
#define RELAX_V 0
#endif
template <class Epi, class Sched, bool ALIGN_EPI = false, bool SP2 = false>
__device__ __forceinline__ void gemm_phase(PG8_LAS unsigned char* lds, const Gemm g, const Sched& S, const Epi& E, int wave_) {
    int tid_o = wave_ * 64 + lane_id_v(); asm volatile("" : "+v"(tid_o));
    const int tid = tid_o, wid = __builtin_amdgcn_readfirstlane(tid >> 6), lane = tid & 63, wr = wid >> 2, wc = wid & 3, fr = lane & 15, fq = lane >> 4;
    const int K = g.K, nt = K / BK;
    unsigned voffA[2], voffB[2];
#pragma unroll
    for (int i = 0; i < 2; ++i) { int R, C; stage_rc(tid * 16 + i * 8192, R, C); const int Rb = Epi::PERM ? ((R & ~31) + perm32(R & 31)) : R;
        voffA[i] = (unsigned)(R * K + C) * 2u; voffB[i] = (unsigned)(Rb * K + C) * 2u; }
    const size_t kstep = (size_t)(BK * 2);
    const size_t hstep = (size_t)HALF * K * 2;
    const size_t tstep = 2 * hstep;
    const unsigned ldsw = (unsigned)wid * 1024u;
    const int aoff = lds_byte(wr * 64 + fr, fq * 8), boff = lds_byte(wc * 32 + fr, fq * 8);
#define PG8_SA(b, h) (((b) * 2 + (h)) * HTB)
#define PG8_SB(b, h) ((4 + (b) * 2 + (h)) * HTB)
#define PG8_STAGE(bufoff, gbase, voff) do { _Pragma("unroll") for (int _i = 0; _i < 2; ++_i) \
        __builtin_amdgcn_global_load_lds((const unsigned*)((const char*)(gbase) + (voff)[_i]), (PG8_LAS unsigned*)(lds + (bufoff) + ldsw + _i * 8192), 16, 0, 0); } while (0)
#define PG8_LDA(dst, b, h) do { _Pragma("unroll") for (int m = 0; m < 4; ++m) _Pragma("unroll") for (int k = 0; k < 2; ++k) dst[m][k] = *(const PG8_LAS bf16x8*)(lds + PG8_SA(b, h) + aoff + m * 2048 + k * 1024); } while (0)
#define PG8_LDB(dst, b, h) do { _Pragma("unroll") for (int n = 0; n < 2; ++n) _Pragma("unroll") for (int k = 0; k < 2; ++k) dst[n][k] = *(const PG8_LAS bf16x8*)(lds + PG8_SB(b, h) + boff + n * 2048 + k * 1024); } while (0)
#define PG8_MMA(ai, bj, At, Bt) do { __builtin_amdgcn_s_setprio(1); _Pragma("unroll") for (int m = 0; m < 4; ++m) _Pragma("unroll") for (int n = 0; n < 2; ++n) _Pragma("unroll") for (int k = 0; k < 2; ++k) \
        acc[ai][bj][m][n] = __builtin_amdgcn_mfma_f32_16x16x32_bf16(Bt[n][k], At[m][k], acc[ai][bj][m][n], 0, 0, 0); __builtin_amdgcn_s_setprio(0); } while (0)
#define PG8_WAIT_V(n) asm volatile("s_waitcnt vmcnt(" #n ")" ::: "memory")
#define PG8_WAIT_L(n) asm volatile("s_waitcnt lgkmcnt(" #n ")" ::: "memory")
#define PG8_BAR __builtin_amdgcn_s_barrier()
#define PG8_SCHED __builtin_amdgcn_sched_barrier(0)
    Unit cur, nxt; int ui = 0;
    if (!S.next(0, cur)) return;
    f32x4 acc[2][2][4][2];
#pragma unroll
    for (int a = 0; a < 2; ++a)
#pragma unroll
        for (int b = 0; b < 2; ++b)
#pragma unroll
            for (int m = 0; m < 4; ++m)
#pragma unroll
                for (int n = 0; n < 2; ++n) acc[a][b][m][n] = (f32x4){0.f, 0.f, 0.f, 0.f};
    bf16x8 At[4][2], B0[2][2], B1[2][2];
    const char* cA = (const char*)g.A + (size_t)cur.pm * tstep; const char* cB = (const char*)g.Bt + (size_t)cur.pn * tstep;
    S.a_ready(cur);
    if constexpr (SP2) {
        PG8_STAGE(PG8_SB(0, 0), cB, voffB); PG8_STAGE(PG8_SB(0, 1), cB + hstep, voffB); PG8_STAGE(PG8_SA(0, 0), cA, voffA); PG8_STAGE(PG8_SA(0, 1), cA + hstep, voffA);
        if (wr == 1) PG8_BAR;
        PG8_WAIT_V(2); PG8_BAR;
        PG8_STAGE(PG8_SB(1, 0), cB + kstep, voffB); PG8_STAGE(PG8_SA(1, 0), cA + kstep, voffA); PG8_STAGE(PG8_SB(1, 1), cB + hstep + kstep, voffB);
        PG8_WAIT_V(6); PG8_BAR;
    } else {
        PG8_STAGE(PG8_SB(0, 0), cB, voffB); PG8_STAGE(PG8_SA(0, 0), cA, voffA); PG8_STAGE(PG8_SB(0, 1), cB + hstep, voffB); PG8_STAGE(PG8_SA(0, 1), cA + hstep, voffA);
        if (wr == 1) PG8_BAR;
        PG8_WAIT_V(4); PG8_BAR;
        PG8_STAGE(PG8_SB(1, 0), cB + kstep, voffB); PG8_STAGE(PG8_SA(1, 0), cA + kstep, voffA); PG8_STAGE(PG8_SB(1, 1), cB + hstep + kstep, voffB);
        PG8_WAIT_V(6); PG8_BAR;
    }
    for (;;) {
        const bool has_next = S.next(ui + 1, nxt);
        const char* nA = has_next ? (const char*)g.A + (size_t)nxt.pm * tstep : cA; const char* nB = has_next ? (const char*)g.Bt + (size_t)nxt.pn * tstep : cB;
#ifdef KREP_PROBE
        _Pragma("unroll 1") for (int kr = 0; kr < Epi::KREP; ++kr) {
        if (kr > 0) {
            _Pragma("unroll") for (int a = 0; a < 2; ++a) _Pragma("unroll") for (int b = 0; b < 2; ++b) _Pragma("unroll") for (int m = 0; m < 4; ++m) _Pragma("unroll") for (int n = 0; n < 2; ++n) acc[a][b][m][n] = (f32x4){0.f, 0.f, 0.f, 0.f};
        }
        const bool lastrep = (kr == Epi::KREP - 1);
#else
        const bool lastrep = true;
#endif
        for (int t = 0; t < nt; t += 2) {
            const bool last = (t == nt - 2);
            const char* a1 = cA + (size_t)(t + 1) * kstep;
            const char* a2 = last ? (lastrep ? nA : cA) : cA + (size_t)(t + 2) * kstep; const char* b2 = last ? (lastrep ? nB : cB) : cB + (size_t)(t + 2) * kstep;
            const char* a3 = a2 + kstep; const char* b3 = b2 + kstep;
            if (last && has_next) S.a_ready(nxt);
            if constexpr (SP2) {
            PG8_LDB(B0, 0, 0); PG8_LDB(B1, 0, 1); PG8_SCHED; PG8_LDA(At, 0, 0); PG8_STAGE(PG8_SA(1, 1), a1 + hstep, voffA);
            if constexpr (RELAX_V != 0) { const int rlx = __builtin_amdgcn_readfirstlane((t == 0 && ui > 0) ? 1 : 0);
                asm volatile("s_cmp_lg_u32 %0, 0\n\ts_cbranch_scc1 .Lrlx%=\n\ts_waitcnt vmcnt(8)\n.Lrlx%=:\n\ts_waitcnt vmcnt(%1)" :: "s"(rlx), "n"(8 + Epi::NVM) : "memory", "scc"); }
            else PG8_WAIT_V(8);
            PG8_WAIT_L(0); PG8_BAR; PG8_MMA(0, 0, At, B0); PG8_MMA(0, 1, At, B1); PG8_BAR; PG8_SCHED;
            PG8_LDA(At, 0, 1); PG8_STAGE(PG8_SB(0, 0), b2, voffB); PG8_STAGE(PG8_SB(0, 1), b2 + hstep, voffB); PG8_STAGE(PG8_SA(0, 0), a2, voffA);
            PG8_WAIT_V(8); PG8_WAIT_L(0); PG8_BAR; PG8_MMA(1, 0, At, B0); PG8_MMA(1, 1, At, B1); PG8_BAR; PG8_SCHED;
            PG8_LDB(B0, 1, 0); PG8_LDB(B1, 1, 1); PG8_SCHED; PG8_LDA(At, 1, 0); PG8_STAGE(PG8_SA(0, 1), a2 + hstep, voffA);
            PG8_WAIT_V(8); PG8_WAIT_L(0); PG8_BAR; PG8_MMA(0, 0, At, B0); PG8_MMA(0, 1, At, B1); PG8_BAR; PG8_SCHED;
            PG8_LDA(At, 1, 1); PG8_STAGE(PG8_SB(1, 0), b3, voffB); PG8_STAGE(PG8_SB(1, 1), b3 + hstep, voffB); PG8_STAGE(PG8_SA(1, 0), a3, voffA);
            PG8_WAIT_V(8); PG8_WAIT_L(0); PG8_BAR; PG8_MMA(1, 0, At, B0); PG8_MMA(1, 1, At, B1); PG8_BAR; PG8_SCHED;
            } else {
            PG8_LDB(B0, 0, 0); PG8_SCHED; PG8_LDA(At, 0, 0); PG8_STAGE(PG8_SA(1, 1), a1 + hstep, voffA);
            PG8_WAIT_L(8); PG8_BAR; PG8_WAIT_L(0); PG8_MMA(0, 0, At, B0); PG8_BAR; PG8_SCHED;
            PG8_LDB(B1, 0, 1); PG8_STAGE(PG8_SB(0, 0), b2, voffB);
            PG8_BAR; PG8_WAIT_L(0); PG8_MMA(0, 1, At, B1); PG8_BAR;
            PG8_LDA(At, 0, 1); PG8_STAGE(PG8_SA(0, 0), a2, voffA);
            PG8_BAR; PG8_WAIT_L(0); PG8_MMA(1, 0, At, B0); PG8_BAR; PG8_SCHED;
            PG8_STAGE(PG8_SB(0, 1), b2 + hstep, voffB);
            PG8_WAIT_V(6); PG8_BAR; PG8_MMA(1, 1, At, B1); PG8_BAR;
            PG8_LDB(B0, 1, 0); PG8_SCHED; PG8_LDA(At, 1, 0); PG8_STAGE(PG8_SA(0, 1), a2 + hstep, voffA);
            PG8_WAIT_L(8); PG8_BAR; PG8_WAIT_L(0); PG8_MMA(0, 0, At, B0); PG8_BAR; PG8_SCHED;
            PG8_LDB(B1, 1, 1); PG8_STAGE(PG8_SB(1, 0), b3, voffB);
            PG8_BAR; PG8_WAIT_L(0); PG8_MMA(0, 1, At, B1); PG8_BAR;
            PG8_LDA(At, 1, 1); PG8_STAGE(PG8_SA(1, 0), a3, voffA);
            PG8_BAR; PG8_WAIT_L(0); PG8_MMA(1, 0, At, B0); PG8_BAR; PG8_SCHED;
            PG8_STAGE(PG8_SB(1, 1), b3 + hstep, voffB);
            PG8_WAIT_V(6); PG8_BAR; PG8_MMA(1, 1, At, B1); PG8_BAR;
            }
        }
#ifdef KREP_PROBE
        }
#endif
        if constexpr (ALIGN_EPI) { if (wr == 0) PG8_BAR; }
#ifdef KREP_PROBE
        if constexpr (Epi::EREP > 1) { _Pragma("unroll 1") for (int er = 1; er < Epi::EREP; ++er) { int fr2 = fr, fq2 = fq; asm volatile("" : "+v"(fr2), "+v"(fq2)); E(acc, cur, wr, wc, fr2, fq2); asm volatile("" ::: "memory"); } }
#endif
#ifdef TPROBE
        if ((TPROBE >> Epi::TCLS) & 1) { if (tid == (TPROBE_TID)) ((volatile PG8_LAS unsigned*)(lds + 144128))[13] = (unsigned)__builtin_amdgcn_s_memrealtime(); }
#endif
        if constexpr (!Epi::AFTER_DRAIN) { E(acc, cur, wr, wc, fr, fq); S.done(cur); }
#ifdef TPROBE
        if ((TPROBE >> Epi::TCLS) & 1) { if (tid == (TPROBE_TID)) { asm volatile("s_waitcnt vmcnt(0)" ::: "memory"); volatile PG8_LAS unsigned* m_ = (volatile PG8_LAS unsigned*)(lds + 144128); m_[12] = m_[12] + ((unsigned)__builtin_amdgcn_s_memrealtime() - m_[13]); } }
#endif
        if (!has_next) break;
#pragma unroll
        for (int a = 0; a < 2; ++a)
#pragma unroll
            for (int b = 0; b < 2; ++b)
#pragma unroll
                for (int m = 0; m < 4; ++m)
#pragma unroll
                    for (int n = 0; n < 2; ++n) acc[a][b][m][n] = (f32x4){0.f, 0.f, 0.f, 0.f};
        cur = nxt; cA = nA; cB = nB; ++ui;
        if constexpr (ALIGN_EPI) { if (wr == 1) PG8_BAR; }
    }
    PG8_WAIT_V(0);
    if constexpr (!ALIGN_EPI) { if (wr == 0) PG8_BAR; }
    PG8_BAR;
    if constexpr (Epi::AFTER_DRAIN) { E.fused(acc, cur, wr, wc, fr, fq, lds, wid, lane); S.done(cur); }
#undef PG8_SA
#undef PG8_SB
#undef PG8_STAGE
#undef PG8_LDA
#undef PG8_LDB
#undef PG8_MMA
#undef PG8_WAIT_V
#undef PG8_WAIT_L
#undef PG8_BAR
#undef PG8_SCHED
}
}

#define XB_TMO      128
#define XB_XCNT(j)  (256  + 64 * (j))
#define XB_XSUB(j)  (1280 + 64 * (j))
#define XB_XGEN(j)  (2304 + 64 * (j))
#define XB_TOP      3328
#define XB_TOPGEN   3392
#define XCD_BAR_WORDS 3456
#define XB_SPIN_CAP (1u << 24)

__device__ __forceinline__ unsigned xb_ld(unsigned* p)              { return __hip_atomic_load(p, __ATOMIC_RELAXED, __HIP_MEMORY_SCOPE_AGENT); }
__device__ __forceinline__ unsigned xb_add(unsigned* p, unsigned v) { return __hip_atomic_fetch_add(p, v, __ATOMIC_RELAXED, __HIP_MEMORY_SCOPE_AGENT); }
__device__ __forceinline__ unsigned xb_xcc_id() { return (unsigned)__builtin_amdgcn_s_getreg((3 << 11) | 20) & 0xFu; }
#define XB_SPIN(cond, bar) do { unsigned _sp = 0; while (cond) { __builtin_amdgcn_s_sleep(1); \
    if ((++_sp & 255u) == 0u) { if (xb_ld(&(bar)[XB_TMO])) break; if (_sp > XB_SPIN_CAP) { atomicAdd(&(bar)[XB_TMO], 1u); break; } } } } while (0)

struct XcdBarrier {
    unsigned* bar; unsigned x; int w;
    volatile LAS unsigned* st;
};

#define XB_THREAD0(w) ((w) == 0 && lane_id_v() == 0)
__device__ __forceinline__ XcdBarrier xcd_barrier_post(unsigned* bar, volatile LAS unsigned* st, int w) {
    XcdBarrier b; b.bar = bar; b.x = xb_xcc_id(); b.st = st; b.w = w;
    if (XB_THREAD0(w)) (void)xb_add(&bar[XB_XCNT(b.x)], 1u);
    return b;
}
__device__ __forceinline__ void xcd_barrier_complete(unsigned* bar, unsigned x, unsigned& nloc, unsigned& nx) {
    const unsigned G = gridDim.x * gridDim.y * gridDim.z;
    unsigned sum, cnt, mine, sp = 0u;
    for (;;) {
        sum = 0u; cnt = 0u; mine = 0u;
#pragma unroll
        for (unsigned j = 0; j < 16; ++j) { const unsigned c = xb_ld(&bar[XB_XCNT(j)]); sum += c; cnt += (c > 0u) ? 1u : 0u; mine = (j == x) ? c : mine; }
        if (sum == G) break;
        __builtin_amdgcn_s_sleep(1);
        if ((++sp & 255u) == 0u) { if (xb_ld(&bar[XB_TMO])) break; if (sp > XB_SPIN_CAP) { atomicAdd(&bar[XB_TMO], 1u); break; } }
    }
    nloc = mine > 0u ? mine : 1u; nx = cnt > 0u ? cnt : 1u;
}

__device__ __forceinline__ void xcd_barrier(const XcdBarrier& b) {
    asm volatile("s_waitcnt vmcnt(0)" ::: "memory");
    __syncthreads();
    if (XB_THREAD0(b.w)) {
        unsigned* bar = b.bar;
        __builtin_amdgcn_s_waitcnt(0);
        unsigned nloc = b.st[0], nx = b.st[1];
        if (nloc == 0u) { xcd_barrier_complete(bar, b.x, nloc, nx); b.st[0] = nloc; b.st[1] = nx; }
        const unsigned old = xb_add(&bar[XB_XSUB(b.x)], 1u);
        const unsigned gen = old / nloc;
        if (old + 1u == (gen + 1u) * nloc) {
            __builtin_amdgcn_fence(__ATOMIC_RELEASE, "agent");
            asm volatile("s_waitcnt vmcnt(0)" ::: "memory");
            const unsigned og = xb_add(&bar[XB_TOP], 1u);
            const unsigned tg = og / nx;
            if (og + 1u == (tg + 1u) * nx) xb_add(&bar[XB_TOPGEN], 1u);
            else XB_SPIN(xb_ld(&bar[XB_TOPGEN]) == tg, bar);
            __builtin_amdgcn_fence(__ATOMIC_ACQUIRE, "agent");
            xb_add(&bar[XB_XGEN(b.x)], 1u);
            asm volatile("s_waitcnt vmcnt(0)" ::: "memory");
        } else {
            XB_SPIN(xb_ld(&bar[XB_XGEN(b.x)]) == gen, bar);
            __builtin_amdgcn_fence(__ATOMIC_ACQUIRE, "agent");
            asm volatile("s_waitcnt vmcnt(0)" ::: "memory");
        }
    }
    __syncthreads();
}

#define LAS __attribute__((address_space(3)))
#define GAS __attribute__((address_space(1)))
typedef unsigned short bf16_t;
typedef short bf16x8 __attribute__((ext_vector_type(8)));
typedef float f32x4 __attribute__((ext_vector_type(4)));
typedef float f32x2 __attribute__((ext_vector_type(2)));
typedef float f32x16 __attribute__((ext_vector_type(16)));
typedef unsigned u32x4 __attribute__((ext_vector_type(4)));
typedef unsigned u32x2 __attribute__((ext_vector_type(2)));
typedef __bf16 bf16x2v __attribute__((ext_vector_type(2)));

constexpr int NWAVES = 8;
constexpr int BATCH = 32, SEQ = 2048, DM = 1024, DEPTH = 4, MROWS = BATCH * SEQ;
constexpr int NIN = 2304, INCOLS = 2244, DFF = 2816, NGU = 2 * DFF, NVS = 7;
constexpr float EPS = 1e-6f, LOG2E = 1.4426950408889634f, C2 = 0.18033688011112042f;
constexpr int NSTEPS = 2 + 5 * DEPTH;
#ifndef TPROBE_TID
#define TPROBE_TID 0
#endif
#ifndef IDX_QD
#define IDX_QD 6
#endif
#ifndef PHMASK
#define PHMASK 0xffff
#endif
#define PH(i) ((PHMASK >> (i)) & 1)
#ifndef DSA_S
#define DSA_S 15
#endif
#ifndef REP_ATT
#define REP_ATT 1
#endif
#ifndef REP_SWA
#define REP_SWA 1
#endif
#ifndef REP_SB
#define REP_SB 1
#endif
#ifndef REP_DSA
#define REP_DSA 1
#endif
#ifndef DSA_R1
#define DSA_R1 1
#endif
#ifndef DSA_R2
#define DSA_R2 1
#endif
#ifndef DSA_R3
#define DSA_R3 1
#endif
#ifndef REP_BIS
#define REP_BIS 1
#endif
#ifndef REP_PA
#define REP_PA 1
#endif
#ifndef REP_PB
#define REP_PB 1
#endif
#ifndef TEST_SELN
#define TEST_SELN 2
#endif
#ifndef STAG_G
#define STAG_G 0
#endif
#ifndef STAG_O
#define STAG_O 0
#endif
#ifndef STAG_D
#define STAG_D 0
#endif
#ifndef STAG_I
#define STAG_I 0
#endif
#ifndef REP_G
#define REP_G 1
#endif
#ifndef REP_G2
#define REP_G2 REP_G
#endif
#ifndef REP_G4
#define REP_G4 REP_G
#endif
#ifndef REP_G6
#define REP_G6 REP_G
#endif
#ifndef REP_G7
#define REP_G7 REP_G
#endif
#ifndef REP_N
#define REP_N 1
#endif

constexpr size_t MiB = 1u << 20;
constexpr size_t WS_CTL = 0, CTL_BYTES = MiB;
constexpr size_t WS_ROPE = 1 * MiB;
constexpr size_t WS_MOD = 2 * MiB;
constexpr size_t WS_WI = 5 * MiB;
constexpr size_t WS_W = 8 * MiB, W_LAYER = 23 * MiB;
constexpr size_t W_IN = 0, W_O = 4608 * 1024, W_GU = W_O + 2 * MiB, W_D = W_GU + 11 * MiB;
constexpr size_t WS_H = 104 * MiB;
constexpr size_t WS_ACT = 232 * MiB;
constexpr size_t WS_P = WS_ACT;
constexpr size_t WS_VT = WS_ACT + 288 * MiB;
constexpr size_t WS_O = 584 * MiB;
constexpr size_t WS_SS = 712 * MiB;
constexpr size_t WS_B1 = 716 * MiB;
constexpr size_t WS_BG = 718 * MiB, WS_BU = 720 * MiB;
constexpr size_t WS_X16 = 724 * MiB;
constexpr size_t WS_END = 852 * MiB, WS_DUMMY = 852 * MiB;
static_assert(W_D + (size_t)DM * DFF * 2 <= W_LAYER && WS_W + DEPTH * W_LAYER <= WS_H && WS_VT + (size_t)BATCH * NVS * 64 * SEQ * 2 <= WS_END, "ws map");
static_assert((size_t)MROWS * NIN * 2 == 288 * MiB && (size_t)MROWS * DFF * 2 == 352 * MiB, "ws map 2");

constexpr int CW_BAR = 4096, CW_QUEUE = 8192;

constexpr int SC_STRIDE = 2052;
constexpr int SCH = 2056;
constexpr int G2_SC = 0;
constexpr int G2_MASK = 16 * SCH * 2, MASK_STRIDE = 66;
constexpr int G2_LSUM = G2_MASK + 16 * MASK_STRIDE * 4;
constexpr int G2_SSUM = G2_LSUM + 1024;
constexpr int G2_BYTES = G2_SSUM + 1024;
constexpr int LDS_MISC = 2 * G2_BYTES;
constexpr int LDS_BYTES = 147456;
static_assert(LDS_MISC + 64 <= LDS_BYTES && 4 * 64 * 64 * 4 <= G2_MASK && (G2_BYTES % 16) == 0 && LDS_MISC >= 131072 + 4096, "lds map");

#define LDS_WAIT() asm volatile("s_waitcnt lgkmcnt(0)" ::: "memory")
__device__ __forceinline__ unsigned cvtpk(float lo, float hi) { f32x2 v = {lo, hi}; bf16x2v b = __builtin_convertvector(v, bf16x2v); return __builtin_bit_cast(unsigned, b); }
__device__ __forceinline__ bf16x8 ldg16(const bf16_t* p) { return *(const GAS bf16x8*)p; }
#define RELU(x) __builtin_amdgcn_fmed3f((x), 0.f, __builtin_fabsf(x))
__device__ __forceinline__ float ex2(float x) { return __builtin_amdgcn_exp2f(x); }
__device__ __forceinline__ float lg2(float x) { return __builtin_amdgcn_logf(x); }
__device__ __forceinline__ int crow(int i, int h) { return (i & 3) + 8 * (i >> 2) + 4 * h; }
#define MFMA32(a, b, c) __builtin_amdgcn_mfma_f32_32x32x16_bf16((a), (b), (c), 0, 0, 0)
#define MFMA16(a, b, c) __builtin_amdgcn_mfma_f32_16x16x32_bf16((a), (b), (c), 0, 0, 0)
__device__ __forceinline__ bf16x8 pack8(const f32x16& x, int s) {
    u32x4 p; p.x = cvtpk(x[8 * s], x[8 * s + 1]); p.y = cvtpk(x[8 * s + 2], x[8 * s + 3]); p.z = cvtpk(x[8 * s + 4], x[8 * s + 5]); p.w = cvtpk(x[8 * s + 6], x[8 * s + 7]);
    return __builtin_bit_cast(bf16x8, p);
}
__device__ __forceinline__ f32x16 zero16() { f32x16 z; for (int i = 0; i < 16; ++i) z[i] = 0.f; return z; }
__device__ __forceinline__ int wsum_i(int v) {
    v += __builtin_amdgcn_update_dpp(0, v, 0x111, 0xf, 0xf, false);
    v += __builtin_amdgcn_update_dpp(0, v, 0x112, 0xf, 0xf, false);
    v += __builtin_amdgcn_update_dpp(0, v, 0x114, 0xf, 0xf, false);
    v += __builtin_amdgcn_update_dpp(0, v, 0x118, 0xf, 0xf, false);
    v += __builtin_amdgcn_update_dpp(0, v, 0x142, 0xa, 0xf, false);
    v += __builtin_amdgcn_update_dpp(0, v, 0x143, 0xc, 0xf, false);
    return __builtin_amdgcn_readlane(v, 63);
}
__device__ __forceinline__ void stagger(unsigned ticks) {
    const unsigned g = blockIdx.x & 3u;
    if (ticks && g) { const unsigned long long t0 = __builtin_amdgcn_s_memrealtime(); while (__builtin_amdgcn_s_memrealtime() - t0 < (unsigned long long)(g * ticks)) __builtin_amdgcn_s_sleep(8); }
}
__device__ __forceinline__ float wave_max(float v) {
#pragma unroll
    for (int o = 1; o < 64; o <<= 1) v = fmaxf(v, __shfl_xor(v, o));
    return v;
}
__device__ __forceinline__ float wave_sum(float v) {
#pragma unroll
    for (int o = 1; o < 64; o <<= 1) v += __shfl_xor(v, o);
    return v;
}

__device__ __forceinline__ int slot_col(int s) {
    if (s < 4) return 64 * s;
    if (s < 8) return 384 + 64 * (s - 4);
    if (s == 8) return 256;
    if (s == 9) return 320;
    if (s == 10) return 640;
    if (s == 11) return 704;
    if (s < 16) return 708 + 64 * (s - 12);
    if (s < 20) return 964 + 64 * (s - 16);
    if (s < 24) return 1220 + 64 * (s - 20);
    if (s < 32) return 1476 + 64 * (s - 24);
    if (s < 34) return 1988 + 64 * (s - 32);
    return 2116 + 64 * (s - 34);
}

namespace pg8 {
struct EpiInProj {
    static constexpr bool PERM = true, AFTER_DRAIN = false;
#ifndef KREP_I
#define KREP_I 1
#endif
#ifndef KREP_R
#define KREP_R 1
#endif
#ifndef KREP_S
#define KREP_S 1
#endif
#ifndef EREP_I
#define EREP_I 1
#endif
#ifndef EREP_R
#define EREP_R 1
#endif
#ifndef EREP_S
#define EREP_S 1
#endif
    static constexpr int KREP = KREP_I, EREP = EREP_I, TCLS = 20;
    static constexpr int NVM = 16;
    bf16_t* P; bf16_t* VT; float* WI; const float* cs; const float* sn; const float* qn_a; const float* kn_a; const float* qn_c; const float* kn_c;
    const float* SS; const float* bias;
    LAS float* xl;
    __device__ __forceinline__ void operator()(const f32x4 (&acc)[2][2][4][2], const Unit& u, int wr, int wc, int fr, int fq) const {
        const int slot = u.pn * 4 + wc;
        int mode = 0; const float* gain = nullptr; float osc = 1.f; int vslot = 0;
        if (slot < 4) { mode = 2; gain = qn_a; osc = C2; }
        else if (slot < 8) { mode = 1; }
        else if (slot == 8) { mode = 2; gain = kn_a; }
        else if (slot == 9) { mode = 3; vslot = 0; }
        else if (slot == 10) { mode = 1; }
        else if (slot == 11) { mode = 4; }
        else if (slot < 16) { mode = 0; osc = C2; }
        else if (slot < 20) { mode = 0; }
        else if (slot < 24) { mode = 3; vslot = 1 + (slot - 20); }
        else if (slot < 32) { mode = 2; gain = qn_c; osc = C2; }
        else if (slot < 34) { mode = 2; gain = kn_c; }
        else { mode = 3; vslot = 5 + (slot - 34); }
        const int rowt = u.pm * BM + wr * 64 + fr;
        const int b = rowt / SEQ; const int tt = rowt % SEQ;
        const int pfr = (fr & 3) | ((fr & 4) << 1) | ((fr & 8) >> 1);
        bf16_t* vb = VT + ((size_t)(b * NVS + vslot) * 64) * SEQ;
        float rsv[2][4];
        LAS float* wl = xl + (wr * 4 + wc) * 128;
        LAS float* wb = wl + 8 * fq; LAS float* wg = wl + 64 + 8 * fq;
        f32x4 rc[2], rsn[2];
        { f32x4 p4[2][4];
#pragma unroll
          for (int ai = 0; ai < 2; ++ai)
#pragma unroll
              for (int m = 0; m < 4; ++m) p4[ai][m] = *(const f32x4*)(SS + (size_t)(rowt + ai * HALF + m * 16) * 16 + 4 * fq);
          const int l64 = fr + 16 * fq;
          const float bval = bias[(size_t)((u.pm * BM) / SEQ) * NIN + slot_col(slot) + l64], gval = (mode == 2) ? gain[l64] : 1.f;
          if (mode == 1 || mode == 2) { const int t = rowt % SEQ;
#pragma unroll
              for (int n = 0; n < 2; ++n) { rc[n] = *(const f32x4*)(cs + t * 32 + 8 * fq + 4 * n); rsn[n] = *(const f32x4*)(sn + t * 32 + 8 * fq + 4 * n); } }
          wl[l64] = bval; wl[64 + l64] = gval;
#pragma unroll
          for (int ai = 0; ai < 2; ++ai)
#pragma unroll
              for (int m = 0; m < 4; ++m) { float sq = (p4[ai][m][0] + p4[ai][m][1]) + (p4[ai][m][2] + p4[ai][m][3]); sq += __shfl_xor(sq, 16); sq += __shfl_xor(sq, 32);
                  rsv[ai][m] = __builtin_amdgcn_rsqf(sq * (1.f / DM) + EPS); } }
        asm volatile("" ::: "memory");
#define ADJ_ROW(AI, M) const float rs = rsv[AI][M]; \
                f32x4 v1[2] = {acc[AI][0][M][0] * rs + *(LAS f32x4*)(wb), acc[AI][0][M][1] * rs + *(LAS f32x4*)(wb + 4)}, v2[2] = {acc[AI][1][M][0] * rs + *(LAS f32x4*)(wb + 32), acc[AI][1][M][1] * rs + *(LAS f32x4*)(wb + 36)}
#define STORE_ROW(ROW) do { u32x4 w1, w2; \
                w1.x = cvtpk(v1[0][0] * osc, v1[0][1] * osc); w1.y = cvtpk(v1[0][2] * osc, v1[0][3] * osc); w1.z = cvtpk(v1[1][0] * osc, v1[1][1] * osc); w1.w = cvtpk(v1[1][2] * osc, v1[1][3] * osc); \
                w2.x = cvtpk(v2[0][0] * osc, v2[0][1] * osc); w2.y = cvtpk(v2[0][2] * osc, v2[0][3] * osc); w2.z = cvtpk(v2[1][0] * osc, v2[1][1] * osc); w2.w = cvtpk(v2[1][2] * osc, v2[1][3] * osc); \
                bf16_t* op = P + (size_t)(ROW) * NIN + slot * 64 + 8 * fq; *(u32x4*)op = w1; *(u32x4*)(op + 32) = w2; } while (0)
        if (mode == 3) {
            LAS unsigned short* vt = (LAS unsigned short*)(xl + 1024) + (wr * 4 + wc) * 512;
            const int l64 = fr + 16 * fq;
            LAS unsigned short* vw = vt + 128 * fq + pfr;
            const LAS u32x4* vr = (const LAS u32x4*)(vt + 8 * l64);
            const unsigned gofs = (unsigned)((l64 >> 1) * SEQ + 8 * (l64 & 1));
            bf16_t* vgb = vb + (u.pm * BM + wr * 64) % SEQ;
#pragma unroll
            for (int ai = 0; ai < 2; ++ai)
#pragma unroll
                for (int m = 0; m < 4; ++m) { ADJ_ROW(ai, m);
#pragma unroll
                    for (int n = 0; n < 2; ++n)
#pragma unroll
                        for (int e = 0; e < 4; e += 2) { const unsigned w = cvtpk(v1[n][e], v1[n][e + 1]); vw[(4 * n + e) * 16] = (unsigned short)(w & 0xffffu); vw[(4 * n + e + 1) * 16] = (unsigned short)(w >> 16); }
                    const u32x4 r1 = *vr;
                    asm volatile("" ::: "memory");
#pragma unroll
                    for (int n = 0; n < 2; ++n)
#pragma unroll
                        for (int e = 0; e < 4; e += 2) { const unsigned w = cvtpk(v2[n][e], v2[n][e + 1]); vw[(4 * n + e) * 16] = (unsigned short)(w & 0xffffu); vw[(4 * n + e + 1) * 16] = (unsigned short)(w >> 16); }
                    const u32x4 r2 = *vr;
                    *(u32x4*)(vgb + (ai * HALF + m * 16) + gofs) = r1; *(u32x4*)(vgb + (32 * SEQ + ai * HALF + m * 16) + gofs) = r2;
                    asm volatile("" ::: "memory"); }
        } else if (mode == 4) {
#pragma unroll
            for (int ai = 0; ai < 2; ++ai)
#pragma unroll
                for (int m = 0; m < 4; ++m) { ADJ_ROW(ai, m); (void)v2; if (fq == 0) *(f32x4*)(WI + (size_t)(rowt + ai * HALF + m * 16) * 4) = v1[0]; asm volatile("" ::: "memory"); }
        } else if (mode == 0) {
#pragma unroll
            for (int ai = 0; ai < 2; ++ai)
#pragma unroll
                for (int m = 0; m < 4; ++m) { ADJ_ROW(ai, m); STORE_ROW(rowt + ai * HALF + m * 16); asm volatile("" ::: "memory"); }
        } else {
#pragma unroll
            for (int ai = 0; ai < 2; ++ai)
#pragma unroll
                for (int m = 0; m < 4; ++m) {
                    f32x4 nc[2], ns[2];
                    if ((ai * 4 + m) < 7) { const int k1 = ai * 4 + m + 1; const int t = (rowt + (k1 >> 2) * HALF + (k1 & 3) * 16) % SEQ;
#pragma unroll
                        for (int n = 0; n < 2; ++n) { nc[n] = *(const f32x4*)(cs + t * 32 + 8 * fq + 4 * n); ns[n] = *(const f32x4*)(sn + t * 32 + 8 * fq + 4 * n); } }
                    ADJ_ROW(ai, m);
                    if (mode == 2) {
                        float ss = 0.f;
#pragma unroll
                        for (int n = 0; n < 2; ++n)
#pragma unroll
                            for (int e = 0; e < 4; ++e) ss += v1[n][e] * v1[n][e] + v2[n][e] * v2[n][e];
                        ss += __shfl_xor(ss, 16); ss += __shfl_xor(ss, 32);
                        const float ri = __builtin_amdgcn_rsqf(ss * (1.f / 64.f) + EPS);
#pragma unroll
                        for (int n = 0; n < 2; ++n) { v1[n] = (v1[n] * ri) * *(LAS f32x4*)(wg + 4 * n); v2[n] = (v2[n] * ri) * *(LAS f32x4*)(wg + 32 + 4 * n); }
                    }
#pragma unroll
                    for (int n = 0; n < 2; ++n) { const f32x4 xa = v1[n], xb = v2[n]; v1[n] = xa * rc[n] - xb * rsn[n]; v2[n] = xb * rc[n] + xa * rsn[n]; }
                    STORE_ROW(rowt + ai * HALF + m * 16);
                    if ((ai * 4 + m) < 7) { rc[0] = nc[0]; rc[1] = nc[1]; rsn[0] = ns[0]; rsn[1] = ns[1]; }
                    asm volatile("" ::: "memory");
                }
        }
#undef ADJ_ROW
#undef STORE_ROW
    }
};
typedef _Float16 h16x8 __attribute__((ext_vector_type(8)));
typedef float f32x8 __attribute__((ext_vector_type(8)));
struct EpiResid {
    static constexpr bool PERM = true, AFTER_DRAIN = false;
    static constexpr int KREP = KREP_R, EREP = EREP_R, TCLS = 21;
    static constexpr int NVM = 36;
    const void* base; void* out; const float* gate;
    bf16_t* Hn; const float* lnn; const float* scn; float* SS; int do_next;
    int base_f32, out_f32;
    __device__ __forceinline__ void operator()(const f32x4 (&acc)[2][2][4][2], const Unit& u, int wr, int wc, int fr, int fq) const {
        const int row0 = u.pm * BM + wr * 64 + fr, col0 = u.pn * BM + wc * 32 + 8 * fq;
        const size_t bo = (size_t)((u.pm * BM) / SEQ) * 6144 + col0;
        f32x4 gv[2][2], vv[2][2];
#pragma unroll
        for (int bj = 0; bj < 2; ++bj)
#pragma unroll
            for (int n = 0; n < 2; ++n) { gv[bj][n] = *(const f32x4*)(gate + bo + bj * HALF + 4 * n);
                if (do_next) vv[bj][n] = *(const f32x4*)(lnn + col0 + bj * HALF + 4 * n) * (*(const f32x4*)(scn + bo + bj * HALF + 4 * n) + 1.f); }
#define RESID_ROW(AI, M, X0, X1, BJ) do { const int row_ = row0 + (AI) * HALF + (M) * 16; const size_t off_ = (size_t)row_ * DM + col0 + (BJ) * HALF; \
            if (out_f32) { *(f32x4*)((float*)out + off_) = X0; *(f32x4*)((float*)out + off_ + 4) = X1; } \
            else { f32x8 xx_; xx_[0] = X0[0]; xx_[1] = X0[1]; xx_[2] = X0[2]; xx_[3] = X0[3]; xx_[4] = X1[0]; xx_[5] = X1[1]; xx_[6] = X1[2]; xx_[7] = X1[3]; \
                   *(h16x8*)((_Float16*)out + off_) = __builtin_convertvector(xx_, h16x8); } \
            if (do_next) { ss += (X0[0] * X0[0] + X0[1] * X0[1]) + (X0[2] * X0[2] + X0[3] * X0[3]) + (X1[0] * X1[0] + X1[1] * X1[1]) + (X1[2] * X1[2] + X1[3] * X1[3]); \
                const f32x4 a0_ = X0 * vv[BJ][0], a1_ = X1 * vv[BJ][1]; \
                u32x4 w_; w_.x = cvtpk(a0_[0], a0_[1]); w_.y = cvtpk(a0_[2], a0_[3]); w_.z = cvtpk(a1_[0], a1_[1]); w_.w = cvtpk(a1_[2], a1_[3]); \
                *(u32x4*)(Hn + off_) = w_; } } while (0)
        if (base_f32) {
#pragma unroll
            for (int ai = 0; ai < 2; ++ai)
#pragma unroll
            for (int mh = 0; mh < 2; ++mh) {
                f32x4 bs[2][2][2];
#pragma unroll
                for (int mm = 0; mm < 2; ++mm) { const size_t off = (size_t)(row0 + ai * HALF + (2 * mh + mm) * 16) * DM + col0;
#pragma unroll
                    for (int bj = 0; bj < 2; ++bj) { bs[mm][bj][0] = *(const f32x4*)((const float*)base + off + bj * HALF); bs[mm][bj][1] = *(const f32x4*)((const float*)base + off + bj * HALF + 4); } }
#pragma unroll
                for (int mm = 0; mm < 2; ++mm) { const int m = 2 * mh + mm; float ss = 0.f;
#pragma unroll
                    for (int bj = 0; bj < 2; ++bj) { const f32x4 x0 = bs[mm][bj][0] + gv[bj][0] * acc[ai][bj][m][0], x1 = bs[mm][bj][1] + gv[bj][1] * acc[ai][bj][m][1]; RESID_ROW(ai, m, x0, x1, bj); }
                    if (do_next) { ss += __shfl_xor(ss, 16); ss += __shfl_xor(ss, 32); if (fq == 0) SS[(size_t)(row0 + ai * HALF + m * 16) * 16 + u.pn * 4 + wc] = ss; } }
                asm volatile("" ::: "memory");
            }
        } else {
#pragma unroll
            for (int ai = 0; ai < 2; ++ai) {
                h16x8 bh[4][2];
#pragma unroll
                for (int m = 0; m < 4; ++m) { const size_t off = (size_t)(row0 + ai * HALF + m * 16) * DM + col0;
#pragma unroll
                    for (int bj = 0; bj < 2; ++bj) bh[m][bj] = *(const h16x8*)((const _Float16*)base + off + bj * HALF); }
#pragma unroll
                for (int m = 0; m < 4; ++m) { float ss = 0.f;
#pragma unroll
                    for (int bj = 0; bj < 2; ++bj) { const f32x8 bf = __builtin_convertvector(bh[m][bj], f32x8);
                        const f32x4 x0 = (f32x4){bf[0], bf[1], bf[2], bf[3]} + gv[bj][0] * acc[ai][bj][m][0], x1 = (f32x4){bf[4], bf[5], bf[6], bf[7]} + gv[bj][1] * acc[ai][bj][m][1];
                        RESID_ROW(ai, m, x0, x1, bj); }
                    if (do_next) { ss += __shfl_xor(ss, 16); ss += __shfl_xor(ss, 32); if (fq == 0) SS[(size_t)(row0 + ai * HALF + m * 16) * 16 + u.pn * 4 + wc] = ss; } }
                asm volatile("" ::: "memory");
            }
        }
#undef RESID_ROW
    }
};
struct EpiSwiGLU {
    static constexpr bool PERM = true, AFTER_DRAIN = false;
    static constexpr int KREP = KREP_S, EREP = EREP_S, TCLS = 22;
    static constexpr int NVM = 20;
    bf16_t* ACT; const float* SS; const float* bg; const float* bu;
    __device__ __forceinline__ void operator()(const f32x4 (&acc)[2][2][4][2], const Unit& u, int wr, int wc, int fr, int fq) const {
        const int row0 = u.pm * BM + wr * 64 + fr, col0 = u.pn * HALF + wc * 32 + 8 * fq;
        const size_t bo = (size_t)((u.pm * BM) / SEQ) * DFF + col0;
        const f32x4 g0 = *(const f32x4*)(bg + bo), g1 = *(const f32x4*)(bg + bo + 4), u0 = *(const f32x4*)(bu + bo), u1 = *(const f32x4*)(bu + bo + 4);
        float rsv[2][4];
        { f32x4 p4[2][4];
#pragma unroll
          for (int ai = 0; ai < 2; ++ai)
#pragma unroll
              for (int m = 0; m < 4; ++m) p4[ai][m] = *(const f32x4*)(SS + (size_t)(row0 + ai * HALF + m * 16) * 16 + 4 * fq);
#pragma unroll
          for (int ai = 0; ai < 2; ++ai)
#pragma unroll
              for (int m = 0; m < 4; ++m) { float sq = (p4[ai][m][0] + p4[ai][m][1]) + (p4[ai][m][2] + p4[ai][m][3]); sq += __shfl_xor(sq, 16); sq += __shfl_xor(sq, 32);
                  rsv[ai][m] = __builtin_amdgcn_rsqf(sq * (1.f / DM) + EPS); } }
#pragma unroll
        for (int ai = 0; ai < 2; ++ai)
#pragma unroll
            for (int m = 0; m < 4; ++m) {
                const int row = row0 + ai * HALF + m * 16;
                const float rs = rsv[ai][m];
                const f32x4 ga[2] = {acc[ai][0][m][0] * rs + g0, acc[ai][0][m][1] * rs + g1}, ua[2] = {acc[ai][1][m][0] * rs + u0, acc[ai][1][m][1] * rs + u1};
                float r[8];
#pragma unroll
                for (int n = 0; n < 2; ++n)
#pragma unroll
                    for (int e = 0; e < 4; ++e) { const float g = ga[n][e]; r[4 * n + e] = g * __builtin_amdgcn_rcpf(1.f + ex2(-g * LOG2E)) * ua[n][e]; }
                u32x4 w; w.x = cvtpk(r[0], r[1]); w.y = cvtpk(r[2], r[3]); w.z = cvtpk(r[4], r[5]); w.w = cvtpk(r[6], r[7]);
                *(u32x4*)(ACT + (size_t)row * DFF + col0) = w;
            }
    }
};
}

#ifdef TPROBE
#define DTB(cls) do { if ((TPROBE >> (cls)) & 1) { if (threadIdx.x == 0) ((volatile LAS unsigned*)(lds + LDS_MISC))[13] = (unsigned)__builtin_amdgcn_s_memrealtime(); } } while (0)
#define DTE(cls) do { if ((TPROBE >> (cls)) & 1) { if (threadIdx.x == 0) { volatile LAS unsigned* m_ = (volatile LAS unsigned*)(lds + LDS_MISC); m_[12] = m_[12] + ((unsigned)__builtin_amdgcn_s_memrealtime() - m_[13]); } } } while (0)
#else
#define DTB(cls) do { } while (0)
#define DTE(cls) do { } while (0)
#endif
__device__ __forceinline__ void tr_item(const float* W, int ldw, int K, bf16_t* WT, int k0, int drow0, int sc, LAS float* scr, int lane) {
    float tv[32];
#pragma unroll
    for (int i = 0; i < 32; ++i) { const int kk = 2 * i + (lane >> 5); tv[i] = 0.f; if (sc >= 0) tv[i] = W[(size_t)(k0 + kk) * ldw + sc]; }
#pragma unroll
    for (int i = 0; i < 32; ++i) { const int kk = 2 * i + (lane >> 5); scr[kk * 33 + (lane & 31)] = tv[i]; }
    LDS_WAIT(); asm volatile("" ::: "memory");
    const int c = lane & 7;
#pragma unroll
    for (int j = 0; j < 4; ++j) { const int n = (lane >> 3) + 8 * j; const LAS float* s = scr + (8 * c) * 33 + n;
        u32x4 o; o.x = cvtpk(s[0 * 33], s[1 * 33]); o.y = cvtpk(s[2 * 33], s[3 * 33]); o.z = cvtpk(s[4 * 33], s[5 * 33]); o.w = cvtpk(s[6 * 33], s[7 * 33]);
        *(GAS u32x4*)(WT + (size_t)(drow0 + n) * K + k0 + 8 * c) = o; }
    LDS_WAIT(); asm volatile("" ::: "memory");
}

__device__ __forceinline__ void gemv32_ksplit(const float* wcol  , size_t ldw, const LAS float* cact  , LAS float* red  ,
                                              float* out  , size_t ldo, int nvalid  , float bias, int wave, int lane, int tid) {
    float acc[32];
#pragma unroll
    for (int i = 0; i < 32; ++i) acc[i] = 0.f;
    const float* w0 = wcol + (size_t)(128 * wave) * ldw;
    const LAS float* c0 = cact + (128 * wave) * 32;
    float wn[16];
#pragma unroll
    for (int j = 0; j < 16; ++j) wn[j] = w0[(size_t)j * ldw];
#pragma unroll 1
    for (int kk = 0; kk < 128; kk += 16) {
        float wv[16];
#pragma unroll
        for (int j = 0; j < 16; ++j) wv[j] = wn[j];
        if (kk + 16 < 128) {
#pragma unroll
            for (int j = 0; j < 16; ++j) wn[j] = w0[(size_t)(kk + 16 + j) * ldw];
        }
#pragma unroll
        for (int j = 0; j < 16; ++j) { const LAS f32x4* cp = (const LAS f32x4*)(c0 + (kk + j) * 32);
#pragma unroll
            for (int q = 0; q < 8; ++q) { const f32x4 c4 = cp[q]; acc[4 * q] += c4[0] * wv[j]; acc[4 * q + 1] += c4[1] * wv[j]; acc[4 * q + 2] += c4[2] * wv[j]; acc[4 * q + 3] += c4[3] * wv[j]; } }
    }
#pragma unroll
    for (int r = 0; r < 8; ++r) {
#pragma unroll
        for (int i = 0; i < 4; ++i) red[(wave * 4 + i) * 64 + lane] = acc[4 * r + i];
        __syncthreads();
        if (tid < 256) { const int bb = tid >> 6, cc = tid & 63; float sum = 0.f;
#pragma unroll
            for (int w = 0; w < 8; ++w) sum += red[(w * 4 + bb) * 64 + cc];
            if (cc < nvalid) out[(size_t)(4 * r + bb) * ldo + cc] = sum + bias; }
        __syncthreads();
    }
}

struct Args { const float* in[17]; float* out; unsigned char* ws; int lo, hi; };

__device__ __forceinline__ void prologue(const Args& a, LAS unsigned char* lds, int tid, int lane, int wave, int G) {
    unsigned char* ws = a.ws;
    const float* w_in = a.in[6]; const float* w_o = a.in[13]; const float* w_gate = a.in[14]; const float* w_up = a.in[15]; const float* w_down = a.in[16];
    LAS float* scr = (LAS float*)(lds + wave * 16384);
    const int gw = blockIdx.x * NWAVES + wave, NGW = G * NWAVES;
    constexpr int I_IN = 16 * 72, I_O = 16 * 32, I_GU = 16 * 176, I_D = 44 * 32, I_L = I_IN + I_O + I_GU + I_D;
    for (int it = gw; it < DEPTH * I_L; it += NGW) {
        const int l = it / I_L; int r = it % I_L;
        bf16_t* wl = (bf16_t*)(ws + WS_W + (size_t)l * W_LAYER);
        if (r < I_IN) {
            const int kb = r / 72, nb = r % 72, np = 32 * nb + (lane & 31), p = np & 255;
            const int slot = (np >> 8) * 4 + ((p & 127) >> 5), dim = 32 * (p >> 7) + (p & 31);
            int sc = slot_col(slot) + dim; if (slot == 11 && dim >= 4) sc = -1;
            tr_item(w_in + (size_t)l * DM * INCOLS, INCOLS, DM, wl + W_IN / 2, 64 * kb, 32 * nb, sc, scr, lane); continue; }
        r -= I_IN;
        if (r < I_O) { const int kb = r / 32, nb = r % 32;
            tr_item(w_o + (size_t)l * DM * DM, DM, DM, wl + W_O / 2, 64 * kb, 32 * nb, 32 * nb + (lane & 31), scr, lane); continue; }
        r -= I_O;
        if (r < I_GU) { const int kb = r / 176, nb = r % 176, d0 = 32 * nb, p0 = d0 & 255;
            const float* src = (p0 < 128 ? w_gate : w_up) + (size_t)l * DM * DFF;
            tr_item(src, DFF, DM, wl + W_GU / 2, 64 * kb, d0, (d0 >> 8) * 128 + (p0 & 127) + (lane & 31), scr, lane); continue; }
        r -= I_GU;
        { const int kb = r / 32, nb = r % 32;
            tr_item(w_down + (size_t)l * DFF * DM, DM, DFF, wl + W_D / 2, 64 * kb, 32 * nb, 32 * nb + (lane & 31), scr, lane); }
    }
    {
        float* cs = (float*)(ws + WS_ROPE); float* sn = cs + SEQ * 32;
        for (int idx = blockIdx.x * 512 + tid; idx < SEQ * 32; idx += G * 512) {
            const int t = idx >> 5, i = idx & 31;
            double inv = 1.0; for (int k = 0; k < i; ++k) inv *= 0.7498942093324559;
            const float ang = (float)t * (float)inv;
            double rv = (double)ang * 0.15915494309189535; rv -= __builtin_floor(rv);
            const float fr = (float)rv;
            cs[idx] = __builtin_amdgcn_cosf(fr); sn[idx] = __builtin_amdgcn_sinf(fr);
        }
    }
    __syncthreads();
    {
        const float* c = a.in[1]; const float* w_mod = a.in[4]; const float* b_mod = a.in[5];
        float* mod = (float*)(ws + WS_MOD);
        LAS float* cact = (LAS float*)lds;
        DTB(17);
        for (int idx = tid; idx < BATCH * DM; idx += 512) { const int b = idx >> 10, k = idx & 1023; const float v = c[idx]; cact[k * 32 + b] = v * __builtin_amdgcn_rcpf(1.f + ex2(-v * LOG2E)); }
        __syncthreads();
        for (int unit = blockIdx.x; unit < DEPTH * 6144 / 64; unit += G) {
            const int col = unit * 64 + lane, l = col / 6144, j = col % 6144;
            gemv32_ksplit(w_mod + (size_t)l * DM * 6144 + j, 6144, cact, (LAS float*)(lds + 131072), mod + (size_t)l * BATCH * 6144 + (j - lane), 6144, 64, b_mod[l * 6144 + j], wave, lane, tid);
        }
        DTE(17);
    }
    __syncthreads();
}

__device__ __forceinline__ void prologue_b(const Args& a, LAS unsigned char* lds, int tid, int lane, int wave, int G) {
    unsigned char* ws = a.ws;
    const float* mod = (const float*)(ws + WS_MOD);
    LAS float* cact = (LAS float*)lds;
    constexpr int U_IN = (INCOLS + 63) / 64, U_FF = DFF / 64, U_L = U_IN + 2 * U_FF;
    for (int un = blockIdx.x; un < DEPTH * U_L; un += G) {
        const int l = un / U_L; int r = un % U_L; int type = 0; if (r >= U_IN) { r -= U_IN; type = 1; if (r >= U_FF) { r -= U_FF; type = 2; } }
        const float* shp = mod + (size_t)l * BATCH * 6144 + (type == 0 ? 0 : 3 * DM);
        for (int idx = tid; idx < BATCH * DM; idx += 512) { const int b = idx >> 10, k = idx & 1023; cact[k * 32 + b] = shp[(size_t)b * 6144 + k]; }
        __syncthreads();
        const int ncols = type == 0 ? INCOLS : DFF;
        const float* W = type == 0 ? a.in[6] + (size_t)l * DM * INCOLS : (type == 1 ? a.in[14] : a.in[15]) + (size_t)l * DM * DFF;
        const int col = r * 64 + lane, cc = col < ncols ? col : ncols - 1;
        const int ldb = type == 0 ? NIN : DFF;
        float* bo = (float*)(ws + (type == 0 ? WS_B1 : (type == 1 ? WS_BG : WS_BU))) + (size_t)l * BATCH * ldb + r * 64;
        gemv32_ksplit(W + cc, (size_t)ncols, cact, (LAS float*)(lds + 131072), bo, (size_t)ldb, ncols - r * 64 < 64 ? ncols - r * 64 : 64, 0.f, wave, lane, tid);
        __syncthreads();
    }
}

__device__ __forceinline__ float wsum_f(float v) {
#define DPP_ADD(CTRL, RM) v += __uint_as_float((unsigned)__builtin_amdgcn_update_dpp(0, (int)__float_as_uint(v), CTRL, RM, 0xf, false))
    DPP_ADD(0x111, 0xf); DPP_ADD(0x112, 0xf); DPP_ADD(0x114, 0xf); DPP_ADD(0x118, 0xf); DPP_ADD(0x142, 0xa); DPP_ADD(0x143, 0xc);
#undef DPP_ADD
    return __uint_as_float((unsigned)__builtin_amdgcn_readlane((int)__float_as_uint(v), 63));
}
__device__ __forceinline__ void pre_phase(const float* x, const float* ln, const float* modl  , bf16_t* H, float* SS, int lane, int gw, int NGW) {
    for (int m0 = 4 * gw; m0 < MROWS; m0 += 4 * NGW) {
        f32x4 v[4][4]; float s[4];
#pragma unroll
        for (int rr = 0; rr < 4; ++rr) { const GAS f32x4* xr = (const GAS f32x4*)(x + (size_t)(m0 + rr) * DM) + lane;
#pragma unroll
            for (int j = 0; j < 4; ++j) v[rr][j] = xr[64 * j]; }
#pragma unroll
        for (int rr = 0; rr < 4; ++rr) { float a = 0.f;
#pragma unroll
            for (int j = 0; j < 4; ++j) a += (v[rr][j].x * v[rr][j].x + v[rr][j].y * v[rr][j].y) + (v[rr][j].z * v[rr][j].z + v[rr][j].w * v[rr][j].w);
            s[rr] = wsum_f(a); }
        const int b = m0 / SEQ;
        const float* mb = modl + (size_t)b * 6144;
        f32x4 gv[4];
#pragma unroll
        for (int j = 0; j < 4; ++j) gv[j] = *((const GAS f32x4*)ln + lane + 64 * j) * (*((const GAS f32x4*)(mb + DM) + lane + 64 * j) + 1.f);
#pragma unroll
        for (int rr = 0; rr < 4; ++rr) {
            if (lane < 16) SS[(size_t)(m0 + rr) * 16 + lane] = (lane == 0) ? s[rr] : 0.f;
            GAS u32x2* o8 = (GAS u32x2*)(H + (size_t)(m0 + rr) * DM) + lane;
#pragma unroll
            for (int j = 0; j < 4; ++j) { const f32x4 y = v[rr][j] * gv[j]; u32x2 w; w.x = cvtpk(y.x, y.y); w.y = cvtpk(y.z, y.w); o8[64 * j] = w; }
        }
    }
}

__device__ __forceinline__ void store_head(const f32x16& o0, const f32x16& o1, float inv, const float* gout, bf16_t* orow, int h) {
    float ss = 0.f;
#pragma unroll
    for (int i = 0; i < 16; ++i) { const float a = o0[i] * inv, b = o1[i] * inv; ss += a * a + b * b; }
    ss += __shfl_xor(ss, 32);
    const float rn = __builtin_amdgcn_rsqf(ss * (1.f / 64.f) + EPS) * inv;
#pragma unroll
    for (int g = 0; g < 4; ++g) {
        const int d0 = 8 * g + 4 * h;
        const f32x4 ga = *(const f32x4*)(gout + d0), gb = *(const f32x4*)(gout + 32 + d0);
        u32x2 wa, wb;
        wa.x = cvtpk(o0[4 * g] * rn * ga[0], o0[4 * g + 1] * rn * ga[1]); wa.y = cvtpk(o0[4 * g + 2] * rn * ga[2], o0[4 * g + 3] * rn * ga[3]);
        wb.x = cvtpk(o1[4 * g] * rn * gb[0], o1[4 * g + 1] * rn * gb[1]); wb.y = cvtpk(o1[4 * g + 2] * rn * gb[2], o1[4 * g + 3] * rn * gb[3]);
        *(GAS u32x2*)(orow + d0) = wa; *(GAS u32x2*)(orow + 32 + d0) = wb;
    }
}

__device__ __forceinline__ void swa_unit(int b, int hc, int qt, const bf16_t* P, const bf16_t* VT, bf16_t* O, float M2, float sink2, const float* gout, int lane) {
    const int r = lane & 31, h = lane >> 5, t0 = qt * 32, kv = hc >> 2;
    const size_t rowbase = (size_t)b * SEQ;
    bf16x8 qf[4];
    { const bf16_t* qp = P + (rowbase + t0 + r) * NIN + (24 + hc) * 64 + 8 * h;
#pragma unroll
      for (int ks = 0; ks < 4; ++ks) qf[ks] = ldg16(qp + 16 * ks); }
    const bf16_t* kbase = P + rowbase * NIN + (32 + kv) * 64 + 8 * h + (size_t)r * NIN;
    const bf16_t* vbase = VT + ((size_t)(b * NVS + 5 + kv) * 64 + r) * SEQ + 8 * h;
    f32x16 o0 = zero16(), o1 = zero16(); float lsum = 0.f;
    const int t = t0 + r;
    const int kt_lo = qt - 4 < 0 ? 0 : qt - 4;
    bf16x8 kf[4];
#pragma unroll
    for (int ks = 0; ks < 4; ++ks) kf[ks] = ldg16(kbase + (size_t)(kt_lo * 32) * NIN + 16 * ks);
    for (int kt = kt_lo; kt <= qt; ++kt) {
        bf16x8 kn[4], vf[2][2];
#pragma unroll
        for (int dt = 0; dt < 2; ++dt)
#pragma unroll
            for (int s = 0; s < 2; ++s) vf[dt][s] = ldg16(vbase + (size_t)(dt * 32) * SEQ + kt * 32 + 16 * s);
        { const bf16_t* kp = kbase + (size_t)((kt < qt ? kt + 1 : kt) * 32) * NIN;
#pragma unroll
          for (int ks = 0; ks < 4; ++ks) kn[ks] = ldg16(kp + 16 * ks); }
        f32x16 sc = zero16();
#pragma unroll
        for (int ks = 0; ks < 4; ++ks) sc = MFMA32(kf[ks], qf[ks], sc);
#pragma unroll
        for (int i = 0; i < 16; ++i) { const int key = kt * 32 + crow(i, h); const bool valid = (unsigned)(t - key) < 128u;
            const float p = valid ? ex2(sc[i] - M2) : 0.f; sc[i] = p; lsum += p; }
        const bf16x8 p0 = pack8(sc, 0), p1 = pack8(sc, 1);
        o0 = MFMA32(vf[0][0], p0, o0); o0 = MFMA32(vf[0][1], p1, o0);
        o1 = MFMA32(vf[1][0], p0, o1); o1 = MFMA32(vf[1][1], p1, o1);
#pragma unroll
        for (int ks = 0; ks < 4; ++ks) kf[ks] = kn[ks];
    }
    lsum += __shfl_xor(lsum, 32); lsum += ex2(sink2 - M2);
    store_head(o0, o1, 1.f / lsum, gout, O + (rowbase + t0 + r) * DM + (8 + hc) * 64, h);
}

__device__ __forceinline__ void sb_unit(int b, int hb, int qt, const bf16_t* P, const bf16_t* VT, bf16_t* O, const float* gout, int lane) {
    const int r = lane & 31, h = lane >> 5, t0 = qt * 32;
    const size_t rowbase = (size_t)b * SEQ;
    bf16x8 qf[4];
    { const bf16_t* qp = P + (rowbase + t0 + r) * NIN + (12 + hb) * 64 + 8 * h;
#pragma unroll
      for (int ks = 0; ks < 4; ++ks) qf[ks] = ldg16(qp + 16 * ks); }
    const bf16_t* kbase = P + rowbase * NIN + (16 + hb) * 64 + 8 * h + (size_t)r * NIN;
    const bf16_t* vbase = VT + ((size_t)(b * NVS + 1 + hb) * 64 + r) * SEQ + 8 * h;
    f32x16 o0 = zero16(), o1 = zero16(); float C = 0.f;
    const int t = t0 + r;
    bf16x8 kf[4];
#pragma unroll
    for (int ks = 0; ks < 4; ++ks) kf[ks] = ldg16(kbase + (size_t)(qt * 32) * NIN + 16 * ks);
    for (int kt = qt; kt >= 0; --kt) {
        bf16x8 kn[4], vf[2][2];
#pragma unroll
        for (int dt = 0; dt < 2; ++dt)
#pragma unroll
            for (int s = 0; s < 2; ++s) vf[dt][s] = ldg16(vbase + (size_t)(dt * 32) * SEQ + kt * 32 + 16 * s);
        { const bf16_t* kp = kbase + (size_t)((kt > 0 ? kt - 1 : 0) * 32) * NIN;
#pragma unroll
          for (int ks = 0; ks < 4; ++ks) kn[ks] = ldg16(kp + 16 * ks); }
        f32x16 z = zero16();
#pragma unroll
        for (int ks = 0; ks < 4; ++ks) z = MFMA32(kf[ks], qf[ks], z);
        float L[16];
#pragma unroll
        for (int i = 0; i < 16; ++i) { const int key = kt * 32 + crow(i, h); const float zz = z[i];
            const float sp = RELU(zz) + lg2(1.f + ex2(-fabsf(zz)));
            L[i] = (key < t) ? -sp : 0.f; }
        float G4[4], Gp[4], ps[4], aft[4];
#pragma unroll
        for (int g = 0; g < 4; ++g) { G4[g] = (L[4 * g] + L[4 * g + 1]) + (L[4 * g + 2] + L[4 * g + 3]); Gp[g] = __shfl_xor(G4[g], 32); ps[g] = G4[g] + Gp[g]; }
        aft[3] = 0.f; aft[2] = ps[3]; aft[1] = aft[2] + ps[2]; aft[0] = aft[1] + ps[1];
#pragma unroll
        for (int g = 0; g < 4; ++g) {
            const float bg = C + aft[g] + (h == 0 ? Gp[g] : 0.f);
            const float b3 = bg, b2 = b3 + L[4 * g + 3], b1 = b2 + L[4 * g + 2], b0 = b1 + L[4 * g + 1];
            const float bt[4] = {b0, b1, b2, b3};
#pragma unroll
            for (int e = 0; e < 4; ++e) { const int i = 4 * g + e; const int key = kt * 32 + crow(i, h);
                z[i] = (key < t) ? ex2(z[i] + L[i] + bt[e]) : 0.f; }
        }
        C += aft[0] + ps[0];
        const bf16x8 p0 = pack8(z, 0), p1 = pack8(z, 1);
        o0 = MFMA32(vf[0][0], p0, o0); o0 = MFMA32(vf[0][1], p1, o0);
        o1 = MFMA32(vf[1][0], p0, o1); o1 = MFMA32(vf[1][1], p1, o1);
        if (__all(C < -160.f)) break;
#pragma unroll
        for (int ks = 0; ks < 4; ++ks) kf[ks] = kn[ks];
    }
    store_head(o0, o1, 1.f, gout, O + (rowbase + t0 + r) * DM + (4 + hb) * 64, h);
}

template <int NROWS, int VCH>
__device__ __forceinline__ void stage_kv(LAS unsigned char* ldsK, LAS unsigned char* ldsV, const bf16_t* kg  , const bf16_t* vg  , int tk0  , int tid) {
    constexpr int KCH = NROWS * 8 / 512, NTC = NROWS / 8, VCHT = 64 * NTC / 512;
    const int first_row = tk0 < 0 ? -tk0 : 0;
    const unsigned char* kb = (const unsigned char*)(kg + (size_t)(tk0 + first_row) * NIN);
    const unsigned char* vb = (const unsigned char*)(vg + (tk0 + first_row));
    u32x4 kr[KCH], vr[VCHT];
#pragma unroll
    for (int i = 0; i < KCH; ++i) { const int q = tid + 512 * i, row = q >> 3, c = q & 7; kr[i] = (u32x4){0u, 0u, 0u, 0u};
        if (row >= first_row) kr[i] = *(const GAS u32x4*)(kb + (unsigned)((row - first_row) * (NIN * 2) + 16 * c)); }
#pragma unroll
    for (int i = 0; i < VCHT; ++i) { const int q = tid + 512 * i, d = q / NTC, c = q % NTC; vr[i] = (u32x4){0u, 0u, 0u, 0u};
        if (8 * c >= first_row) vr[i] = *(const GAS u32x4*)(vb + (unsigned)(d * (SEQ * 2) + (8 * c - first_row) * 2)); }
#pragma unroll
    for (int i = 0; i < KCH; ++i) { const int q = tid + 512 * i, row = q >> 3, c = q & 7; *(LAS u32x4*)(ldsK + row * 128 + ((c ^ ((row >> 1) & 7)) << 4)) = kr[i]; }
#pragma unroll
    for (int i = 0; i < VCHT; ++i) { const int q = tid + 512 * i, d = q / NTC, c = q % NTC; *(LAS u32x4*)(ldsV + d * (VCH * 16) + ((c ^ (d & 15)) << 4)) = vr[i]; }
    asm volatile("" ::: "memory");
}
__device__ __forceinline__ bf16x8 lds_kfrag(LAS unsigned char* ldsK, int row, int ch) { return *(const LAS bf16x8*)(ldsK + row * 128 + ((ch ^ ((row >> 1) & 7)) << 4)); }
template <int VCH> __device__ __forceinline__ bf16x8 lds_vfrag(LAS unsigned char* ldsV, int d, int ch) { return *(const LAS bf16x8*)(ldsV + d * (VCH * 16) + ((ch ^ (d & 15)) << 4)); }

__device__ __forceinline__ void swa_block(int b, int kv, int qb, const bf16_t* P, const bf16_t* VT, bf16_t* O, float M2, const float* sinks  , const float* gout  ,
                                          LAS unsigned char* lds, int tid, int lane, int wave) {
    LAS unsigned char* ldsK = lds; LAS unsigned char* ldsV = lds + 32768;
    DTB(16);
    const int t0 = qb * 128, tk0 = t0 - 128;
    const size_t rowbase = (size_t)b * SEQ;
    const int r = lane & 31, h = lane >> 5, j = wave & 3, hc0 = kv * 4 + 2 * (wave >> 2), t0q = t0 + 32 * j;
    bf16x8 qf[2][4];
#pragma unroll
    for (int hd = 0; hd < 2; ++hd) { const bf16_t* qp = P + (rowbase + t0q + r) * NIN + (24 + hc0 + hd) * 64 + 8 * h;
#pragma unroll
        for (int ks = 0; ks < 4; ++ks) qf[hd][ks] = ldg16(qp + 16 * ks); }
    stage_kv<256, 32>(ldsK, ldsV, P + rowbase * NIN + (32 + kv) * 64, VT + ((size_t)(b * NVS + 5 + kv) * 64) * SEQ, tk0, tid);
    __syncthreads();
    f32x16 o[2][2]; o[0][0] = zero16(); o[0][1] = zero16(); o[1][0] = zero16(); o[1][1] = zero16();
    float ls[2] = {0.f, 0.f};
    const int t = t0q + r;
    for (int i = (tk0 < 0 && j < 4) ? (4 > j ? 4 : j) : j; i <= j + 4; ++i) {
        bf16x8 kf[4], vf[2][2];
#pragma unroll
        for (int ks = 0; ks < 4; ++ks) kf[ks] = lds_kfrag(ldsK, 32 * i + r, 2 * ks + h);
#pragma unroll
        for (int dt = 0; dt < 2; ++dt)
#pragma unroll
            for (int s2 = 0; s2 < 2; ++s2) vf[dt][s2] = lds_vfrag<32>(ldsV, 32 * dt + r, 4 * i + 2 * s2 + h);
#pragma unroll
        for (int hd = 0; hd < 2; ++hd) {
            f32x16 sc;
#pragma unroll
            for (int e = 0; e < 16; ++e) sc[e] = -M2;
#pragma unroll
            for (int ks = 0; ks < 4; ++ks) sc = MFMA32(kf[ks], qf[hd][ks], sc);
            if (i == j || i == j + 4) {
#pragma unroll
                for (int e = 0; e < 16; ++e) { const int key = tk0 + 32 * i + crow(e, h); const bool valid = (unsigned)(t - key) < 128u;
                    const float p = valid ? ex2(sc[e]) : 0.f; sc[e] = p; ls[hd] += p; }
            } else {
#pragma unroll
                for (int e = 0; e < 16; ++e) { const float p = ex2(sc[e]); sc[e] = p; ls[hd] += p; }
            }
            const bf16x8 p0 = pack8(sc, 0), p1 = pack8(sc, 1);
            o[hd][0] = MFMA32(vf[0][0], p0, o[hd][0]); o[hd][0] = MFMA32(vf[0][1], p1, o[hd][0]);
            o[hd][1] = MFMA32(vf[1][0], p0, o[hd][1]); o[hd][1] = MFMA32(vf[1][1], p1, o[hd][1]);
        }
    }
#pragma unroll
    for (int hd = 0; hd < 2; ++hd) {
        float l2 = ls[hd]; l2 += __shfl_xor(l2, 32); l2 += ex2(sinks[hc0 + hd] * LOG2E - M2);
        store_head(o[hd][0], o[hd][1], 1.f / l2, gout + (8 + hc0 + hd) * 64, O + (rowbase + t0q + r) * DM + (8 + hc0 + hd) * 64, h);
    }
    __syncthreads();
    DTE(16);
}

__device__ __forceinline__ void sb_block(int b, int hb, int qb, const bf16_t* P, const bf16_t* VT, bf16_t* O, const float* gout  , LAS unsigned char* lds, int tid, int lane, int wave) {
    LAS unsigned char* ldsK = lds; LAS unsigned char* ldsV = lds + 57344;
    const int t0 = qb * 256, tk0 = t0 - 192;
    const size_t rowbase = (size_t)b * SEQ;
    const int r = lane & 31, h = lane >> 5, t0q = t0 + 32 * wave;
    bf16x8 qf[4];
    { const bf16_t* qp = P + (rowbase + t0q + r) * NIN + (12 + hb) * 64 + 8 * h;
#pragma unroll
      for (int ks = 0; ks < 4; ++ks) qf[ks] = ldg16(qp + 16 * ks); }
    const bf16_t* kg = P + rowbase * NIN + (16 + hb) * 64;
    const bf16_t* vg = VT + ((size_t)(b * NVS + 1 + hb) * 64) * SEQ;
    stage_kv<448, 64>(ldsK, ldsV, kg, vg, tk0, tid);
    __syncthreads();
    f32x16 o0 = zero16(), o1 = zero16(); float C = 0.f;
    const int t = t0q + r;
#pragma unroll 1
    for (int kt = t0q >> 5; kt >= 0; --kt) {
        bf16x8 kf[4], vf[2][2];
        const int i = kt - (tk0 >> 5);
        if (i >= 0) {
#pragma unroll
            for (int ks = 0; ks < 4; ++ks) kf[ks] = lds_kfrag(ldsK, 32 * i + r, 2 * ks + h);
#pragma unroll
            for (int dt = 0; dt < 2; ++dt)
#pragma unroll
                for (int s2 = 0; s2 < 2; ++s2) vf[dt][s2] = lds_vfrag<64>(ldsV, 32 * dt + r, 4 * i + 2 * s2 + h);
        } else {
            const bf16_t* kp = kg + (size_t)(kt * 32 + r) * NIN + 8 * h;
#pragma unroll
            for (int ks = 0; ks < 4; ++ks) kf[ks] = ldg16(kp + 16 * ks);
#pragma unroll
            for (int dt = 0; dt < 2; ++dt)
#pragma unroll
                for (int s2 = 0; s2 < 2; ++s2) vf[dt][s2] = ldg16(vg + (size_t)(dt * 32 + r) * SEQ + kt * 32 + 16 * s2 + 8 * h);
        }
        f32x16 z = zero16();
#pragma unroll
        for (int ks = 0; ks < 4; ++ks) z = MFMA32(kf[ks], qf[ks], z);
        float L[16];
        const bool diag = (kt == (t0q >> 5));
#pragma unroll
        for (int e = 0; e < 16; ++e) { const float zz = z[e];
            L[e] = -(RELU(zz) + lg2(1.f + ex2(-fabsf(zz)))); }
        if (diag) {
#pragma unroll
            for (int e = 0; e < 16; ++e) { const int key = kt * 32 + crow(e, h); L[e] = (key < t) ? L[e] : 0.f; }
        }
        float G4[4], Gp[4], ps[4], aft[4];
#pragma unroll
        for (int g = 0; g < 4; ++g) { G4[g] = (L[4 * g] + L[4 * g + 1]) + (L[4 * g + 2] + L[4 * g + 3]); Gp[g] = __shfl_xor(G4[g], 32); ps[g] = G4[g] + Gp[g]; }
        aft[3] = 0.f; aft[2] = ps[3]; aft[1] = aft[2] + ps[2]; aft[0] = aft[1] + ps[1];
#pragma unroll
        for (int g = 0; g < 4; ++g) {
            const float bg = C + aft[g] + (h == 0 ? Gp[g] : 0.f);
            const float b3 = bg, b2 = b3 + L[4 * g + 3], b1 = b2 + L[4 * g + 2], b0 = b1 + L[4 * g + 1];
            const float bt[4] = {b0, b1, b2, b3};
#pragma unroll
            for (int e = 0; e < 4; ++e) { const int ii = 4 * g + e; z[ii] = ex2(z[ii] + L[ii] + bt[e]); }
        }
        C += aft[0] + ps[0];
        if (diag) {
#pragma unroll
            for (int e = 0; e < 16; ++e) { const int key = kt * 32 + crow(e, h); z[e] = (key < t) ? z[e] : 0.f; }
        }
        const bf16x8 p0 = pack8(z, 0), p1 = pack8(z, 1);
        o0 = MFMA32(vf[0][0], p0, o0); o0 = MFMA32(vf[0][1], p1, o0);
        o1 = MFMA32(vf[1][0], p0, o1); o1 = MFMA32(vf[1][1], p1, o1);
        if (__all(C < -160.f)) break;
    }
    store_head(o0, o1, 1.f, gout + (4 + hb) * 64, O + (rowbase + t0q + r) * DM + (4 + hb) * 64, h);
    __syncthreads();
}

__device__ __forceinline__ void group_sync(volatile LAS unsigned* cnt, unsigned& target, int lane) {
    asm volatile("s_waitcnt lgkmcnt(0)" ::: "memory");
    target += 4u;
    if (lane == 0) __hip_atomic_fetch_add((LAS unsigned*)cnt, 1u, __ATOMIC_RELAXED, __HIP_MEMORY_SCOPE_WORKGROUP);
    while (*cnt - (target - 4u) < 4u) __builtin_amdgcn_s_sleep(1);
    asm volatile("" ::: "memory");
}
__device__ __forceinline__ void dsa_phase(const bf16_t* P, const bf16_t* VT, const float* WI, bf16_t* O, const float* gout  , float M2, unsigned* queue,
                                          LAS unsigned char* lds, int tid, int lane, int wave) {
    const int grp = wave >> 2, gwv = wave & 3;
    LAS unsigned char* gl = lds + grp * G2_BYTES;
    LAS _Float16* SC = (LAS _Float16*)(gl + G2_SC);
    LAS float* PART = (LAS float*)(gl + G2_SC);
    LAS unsigned* MASK = (LAS unsigned*)(gl + G2_MASK);
    LAS float* LSUM = (LAS float*)(gl + G2_LSUM);
    LAS float* SSUM = (LAS float*)(gl + G2_SSUM);
    volatile LAS unsigned* QW = (volatile LAS unsigned*)(lds + LDS_MISC) + 2 * grp;
    volatile LAS unsigned* GC = (volatile LAS unsigned*)(lds + LDS_MISC) + 8 + grp;
    unsigned gtarget = *GC;
    __syncthreads();
#define GSYNC() group_sync(GC, gtarget, lane)
    constexpr int NU = BATCH * 128, NUX = NU / 8;
    const unsigned xq = xb_xcc_id() & 7u;
#define FETCH_UNIT(DST) do { unsigned got_ = (unsigned)NU; \
        for (unsigned k_ = 0; k_ < 8u; ++k_) { const unsigned x_ = (xq + k_) & 7u; \
            if (__hip_atomic_load(queue + 16 * x_, __ATOMIC_RELAXED, __HIP_MEMORY_SCOPE_AGENT) >= (unsigned)NUX) continue; \
            const unsigned i_ = __hip_atomic_fetch_add(queue + 16 * x_, 1u, __ATOMIC_RELAXED, __HIP_MEMORY_SCOPE_AGENT); \
            if (i_ < (unsigned)NUX) { got_ = x_ * NUX + i_; break; } } \
        DST = got_; } while (0)
#define FETCH_EARLY() __hip_atomic_fetch_add(queue + 16 * xq, 1u, __ATOMIC_RELAXED, __HIP_MEMORY_SCOPE_AGENT)
#define FETCH_LATE(DST, I0) do { unsigned got_ = (unsigned)NU; \
        if ((I0) < (unsigned)NUX) got_ = xq * NUX + (I0); \
        else for (unsigned k_ = 1; k_ < 8u; ++k_) { const unsigned x_ = (xq + k_) & 7u; \
            if (__hip_atomic_load(queue + 16 * x_, __ATOMIC_RELAXED, __HIP_MEMORY_SCOPE_AGENT) >= (unsigned)NUX) continue; \
            const unsigned i_ = __hip_atomic_fetch_add(queue + 16 * x_, 1u, __ATOMIC_RELAXED, __HIP_MEMORY_SCOPE_AGENT); \
            if (i_ < (unsigned)NUX) { got_ = x_ * NUX + i_; break; } } \
        DST = got_; } while (0)
#define UNIT_B(Q) (4 * ((Q) / NUX) + (((Q) % NUX) & 3))
#define UNIT_TAU(Q) (127 - (((Q) % NUX) >> 2))
    if (gwv == 0 && lane == 0) FETCH_UNIT(QW[0]);
    GSYNC();
    int q = (int)QW[0], par = 0;
    bf16x8 qi[4][2]; f32x4 wq;
    { const int c = lane & 15, g = lane >> 4; const int qq = q < NU ? q : 0; const size_t row = (size_t)UNIT_B(qq) * SEQ + 16 * UNIT_TAU(qq) + c;
      const bf16_t* qp = P + row * NIN + 4 * 64 + 8 * g;
#pragma unroll
      for (int hh = 0; hh < 4; ++hh) { qi[hh][0] = ldg16(qp + hh * 64); qi[hh][1] = ldg16(qp + hh * 64 + 32); }
      wq = *(const GAS f32x4*)(WI + row * 4); }
    while (q < NU) {
        const int tau = UNIT_TAU(q), b = UNIT_B(q), t0 = 16 * tau;
        const size_t rowbase = (size_t)b * SEQ;
        DTB(12);
        unsigned fu0 = 0u;
        if (gwv == 0 && lane == 0) fu0 = FETCH_EARLY();
        {
            int lane1 = lane; asm volatile("" : "+v"(lane1));
            const int c = lane1 & 15, g = lane1 >> 4;
            const bf16_t* kp0 = P + (rowbase + c) * NIN + 10 * 64 + 8 * g;
#define IDX_TILE(KT, K0, K1) do { f32x4 sc_ = {0.f, 0.f, 0.f, 0.f}, a_[4]; \
                _Pragma("unroll") for (int hh = 0; hh < 4; ++hh) a_[hh] = MFMA16(K0, qi[hh][0], ((f32x4){0.f, 0.f, 0.f, 0.f}));        \
                _Pragma("unroll") for (int hh = 0; hh < 4; ++hh) a_[hh] = MFMA16(K1, qi[hh][1], a_[hh]); \
                asm volatile("" : "+v"(a_[0]), "+v"(a_[1]), "+v"(a_[2]), "+v"(a_[3])); \
                _Pragma("unroll") for (int hh = 0; hh < 4; ++hh) { \
                    _Pragma("unroll") for (int j = 0; j < 4; ++j) sc_[j] += wq[hh] * RELU(a_[hh][j]); } \
                LAS _Float16* sp_ = SC + c * SCH + (16 * ((KT) & 1) + 4 * g) * 64 + ((KT) >> 1);     \
                sp_[0] = (_Float16)sc_[0]; sp_[64] = (_Float16)sc_[1]; sp_[128] = (_Float16)sc_[2]; sp_[192] = (_Float16)sc_[3]; } while (0)
            bf16x8 ka0 = qi[0][0], ka1 = qi[0][1], kb0 = qi[0][0], kb1 = qi[0][1];
            if (gwv <= tau) { const bf16_t* kp = kp0 + (size_t)(gwv * 16) * NIN; ka0 = ldg16(kp); ka1 = ldg16(kp + 32); }
            if (gwv + 4 <= tau) { const bf16_t* kp = kp0 + (size_t)((gwv + 4) * 16) * NIN; kb0 = ldg16(kp); kb1 = ldg16(kp + 32); }
            for (int kt = gwv; kt <= tau; kt += 8) {
                bf16x8 na0 = ka0, na1 = ka1, nb0 = kb0, nb1 = kb1;
                if (kt + 8 <= tau) { const bf16_t* kp = kp0 + (size_t)((kt + 8) * 16) * NIN; na0 = ldg16(kp); na1 = ldg16(kp + 32); }
                if (kt + 12 <= tau) { const bf16_t* kp = kp0 + (size_t)((kt + 12) * 16) * NIN; nb0 = ldg16(kp); nb1 = ldg16(kp + 32); }
                IDX_TILE(kt, ka0, ka1);
                if (kt + 4 <= tau) IDX_TILE(kt + 4, kb0, kb1);
                ka0 = na0; ka1 = na1; kb0 = nb0; kb1 = nb1;
            }
#undef IDX_TILE
        }
        bf16x8 qf[2][4];
        { int lane2 = lane; asm volatile("" : "+v"(lane2));
          const int r = lane2 & 31, h = lane2 >> 5, c = r & 15;
#pragma unroll
          for (int nt = 0; nt < 2; ++nt) { const bf16_t* qp = P + (rowbase + t0 + c) * NIN + (2 * nt + (r >> 4)) * 64 + 8 * h;
#pragma unroll
              for (int ks = 0; ks < 4; ++ks) qf[nt][ks] = ldg16(qp + 16 * ks); } }
        GSYNC();
        DTE(12); DTB(13);
#define SEL_LOAD(PL, R) do { _Pragma("unroll") for (int i = 0; i < 16; ++i) { \
                const unsigned lo_ = (unsigned)__builtin_bit_cast(unsigned short, SC[(R) * SCH + 64 * i + lane]), hi_ = (unsigned)__builtin_bit_cast(unsigned short, SC[(R) * SCH + 64 * (i + 16) + lane]); \
                PL[i] = lo_ | (hi_ << 16); } } while (0)
#define TSTAGE(PL, J, MSK) _Pragma("unroll") for (int k_ = 0; k_ < 16; ++k_) if ((k_ & (J)) == 0) { const unsigned lo_ = PL[k_], hi_ = PL[k_ + (J)]; \
                PL[k_] = (lo_ & (MSK)) | ((hi_ << (J)) & ~(MSK)); PL[k_ + (J)] = ((lo_ >> (J)) & (MSK)) | (hi_ & ~(MSK)); }
#define SEL_PLANES(PL) do { TSTAGE(PL, 8, 0x00ff00ffu) TSTAGE(PL, 4, 0x0f0f0f0fu) TSTAGE(PL, 2, 0x33333333u) TSTAGE(PL, 1, 0x55555555u) \
                _Pragma("unroll") for (int bq = 0; bq < 15; ++bq) PL[bq] ^= PL[15]; PL[15] = ~PL[15]; } while (0)
#define SEL_STEP(PL, X, C, A, G, CNTG, NA, DONE) do { if (!DONE) { if (CNTG + C >= 256) { A = X; NA = C; } else { G |= X; CNTG += C; A &= ~PL; NA -= C; } DONE = (CNTG + NA == 256); } } while (0)
#define SEL_TIES(A, CNTG) do { const int need_ = 256 - CNTG, pc_ = __builtin_popcount(A); int inc_ = pc_; \
                inc_ += __builtin_amdgcn_update_dpp(0, inc_, 0x111, 0xf, 0xf, false); inc_ += __builtin_amdgcn_update_dpp(0, inc_, 0x112, 0xf, 0xf, false); \
                inc_ += __builtin_amdgcn_update_dpp(0, inc_, 0x114, 0xf, 0xf, false); inc_ += __builtin_amdgcn_update_dpp(0, inc_, 0x118, 0xf, 0xf, false); \
                inc_ += __builtin_amdgcn_update_dpp(0, inc_, 0x142, 0xa, 0xf, false); inc_ += __builtin_amdgcn_update_dpp(0, inc_, 0x143, 0xc, 0xf, false); \
                int take_ = need_ - (inc_ - pc_); take_ = take_ < 0 ? 0 : (take_ > pc_ ? pc_ : take_); \
                while (__builtin_popcount(A) > take_) A &= ~(0x80000000u >> __builtin_clz(A)); } while (0)
#pragma unroll 1
        for (int rp = 0; rp < 2; ++rp) {
            const int ra = 4 * gwv + 2 * rp, rb = ra + 1, na = t0 + ra + 1, nb = na + 1;
            const int cva = na - 32 * lane, cvb = nb - 32 * lane;
            unsigned Aa = cva >= 32 ? ~0u : (cva <= 0 ? 0u : ((1u << cva) - 1u)), Ab = cvb >= 32 ? ~0u : (cvb <= 0 ? 0u : ((1u << cvb) - 1u));
            unsigned Ga = 0u, Gb = 0u; int cntGa = 0, cntGb = 0, nAa = na, nAb = nb;
            bool donea = (na <= 256), doneb = (nb <= 256);
            if (!(donea && doneb)) {
                unsigned PA[16], PB[16];
                SEL_LOAD(PA, ra); SEL_LOAD(PB, rb);
                SEL_PLANES(PA); SEL_PLANES(PB);
#pragma unroll
                for (int bq = 15; bq >= 0; --bq) {
                    if (!(donea && doneb)) {
                        const unsigned Xa = Aa & PA[bq], Xb = Ab & PB[bq];
                        const unsigned tot = (unsigned)wsum_i(__builtin_popcount(Xa) + (__builtin_popcount(Xb) << 16));
                        const int ca = (int)(tot & 0xffffu), cb = (int)(tot >> 16);
                        SEL_STEP(PA[bq], Xa, ca, Aa, Ga, cntGa, nAa, donea);
                        SEL_STEP(PB[bq], Xb, cb, Ab, Gb, cntGb, nAb, doneb);
                    }
                }
                if (!donea) SEL_TIES(Aa, cntGa);
                if (!doneb) SEL_TIES(Ab, cntGb);
            }
            MASK[ra * MASK_STRIDE + lane] = Ga | Aa;
            MASK[rb * MASK_STRIDE + lane] = Gb | Ab;
        }
#undef SEL_LOAD
#undef TSTAGE
#undef SEL_PLANES
#undef SEL_STEP
#undef SEL_TIES
        if (gwv == 0 && lane == 0) FETCH_LATE(QW[par ^ 1], fu0);
        GSYNC();
        DTE(13); DTB(14);
        {
            int lane3 = lane; asm volatile("" : "+v"(lane3));
            const int r = lane3 & 31, h = lane3 >> 5, c = r & 15;
            f32x16 o[2][2]; float ls[2];
            o[0][0] = zero16(); o[0][1] = zero16(); o[1][0] = zero16(); o[1][1] = zero16(); ls[0] = 0.f; ls[1] = 0.f;
            const int nkt = ((t0 + 15) >> 5) + 1;
            f32x16 negm2; _Pragma("unroll") for (int i = 0; i < 16; ++i) negm2[i] = -M2;
            asm volatile("" : "+v"(negm2));
#define ATT_TILE(KT, KF, VF) do { const unsigned mw_ = MASK[c * MASK_STRIDE + (KT)] >> (4 * h); \
                int mk_[16]; _Pragma("unroll") for (int i = 0; i < 16; ++i) mk_[i] = __builtin_amdgcn_sbfe((int)mw_, crow(i, 0), 1);        \
                _Pragma("unroll") for (int nt = 0; nt < 2; ++nt) { \
                    f32x16 sc_ = negm2; \
                    _Pragma("unroll") for (int ks = 0; ks < 4; ++ks) sc_ = MFMA32(KF[ks], qf[nt][ks], sc_); \
                    _Pragma("unroll") for (int i = 0; i < 16; ++i) { const float p_ = __builtin_bit_cast(float, __builtin_bit_cast(int, ex2(sc_[i])) & mk_[i]); sc_[i] = p_; ls[nt] += p_; } \
                    const bf16x8 p0_ = pack8(sc_, 0), p1_ = pack8(sc_, 1); \
                    o[nt][0] = MFMA32(VF[0][0], p0_, o[nt][0]); o[nt][0] = MFMA32(VF[0][1], p1_, o[nt][0]); \
                    o[nt][1] = MFMA32(VF[1][0], p0_, o[nt][1]); o[nt][1] = MFMA32(VF[1][1], p1_, o[nt][1]); } } while (0)
            LAS unsigned char* const wslot = (LAS unsigned char*)PART + gwv * 16384;
            const unsigned char* const kgb = (const unsigned char*)(P + rowbase * NIN + 8 * 64);
            const unsigned char* const vgb = (const unsigned char*)(VT + ((size_t)(b * NVS) * 64) * SEQ);
            unsigned koff[4], voff[4];
#pragma unroll
            for (int i = 0; i < 4; ++i) { const int row = 8 * i + (lane3 >> 3), ch = (lane3 & 7) ^ ((row >> 1) & 7); koff[i] = (unsigned)(row * (NIN * 2) + 16 * ch);
                const int d = 16 * i + (lane3 >> 2), cv = (lane3 & 3) ^ ((d >> 2) & 3); voff[i] = (unsigned)(d * (SEQ * 2) + 16 * cv); }
#define DMA_TILE(KT, SLOT) do { const unsigned char* kt_ = kgb + (size_t)((KT) * 32) * (NIN * 2); const unsigned char* vt_ = vgb + (size_t)(KT) * 64; \
                _Pragma("unroll") for (int i = 0; i < 4; ++i) __builtin_amdgcn_global_load_lds((const unsigned*)(kt_ + koff[i]), (LAS unsigned*)(wslot + (SLOT) * 8192 + 1024 * i), 16, 0, 0); \
                _Pragma("unroll") for (int i = 0; i < 4; ++i) __builtin_amdgcn_global_load_lds((const unsigned*)(vt_ + voff[i]), (LAS unsigned*)(wslot + (SLOT) * 8192 + 4096 + 1024 * i), 16, 0, 0); } while (0)
            const int ntl = gwv < nkt ? (nkt - gwv + 3) >> 2 : 0;
            if (ntl > 0) DMA_TILE(gwv, 0);
            if (ntl > 1) DMA_TILE(gwv + 4, 1);
            for (int j = 0; j < ntl; ++j) {
                const int kt = gwv + 4 * j;
                if (j + 1 < ntl) asm volatile("s_waitcnt vmcnt(8)" ::: "memory"); else asm volatile("s_waitcnt vmcnt(0)" ::: "memory");
                LAS unsigned char* const sl = wslot + (j & 1) * 8192;
                bf16x8 kf[4], vf[2][2];
#pragma unroll
                for (int ks = 0; ks < 4; ++ks) kf[ks] = *(const LAS bf16x8*)(sl + r * 128 + (((2 * ks + h) ^ ((r >> 1) & 7)) << 4));
#pragma unroll
                for (int dt = 0; dt < 2; ++dt)
#pragma unroll
                    for (int s2 = 0; s2 < 2; ++s2) { const int d = 32 * dt + r; vf[dt][s2] = *(const LAS bf16x8*)(sl + 4096 + d * 64 + (((2 * s2 + h) ^ ((d >> 2) & 3)) << 4)); }
                asm volatile("s_waitcnt lgkmcnt(0)" ::: "memory");
                if (j + 2 < ntl) DMA_TILE(kt + 8, j & 1);
                ATT_TILE(kt, kf, vf);
            }
            asm volatile("s_waitcnt vmcnt(0) lgkmcnt(0)" ::: "memory");
#undef DMA_TILE
#undef ATT_TILE
#pragma unroll
            for (int nt = 0; nt < 2; ++nt) {
#pragma unroll
                for (int dt = 0; dt < 2; ++dt)
#pragma unroll
                    for (int i = 0; i < 16; ++i) PART[(gwv * 64 + 32 * dt + crow(i, h)) * 64 + 32 * nt + r] = o[nt][dt][i];
                float l2 = ls[nt]; l2 += __shfl_xor(l2, 32);
                if (h == 0) LSUM[gwv * 64 + 32 * nt + r] = l2;
            }
        }
        const int qn = (int)QW[par ^ 1];
        { int lane4 = lane; asm volatile("" : "+v"(lane4));
          const int c = lane4 & 15, g = lane4 >> 4; const int qq = qn < NU ? qn : 0; const size_t row = (size_t)UNIT_B(qq) * SEQ + 16 * UNIT_TAU(qq) + c;
          const bf16_t* qp = P + row * NIN + 4 * 64 + 8 * g;
#pragma unroll
          for (int hh = 0; hh < 4; ++hh) { qi[hh][0] = ldg16(qp + hh * 64); qi[hh][1] = ldg16(qp + hh * 64 + 32); }
          wq = *(const GAS f32x4*)(WI + row * 4); }
        GSYNC();
        DTE(14); DTB(15);
        {
            int n = lane; asm volatile("" : "+v"(n));
            float l = 0.f;
#pragma unroll
            for (int w = 0; w < 4; ++w) l += LSUM[w * 64 + n];
            const float inv = 1.f / l;
            float ov[16]; float ssp = 0.f;
#pragma unroll
            for (int dd = 0; dd < 16; ++dd) { float a = 0.f;
#pragma unroll
                for (int w = 0; w < 4; ++w) a += PART[(w * 64 + 16 * gwv + dd) * 64 + n];
                ov[dd] = a * inv; ssp += ov[dd] * ov[dd]; }
            SSUM[gwv * 64 + n] = ssp;
            GSYNC();
            float ss = 0.f;
#pragma unroll
            for (int w = 0; w < 4; ++w) ss += SSUM[w * 64 + n];
            const float rn = __builtin_amdgcn_rsqf(ss * (1.f / 64.f) + EPS);
            const int head = n >> 4, c = n & 15;
            bf16_t* op = O + (rowbase + t0 + c) * DM + head * 64 + 16 * gwv;
#pragma unroll
            for (int hf = 0; hf < 2; ++hf) {
                const f32x4 ga = *(const f32x4*)(gout + head * 64 + 16 * gwv + 8 * hf), gb = *(const f32x4*)(gout + head * 64 + 16 * gwv + 8 * hf + 4);
                u32x4 wv; wv.x = cvtpk(ov[8 * hf] * rn * ga[0], ov[8 * hf + 1] * rn * ga[1]); wv.y = cvtpk(ov[8 * hf + 2] * rn * ga[2], ov[8 * hf + 3] * rn * ga[3]);
                wv.z = cvtpk(ov[8 * hf + 4] * rn * gb[0], ov[8 * hf + 5] * rn * gb[1]); wv.w = cvtpk(ov[8 * hf + 6] * rn * gb[2], ov[8 * hf + 7] * rn * gb[3]);
                *(GAS u32x4*)(op + 8 * hf) = wv; }
        }
        GSYNC();
        DTE(15);
        q = qn; par ^= 1;
    }
#undef GSYNC
#undef FETCH_UNIT
#undef FETCH_EARLY
#undef FETCH_LATE
#undef UNIT_B
#undef UNIT_TAU
}

typedef const __attribute__((address_space(4))) char* kargp_t;
#define KP() kargp_t kp_ = (kargp_t)__builtin_amdgcn_kernarg_segment_ptr(); asm volatile("" : "+s"(kp_)); unsigned char* const ws = *(unsigned char* const __attribute__((address_space(4)))*)(kp_ + 144); (void)ws
#define AIN(k) (*(const float* const __attribute__((address_space(4)))*)(kp_ + 8 * (k)))
#define AOUT() (*(float* const __attribute__((address_space(4)))*)(kp_ + 136))
static_assert(sizeof(Args) == 160, "Args layout: in[17] | out | ws | lo | hi");
__global__ void __launch_bounds__(NWAVES * 64, 2) fwd(Args args) {
    extern __shared__ __attribute__((aligned(16))) unsigned char lds_raw[];
    LAS unsigned char* lds = (LAS unsigned char*)lds_raw;
    const int wave = __builtin_amdgcn_readfirstlane(threadIdx.x >> 6);
    const int G = gridDim.x;
    const int gw = blockIdx.x * NWAVES + wave, NGW = G * NWAVES;
    volatile LAS unsigned* MISC = (volatile LAS unsigned*)(lds + LDS_MISC);
    if (threadIdx.x < 16) MISC[threadIdx.x] = 0u;
    __syncthreads();
    XcdBarrier bar; bar.bar = (unsigned*)(args.ws + WS_CTL) + CW_BAR; bar.x = 0; bar.st = nullptr; bar.w = wave;
    if (!MK_MULTI) bar = xcd_barrier_post((unsigned*)(args.ws + WS_CTL) + CW_BAR, MISC + 4, wave);
    const int lo = args.lo, hi = args.hi;
#define IN(k) (lo <= (k) && (k) < hi)
#define SEAM(k) do { if (IN(k) && IN((k) + 1)) xcd_barrier(bar); } while (0)
#define OPQ() int tid = wave * 64 + lane_id_v(); asm volatile("" : "+v"(tid)); const int lane = tid & 63; (void)lane
#ifdef TPROBE
#define TBEG(cls) do { if ((TPROBE >> (cls)) & 1) { if (threadIdx.x == 0) MISC[13] = (unsigned)__builtin_amdgcn_s_memrealtime(); } } while (0)
#define TEND(cls) do { if ((TPROBE >> (cls)) & 1) { if (threadIdx.x == 0) MISC[12] = MISC[12] + ((unsigned)__builtin_amdgcn_s_memrealtime() - MISC[13]); } } while (0)
#else
#define TBEG(cls) do { } while (0)
#define TEND(cls) do { } while (0)
#endif
#ifdef TPROBE_BODY
#define TENDB(cls) TEND(cls)
#define TENDS(cls) do { } while (0)
#else
#define TENDB(cls) do { } while (0)
#define TENDS(cls) TEND(cls)
#endif
    TBEG(0);
    if (PH(0) && IN(0)) _Pragma("unroll 1") for (int rep = 0; rep < REP_PA; ++rep) { OPQ(); prologue(args, lds, tid, lane, wave, G); }
    TENDB(0); SEAM(0); TENDS(0);
    TBEG(1);
    if (PH(0) && IN(1)) _Pragma("unroll 1") for (int rep = 0; rep < REP_PB; ++rep) { OPQ(); prologue_b(args, lds, tid, lane, wave, G); }
    if (PH(1) && IN(1)) _Pragma("unroll 1") for (int rep = 0; rep < REP_N; ++rep) { OPQ(); KP();
        pre_phase(AIN(0), AIN(2), (const float*)(ws + WS_MOD), (bf16_t*)(ws + WS_H), (float*)(ws + WS_SS), lane, gw, NGW); }
    TENDB(1); SEAM(1); TENDS(1);

    for (int l = 0; l < DEPTH; ++l) {
        const int s0 = 1 + 5 * l;
        TBEG(2);
        if (PH(2) && IN(s0 + 1)) _Pragma("unroll 1") for (int rep = 0; rep < REP_G2; ++rep) {
            KP(); stagger(STAG_I);
            const bf16_t* wl = (const bf16_t*)(ws + WS_W + (size_t)l * W_LAYER);
            pg8::Gemm g{(const bf16_t*)(ws + WS_H), wl + W_IN / 2, MROWS, NIN, DM}; pg8::StaticOrder S; S.init(MROWS, NIN, G, (int)blockIdx.x);
            pg8::EpiInProj E{(bf16_t*)(ws + WS_P), (bf16_t*)(ws + WS_VT), (float*)(ws + WS_WI), (const float*)(ws + WS_ROPE), (const float*)(ws + WS_ROPE) + SEQ * 32,
                             AIN(7) + l * 64, AIN(8) + l * 64, AIN(9) + l * 64, AIN(10) + l * 64, (const float*)(ws + WS_SS), (const float*)(ws + WS_B1) + (size_t)l * BATCH * NIN, (LAS float*)(lds + 131072)};
            pg8::gemm_phase<pg8::EpiInProj, pg8::StaticOrder, true, true>(lds, g, S, E, wave);
        }
        TENDB(2); SEAM(s0 + 1); TENDS(2); TBEG(3);
        if (PH(3) && IN(s0 + 2)) {
            OPQ(); KP();
            const bf16_t* P = (const bf16_t*)(ws + WS_P); const bf16_t* VT = (const bf16_t*)(ws + WS_VT); bf16_t* OB = (bf16_t*)(ws + WS_O);
            const float* gout = AIN(12) + l * 1024;
            const float gqa = wave_max(fabsf(AIN(7)[l * 64 + lane])), gka = wave_max(fabsf(AIN(8)[l * 64 + lane]));
            const float gqc = wave_max(fabsf(AIN(9)[l * 64 + lane])), gkc = wave_max(fabsf(AIN(10)[l * 64 + lane]));
            const float M2a = 8.f * gqa * gka * LOG2E, M2c = 8.f * gqc * gkc * LOG2E;
            _Pragma("unroll 1") for (int rep = 0; rep < REP_ATT; ++rep) {
            const int xs = (G % 8 == 0) ? (int)(blockIdx.x & 7) : 0, js = (G % 8 == 0) ? (int)(blockIdx.x >> 3) : (int)blockIdx.x, njs = (G % 8 == 0) ? G / 8 : G, nvs = (G % 8 == 0) ? 128 : 1024;
            TBEG(8); TBEG(11);
            if (PH(8)) _Pragma("unroll 1") for (int r2 = 0; r2 < REP_SWA; ++r2) for (int v = js; v < nvs; v += njs) { const int b = 4 * xs + (v >> 5), kv = (v >> 4) & 1, qb = v & 15;
                swa_block(b, kv, qb, P, VT, OB, M2c, AIN(11) + l * 8, gout, lds, tid, lane, wave); }
            TEND(8); TBEG(9);
            if (PH(9)) _Pragma("unroll 1") for (int r2 = 0; r2 < REP_SB; ++r2) for (int v = js; v < nvs; v += njs) { const int b = 4 * xs + (v >> 5), hb = (v >> 3) & 3, qb = v & 7;
                sb_block(b, hb, qb, P, VT, OB, gout, lds, tid, lane, wave); }
            TEND(9); TEND(11); TBEG(10);
            if (PH(10)) _Pragma("unroll 1") for (int r2 = 0; r2 < REP_DSA; ++r2) dsa_phase(P, VT, (const float*)(ws + WS_WI), OB, gout, M2a, (unsigned*)(ws + WS_CTL) + CW_QUEUE + 1024 * l + 256 * rep + 128 * r2, lds, tid, lane, wave);
            TEND(10);
            }
        }
        TENDB(3); SEAM(s0 + 2); TENDS(3); TBEG(4);
        if (PH(4) && IN(s0 + 3)) _Pragma("unroll 1") for (int rep = 0; rep < REP_G4; ++rep) {
            KP(); stagger(STAG_O);
            const bf16_t* wl = (const bf16_t*)(ws + WS_W + (size_t)l * W_LAYER); const float* modl = (const float*)(ws + WS_MOD) + (size_t)l * BATCH * 6144;
            pg8::Gemm g{(const bf16_t*)(ws + WS_O), wl + W_O / 2, MROWS, DM, DM}; pg8::StaticOrder S; S.init(MROWS, DM, G, (int)blockIdx.x);
            pg8::EpiResid E{l == 0 ? (const void*)AIN(0) : (const void*)(ws + WS_X16), rep ? (void*)(ws + WS_DUMMY) : (void*)(ws + WS_X16), modl + 2 * DM, rep ? (bf16_t*)(ws + WS_DUMMY) : (bf16_t*)(ws + WS_H),
                            AIN(3) + l * DM, modl + 4 * DM, rep ? (float*)(ws + WS_DUMMY) : (float*)(ws + WS_SS), 1, l == 0 ? 1 : 0, 0};
            pg8::gemm_phase<pg8::EpiResid, pg8::StaticOrder, true, true>(lds, g, S, E, wave);
        }
        TENDB(4); SEAM(s0 + 3); TENDS(4); TBEG(5);
        if (PH(6) && IN(s0 + 4)) _Pragma("unroll 1") for (int rep = 0; rep < REP_G6; ++rep) {
            KP(); stagger(STAG_G);
            const bf16_t* wl = (const bf16_t*)(ws + WS_W + (size_t)l * W_LAYER);
            pg8::Gemm g{(const bf16_t*)(ws + WS_H), wl + W_GU / 2, MROWS, NGU, DM}; pg8::StaticOrder S; S.init(MROWS, NGU, G, (int)blockIdx.x);
            pg8::EpiSwiGLU E{(bf16_t*)(ws + WS_ACT), (const float*)(ws + WS_SS), (const float*)(ws + WS_BG) + (size_t)l * BATCH * DFF, (const float*)(ws + WS_BU) + (size_t)l * BATCH * DFF};
            pg8::gemm_phase<pg8::EpiSwiGLU, pg8::StaticOrder, true, true>(lds, g, S, E, wave);
        }
        TENDB(5); SEAM(s0 + 4); TENDS(5); TBEG(6);
        if (PH(7) && IN(s0 + 5)) _Pragma("unroll 1") for (int rep = 0; rep < REP_G7; ++rep) {
            KP(); stagger(STAG_D);
            const bf16_t* wl = (const bf16_t*)(ws + WS_W + (size_t)l * W_LAYER); const float* mod = (const float*)(ws + WS_MOD); const float* modl = mod + (size_t)l * BATCH * 6144;
            pg8::Gemm g{(const bf16_t*)(ws + WS_ACT), wl + W_D / 2, MROWS, DM, DFF}; pg8::StaticOrder S; S.init(MROWS, DM, G, (int)blockIdx.x);
            const int ln = (l + 1 < DEPTH) ? l + 1 : l;
            const int last = (l + 1 == DEPTH);
            pg8::EpiResid E{(const void*)(ws + WS_X16), rep ? (void*)(ws + WS_DUMMY) : (last ? (void*)AOUT() : (void*)(ws + WS_X16)), modl + 5 * DM, rep ? (bf16_t*)(ws + WS_DUMMY) : (bf16_t*)(ws + WS_H),
                            AIN(2) + ln * DM, mod + (size_t)ln * BATCH * 6144 + DM, rep ? (float*)(ws + WS_DUMMY) : (float*)(ws + WS_SS), last ? 0 : 1, 0, (last && !rep) ? 1 : 0};
            pg8::gemm_phase<pg8::EpiResid, pg8::StaticOrder, true, true>(lds, g, S, E, wave);
        }
        TENDB(6); SEAM(s0 + 5); TENDS(6);
    }
#ifdef TPROBE
    __syncthreads();
    { unsigned tacc = MISC[12];
#ifdef TPROBE_BLK
      if ((int)blockIdx.x != (TPROBE_BLK)) tacc = 0u;
#endif
      const unsigned tend = (unsigned)__builtin_amdgcn_s_memrealtime(), span = tacc * (unsigned)(TPROBE_K);
      while ((unsigned)__builtin_amdgcn_s_memrealtime() - tend < span) __builtin_amdgcn_s_sleep(8); }
#endif
#undef IN
#undef SEAM
}

extern "C" void kernel_launch(void* const* d_in, const int* in_sizes, int n_in, void* d_out, int out_size, void* d_ws, size_t ws_size, hipStream_t stream) {
    static int grid = 0;
    if (grid == 0) {
        if (n_in != 17 || in_sizes[0] != MROWS * DM || out_size != MROWS * DM || ws_size < WS_END) {
            fprintf(stderr, "kernel_launch: unexpected problem (n_in %d, in0 %d, out %d, ws %zu); nothing launched\n", n_in, n_in > 0 ? in_sizes[0] : -1, out_size, ws_size); grid = -1; return; }
        int dev = 0, cus = 0, per_cu = 0;
        if (hipGetDevice(&dev) != hipSuccess || hipDeviceGetAttribute(&cus, hipDeviceAttributeMultiprocessorCount, dev) != hipSuccess) { grid = -1; return; }
        if (hipFuncSetAttribute((const void*)fwd, hipFuncAttributeMaxDynamicSharedMemorySize, LDS_BYTES) != hipSuccess) { fprintf(stderr, "kernel_launch: hipFuncSetAttribute failed\n"); grid = -1; return; }
        if (hipOccupancyMaxActiveBlocksPerMultiprocessor(&per_cu, (const void*)fwd, NWAVES * 64, LDS_BYTES) != hipSuccess || per_cu < 1) {
            fprintf(stderr, "kernel_launch: occupancy query reports %d workgroups per CU\n", per_cu); per_cu = 1; }
        (void)hipGetLastError();
        grid = cus;
    }
    if (grid < 0) return;
    if (hipMemsetAsync((char*)d_ws + WS_CTL, 0, CTL_BYTES, stream) != hipSuccess) return;
    Args a{};
    for (int i = 0; i < 17; ++i) a.in[i] = (const float*)d_in[i];
    a.out = (float*)d_out; a.ws = (unsigned char*)d_ws;
#if MK_MULTI
    for (int s = 0; s < NSTEPS; ++s) { a.lo = s; a.hi = s + 1; hipLaunchKernelGGL(fwd, dim3(grid), dim3(NWAVES * 64), LDS_BYTES, stream, a); }
#else
    a.lo = 0; a.hi = NSTEPS;
    hipLaunchKernelGGL(fwd, dim3(grid), dim3(NWAVES * 64), LDS_BYTES, stream, a);
#endif
}
```

```cpp
#include <hip/hip_runtime.h>
#include <cstdio>
#include <cstdint>

#ifndef MK_MULTI
#define MK_MULTI 0
#endif

#define LAS __attribute__((address_space(3)))
#define GAS __attribute__((address_space(1)))
__device__ __forceinline__ int lane_id_v() { int l; asm volatile("v_mbcnt_lo_u32_b32 %0, -1, 0\n\tv_mbcnt_hi_u32_b32 %0, -1, %0" : "=v"(l)); return l; }
namespace pg8 {
#define PG8_LAS __attribute__((address_space(3)))
typedef unsigned short bf16_t;
typedef short bf16x8 __attribute__((ext_vector_type(8)));
typedef float f32x4 __attribute__((ext_vector_type(4)));
typedef unsigned u32x4 __attribute__((ext_vector_type(4)));
constexpr int BM = 256, BK = 64, HALF = 128, HTB = HALF * BK * 2  , STAGE_BYTES = 8 * HTB, NXCD = 8, WGM = 8;

__host__ __device__ __forceinline__ int lds_byte(int r, int c) { const int st = (r >> 4) * 2 + (c >> 5), rr = r & 15, cc = c & 31, ob = rr * 64 + cc * 2; return st * 1024 + (ob ^ (((ob >> 9) & 1) << 5)); }
__host__ __device__ __forceinline__ void stage_rc(int b, int& R, int& C) { const int st = b / 1024, sb = b % 1024, swz = sb ^ (((sb >> 9) & 1) << 5); R = (st >> 1) * 16 + swz / 64; C = (st & 1) * 32 + (swz % 64) / 2; }
__host__ __device__ __forceinline__ int perm32(int rho) { const int n = rho >> 4, i = rho & 15; return 8 * (i >> 2) + 4 * n + (i & 3); }

struct Unit { int pm, pn; };
struct Gemm { const bf16_t* A; const bf16_t* Bt; int M, N, K; };

struct StaticOrder {
    int nM, nN, nwg, G, c;
    __host__ __device__ void init(int M, int N, int G_, int c_) { nM = M / BM; nN = N / BM; nwg = nM * nN; G = G_; c = c_; }
    __host__ __device__ bool next(int i, Unit& u) const {
        const long L = (long)i * G + c; if (L >= nwg) return false;
        int wgid = (int)L; { const int q = nwg / NXCD, r = nwg % NXCD, xcd = wgid % NXCD, off = wgid / NXCD; wgid = (xcd < r ? xcd * (q + 1) : r * (q + 1) + (xcd - r) * q) + off; }
        const int nig = WGM * nN, gid = wgid / nig, fm = gid * WGM, gsz = (nM - fm) < WGM ? (nM - fm) : WGM;
        u.pm = fm + ((wgid % nig) % gsz); u.pn = (wgid % nig) / gsz; return true;
    }
    __device__ __forceinline__ void a_ready(const Unit&) const {}
    __device__ __forceinline__ void done(const Unit&) const {}
};
#ifndef RELAX_V
#define RELAX_V 0
#endif
template <class Epi, class Sched, bool ALIGN_EPI = false, bool SP2 = false>
__device__ __forceinline__ void gemm_phase(PG8_LAS unsigned char* lds, const Gemm g, const Sched& S, const Epi& E, int wave_) {
    int tid_o = wave_ * 64 + lane_id_v(); asm volatile("" : "+v"(tid_o));
    const int tid = tid_o, wid = __builtin_amdgcn_readfirstlane(tid >> 6), lane = tid & 63, wr = wid >> 2, wc = wid & 3, fr = lane & 15, fq = lane >> 4;
    const int K = g.K, nt = K / BK;
    unsigned voffA[2], voffB[2];
#pragma unroll
    for (int i = 0; i < 2; ++i) { int R, C; stage_rc(tid * 16 + i * 8192, R, C); const int Rb = Epi::PERM ? ((R & ~31) + perm32(R & 31)) : R;
        voffA[i] = (unsigned)(R * K + C) * 2u; voffB[i] = (unsigned)(Rb * K + C) * 2u; }
    const size_t kstep = (size_t)(BK * 2);
    const size_t hstep = (size_t)HALF * K * 2;
    const size_t tstep = 2 * hstep;
    const unsigned ldsw = (unsigned)wid * 1024u;
    const int aoff = lds_byte(wr * 64 + fr, fq * 8), boff = lds_byte(wc * 32 + fr, fq * 8);
#define PG8_SA(b, h) (((b) * 2 + (h)) * HTB)
#define PG8_SB(b, h) ((4 + (b) * 2 + (h)) * HTB)
#define PG8_STAGE(bufoff, gbase, voff) do { _Pragma("unroll") for (int _i = 0; _i < 2; ++_i) \
        __builtin_amdgcn_global_load_lds((const unsigned*)((const char*)(gbase) + (voff)[_i]), (PG8_LAS unsigned*)(lds + (bufoff) + ldsw + _i * 8192), 16, 0, 0); } while (0)
#define PG8_LDA(dst, b, h) do { _Pragma("unroll") for (int m = 0; m < 4; ++m) _Pragma("unroll") for (int k = 0; k < 2; ++k) dst[m][k] = *(const PG8_LAS bf16x8*)(lds + PG8_SA(b, h) + aoff + m * 2048 + k * 1024); } while (0)
#define PG8_LDB(dst, b, h) do { _Pragma("unroll") for (int n = 0; n < 2; ++n) _Pragma("unroll") for (int k = 0; k < 2; ++k) dst[n][k] = *(const PG8_LAS bf16x8*)(lds + PG8_SB(b, h) + boff + n * 2048 + k * 1024); } while (0)
#define PG8_MMA(ai, bj, At, Bt) do { __builtin_amdgcn_s_setprio(1); _Pragma("unroll") for (int m = 0; m < 4; ++m) _Pragma("unroll") for (int n = 0; n < 2; ++n) _Pragma("unroll") for (int k = 0; k < 2; ++k) \
        acc[ai][bj][m][n] = __builtin_amdgcn_mfma_f32_16x16x32_bf16(Bt[n][k], At[m][k], acc[ai][bj][m][n], 0, 0, 0); __builtin_amdgcn_s_setprio(0); } while (0)
#define PG8_WAIT_V(n) asm volatile("s_waitcnt vmcnt(" #n ")" ::: "memory")
#define PG8_WAIT_L(n) asm volatile("s_waitcnt lgkmcnt(" #n ")" ::: "memory")
#define PG8_BAR __builtin_amdgcn_s_barrier()
#define PG8_SCHED __builtin_amdgcn_sched_barrier(0)
    Unit cur, nxt; int ui = 0;
    if (!S.next(0, cur)) return;
    f32x4 acc[2][2][4][2];
#pragma unroll
    for (int a = 0; a < 2; ++a)
#pragma unroll
        for (int b = 0; b < 2; ++b)
#pragma unroll
            for (int m = 0; m < 4; ++m)
#pragma unroll
                for (int n = 0; n < 2; ++n) acc[a][b][m][n] = (f32x4){0.f, 0.f, 0.f, 0.f};
    bf16x8 At[4][2], B0[2][2], B1[2][2];
    const char* cA = (const char*)g.A + (size_t)cur.pm * tstep; const char* cB = (const char*)g.Bt + (size_t)cur.pn * tstep;
    S.a_ready(cur);
    if constexpr (SP2) {
        PG8_STAGE(PG8_SB(0, 0), cB, voffB); PG8_STAGE(PG8_SB(0, 1), cB + hstep, voffB); PG8_STAGE(PG8_SA(0, 0), cA, voffA); PG8_STAGE(PG8_SA(0, 1), cA + hstep, voffA);
        if (wr == 1) PG8_BAR;
        PG8_WAIT_V(2); PG8_BAR;
        PG8_STAGE(PG8_SB(1, 0), cB + kstep, voffB); PG8_STAGE(PG8_SA(1, 0), cA + kstep, voffA); PG8_STAGE(PG8_SB(1, 1), cB + hstep + kstep, voffB);
        PG8_WAIT_V(6); PG8_BAR;
    } else {
        PG8_STAGE(PG8_SB(0, 0), cB, voffB); PG8_STAGE(PG8_SA(0, 0), cA, voffA); PG8_STAGE(PG8_SB(0, 1), cB + hstep, voffB); PG8_STAGE(PG8_SA(0, 1), cA + hstep, voffA);
        if (wr == 1) PG8_BAR;
        PG8_WAIT_V(4); PG8_BAR;
        PG8_STAGE(PG8_SB(1, 0), cB + kstep, voffB); PG8_STAGE(PG8_SA(1, 0), cA + kstep, voffA); PG8_STAGE(PG8_SB(1, 1), cB + hstep + kstep, voffB);
        PG8_WAIT_V(6); PG8_BAR;
    }
    for (;;) {
        const bool has_next = S.next(ui + 1, nxt);
        const char* nA = has_next ? (const char*)g.A + (size_t)nxt.pm * tstep : cA; const char* nB = has_next ? (const char*)g.Bt + (size_t)nxt.pn * tstep : cB;
#ifdef KREP_PROBE
        _Pragma("unroll 1") for (int kr = 0; kr < Epi::KREP; ++kr) {
        if (kr > 0) {
            _Pragma("unroll") for (int a = 0; a < 2; ++a) _Pragma("unroll") for (int b = 0; b < 2; ++b) _Pragma("unroll") for (int m = 0; m < 4; ++m) _Pragma("unroll") for (int n = 0; n < 2; ++n) acc[a][b][m][n] = (f32x4){0.f, 0.f, 0.f, 0.f};
        }
        const bool lastrep = (kr == Epi::KREP - 1);
#else
        const bool lastrep = true;
#endif
        for (int t = 0; t < nt; t += 2) {
            const bool last = (t == nt - 2);
            const char* a1 = cA + (size_t)(t + 1) * kstep;
            const char* a2 = last ? (lastrep ? nA : cA) : cA + (size_t)(t + 2) * kstep; const char* b2 = last ? (lastrep ? nB : cB) : cB + (size_t)(t + 2) * kstep;
            const char* a3 = a2 + kstep; const char* b3 = b2 + kstep;
            if (last && has_next) S.a_ready(nxt);
            if constexpr (SP2) {
            PG8_LDB(B0, 0, 0); PG8_LDB(B1, 0, 1); PG8_SCHED; PG8_LDA(At, 0, 0); PG8_STAGE(PG8_SA(1, 1), a1 + hstep, voffA);
            if constexpr (RELAX_V != 0) { const int rlx = __builtin_amdgcn_readfirstlane((t == 0 && ui > 0) ? 1 : 0);
                asm volatile("s_cmp_lg_u32 %0, 0\n\ts_cbranch_scc1 .Lrlx%=\n\ts_waitcnt vmcnt(8)\n.Lrlx%=:\n\ts_waitcnt vmcnt(%1)" :: "s"(rlx), "n"(8 + Epi::NVM) : "memory", "scc"); }
            else PG8_WAIT_V(8);
            PG8_WAIT_L(0); PG8_BAR; PG8_MMA(0, 0, At, B0); PG8_MMA(0, 1, At, B1); PG8_BAR; PG8_SCHED;
            PG8_LDA(At, 0, 1); PG8_STAGE(PG8_SB(0, 0), b2, voffB); PG8_STAGE(PG8_SB(0, 1), b2 + hstep, voffB); PG8_STAGE(PG8_SA(0, 0), a2, voffA);
            PG8_WAIT_V(8); PG8_WAIT_L(0); PG8_BAR; PG8_MMA(1, 0, At, B0); PG8_MMA(1, 1, At, B1); PG8_BAR; PG8_SCHED;
            PG8_LDB(B0, 1, 0); PG8_LDB(B1, 1, 1); PG8_SCHED; PG8_LDA(At, 1, 0); PG8_STAGE(PG8_SA(0, 1), a2 + hstep, voffA);
            PG8_WAIT_V(8); PG8_WAIT_L(0); PG8_BAR; PG8_MMA(0, 0, At, B0); PG8_MMA(0, 1, At, B1); PG8_BAR; PG8_SCHED;
            PG8_LDA(At, 1, 1); PG8_STAGE(PG8_SB(1, 0), b3, voffB); PG8_STAGE(PG8_SB(1, 1), b3 + hstep, voffB); PG8_STAGE(PG8_SA(1, 0), a3, voffA);
            PG8_WAIT_V(8); PG8_WAIT_L(0); PG8_BAR; PG8_MMA(1, 0, At, B0); PG8_MMA(1, 1, At, B1); PG8_BAR; PG8_SCHED;
            } else {
            PG8_LDB(B0, 0, 0); PG8_SCHED; PG8_LDA(At, 0, 0); PG8_STAGE(PG8_SA(1, 1), a1 + hstep, voffA);
            PG8_WAIT_L(8); PG8_BAR; PG8_WAIT_L(0); PG8_MMA(0, 0, At, B0); PG8_BAR; PG8_SCHED;
            PG8_LDB(B1, 0, 1); PG8_STAGE(PG8_SB(0, 0), b2, voffB);
            PG8_BAR; PG8_WAIT_L(0); PG8_MMA(0, 1, At, B1); PG8_BAR;
            PG8_LDA(At, 0, 1); PG8_STAGE(PG8_SA(0, 0), a2, voffA);
            PG8_BAR; PG8_WAIT_L(0); PG8_MMA(1, 0, At, B0); PG8_BAR; PG8_SCHED;
            PG8_STAGE(PG8_SB(0, 1), b2 + hstep, voffB);
            PG8_WAIT_V(6); PG8_BAR; PG8_MMA(1, 1, At, B1); PG8_BAR;
            PG8_LDB(B0, 1, 0); PG8_SCHED; PG8_LDA(At, 1, 0); PG8_STAGE(PG8_SA(0, 1), a2 + hstep, voffA);
            PG8_WAIT_L(8); PG8_BAR; PG8_WAIT_L(0); PG8_MMA(0, 0, At, B0); PG8_BAR; PG8_SCHED;
            PG8_LDB(B1, 1, 1); PG8_STAGE(PG8_SB(1, 0), b3, voffB);
            PG8_BAR; PG8_WAIT_L(0); PG8_MMA(0, 1, At, B1); PG8_BAR;
            PG8_LDA(At, 1, 1); PG8_STAGE(PG8_SA(1, 0), a3, voffA);
            PG8_BAR; PG8_WAIT_L(0); PG8_MMA(1, 0, At, B0); PG8_BAR; PG8_SCHED;
            PG8_STAGE(PG8_SB(1, 1), b3 + hstep, voffB);
            PG8_WAIT_V(6); PG8_BAR; PG8_MMA(1, 1, At, B1); PG8_BAR;
            }
        }
#ifdef KREP_PROBE
        }
#endif
        if constexpr (ALIGN_EPI) { if (wr == 0) PG8_BAR; }
#ifdef KREP_PROBE
        if constexpr (Epi::EREP > 1) { _Pragma("unroll 1") for (int er = 1; er < Epi::EREP; ++er) { int fr2 = fr, fq2 = fq; asm volatile("" : "+v"(fr2), "+v"(fq2)); E(acc, cur, wr, wc, fr2, fq2); asm volatile("" ::: "memory"); } }
#endif
#ifdef TPROBE
        if ((TPROBE >> Epi::TCLS) & 1) { if (tid == (TPROBE_TID)) ((volatile PG8_LAS unsigned*)(lds + 144128))[13] = (unsigned)__builtin_amdgcn_s_memrealtime(); }
#endif
        if constexpr (!Epi::AFTER_DRAIN) { E(acc, cur, wr, wc, fr, fq); S.done(cur); }
#ifdef TPROBE
        if ((TPROBE >> Epi::TCLS) & 1) { if (tid == (TPROBE_TID)) { asm volatile("s_waitcnt vmcnt(0)" ::: "memory"); volatile PG8_LAS unsigned* m_ = (volatile PG8_LAS unsigned*)(lds + 144128); m_[12] = m_[12] + ((unsigned)__builtin_amdgcn_s_memrealtime() - m_[13]); } }
#endif
        if (!has_next) break;
#pragma unroll
        for (int a = 0; a < 2; ++a)
#pragma unroll
            for (int b = 0; b < 2; ++b)
#pragma unroll
                for (int m = 0; m < 4; ++m)
#pragma unroll
                    for (int n = 0; n < 2; ++n) acc[a][b][m][n] = (f32x4){0.f, 0.f, 0.f, 0.f};
        cur = nxt; cA = nA; cB = nB; ++ui;
        if constexpr (ALIGN_EPI) { if (wr == 1) PG8_BAR; }
    }
    PG8_WAIT_V(0);
    if constexpr (!ALIGN_EPI) { if (wr == 0) PG8_BAR; }
    PG8_BAR;
    if constexpr (Epi::AFTER_DRAIN) { E.fused(acc, cur, wr, wc, fr, fq, lds, wid, lane); S.done(cur); }
#undef PG8_SA
#undef PG8_SB
#undef PG8_STAGE
#undef PG8_LDA
#undef PG8_LDB
#undef PG8_MMA
#undef PG8_WAIT_V
#undef PG8_WAIT_L
#undef PG8_BAR
#undef PG8_SCHED
}
}

#define XB_TMO      128
#define XB_XCNT(j)  (256  + 64 * (j))
#define XB_XSUB(j)  (1280 + 64 * (j))
#define XB_XGEN(j)  (2304 + 64 * (j))
#define XB_TOP      3328
#define XB_TOPGEN   3392
#define XCD_BAR_WORDS 3456
#define XB_SPIN_CAP (1u << 24)

__device__ __forceinline__ unsigned xb_ld(unsigned* p)              { return __hip_atomic_load(p, __ATOMIC_RELAXED, __HIP_MEMORY_SCOPE_AGENT); }
__device__ __forceinline__ unsigned xb_add(unsigned* p, unsigned v) { return __hip_atomic_fetch_add(p, v, __ATOMIC_RELAXED, __HIP_MEMORY_SCOPE_AGENT); }
__device__ __forceinline__ unsigned xb_xcc_id() { return (unsigned)__builtin_amdgcn_s_getreg((3 << 11) | 20) & 0xFu; }
#define XB_SPIN(cond, bar) do { unsigned _sp = 0; while (cond) { __builtin_amdgcn_s_sleep(1); \
    if ((++_sp & 255u) == 0u) { if (xb_ld(&(bar)[XB_TMO])) break; if (_sp > XB_SPIN_CAP) { atomicAdd(&(bar)[XB_TMO], 1u); break; } } } } while (0)

struct XcdBarrier {
    unsigned* bar; unsigned x; int w;
    volatile LAS unsigned* st;
};

#define XB_THREAD0(w) ((w) == 0 && lane_id_v() == 0)
__device__ __forceinline__ XcdBarrier xcd_barrier_post(unsigned* bar, volatile LAS unsigned* st, int w) {
    XcdBarrier b; b.bar = bar; b.x = xb_xcc_id(); b.st = st; b.w = w;
    if (XB_THREAD0(w)) (void)xb_add(&bar[XB_XCNT(b.x)], 1u);
    return b;
}
__device__ __forceinline__ void xcd_barrier_complete(unsigned* bar, unsigned x, unsigned& nloc, unsigned& nx) {
    const unsigned G = gridDim.x * gridDim.y * gridDim.z;
    unsigned sum, cnt, mine, sp = 0u;
    for (;;) {
        sum = 0u; cnt = 0u; mine = 0u;
#pragma unroll
        for (unsigned j = 0; j < 16; ++j) { const unsigned c = xb_ld(&bar[XB_XCNT(j)]); sum += c; cnt += (c > 0u) ? 1u : 0u; mine = (j == x) ? c : mine; }
        if (sum == G) break;
        __builtin_amdgcn_s_sleep(1);
        if ((++sp & 255u) == 0u) { if (xb_ld(&bar[XB_TMO])) break; if (sp > XB_SPIN_CAP) { atomicAdd(&bar[XB_TMO], 1u); break; } }
    }
    nloc = mine > 0u ? mine : 1u; nx = cnt > 0u ? cnt : 1u;
}

__device__ __forceinline__ void xcd_barrier(const XcdBarrier& b) {
    asm volatile("s_waitcnt vmcnt(0)" ::: "memory");
    __syncthreads();
    if (XB_THREAD0(b.w)) {
        unsigned* bar = b.bar;
        __builtin_amdgcn_s_waitcnt(0);
        unsigned nloc = b.st[0], nx = b.st[1];
        if (nloc == 0u) { xcd_barrier_complete(bar, b.x, nloc, nx); b.st[0] = nloc; b.st[1] = nx; }
        const unsigned old = xb_add(&bar[XB_XSUB(b.x)], 1u);
        const unsigned gen = old / nloc;
        if (old + 1u == (gen + 1u) * nloc) {
            __builtin_amdgcn_fence(__ATOMIC_RELEASE, "agent");
            asm volatile("s_waitcnt vmcnt(0)" ::: "memory");
            const unsigned og = xb_add(&bar[XB_TOP], 1u);
            const unsigned tg = og / nx;
            if (og + 1u == (tg + 1u) * nx) xb_add(&bar[XB_TOPGEN], 1u);
            else XB_SPIN(xb_ld(&bar[XB_TOPGEN]) == tg, bar);
            __builtin_amdgcn_fence(__ATOMIC_ACQUIRE, "agent");
            xb_add(&bar[XB_XGEN(b.x)], 1u);
            asm volatile("s_waitcnt vmcnt(0)" ::: "memory");
        } else {
            XB_SPIN(xb_ld(&bar[XB_XGEN(b.x)]) == gen, bar);
            __builtin_amdgcn_fence(__ATOMIC_ACQUIRE, "agent");
            asm volatile("s_waitcnt vmcnt(0)" ::: "memory");
        }
    }
    __syncthreads();
}

#define LAS __attribute__((address_space(3)))
#define GAS __attribute__((address_space(1)))
typedef unsigned short bf16_t;
typedef short bf16x8 __attribute__((ext_vector_type(8)));
typedef float f32x4 __attribute__((ext_vector_type(4)));
typedef float f32x2 __attribute__((ext_vector_type(2)));
typedef float f32x16 __attribute__((ext_vector_type(16)));
typedef unsigned u32x4 __attribute__((ext_vector_type(4)));
typedef unsigned u32x2 __attribute__((ext_vector_type(2)));
typedef __bf16 bf16x2v __attribute__((ext_vector_type(2)));

constexpr int NWAVES = 8;
constexpr int BATCH = 32, SEQ = 2048, DM = 1024, DEPTH = 4, MROWS = BATCH * SEQ;
constexpr int NIN = 2304, INCOLS = 2244, DFF = 2816, NGU = 2 * DFF, NVS = 7;
constexpr float EPS = 1e-6f, LOG2E = 1.4426950408889634f, C2 = 0.18033688011112042f;
constexpr int NSTEPS = 2 + 5 * DEPTH;
#ifndef TPROBE_TID
#define TPROBE_TID 0
#endif
#ifndef IDX_QD
#define IDX_QD 6
#endif
#ifndef PHMASK
#define PHMASK 0xffff
#endif
#define PH(i) ((PHMASK >> (i)) & 1)
#ifndef DSA_S
#define DSA_S 15
#endif
#ifndef REP_ATT
#define REP_ATT 1
#endif
#ifndef REP_SWA
#define REP_SWA 1
#endif
#ifndef REP_SB
#define REP_SB 1
#endif
#ifndef REP_DSA
#define REP_DSA 1
#endif
#ifndef DSA_R1
#define DSA_R1 1
#endif
#ifndef DSA_R2
#define DSA_R2 1
#endif
#ifndef DSA_R3
#define DSA_R3 1
#endif
#ifndef REP_BIS
#define REP_BIS 1
#endif
#ifndef REP_PA
#define REP_PA 1
#endif
#ifndef REP_PB
#define REP_PB 1
#endif
#ifndef TEST_SELN
#define TEST_SELN 2
#endif
#ifndef STAG_G
#define STAG_G 0
#endif
#ifndef STAG_O
#define STAG_O 0
#endif
#ifndef STAG_D
#define STAG_D 0
#endif
#ifndef STAG_I
#define STAG_I 0
#endif
#ifndef REP_G
#define REP_G 1
#endif
#ifndef REP_G2
#define REP_G2 REP_G
#endif
#ifndef REP_G4
#define REP_G4 REP_G
#endif
#ifndef REP_G6
#define REP_G6 REP_G
#endif
#ifndef REP_G7
#define REP_G7 REP_G
#endif
#ifndef REP_N
#define REP_N 1
#endif

constexpr size_t MiB = 1u << 20;
constexpr size_t WS_CTL = 0, CTL_BYTES = MiB;
constexpr size_t WS_ROPE = 1 * MiB;
constexpr size_t WS_MOD = 2 * MiB;
constexpr size_t WS_WI = 5 * MiB;
constexpr size_t WS_W = 8 * MiB, W_LAYER = 23 * MiB;
constexpr size_t W_IN = 0, W_O = 4608 * 1024, W_GU = W_O + 2 * MiB, W_D = W_GU + 11 * MiB;
constexpr size_t WS_H = 104 * MiB;
constexpr size_t WS_ACT = 232 * MiB;
constexpr size_t WS_P = WS_ACT;
constexpr size_t WS_VT = WS_ACT + 288 * MiB;
constexpr size_t WS_O = 584 * MiB;
constexpr size_t WS_SS = 712 * MiB;
constexpr size_t WS_B1 = 716 * MiB;
constexpr size_t WS_BG = 718 * MiB, WS_BU = 720 * MiB;
constexpr size_t WS_X16 = 724 * MiB;
constexpr size_t WS_END = 852 * MiB, WS_DUMMY = 852 * MiB;
static_assert(W_D + (size_t)DM * DFF * 2 <= W_LAYER && WS_W + DEPTH * W_LAYER <= WS_H && WS_VT + (size_t)BATCH * NVS * 64 * SEQ * 2 <= WS_END, "ws map");
static_assert((size_t)MROWS * NIN * 2 == 288 * MiB && (size_t)MROWS * DFF * 2 == 352 * MiB, "ws map 2");

constexpr int CW_BAR = 4096, CW_QUEUE = 8192;

constexpr int SC_STRIDE = 2052;
constexpr int SCH = 2056;
constexpr int G2_SC = 0;
constexpr int G2_MASK = 16 * SCH * 2, MASK_STRIDE = 66;
constexpr int G2_LSUM = G2_MASK + 16 * MASK_STRIDE * 4;
constexpr int G2_SSUM = G2_LSUM + 1024;
constexpr int G2_BYTES = G2_SSUM + 1024;
constexpr int LDS_MISC = 2 * G2_BYTES;
constexpr int LDS_BYTES = 147456;
static_assert(LDS_MISC + 64 <= LDS_BYTES && 4 * 64 * 64 * 4 <= G2_MASK && (G2_BYTES % 16) == 0 && LDS_MISC >= 131072 + 4096, "lds map");

#define LDS_WAIT() asm volatile("s_waitcnt lgkmcnt(0)" ::: "memory")
__device__ __forceinline__ unsigned cvtpk(float lo, float hi) { f32x2 v = {lo, hi}; bf16x2v b = __builtin_convertvector(v, bf16x2v); return __builtin_bit_cast(unsigned, b); }
__device__ __forceinline__ bf16x8 ldg16(const bf16_t* p) { return *(const GAS bf16x8*)p; }
#define RELU(x) __builtin_amdgcn_fmed3f((x), 0.f, __builtin_fabsf(x))
__device__ __forceinline__ float ex2(float x) { return __builtin_amdgcn_exp2f(x); }
__device__ __forceinline__ float lg2(float x) { return __builtin_amdgcn_logf(x); }
__device__ __forceinline__ int crow(int i, int h) { return (i & 3) + 8 * (i >> 2) + 4 * h; }
#define MFMA32(a, b, c) __builtin_amdgcn_mfma_f32_32x32x16_bf16((a), (b), (c), 0, 0, 0)
#define MFMA16(a, b, c) __builtin_amdgcn_mfma_f32_16x16x32_bf16((a), (b), (c), 0, 0, 0)
__device__ __forceinline__ bf16x8 pack8(const f32x16& x, int s) {
    u32x4 p; p.x = cvtpk(x[8 * s], x[8 * s + 1]); p.y = cvtpk(x[8 * s + 2], x[8 * s + 3]); p.z = cvtpk(x[8 * s + 4], x[8 * s + 5]); p.w = cvtpk(x[8 * s + 6], x[8 * s + 7]);
    return __builtin_bit_cast(bf16x8, p);
}
__device__ __forceinline__ f32x16 zero16() { f32x16 z; for (int i = 0; i < 16; ++i) z[i] = 0.f; return z; }
__device__ __forceinline__ int wsum_i(int v) {
    v += __builtin_amdgcn_update_dpp(0, v, 0x111, 0xf, 0xf, false);
    v += __builtin_amdgcn_update_dpp(0, v, 0x112, 0xf, 0xf, false);
    v += __builtin_amdgcn_update_dpp(0, v, 0x114, 0xf, 0xf, false);
    v += __builtin_amdgcn_update_dpp(0, v, 0x118, 0xf, 0xf, false);
    v += __builtin_amdgcn_update_dpp(0, v, 0x142, 0xa, 0xf, false);
    v += __builtin_amdgcn_update_dpp(0, v, 0x143, 0xc, 0xf, false);
    return __builtin_amdgcn_readlane(v, 63);
}
__device__ __forceinline__ void stagger(unsigned ticks) {
    const unsigned g = blockIdx.x & 3u;
    if (ticks && g) { const unsigned long long t0 = __builtin_amdgcn_s_memrealtime(); while (__builtin_amdgcn_s_memrealtime() - t0 < (unsigned long long)(g * ticks)) __builtin_amdgcn_s_sleep(8); }
}
__device__ __forceinline__ float wave_max(float v) {
#pragma unroll
    for (int o = 1; o < 64; o <<= 1) v = fmaxf(v, __shfl_xor(v, o));
    return v;
}
__device__ __forceinline__ float wave_sum(float v) {
#pragma unroll
    for (int o = 1; o < 64; o <<= 1) v += __shfl_xor(v, o);
    return v;
}

__device__ __forceinline__ int slot_col(int s) {
    if (s < 4) return 64 * s;
    if (s < 8) return 384 + 64 * (s - 4);
    if (s == 8) return 256;
    if (s == 9) return 320;
    if (s == 10) return 640;
    if (s == 11) return 704;
    if (s < 16) return 708 + 64 * (s - 12);
    if (s < 20) return 964 + 64 * (s - 16);
    if (s < 24) return 1220 + 64 * (s - 20);
    if (s < 32) return 1476 + 64 * (s - 24);
    if (s < 34) return 1988 + 64 * (s - 32);
    return 2116 + 64 * (s - 34);
}

namespace pg8 {
struct EpiInProj {
    static constexpr bool PERM = true, AFTER_DRAIN = false;
#ifndef KREP_I
#define KREP_I 1
#endif
#ifndef KREP_R
#define KREP_R 1
#endif
#ifndef KREP_S
#define KREP_S 1
#endif
#ifndef EREP_I
#define EREP_I 1
#endif
#ifndef EREP_R
#define EREP_R 1
#endif
#ifndef EREP_S
#define EREP_S 1
#endif
    static constexpr int KREP = KREP_I, EREP = EREP_I, TCLS = 20;
    static constexpr int NVM = 16;
    bf16_t* P; bf16_t* VT; float* WI; const float* cs; const float* sn; const float* qn_a; const float* kn_a; const float* qn_c; const float* kn_c;
    const float* SS; const float* bias;
    LAS float* xl;
    __device__ __forceinline__ void operator()(const f32x4 (&acc)[2][2][4][2], const Unit& u, int wr, int wc, int fr, int fq) const {
        const int slot = u.pn * 4 + wc;
        int mode = 0; const float* gain = nullptr; float osc = 1.f; int vslot = 0;
        if (slot < 4) { mode = 2; gain = qn_a; osc = C2; }
        else if (slot < 8) { mode = 1; }
        else if (slot == 8) { mode = 2; gain = kn_a; }
        else if (slot == 9) { mode = 3; vslot = 0; }
        else if (slot == 10) { mode = 1; }
        else if (slot == 11) { mode = 4; }
        else if (slot < 16) { mode = 0; osc = C2; }
        else if (slot < 20) { mode = 0; }
        else if (slot < 24) { mode = 3; vslot = 1 + (slot - 20); }
        else if (slot < 32) { mode = 2; gain = qn_c; osc = C2; }
        else if (slot < 34) { mode = 2; gain = kn_c; }
        else { mode = 3; vslot = 5 + (slot - 34); }
        const int rowt = u.pm * BM + wr * 64 + fr;
        const int b = rowt / SEQ; const int tt = rowt % SEQ;
        const int pfr = (fr & 3) | ((fr & 4) << 1) | ((fr & 8) >> 1);
        bf16_t* vb = VT + ((size_t)(b * NVS + vslot) * 64) * SEQ;
        float rsv[2][4];
        LAS float* wl = xl + (wr * 4 + wc) * 128;
        LAS float* wb = wl + 8 * fq; LAS float* wg = wl + 64 + 8 * fq;
        f32x4 rc[2], rsn[2];
        { f32x4 p4[2][4];
#pragma unroll
          for (int ai = 0; ai < 2; ++ai)
#pragma unroll
              for (int m = 0; m < 4; ++m) p4[ai][m] = *(const f32x4*)(SS + (size_t)(rowt + ai * HALF + m * 16) * 16 + 4 * fq);
          const int l64 = fr + 16 * fq;
          const float bval = bias[(size_t)((u.pm * BM) / SEQ) * NIN + slot_col(slot) + l64], gval = (mode == 2) ? gain[l64] : 1.f;
          if (mode == 1 || mode == 2) { const int t = rowt % SEQ;
#pragma unroll
              for (int n = 0; n < 2; ++n) { rc[n] = *(const f32x4*)(cs + t * 32 + 8 * fq + 4 * n); rsn[n] = *(const f32x4*)(sn + t * 32 + 8 * fq + 4 * n); } }
          wl[l64] = (mode == 0) ? bval * osc : bval; wl[64 + l64] = gval;
#pragma unroll
          for (int ai = 0; ai < 2; ++ai)
#pragma unroll
              for (int m = 0; m < 4; ++m) { float sq = (p4[ai][m][0] + p4[ai][m][1]) + (p4[ai][m][2] + p4[ai][m][3]); sq += __shfl_xor(sq, 16); sq += __shfl_xor(sq, 32);
                  rsv[ai][m] = __builtin_amdgcn_rsqf(sq * (1.f / DM) + EPS) * ((mode == 0) ? osc : 1.f); } }
        asm volatile("" ::: "memory");
#define ADJ_ROW(AI, M) const float rs = rsv[AI][M]; \
                f32x4 v1[2] = {acc[AI][0][M][0] * rs + *(LAS f32x4*)(wb), acc[AI][0][M][1] * rs + *(LAS f32x4*)(wb + 4)}, v2[2] = {acc[AI][1][M][0] * rs + *(LAS f32x4*)(wb + 32), acc[AI][1][M][1] * rs + *(LAS f32x4*)(wb + 36)}
#define STORE_ROW(ROW) do { u32x4 w1, w2; \
                w1.x = cvtpk(v1[0][0], v1[0][1]); w1.y = cvtpk(v1[0][2], v1[0][3]); w1.z = cvtpk(v1[1][0], v1[1][1]); w1.w = cvtpk(v1[1][2], v1[1][3]); \
                w2.x = cvtpk(v2[0][0], v2[0][1]); w2.y = cvtpk(v2[0][2], v2[0][3]); w2.z = cvtpk(v2[1][0], v2[1][1]); w2.w = cvtpk(v2[1][2], v2[1][3]); \
                bf16_t* op = P + (size_t)(ROW) * NIN + slot * 64 + 8 * fq; *(u32x4*)op = w1; *(u32x4*)(op + 32) = w2; } while (0)
        if (mode == 3) {
            LAS unsigned short* vt = (LAS unsigned short*)(xl + 1024) + (wr * 4 + wc) * 512;
            const int l64 = fr + 16 * fq;
            LAS unsigned short* vw = vt + 128 * fq + pfr;
            const LAS u32x4* vr = (const LAS u32x4*)(vt + 8 * l64);
            const unsigned gofs = (unsigned)((l64 >> 1) * SEQ + 8 * (l64 & 1));
            bf16_t* vgb = vb + (u.pm * BM + wr * 64) % SEQ;
#pragma unroll
            for (int ai = 0; ai < 2; ++ai)
#pragma unroll
                for (int m = 0; m < 4; ++m) { ADJ_ROW(ai, m);
#pragma unroll
                    for (int n = 0; n < 2; ++n)
#pragma unroll
                        for (int e = 0; e < 4; e += 2) { const unsigned w = cvtpk(v1[n][e], v1[n][e + 1]); vw[(4 * n + e) * 16] = (unsigned short)(w & 0xffffu); vw[(4 * n + e + 1) * 16] = (unsigned short)(w >> 16); }
                    const u32x4 r1 = *vr;
                    asm volatile("" ::: "memory");
#pragma unroll
                    for (int n = 0; n < 2; ++n)
#pragma unroll
                        for (int e = 0; e < 4; e += 2) { const unsigned w = cvtpk(v2[n][e], v2[n][e + 1]); vw[(4 * n + e) * 16] = (unsigned short)(w & 0xffffu); vw[(4 * n + e + 1) * 16] = (unsigned short)(w >> 16); }
                    const u32x4 r2 = *vr;
                    *(u32x4*)(vgb + (ai * HALF + m * 16) + gofs) = r1; *(u32x4*)(vgb + (32 * SEQ + ai * HALF + m * 16) + gofs) = r2;
                    asm volatile("" ::: "memory"); }
        } else if (mode == 4) {
#pragma unroll
            for (int ai = 0; ai < 2; ++ai)
#pragma unroll
                for (int m = 0; m < 4; ++m) { ADJ_ROW(ai, m); (void)v2; if (fq == 0) *(f32x4*)(WI + (size_t)(rowt + ai * HALF + m * 16) * 4) = v1[0]; asm volatile("" ::: "memory"); }
        } else if (mode == 0) {
#pragma unroll
            for (int ai = 0; ai < 2; ++ai)
#pragma unroll
                for (int m = 0; m < 4; ++m) { ADJ_ROW(ai, m); STORE_ROW(rowt + ai * HALF + m * 16); asm volatile("" ::: "memory"); }
        } else {
#pragma unroll
            for (int ai = 0; ai < 2; ++ai)
#pragma unroll
                for (int m = 0; m < 4; ++m) {
                    f32x4 nc[2], ns[2];
                    if ((ai * 4 + m) < 7) { const int k1 = ai * 4 + m + 1; const int t = (rowt + (k1 >> 2) * HALF + (k1 & 3) * 16) % SEQ;
#pragma unroll
                        for (int n = 0; n < 2; ++n) { nc[n] = *(const f32x4*)(cs + t * 32 + 8 * fq + 4 * n); ns[n] = *(const f32x4*)(sn + t * 32 + 8 * fq + 4 * n); } }
                    ADJ_ROW(ai, m);
                    if (mode == 2) {
                        float ss = 0.f;
#pragma unroll
                        for (int n = 0; n < 2; ++n)
#pragma unroll
                            for (int e = 0; e < 4; ++e) ss += v1[n][e] * v1[n][e] + v2[n][e] * v2[n][e];
                        ss += __shfl_xor(ss, 16); ss += __shfl_xor(ss, 32);
                        const float ri = __builtin_amdgcn_rsqf(ss * (1.f / 64.f) + EPS) * osc;
#pragma unroll
                        for (int n = 0; n < 2; ++n) { v1[n] = (v1[n] * ri) * *(LAS f32x4*)(wg + 4 * n); v2[n] = (v2[n] * ri) * *(LAS f32x4*)(wg + 32 + 4 * n); }
                    }
#pragma unroll
                    for (int n = 0; n < 2; ++n) { const f32x4 xa = v1[n], xb = v2[n]; v1[n] = xa * rc[n] - xb * rsn[n]; v2[n] = xb * rc[n] + xa * rsn[n]; }
                    STORE_ROW(rowt + ai * HALF + m * 16);
                    if ((ai * 4 + m) < 7) { rc[0] = nc[0]; rc[1] = nc[1]; rsn[0] = ns[0]; rsn[1] = ns[1]; }
                    asm volatile("" ::: "memory");
                }
        }
#undef ADJ_ROW
#undef STORE_ROW
    }
};
typedef _Float16 h16x8 __attribute__((ext_vector_type(8)));
typedef float f32x8 __attribute__((ext_vector_type(8)));
struct EpiResid {
    static constexpr bool PERM = true, AFTER_DRAIN = false;
    static constexpr int KREP = KREP_R, EREP = EREP_R, TCLS = 21;
    static constexpr int NVM = 36;
    const void* base; void* out; const float* gate;
    bf16_t* Hn; const float* lnn; const float* scn; float* SS; int do_next;
    int base_f32, out_f32;
    __device__ __forceinline__ void operator()(const f32x4 (&acc)[2][2][4][2], const Unit& u, int wr, int wc, int fr, int fq) const {
        const int row0 = u.pm * BM + wr * 64 + fr, col0 = u.pn * BM + wc * 32 + 8 * fq;
        const size_t bo = (size_t)((u.pm * BM) / SEQ) * 6144 + col0;
        f32x4 gv[2][2], vv[2][2];
#pragma unroll
        for (int bj = 0; bj < 2; ++bj)
#pragma unroll
            for (int n = 0; n < 2; ++n) { gv[bj][n] = *(const f32x4*)(gate + bo + bj * HALF + 4 * n);
                if (do_next) vv[bj][n] = *(const f32x4*)(lnn + col0 + bj * HALF + 4 * n) * (*(const f32x4*)(scn + bo + bj * HALF + 4 * n) + 1.f); }
#define RESID_ROW(AI, M, X0, X1, BJ) do { const int row_ = row0 + (AI) * HALF + (M) * 16; const size_t off_ = (size_t)row_ * DM + col0 + (BJ) * HALF; \
            if (out_f32) { *(f32x4*)((float*)out + off_) = X0; *(f32x4*)((float*)out + off_ + 4) = X1; } \
            else { f32x8 xx_; xx_[0] = X0[0]; xx_[1] = X0[1]; xx_[2] = X0[2]; xx_[3] = X0[3]; xx_[4] = X1[0]; xx_[5] = X1[1]; xx_[6] = X1[2]; xx_[7] = X1[3]; \
                   *(h16x8*)((_Float16*)out + off_) = __builtin_convertvector(xx_, h16x8); } \
            if (do_next) { ss += (X0[0] * X0[0] + X0[1] * X0[1]) + (X0[2] * X0[2] + X0[3] * X0[3]) + (X1[0] * X1[0] + X1[1] * X1[1]) + (X1[2] * X1[2] + X1[3] * X1[3]); \
                const f32x4 a0_ = X0 * vv[BJ][0], a1_ = X1 * vv[BJ][1]; \
                u32x4 w_; w_.x = cvtpk(a0_[0], a0_[1]); w_.y = cvtpk(a0_[2], a0_[3]); w_.z = cvtpk(a1_[0], a1_[1]); w_.w = cvtpk(a1_[2], a1_[3]); \
                *(u32x4*)(Hn + off_) = w_; } } while (0)
        if (base_f32) {
#pragma unroll
            for (int ai = 0; ai < 2; ++ai)
#pragma unroll
            for (int mh = 0; mh < 2; ++mh) {
                f32x4 bs[2][2][2];
#pragma unroll
                for (int mm = 0; mm < 2; ++mm) { const size_t off = (size_t)(row0 + ai * HALF + (2 * mh + mm) * 16) * DM + col0;
#pragma unroll
                    for (int bj = 0; bj < 2; ++bj) { bs[mm][bj][0] = *(const f32x4*)((const float*)base + off + bj * HALF); bs[mm][bj][1] = *(const f32x4*)((const float*)base + off + bj * HALF + 4); } }
#pragma unroll
                for (int mm = 0; mm < 2; ++mm) { const int m = 2 * mh + mm; float ss = 0.f;
#pragma unroll
                    for (int bj = 0; bj < 2; ++bj) { const f32x4 x0 = bs[mm][bj][0] + gv[bj][0] * acc[ai][bj][m][0], x1 = bs[mm][bj][1] + gv[bj][1] * acc[ai][bj][m][1]; RESID_ROW(ai, m, x0, x1, bj); }
                    if (do_next) { ss += __shfl_xor(ss, 16); ss += __shfl_xor(ss, 32); if (fq == 0) SS[(size_t)(row0 + ai * HALF + m * 16) * 16 + u.pn * 4 + wc] = ss; } }
                asm volatile("" ::: "memory");
            }
        } else {
#pragma unroll
            for (int ai = 0; ai < 2; ++ai) {
                h16x8 bh[4][2];
#pragma unroll
                for (int m = 0; m < 4; ++m) { const size_t off = (size_t)(row0 + ai * HALF + m * 16) * DM + col0;
#pragma unroll
                    for (int bj = 0; bj < 2; ++bj) bh[m][bj] = *(const h16x8*)((const _Float16*)base + off + bj * HALF); }
#pragma unroll
                for (int m = 0; m < 4; ++m) { float ss = 0.f;
#pragma unroll
                    for (int bj = 0; bj < 2; ++bj) { const f32x8 bf = __builtin_convertvector(bh[m][bj], f32x8);
                        const f32x4 x0 = (f32x4){bf[0], bf[1], bf[2], bf[3]} + gv[bj][0] * acc[ai][bj][m][0], x1 = (f32x4){bf[4], bf[5], bf[6], bf[7]} + gv[bj][1] * acc[ai][bj][m][1];
                        RESID_ROW(ai, m, x0, x1, bj); }
                    if (do_next) { ss += __shfl_xor(ss, 16); ss += __shfl_xor(ss, 32); if (fq == 0) SS[(size_t)(row0 + ai * HALF + m * 16) * 16 + u.pn * 4 + wc] = ss; } }
                asm volatile("" ::: "memory");
            }
        }
#undef RESID_ROW
    }
};
struct EpiSwiGLU {
    static constexpr bool PERM = true, AFTER_DRAIN = false;
    static constexpr int KREP = KREP_S, EREP = EREP_S, TCLS = 22;
    static constexpr int NVM = 20;
    bf16_t* ACT; const float* SS; const float* bg; const float* bu;
    __device__ __forceinline__ void operator()(const f32x4 (&acc)[2][2][4][2], const Unit& u, int wr, int wc, int fr, int fq) const {
        const int row0 = u.pm * BM + wr * 64 + fr, col0 = u.pn * HALF + wc * 32 + 8 * fq;
        const size_t bo = (size_t)((u.pm * BM) / SEQ) * DFF + col0;
        const f32x4 g0 = *(const f32x4*)(bg + bo), g1 = *(const f32x4*)(bg + bo + 4), u0 = *(const f32x4*)(bu + bo), u1 = *(const f32x4*)(bu + bo + 4);
        float rsv[2][4];
        { f32x4 p4[2][4];
#pragma unroll
          for (int ai = 0; ai < 2; ++ai)
#pragma unroll
              for (int m = 0; m < 4; ++m) p4[ai][m] = *(const f32x4*)(SS + (size_t)(row0 + ai * HALF + m * 16) * 16 + 4 * fq);
#pragma unroll
          for (int ai = 0; ai < 2; ++ai)
#pragma unroll
              for (int m = 0; m < 4; ++m) { float sq = (p4[ai][m][0] + p4[ai][m][1]) + (p4[ai][m][2] + p4[ai][m][3]); sq += __shfl_xor(sq, 16); sq += __shfl_xor(sq, 32);
                  rsv[ai][m] = __builtin_amdgcn_rsqf(sq * (1.f / DM) + EPS); } }
#pragma unroll
        for (int ai = 0; ai < 2; ++ai)
#pragma unroll
            for (int m = 0; m < 4; ++m) {
                const int row = row0 + ai * HALF + m * 16;
                const float rs = rsv[ai][m];
                const f32x4 ga[2] = {acc[ai][0][m][0] * rs + g0, acc[ai][0][m][1] * rs + g1}, ua[2] = {acc[ai][1][m][0] * rs + u0, acc[ai][1][m][1] * rs + u1};
                float r[8];
#pragma unroll
                for (int n = 0; n < 2; ++n)
#pragma unroll
                    for (int e = 0; e < 4; ++e) { const float g = ga[n][e]; r[4 * n + e] = g * __builtin_amdgcn_rcpf(1.f + ex2(-g * LOG2E)) * ua[n][e]; }
                u32x4 w; w.x = cvtpk(r[0], r[1]); w.y = cvtpk(r[2], r[3]); w.z = cvtpk(r[4], r[5]); w.w = cvtpk(r[6], r[7]);
                *(u32x4*)(ACT + (size_t)row * DFF + col0) = w;
            }
    }
};
}

#ifdef TPROBE
#define DTB(cls) do { if ((TPROBE >> (cls)) & 1) { if (threadIdx.x == 0) ((volatile LAS unsigned*)(lds + LDS_MISC))[13] = (unsigned)__builtin_amdgcn_s_memrealtime(); } } while (0)
#define DTE(cls) do { if ((TPROBE >> (cls)) & 1) { if (threadIdx.x == 0) { volatile LAS unsigned* m_ = (volatile LAS unsigned*)(lds + LDS_MISC); m_[12] = m_[12] + ((unsigned)__builtin_amdgcn_s_memrealtime() - m_[13]); } } } while (0)
#else
#define DTB(cls) do { } while (0)
#define DTE(cls) do { } while (0)
#endif
__device__ __forceinline__ void tr_item(const float* W, int ldw, int K, bf16_t* WT, int k0, int drow0, int sc, LAS float* scr, int lane) {
    float tv[32];
#pragma unroll
    for (int i = 0; i < 32; ++i) { const int kk = 2 * i + (lane >> 5); tv[i] = 0.f; if (sc >= 0) tv[i] = W[(size_t)(k0 + kk) * ldw + sc]; }
#pragma unroll
    for (int i = 0; i < 32; ++i) { const int kk = 2 * i + (lane >> 5); scr[kk * 33 + (lane & 31)] = tv[i]; }
    LDS_WAIT(); asm volatile("" ::: "memory");
    const int c = lane & 7;
#pragma unroll
    for (int j = 0; j < 4; ++j) { const int n = (lane >> 3) + 8 * j; const LAS float* s = scr + (8 * c) * 33 + n;
        u32x4 o; o.x = cvtpk(s[0 * 33], s[1 * 33]); o.y = cvtpk(s[2 * 33], s[3 * 33]); o.z = cvtpk(s[4 * 33], s[5 * 33]); o.w = cvtpk(s[6 * 33], s[7 * 33]);
        *(GAS u32x4*)(WT + (size_t)(drow0 + n) * K + k0 + 8 * c) = o; }
    LDS_WAIT(); asm volatile("" ::: "memory");
}

__device__ __forceinline__ void gemv32_ksplit(const float* wcol  , size_t ldw, const LAS float* cact  , LAS float* red  ,
                                              float* out  , size_t ldo, int nvalid  , float bias, int wave, int lane, int tid) {
    float acc[32];
#pragma unroll
    for (int i = 0; i < 32; ++i) acc[i] = 0.f;
    const float* w0 = wcol + (size_t)(128 * wave) * ldw;
    const LAS float* c0 = cact + (128 * wave) * 32;
    float wn[16];
#pragma unroll
    for (int j = 0; j < 16; ++j) wn[j] = w0[(size_t)j * ldw];
#pragma unroll 1
    for (int kk = 0; kk < 128; kk += 16) {
        float wv[16];
#pragma unroll
        for (int j = 0; j < 16; ++j) wv[j] = wn[j];
        if (kk + 16 < 128) {
#pragma unroll
            for (int j = 0; j < 16; ++j) wn[j] = w0[(size_t)(kk + 16 + j) * ldw];
        }
#pragma unroll
        for (int j = 0; j < 16; ++j) { const LAS f32x4* cp = (const LAS f32x4*)(c0 + (kk + j) * 32);
#pragma unroll
            for (int q = 0; q < 8; ++q) { const f32x4 c4 = cp[q]; acc[4 * q] += c4[0] * wv[j]; acc[4 * q + 1] += c4[1] * wv[j]; acc[4 * q + 2] += c4[2] * wv[j]; acc[4 * q + 3] += c4[3] * wv[j]; } }
    }
#pragma unroll
    for (int r = 0; r < 8; ++r) {
#pragma unroll
        for (int i = 0; i < 4; ++i) red[(wave * 4 + i) * 64 + lane] = acc[4 * r + i];
        __syncthreads();
        if (tid < 256) { const int bb = tid >> 6, cc = tid & 63; float sum = 0.f;
#pragma unroll
            for (int w = 0; w < 8; ++w) sum += red[(w * 4 + bb) * 64 + cc];
            if (cc < nvalid) out[(size_t)(4 * r + bb) * ldo + cc] = sum + bias; }
        __syncthreads();
    }
}

struct Args { const float* in[17]; float* out; unsigned char* ws; int lo, hi; };

__device__ __forceinline__ void prologue(const Args& a, LAS unsigned char* lds, int tid, int lane, int wave, int G) {
    unsigned char* ws = a.ws;
    const float* w_in = a.in[6]; const float* w_o = a.in[13]; const float* w_gate = a.in[14]; const float* w_up = a.in[15]; const float* w_down = a.in[16];
    LAS float* scr = (LAS float*)(lds + wave * 16384);
    const int gw = blockIdx.x * NWAVES + wave, NGW = G * NWAVES;
    constexpr int I_IN = 16 * 72, I_O = 16 * 32, I_GU = 16 * 176, I_D = 44 * 32, I_L = I_IN + I_O + I_GU + I_D;
#pragma unroll 1
    for (int pass = 0; pass < 2; ++pass) {
    if (((pass ^ (int)blockIdx.x) & 1) == 0) {
    for (int it = gw; it < DEPTH * I_L; it += NGW) {
        const int l = it / I_L; int r = it % I_L;
        bf16_t* wl = (bf16_t*)(ws + WS_W + (size_t)l * W_LAYER);
        if (r < I_IN) {
            const int kb = r / 72, nb = r % 72, np = 32 * nb + (lane & 31), p = np & 255;
            const int slot = (np >> 8) * 4 + ((p & 127) >> 5), dim = 32 * (p >> 7) + (p & 31);
            int sc = slot_col(slot) + dim; if (slot == 11 && dim >= 4) sc = -1;
            tr_item(w_in + (size_t)l * DM * INCOLS, INCOLS, DM, wl + W_IN / 2, 64 * kb, 32 * nb, sc, scr, lane); continue; }
        r -= I_IN;
        if (r < I_O) { const int kb = r / 32, nb = r % 32;
            tr_item(w_o + (size_t)l * DM * DM, DM, DM, wl + W_O / 2, 64 * kb, 32 * nb, 32 * nb + (lane & 31), scr, lane); continue; }
        r -= I_O;
        if (r < I_GU) { const int kb = r / 176, nb = r % 176, d0 = 32 * nb, p0 = d0 & 255;
            const float* src = (p0 < 128 ? w_gate : w_up) + (size_t)l * DM * DFF;
            tr_item(src, DFF, DM, wl + W_GU / 2, 64 * kb, d0, (d0 >> 8) * 128 + (p0 & 127) + (lane & 31), scr, lane); continue; }
        r -= I_GU;
        { const int kb = r / 32, nb = r % 32;
            tr_item(w_down + (size_t)l * DFF * DM, DM, DFF, wl + W_D / 2, 64 * kb, 32 * nb, 32 * nb + (lane & 31), scr, lane); }
    }
    {
        float* cs = (float*)(ws + WS_ROPE); float* sn = cs + SEQ * 32;
        for (int idx = blockIdx.x * 512 + tid; idx < SEQ * 32; idx += G * 512) {
            const int t = idx >> 5, i = idx & 31;
            double inv = 1.0; for (int k = 0; k < i; ++k) inv *= 0.7498942093324559;
            const float ang = (float)t * (float)inv;
            double rv = (double)ang * 0.15915494309189535; rv -= __builtin_floor(rv);
            const float fr = (float)rv;
            cs[idx] = __builtin_amdgcn_cosf(fr); sn[idx] = __builtin_amdgcn_sinf(fr);
        }
    }
    } else
    {
        const float* c = a.in[1]; const float* w_mod = a.in[4]; const float* b_mod = a.in[5];
        float* mod = (float*)(ws + WS_MOD);
        LAS float* cact = (LAS float*)lds;
        DTB(17);
        for (int idx = tid; idx < BATCH * DM; idx += 512) { const int b = idx >> 10, k = idx & 1023; const float v = c[idx]; cact[k * 32 + b] = v * __builtin_amdgcn_rcpf(1.f + ex2(-v * LOG2E)); }
        __syncthreads();
        for (int unit = blockIdx.x; unit < DEPTH * 6144 / 64; unit += G) {
            const int col = unit * 64 + lane, l = col / 6144, j = col % 6144;
            gemv32_ksplit(w_mod + (size_t)l * DM * 6144 + j, 6144, cact, (LAS float*)(lds + 131072), mod + (size_t)l * BATCH * 6144 + (j - lane), 6144, 64, b_mod[l * 6144 + j], wave, lane, tid);
        }
        DTE(17);
    }
    __syncthreads();
    }
}

__device__ __forceinline__ void prologue_b(const Args& a, LAS unsigned char* lds, int tid, int lane, int wave, int G) {
    unsigned char* ws = a.ws;
    const float* mod = (const float*)(ws + WS_MOD);
    LAS float* cact = (LAS float*)lds;
    constexpr int U_IN = (INCOLS + 63) / 64, U_FF = DFF / 64, U_L = U_IN + 2 * U_FF;
    for (int un = blockIdx.x; un < DEPTH * U_L; un += G) {
        const int l = un / U_L; int r = un % U_L; int type = 0; if (r >= U_IN) { r -= U_IN; type = 1; if (r >= U_FF) { r -= U_FF; type = 2; } }
        const float* shp = mod + (size_t)l * BATCH * 6144 + (type == 0 ? 0 : 3 * DM);
        for (int idx = tid; idx < BATCH * DM; idx += 512) { const int b = idx >> 10, k = idx & 1023; cact[k * 32 + b] = shp[(size_t)b * 6144 + k]; }
        __syncthreads();
        const int ncols = type == 0 ? INCOLS : DFF;
        const float* W = type == 0 ? a.in[6] + (size_t)l * DM * INCOLS : (type == 1 ? a.in[14] : a.in[15]) + (size_t)l * DM * DFF;
        const int col = r * 64 + lane, cc = col < ncols ? col : ncols - 1;
        const int ldb = type == 0 ? NIN : DFF;
        float* bo = (float*)(ws + (type == 0 ? WS_B1 : (type == 1 ? WS_BG : WS_BU))) + (size_t)l * BATCH * ldb + r * 64;
        gemv32_ksplit(W + cc, (size_t)ncols, cact, (LAS float*)(lds + 131072), bo, (size_t)ldb, ncols - r * 64 < 64 ? ncols - r * 64 : 64, 0.f, wave, lane, tid);
        __syncthreads();
    }
}

__device__ __forceinline__ float wsum_f(float v) {
#define DPP_ADD(CTRL, RM) v += __uint_as_float((unsigned)__builtin_amdgcn_update_dpp(0, (int)__float_as_uint(v), CTRL, RM, 0xf, false))
    DPP_ADD(0x111, 0xf); DPP_ADD(0x112, 0xf); DPP_ADD(0x114, 0xf); DPP_ADD(0x118, 0xf); DPP_ADD(0x142, 0xa); DPP_ADD(0x143, 0xc);
#undef DPP_ADD
    return __uint_as_float((unsigned)__builtin_amdgcn_readlane((int)__float_as_uint(v), 63));
}
__device__ __forceinline__ void pre_phase(const float* x, const float* ln, const float* modl  , bf16_t* H, float* SS, int lane, int gw, int NGW) {
    for (int m0 = 4 * gw; m0 < MROWS; m0 += 4 * NGW) {
        f32x4 v[4][4]; float s[4];
#pragma unroll
        for (int rr = 0; rr < 4; ++rr) { const GAS f32x4* xr = (const GAS f32x4*)(x + (size_t)(m0 + rr) * DM) + lane;
#pragma unroll
            for (int j = 0; j < 4; ++j) v[rr][j] = xr[64 * j]; }
#pragma unroll
        for (int rr = 0; rr < 4; ++rr) { float a = 0.f;
#pragma unroll
            for (int j = 0; j < 4; ++j) a += (v[rr][j].x * v[rr][j].x + v[rr][j].y * v[rr][j].y) + (v[rr][j].z * v[rr][j].z + v[rr][j].w * v[rr][j].w);
            s[rr] = wsum_f(a); }
        const int b = m0 / SEQ;
        const float* mb = modl + (size_t)b * 6144;
        f32x4 gv[4];
#pragma unroll
        for (int j = 0; j < 4; ++j) gv[j] = *((const GAS f32x4*)ln + lane + 64 * j) * (*((const GAS f32x4*)(mb + DM) + lane + 64 * j) + 1.f);
#pragma unroll
        for (int rr = 0; rr < 4; ++rr) {
            if (lane < 16) SS[(size_t)(m0 + rr) * 16 + lane] = (lane == 0) ? s[rr] : 0.f;
            GAS u32x2* o8 = (GAS u32x2*)(H + (size_t)(m0 + rr) * DM) + lane;
#pragma unroll
            for (int j = 0; j < 4; ++j) { const f32x4 y = v[rr][j] * gv[j]; u32x2 w; w.x = cvtpk(y.x, y.y); w.y = cvtpk(y.z, y.w); o8[64 * j] = w; }
        }
    }
}

__device__ __forceinline__ void store_head(const f32x16& o0, const f32x16& o1, float inv, const float* gout, bf16_t* orow, int h) {
    float ss = 0.f;
#pragma unroll
    for (int i = 0; i < 16; ++i) { const float a = o0[i] * inv, b = o1[i] * inv; ss += a * a + b * b; }
    ss += __shfl_xor(ss, 32);
    const float rn = __builtin_amdgcn_rsqf(ss * (1.f / 64.f) + EPS) * inv;
#pragma unroll
    for (int g = 0; g < 4; ++g) {
        const int d0 = 8 * g + 4 * h;
        const f32x4 ga = *(const f32x4*)(gout + d0), gb = *(const f32x4*)(gout + 32 + d0);
        u32x2 wa, wb;
        wa.x = cvtpk(o0[4 * g] * rn * ga[0], o0[4 * g + 1] * rn * ga[1]); wa.y = cvtpk(o0[4 * g + 2] * rn * ga[2], o0[4 * g + 3] * rn * ga[3]);
        wb.x = cvtpk(o1[4 * g] * rn * gb[0], o1[4 * g + 1] * rn * gb[1]); wb.y = cvtpk(o1[4 * g + 2] * rn * gb[2], o1[4 * g + 3] * rn * gb[3]);
        *(GAS u32x2*)(orow + d0) = wa; *(GAS u32x2*)(orow + 32 + d0) = wb;
    }
}

__device__ __forceinline__ void swa_unit(int b, int hc, int qt, const bf16_t* P, const bf16_t* VT, bf16_t* O, float M2, float sink2, const float* gout, int lane) {
    const int r = lane & 31, h = lane >> 5, t0 = qt * 32, kv = hc >> 2;
    const size_t rowbase = (size_t)b * SEQ;
    bf16x8 qf[4];
    { const bf16_t* qp = P + (rowbase + t0 + r) * NIN + (24 + hc) * 64 + 8 * h;
#pragma unroll
      for (int ks = 0; ks < 4; ++ks) qf[ks] = ldg16(qp + 16 * ks); }
    const bf16_t* kbase = P + rowbase * NIN + (32 + kv) * 64 + 8 * h + (size_t)r * NIN;
    const bf16_t* vbase = VT + ((size_t)(b * NVS + 5 + kv) * 64 + r) * SEQ + 8 * h;
    f32x16 o0 = zero16(), o1 = zero16(); float lsum = 0.f;
    const int t = t0 + r;
    const int kt_lo = qt - 4 < 0 ? 0 : qt - 4;
    bf16x8 kf[4];
#pragma unroll
    for (int ks = 0; ks < 4; ++ks) kf[ks] = ldg16(kbase + (size_t)(kt_lo * 32) * NIN + 16 * ks);
    for (int kt = kt_lo; kt <= qt; ++kt) {
        bf16x8 kn[4], vf[2][2];
#pragma unroll
        for (int dt = 0; dt < 2; ++dt)
#pragma unroll
            for (int s = 0; s < 2; ++s) vf[dt][s] = ldg16(vbase + (size_t)(dt * 32) * SEQ + kt * 32 + 16 * s);
        { const bf16_t* kp = kbase + (size_t)((kt < qt ? kt + 1 : kt) * 32) * NIN;
#pragma unroll
          for (int ks = 0; ks < 4; ++ks) kn[ks] = ldg16(kp + 16 * ks); }
        f32x16 sc = zero16();
#pragma unroll
        for (int ks = 0; ks < 4; ++ks) sc = MFMA32(kf[ks], qf[ks], sc);
#pragma unroll
        for (int i = 0; i < 16; ++i) { const int key = kt * 32 + crow(i, h); const bool valid = (unsigned)(t - key) < 128u;
            const float p = valid ? ex2(sc[i] - M2) : 0.f; sc[i] = p; lsum += p; }
        const bf16x8 p0 = pack8(sc, 0), p1 = pack8(sc, 1);
        o0 = MFMA32(vf[0][0], p0, o0); o0 = MFMA32(vf[0][1], p1, o0);
        o1 = MFMA32(vf[1][0], p0, o1); o1 = MFMA32(vf[1][1], p1, o1);
#pragma unroll
        for (int ks = 0; ks < 4; ++ks) kf[ks] = kn[ks];
    }
    lsum += __shfl_xor(lsum, 32); lsum += ex2(sink2 - M2);
    store_head(o0, o1, 1.f / lsum, gout, O + (rowbase + t0 + r) * DM + (8 + hc) * 64, h);
}

__device__ __forceinline__ void sb_unit(int b, int hb, int qt, const bf16_t* P, const bf16_t* VT, bf16_t* O, const float* gout, int lane) {
    const int r = lane & 31, h = lane >> 5, t0 = qt * 32;
    const size_t rowbase = (size_t)b * SEQ;
    bf16x8 qf[4];
    { const bf16_t* qp = P + (rowbase + t0 + r) * NIN + (12 + hb) * 64 + 8 * h;
#pragma unroll
      for (int ks = 0; ks < 4; ++ks) qf[ks] = ldg16(qp + 16 * ks); }
    const bf16_t* kbase = P + rowbase * NIN + (16 + hb) * 64 + 8 * h + (size_t)r * NIN;
    const bf16_t* vbase = VT + ((size_t)(b * NVS + 1 + hb) * 64 + r) * SEQ + 8 * h;
    f32x16 o0 = zero16(), o1 = zero16(); float C = 0.f;
    const int t = t0 + r;
    bf16x8 kf[4];
#pragma unroll
    for (int ks = 0; ks < 4; ++ks) kf[ks] = ldg16(kbase + (size_t)(qt * 32) * NIN + 16 * ks);
    for (int kt = qt; kt >= 0; --kt) {
        bf16x8 kn[4], vf[2][2];
#pragma unroll
        for (int dt = 0; dt < 2; ++dt)
#pragma unroll
            for (int s = 0; s < 2; ++s) vf[dt][s] = ldg16(vbase + (size_t)(dt * 32) * SEQ + kt * 32 + 16 * s);
        { const bf16_t* kp = kbase + (size_t)((kt > 0 ? kt - 1 : 0) * 32) * NIN;
#pragma unroll
          for (int ks = 0; ks < 4; ++ks) kn[ks] = ldg16(kp + 16 * ks); }
        f32x16 z = zero16();
#pragma unroll
        for (int ks = 0; ks < 4; ++ks) z = MFMA32(kf[ks], qf[ks], z);
        float L[16];
#pragma unroll
        for (int i = 0; i < 16; ++i) { const int key = kt * 32 + crow(i, h); const float zz = z[i];
            const float sp = RELU(zz) + lg2(1.f + ex2(-fabsf(zz)));
            L[i] = (key < t) ? -sp : 0.f; }
        float G4[4], Gp[4], ps[4], aft[4];
#pragma unroll
        for (int g = 0; g < 4; ++g) { G4[g] = (L[4 * g] + L[4 * g + 1]) + (L[4 * g + 2] + L[4 * g + 3]); Gp[g] = __shfl_xor(G4[g], 32); ps[g] = G4[g] + Gp[g]; }
        aft[3] = 0.f; aft[2] = ps[3]; aft[1] = aft[2] + ps[2]; aft[0] = aft[1] + ps[1];
#pragma unroll
        for (int g = 0; g < 4; ++g) {
            const float bg = C + aft[g] + (h == 0 ? Gp[g] : 0.f);
            const float b3 = bg, b2 = b3 + L[4 * g + 3], b1 = b2 + L[4 * g + 2], b0 = b1 + L[4 * g + 1];
            const float bt[4] = {b0, b1, b2, b3};
#pragma unroll
            for (int e = 0; e < 4; ++e) { const int i = 4 * g + e; const int key = kt * 32 + crow(i, h);
                z[i] = (key < t) ? ex2(z[i] + L[i] + bt[e]) : 0.f; }
        }
        C += aft[0] + ps[0];
        const bf16x8 p0 = pack8(z, 0), p1 = pack8(z, 1);
        o0 = MFMA32(vf[0][0], p0, o0); o0 = MFMA32(vf[0][1], p1, o0);
        o1 = MFMA32(vf[1][0], p0, o1); o1 = MFMA32(vf[1][1], p1, o1);
        if (__all(C < -160.f)) break;
#pragma unroll
        for (int ks = 0; ks < 4; ++ks) kf[ks] = kn[ks];
    }
    store_head(o0, o1, 1.f, gout, O + (rowbase + t0 + r) * DM + (4 + hb) * 64, h);
}

template <int NROWS, int VCH>
__device__ __forceinline__ void stage_kv(LAS unsigned char* ldsK, LAS unsigned char* ldsV, const bf16_t* kg  , const bf16_t* vg  , int tk0  , int tid) {
    constexpr int KCH = NROWS * 8 / 512, NTC = NROWS / 8, VCHT = 64 * NTC / 512;
    const int first_row = tk0 < 0 ? -tk0 : 0;
    const unsigned char* kb = (const unsigned char*)(kg + (size_t)(tk0 + first_row) * NIN);
    const unsigned char* vb = (const unsigned char*)(vg + (tk0 + first_row));
    u32x4 kr[KCH], vr[VCHT];
#pragma unroll
    for (int i = 0; i < KCH; ++i) { const int q = tid + 512 * i, row = q >> 3, c = q & 7; kr[i] = (u32x4){0u, 0u, 0u, 0u};
        if (row >= first_row) kr[i] = *(const GAS u32x4*)(kb + (unsigned)((row - first_row) * (NIN * 2) + 16 * c)); }
#pragma unroll
    for (int i = 0; i < VCHT; ++i) { const int q = tid + 512 * i, d = q / NTC, c = q % NTC; vr[i] = (u32x4){0u, 0u, 0u, 0u};
        if (8 * c >= first_row) vr[i] = *(const GAS u32x4*)(vb + (unsigned)(d * (SEQ * 2) + (8 * c - first_row) * 2)); }
#pragma unroll
    for (int i = 0; i < KCH; ++i) { const int q = tid + 512 * i, row = q >> 3, c = q & 7; *(LAS u32x4*)(ldsK + row * 128 + ((c ^ ((row >> 1) & 7)) << 4)) = kr[i]; }
#pragma unroll
    for (int i = 0; i < VCHT; ++i) { const int q = tid + 512 * i, d = q / NTC, c = q % NTC; *(LAS u32x4*)(ldsV + d * (VCH * 16) + ((c ^ (d & 15)) << 4)) = vr[i]; }
    asm volatile("" ::: "memory");
}
__device__ __forceinline__ bf16x8 lds_kfrag(LAS unsigned char* ldsK, int row, int ch) { return *(const LAS bf16x8*)(ldsK + row * 128 + ((ch ^ ((row >> 1) & 7)) << 4)); }
template <int VCH> __device__ __forceinline__ bf16x8 lds_vfrag(LAS unsigned char* ldsV, int d, int ch) { return *(const LAS bf16x8*)(ldsV + d * (VCH * 16) + ((ch ^ (d & 15)) << 4)); }

__device__ __forceinline__ void swa_block(int b, int kv, int qb, const bf16_t* P, const bf16_t* VT, bf16_t* O, float M2, const float* sinks  , const float* gout  ,
                                          LAS unsigned char* lds, int tid, int lane, int wave) {
    LAS unsigned char* ldsK = lds; LAS unsigned char* ldsV = lds + 32768;
    DTB(16);
    const int t0 = qb * 128, tk0 = t0 - 128;
    const size_t rowbase = (size_t)b * SEQ;
    const int r = lane & 31, h = lane >> 5, j = wave & 3, hc0 = kv * 4 + 2 * (wave >> 2), t0q = t0 + 32 * j;
    bf16x8 qf[2][4];
#pragma unroll
    for (int hd = 0; hd < 2; ++hd) { const bf16_t* qp = P + (rowbase + t0q + r) * NIN + (24 + hc0 + hd) * 64 + 8 * h;
#pragma unroll
        for (int ks = 0; ks < 4; ++ks) qf[hd][ks] = ldg16(qp + 16 * ks); }
    stage_kv<256, 32>(ldsK, ldsV, P + rowbase * NIN + (32 + kv) * 64, VT + ((size_t)(b * NVS + 5 + kv) * 64) * SEQ, tk0, tid);
    __syncthreads();
    f32x16 o[2][2]; o[0][0] = zero16(); o[0][1] = zero16(); o[1][0] = zero16(); o[1][1] = zero16();
    float ls[2] = {0.f, 0.f};
    const int t = t0q + r;
    for (int i = (tk0 < 0 && j < 4) ? (4 > j ? 4 : j) : j; i <= j + 4; ++i) {
        bf16x8 kf[4], vf[2][2];
#pragma unroll
        for (int ks = 0; ks < 4; ++ks) kf[ks] = lds_kfrag(ldsK, 32 * i + r, 2 * ks + h);
#pragma unroll
        for (int dt = 0; dt < 2; ++dt)
#pragma unroll
            for (int s2 = 0; s2 < 2; ++s2) vf[dt][s2] = lds_vfrag<32>(ldsV, 32 * dt + r, 4 * i + 2 * s2 + h);
#pragma unroll
        for (int hd = 0; hd < 2; ++hd) {
            f32x16 sc;
#pragma unroll
            for (int e = 0; e < 16; ++e) sc[e] = -M2;
#pragma unroll
            for (int ks = 0; ks < 4; ++ks) sc = MFMA32(kf[ks], qf[hd][ks], sc);
            if (i == j || i == j + 4) {
#pragma unroll
                for (int e = 0; e < 16; ++e) { const int key = tk0 + 32 * i + crow(e, h); const bool valid = (unsigned)(t - key) < 128u;
                    const float p = valid ? ex2(sc[e]) : 0.f; sc[e] = p; ls[hd] += p; }
            } else {
#pragma unroll
                for (int e = 0; e < 16; ++e) { const float p = ex2(sc[e]); sc[e] = p; ls[hd] += p; }
            }
            const bf16x8 p0 = pack8(sc, 0), p1 = pack8(sc, 1);
            o[hd][0] = MFMA32(vf[0][0], p0, o[hd][0]); o[hd][0] = MFMA32(vf[0][1], p1, o[hd][0]);
            o[hd][1] = MFMA32(vf[1][0], p0, o[hd][1]); o[hd][1] = MFMA32(vf[1][1], p1, o[hd][1]);
        }
    }
#pragma unroll
    for (int hd = 0; hd < 2; ++hd) {
        float l2 = ls[hd]; l2 += __shfl_xor(l2, 32); l2 += ex2(sinks[hc0 + hd] * LOG2E - M2);
        store_head(o[hd][0], o[hd][1], 1.f / l2, gout + (8 + hc0 + hd) * 64, O + (rowbase + t0q + r) * DM + (8 + hc0 + hd) * 64, h);
    }
    __syncthreads();
    DTE(16);
}

__device__ __forceinline__ void sb_block(int b, int hb, int qb, const bf16_t* P, const bf16_t* VT, bf16_t* O, const float* gout  , LAS unsigned char* lds, int tid, int lane, int wave) {
    LAS unsigned char* ldsK = lds; LAS unsigned char* ldsV = lds + 57344;
    const int t0 = qb * 256, tk0 = t0 - 192;
    const size_t rowbase = (size_t)b * SEQ;
    const int r = lane & 31, h = lane >> 5, t0q = t0 + 32 * wave;
    bf16x8 qf[4];
    { const bf16_t* qp = P + (rowbase + t0q + r) * NIN + (12 + hb) * 64 + 8 * h;
#pragma unroll
      for (int ks = 0; ks < 4; ++ks) qf[ks] = ldg16(qp + 16 * ks); }
    const bf16_t* kg = P + rowbase * NIN + (16 + hb) * 64;
    const bf16_t* vg = VT + ((size_t)(b * NVS + 1 + hb) * 64) * SEQ;
    stage_kv<448, 64>(ldsK, ldsV, kg, vg, tk0, tid);
    __syncthreads();
    f32x16 o0 = zero16(), o1 = zero16(); float C = 0.f;
    const int t = t0q + r;
#pragma unroll 1
    for (int kt = t0q >> 5; kt >= 0; --kt) {
        bf16x8 kf[4], vf[2][2];
        const int i = kt - (tk0 >> 5);
        if (i >= 0) {
#pragma unroll
            for (int ks = 0; ks < 4; ++ks) kf[ks] = lds_kfrag(ldsK, 32 * i + r, 2 * ks + h);
#pragma unroll
            for (int dt = 0; dt < 2; ++dt)
#pragma unroll
                for (int s2 = 0; s2 < 2; ++s2) vf[dt][s2] = lds_vfrag<64>(ldsV, 32 * dt + r, 4 * i + 2 * s2 + h);
        } else {
            const bf16_t* kp = kg + (size_t)(kt * 32 + r) * NIN + 8 * h;
#pragma unroll
            for (int ks = 0; ks < 4; ++ks) kf[ks] = ldg16(kp + 16 * ks);
#pragma unroll
            for (int dt = 0; dt < 2; ++dt)
#pragma unroll
                for (int s2 = 0; s2 < 2; ++s2) vf[dt][s2] = ldg16(vg + (size_t)(dt * 32 + r) * SEQ + kt * 32 + 16 * s2 + 8 * h);
        }
        f32x16 z = zero16();
#pragma unroll
        for (int ks = 0; ks < 4; ++ks) z = MFMA32(kf[ks], qf[ks], z);
        float L[16];
        const bool diag = (kt == (t0q >> 5));
#pragma unroll
        for (int e = 0; e < 16; ++e) { const float zz = z[e];
            L[e] = -(RELU(zz) + lg2(1.f + ex2(-fabsf(zz)))); }
        if (diag) {
#pragma unroll
            for (int e = 0; e < 16; ++e) { const int key = kt * 32 + crow(e, h); L[e] = (key < t) ? L[e] : 0.f; }
        }
        float G4[4], Gp[4], ps[4], aft[4];
#pragma unroll
        for (int g = 0; g < 4; ++g) { G4[g] = (L[4 * g] + L[4 * g + 1]) + (L[4 * g + 2] + L[4 * g + 3]); Gp[g] = __shfl_xor(G4[g], 32); ps[g] = G4[g] + Gp[g]; }
        aft[3] = 0.f; aft[2] = ps[3]; aft[1] = aft[2] + ps[2]; aft[0] = aft[1] + ps[1];
#pragma unroll
        for (int g = 0; g < 4; ++g) {
            const float bg = C + aft[g] + (h == 0 ? Gp[g] : 0.f);
            const float b3 = bg, b2 = b3 + L[4 * g + 3], b1 = b2 + L[4 * g + 2], b0 = b1 + L[4 * g + 1];
            const float bt[4] = {b0, b1, b2, b3};
#pragma unroll
            for (int e = 0; e < 4; ++e) { const int ii = 4 * g + e; z[ii] = ex2(z[ii] + L[ii] + bt[e]); }
        }
        C += aft[0] + ps[0];
        if (diag) {
#pragma unroll
            for (int e = 0; e < 16; ++e) { const int key = kt * 32 + crow(e, h); z[e] = (key < t) ? z[e] : 0.f; }
        }
        const bf16x8 p0 = pack8(z, 0), p1 = pack8(z, 1);
        o0 = MFMA32(vf[0][0], p0, o0); o0 = MFMA32(vf[0][1], p1, o0);
        o1 = MFMA32(vf[1][0], p0, o1); o1 = MFMA32(vf[1][1], p1, o1);
        if (__all(C < -160.f)) break;
    }
    store_head(o0, o1, 1.f, gout + (4 + hb) * 64, O + (rowbase + t0q + r) * DM + (4 + hb) * 64, h);
    __syncthreads();
}

__device__ __forceinline__ void group_sync(volatile LAS unsigned* cnt, unsigned& target, int lane) {
    asm volatile("s_waitcnt lgkmcnt(0)" ::: "memory");
    target += 4u;
    if (lane == 0) __hip_atomic_fetch_add((LAS unsigned*)cnt, 1u, __ATOMIC_RELAXED, __HIP_MEMORY_SCOPE_WORKGROUP);
    while (*cnt - (target - 4u) < 4u) __builtin_amdgcn_s_sleep(1);
    asm volatile("" ::: "memory");
}
__device__ __forceinline__ void dsa_phase(const bf16_t* P, const bf16_t* VT, const float* WI, bf16_t* O, const float* gout  , float M2, unsigned* queue,
                                          LAS unsigned char* lds, int tid, int lane, int wave) {
    const int grp = wave >> 2, gwv = wave & 3;
    LAS unsigned char* gl = lds + grp * G2_BYTES;
    LAS _Float16* SC = (LAS _Float16*)(gl + G2_SC);
    LAS float* PART = (LAS float*)(gl + G2_SC);
    LAS unsigned* MASK = (LAS unsigned*)(gl + G2_MASK);
    LAS float* LSUM = (LAS float*)(gl + G2_LSUM);
    LAS float* SSUM = (LAS float*)(gl + G2_SSUM);
    volatile LAS unsigned* QW = (volatile LAS unsigned*)(lds + LDS_MISC) + 2 * grp;
    volatile LAS unsigned* GC = (volatile LAS unsigned*)(lds + LDS_MISC) + 8 + grp;
    unsigned gtarget = *GC;
    __syncthreads();
#define GSYNC() group_sync(GC, gtarget, lane)
    constexpr int NU = BATCH * 128, NUX = NU / 8;
    const unsigned xq = xb_xcc_id() & 7u;
#define FETCH_UNIT(DST) do { unsigned got_ = (unsigned)NU; \
        for (unsigned k_ = 0; k_ < 8u; ++k_) { const unsigned x_ = (xq + k_) & 7u; \
            if (__hip_atomic_load(queue + 16 * x_, __ATOMIC_RELAXED, __HIP_MEMORY_SCOPE_AGENT) >= (unsigned)NUX) continue; \
            const unsigned i_ = __hip_atomic_fetch_add(queue + 16 * x_, 1u, __ATOMIC_RELAXED, __HIP_MEMORY_SCOPE_AGENT); \
            if (i_ < (unsigned)NUX) { got_ = x_ * NUX + i_; break; } } \
        DST = got_; } while (0)
#define FETCH_EARLY() __hip_atomic_fetch_add(queue + 16 * xq, 1u, __ATOMIC_RELAXED, __HIP_MEMORY_SCOPE_AGENT)
#define FETCH_LATE(DST, I0) do { unsigned got_ = (unsigned)NU; \
        if ((I0) < (unsigned)NUX) got_ = xq * NUX + (I0); \
        else for (unsigned k_ = 1; k_ < 8u; ++k_) { const unsigned x_ = (xq + k_) & 7u; \
            if (__hip_atomic_load(queue + 16 * x_, __ATOMIC_RELAXED, __HIP_MEMORY_SCOPE_AGENT) >= (unsigned)NUX) continue; \
            const unsigned i_ = __hip_atomic_fetch_add(queue + 16 * x_, 1u, __ATOMIC_RELAXED, __HIP_MEMORY_SCOPE_AGENT); \
            if (i_ < (unsigned)NUX) { got_ = x_ * NUX + i_; break; } } \
        DST = got_; } while (0)
#define UNIT_B(Q) (4 * ((Q) / NUX) + (((Q) % NUX) & 3))
#define UNIT_TAU(Q) (127 - (((Q) % NUX) >> 2))
    if (gwv == 0 && lane == 0) FETCH_UNIT(QW[0]);
    GSYNC();
    int q = (int)QW[0], par = 0;
    bf16x8 qi[4][2]; f32x4 wq;
    { const int c = lane & 15, g = lane >> 4; const int qq = q < NU ? q : 0; const size_t row = (size_t)UNIT_B(qq) * SEQ + 16 * UNIT_TAU(qq) + c;
      const bf16_t* qp = P + row * NIN + 4 * 64 + 8 * g;
#pragma unroll
      for (int hh = 0; hh < 4; ++hh) { qi[hh][0] = ldg16(qp + hh * 64); qi[hh][1] = ldg16(qp + hh * 64 + 32); }
      wq = *(const GAS f32x4*)(WI + row * 4); }
    while (q < NU) {
        const int tau = UNIT_TAU(q), b = UNIT_B(q), t0 = 16 * tau;
        const size_t rowbase = (size_t)b * SEQ;
        DTB(12);
        unsigned fu0 = 0u;
        if (gwv == 0 && lane == 0) fu0 = FETCH_EARLY();
        {
            int lane1 = lane; asm volatile("" : "+v"(lane1));
            const int c = lane1 & 15, g = lane1 >> 4;
            const bf16_t* kp0 = P + (rowbase + c) * NIN + 10 * 64 + 8 * g;
#define IDX_TILE(KT, K0, K1) do { f32x4 sc_ = {0.f, 0.f, 0.f, 0.f}, a_[4]; \
                _Pragma("unroll") for (int hh = 0; hh < 4; ++hh) a_[hh] = MFMA16(K0, qi[hh][0], ((f32x4){0.f, 0.f, 0.f, 0.f}));        \
                _Pragma("unroll") for (int hh = 0; hh < 4; ++hh) a_[hh] = MFMA16(K1, qi[hh][1], a_[hh]); \
                asm volatile("" : "+v"(a_[0]), "+v"(a_[1]), "+v"(a_[2]), "+v"(a_[3])); \
                _Pragma("unroll") for (int hh = 0; hh < 4; ++hh) { \
                    _Pragma("unroll") for (int j = 0; j < 4; ++j) sc_[j] += wq[hh] * RELU(a_[hh][j]); } \
                LAS _Float16* sp_ = SC + c * SCH + (16 * ((KT) & 1) + 4 * g) * 64 + ((KT) >> 1);     \
                sp_[0] = (_Float16)sc_[0]; sp_[64] = (_Float16)sc_[1]; sp_[128] = (_Float16)sc_[2]; sp_[192] = (_Float16)sc_[3]; } while (0)
            bf16x8 ka0 = qi[0][0], ka1 = qi[0][1], kb0 = qi[0][0], kb1 = qi[0][1];
            if (gwv <= tau) { const bf16_t* kp = kp0 + (size_t)(gwv * 16) * NIN; ka0 = ldg16(kp); ka1 = ldg16(kp + 32); }
            if (gwv + 4 <= tau) { const bf16_t* kp = kp0 + (size_t)((gwv + 4) * 16) * NIN; kb0 = ldg16(kp); kb1 = ldg16(kp + 32); }
            for (int kt = gwv; kt <= tau; kt += 8) {
                bf16x8 na0 = ka0, na1 = ka1, nb0 = kb0, nb1 = kb1;
                if (kt + 8 <= tau) { const bf16_t* kp = kp0 + (size_t)((kt + 8) * 16) * NIN; na0 = ldg16(kp); na1 = ldg16(kp + 32); }
                if (kt + 12 <= tau) { const bf16_t* kp = kp0 + (size_t)((kt + 12) * 16) * NIN; nb0 = ldg16(kp); nb1 = ldg16(kp + 32); }
                IDX_TILE(kt, ka0, ka1);
                if (kt + 4 <= tau) IDX_TILE(kt + 4, kb0, kb1);
                ka0 = na0; ka1 = na1; kb0 = nb0; kb1 = nb1;
            }
#undef IDX_TILE
        }
        bf16x8 qf[2][4];
        { int lane2 = lane; asm volatile("" : "+v"(lane2));
          const int r = lane2 & 31, h = lane2 >> 5, c = r & 15;
#pragma unroll
          for (int nt = 0; nt < 2; ++nt) { const bf16_t* qp = P + (rowbase + t0 + c) * NIN + (2 * nt + (r >> 4)) * 64 + 8 * h;
#pragma unroll
              for (int ks = 0; ks < 4; ++ks) qf[nt][ks] = ldg16(qp + 16 * ks); } }
        GSYNC();
        DTE(12); DTB(13);
#define SEL_LOAD(PL, R) do { _Pragma("unroll") for (int i = 0; i < 16; ++i) { \
                const unsigned lo_ = (unsigned)__builtin_bit_cast(unsigned short, SC[(R) * SCH + 64 * i + lane]), hi_ = (unsigned)__builtin_bit_cast(unsigned short, SC[(R) * SCH + 64 * (i + 16) + lane]); \
                PL[i] = lo_ | (hi_ << 16); } } while (0)
#define TSTAGE(PL, J, MSK) _Pragma("unroll") for (int k_ = 0; k_ < 16; ++k_) if ((k_ & (J)) == 0) { const unsigned lo_ = PL[k_], hi_ = PL[k_ + (J)]; \
                PL[k_] = (lo_ & (MSK)) | ((hi_ << (J)) & ~(MSK)); PL[k_ + (J)] = ((lo_ >> (J)) & (MSK)) | (hi_ & ~(MSK)); }
#define SEL_PLANES(PL) do { TSTAGE(PL, 8, 0x00ff00ffu) TSTAGE(PL, 4, 0x0f0f0f0fu) TSTAGE(PL, 2, 0x33333333u) TSTAGE(PL, 1, 0x55555555u) \
                _Pragma("unroll") for (int bq = 0; bq < 15; ++bq) PL[bq] ^= PL[15]; PL[15] = ~PL[15]; } while (0)
#define SEL_STEP(PL, X, C, A, G, CNTG, NA, DONE) do { if (!DONE) { if (CNTG + C >= 256) { A = X; NA = C; } else { G |= X; CNTG += C; A &= ~PL; NA -= C; } DONE = (CNTG + NA == 256); } } while (0)
#define SEL_TIES(A, CNTG) do { const int need_ = 256 - CNTG, pc_ = __builtin_popcount(A); int inc_ = pc_; \
                inc_ += __builtin_amdgcn_update_dpp(0, inc_, 0x111, 0xf, 0xf, false); inc_ += __builtin_amdgcn_update_dpp(0, inc_, 0x112, 0xf, 0xf, false); \
                inc_ += __builtin_amdgcn_update_dpp(0, inc_, 0x114, 0xf, 0xf, false); inc_ += __builtin_amdgcn_update_dpp(0, inc_, 0x118, 0xf, 0xf, false); \
                inc_ += __builtin_amdgcn_update_dpp(0, inc_, 0x142, 0xa, 0xf, false); inc_ += __builtin_amdgcn_update_dpp(0, inc_, 0x143, 0xc, 0xf, false); \
                int take_ = need_ - (inc_ - pc_); take_ = take_ < 0 ? 0 : (take_ > pc_ ? pc_ : take_); \
                while (__builtin_popcount(A) > take_) A &= ~(0x80000000u >> __builtin_clz(A)); } while (0)
#pragma unroll 1
        for (int rp = 0; rp < 2; ++rp) {
            const int ra = 4 * gwv + 2 * rp, rb = ra + 1, na = t0 + ra + 1, nb = na + 1;
            const int cva = na - 32 * lane, cvb = nb - 32 * lane;
            unsigned Aa = cva >= 32 ? ~0u : (cva <= 0 ? 0u : ((1u << cva) - 1u)), Ab = cvb >= 32 ? ~0u : (cvb <= 0 ? 0u : ((1u << cvb) - 1u));
            unsigned Ga = 0u, Gb = 0u; int cntGa = 0, cntGb = 0, nAa = na, nAb = nb;
            bool donea = (na <= 256), doneb = (nb <= 256);
            if (!(donea && doneb)) {
                unsigned PA[16], PB[16];
                SEL_LOAD(PA, ra); SEL_LOAD(PB, rb);
                SEL_PLANES(PA); SEL_PLANES(PB);
#pragma unroll
                for (int bq = 15; bq >= 0; --bq) {
                    if (!(donea && doneb)) {
                        const unsigned Xa = Aa & PA[bq], Xb = Ab & PB[bq];
                        const unsigned tot = (unsigned)wsum_i(__builtin_popcount(Xa) + (__builtin_popcount(Xb) << 16));
                        const int ca = (int)(tot & 0xffffu), cb = (int)(tot >> 16);
                        SEL_STEP(PA[bq], Xa, ca, Aa, Ga, cntGa, nAa, donea);
                        SEL_STEP(PB[bq], Xb, cb, Ab, Gb, cntGb, nAb, doneb);
                    }
                }
                if (!donea) SEL_TIES(Aa, cntGa);
                if (!doneb) SEL_TIES(Ab, cntGb);
            }
            MASK[ra * MASK_STRIDE + lane] = Ga | Aa;
            MASK[rb * MASK_STRIDE + lane] = Gb | Ab;
        }
#undef SEL_LOAD
#undef TSTAGE
#undef SEL_PLANES
#undef SEL_STEP
#undef SEL_TIES
        if (gwv == 0 && lane == 0) FETCH_LATE(QW[par ^ 1], fu0);
        GSYNC();
        DTE(13); DTB(14);
        {
            int lane3 = lane; asm volatile("" : "+v"(lane3));
            const int r = lane3 & 31, h = lane3 >> 5, c = r & 15;
            f32x16 o[2][2]; float ls[2];
            o[0][0] = zero16(); o[0][1] = zero16(); o[1][0] = zero16(); o[1][1] = zero16(); ls[0] = 0.f; ls[1] = 0.f;
            const int nkt = ((t0 + 15) >> 5) + 1;
            f32x16 negm2; _Pragma("unroll") for (int i = 0; i < 16; ++i) negm2[i] = -M2;
            asm volatile("" : "+v"(negm2));
#define ATT_TILE(KT, KF, VF) do { const unsigned mw_ = MASK[c * MASK_STRIDE + (KT)] >> (4 * h); \
                int mk_[16]; _Pragma("unroll") for (int i = 0; i < 16; ++i) mk_[i] = __builtin_amdgcn_sbfe((int)mw_, crow(i, 0), 1);        \
                _Pragma("unroll") for (int nt = 0; nt < 2; ++nt) { \
                    f32x16 sc_ = negm2; \
                    _Pragma("unroll") for (int ks = 0; ks < 4; ++ks) sc_ = MFMA32(KF[ks], qf[nt][ks], sc_); \
                    _Pragma("unroll") for (int i = 0; i < 16; ++i) { const float p_ = __builtin_bit_cast(float, __builtin_bit_cast(int, ex2(sc_[i])) & mk_[i]); sc_[i] = p_; ls[nt] += p_; } \
                    const bf16x8 p0_ = pack8(sc_, 0), p1_ = pack8(sc_, 1); \
                    o[nt][0] = MFMA32(VF[0][0], p0_, o[nt][0]); o[nt][0] = MFMA32(VF[0][1], p1_, o[nt][0]); \
                    o[nt][1] = MFMA32(VF[1][0], p0_, o[nt][1]); o[nt][1] = MFMA32(VF[1][1], p1_, o[nt][1]); } } while (0)
            LAS unsigned char* const wslot = (LAS unsigned char*)PART + gwv * 16384;
            const unsigned char* const kgb = (const unsigned char*)(P + rowbase * NIN + 8 * 64);
            const unsigned char* const vgb = (const unsigned char*)(VT + ((size_t)(b * NVS) * 64) * SEQ);
            unsigned koff[4], voff[4];
#pragma unroll
            for (int i = 0; i < 4; ++i) { const int row = 8 * i + (lane3 >> 3), ch = (lane3 & 7) ^ ((row >> 1) & 7); koff[i] = (unsigned)(row * (NIN * 2) + 16 * ch);
                const int d = 16 * i + (lane3 >> 2), cv = (lane3 & 3) ^ ((d >> 2) & 3); voff[i] = (unsigned)(d * (SEQ * 2) + 16 * cv); }
#define DMA_TILE(KT, SLOT) do { const unsigned char* kt_ = kgb + (size_t)((KT) * 32) * (NIN * 2); const unsigned char* vt_ = vgb + (size_t)(KT) * 64; \
                _Pragma("unroll") for (int i = 0; i < 4; ++i) __builtin_amdgcn_global_load_lds((const unsigned*)(kt_ + koff[i]), (LAS unsigned*)(wslot + (SLOT) * 8192 + 1024 * i), 16, 0, 0); \
                _Pragma("unroll") for (int i = 0; i < 4; ++i) __builtin_amdgcn_global_load_lds((const unsigned*)(vt_ + voff[i]), (LAS unsigned*)(wslot + (SLOT) * 8192 + 4096 + 1024 * i), 16, 0, 0); } while (0)
            const int ntl = gwv < nkt ? (nkt - gwv + 3) >> 2 : 0;
            if (ntl > 0) DMA_TILE(gwv, 0);
            if (ntl > 1) DMA_TILE(gwv + 4, 1);
            for (int j = 0; j < ntl; ++j) {
                const int kt = gwv + 4 * j;
                if (j + 1 < ntl) asm volatile("s_waitcnt vmcnt(8)" ::: "memory"); else asm volatile("s_waitcnt vmcnt(0)" ::: "memory");
                LAS unsigned char* const sl = wslot + (j & 1) * 8192;
                bf16x8 kf[4], vf[2][2];
#pragma unroll
                for (int ks = 0; ks < 4; ++ks) kf[ks] = *(const LAS bf16x8*)(sl + r * 128 + (((2 * ks + h) ^ ((r >> 1) & 7)) << 4));
#pragma unroll
                for (int dt = 0; dt < 2; ++dt)
#pragma unroll
                    for (int s2 = 0; s2 < 2; ++s2) { const int d = 32 * dt + r; vf[dt][s2] = *(const LAS bf16x8*)(sl + 4096 + d * 64 + (((2 * s2 + h) ^ ((d >> 2) & 3)) << 4)); }
                asm volatile("s_waitcnt lgkmcnt(0)" ::: "memory");
                if (j + 2 < ntl) DMA_TILE(kt + 8, j & 1);
                ATT_TILE(kt, kf, vf);
            }
            asm volatile("s_waitcnt vmcnt(0) lgkmcnt(0)" ::: "memory");
#undef DMA_TILE
#undef ATT_TILE
#pragma unroll
            for (int nt = 0; nt < 2; ++nt) {
#pragma unroll
                for (int dt = 0; dt < 2; ++dt)
#pragma unroll
                    for (int i = 0; i < 16; ++i) PART[(gwv * 64 + 32 * dt + crow(i, h)) * 64 + 32 * nt + r] = o[nt][dt][i];
                float l2 = ls[nt]; l2 += __shfl_xor(l2, 32);
                if (h == 0) LSUM[gwv * 64 + 32 * nt + r] = l2;
            }
        }
        const int qn = (int)QW[par ^ 1];
        { int lane4 = lane; asm volatile("" : "+v"(lane4));
          const int c = lane4 & 15, g = lane4 >> 4; const int qq = qn < NU ? qn : 0; const size_t row = (size_t)UNIT_B(qq) * SEQ + 16 * UNIT_TAU(qq) + c;
          const bf16_t* qp = P + row * NIN + 4 * 64 + 8 * g;
#pragma unroll
          for (int hh = 0; hh < 4; ++hh) { qi[hh][0] = ldg16(qp + hh * 64); qi[hh][1] = ldg16(qp + hh * 64 + 32); }
          wq = *(const GAS f32x4*)(WI + row * 4); }
        GSYNC();
        DTE(14); DTB(15);
        {
            int n = lane; asm volatile("" : "+v"(n));
            float l = 0.f;
#pragma unroll
            for (int w = 0; w < 4; ++w) l += LSUM[w * 64 + n];
            const float inv = 1.f / l;
            float ov[16]; float ssp = 0.f;
#pragma unroll
            for (int dd = 0; dd < 16; ++dd) { float a = 0.f;
#pragma unroll
                for (int w = 0; w < 4; ++w) a += PART[(w * 64 + 16 * gwv + dd) * 64 + n];
                ov[dd] = a * inv; ssp += ov[dd] * ov[dd]; }
            SSUM[gwv * 64 + n] = ssp;
            GSYNC();
            float ss = 0.f;
#pragma unroll
            for (int w = 0; w < 4; ++w) ss += SSUM[w * 64 + n];
            const float rn = __builtin_amdgcn_rsqf(ss * (1.f / 64.f) + EPS);
            const int head = n >> 4, c = n & 15;
            bf16_t* op = O + (rowbase + t0 + c) * DM + head * 64 + 16 * gwv;
#pragma unroll
            for (int hf = 0; hf < 2; ++hf) {
                const f32x4 ga = *(const f32x4*)(gout + head * 64 + 16 * gwv + 8 * hf), gb = *(const f32x4*)(gout + head * 64 + 16 * gwv + 8 * hf + 4);
                u32x4 wv; wv.x = cvtpk(ov[8 * hf] * rn * ga[0], ov[8 * hf + 1] * rn * ga[1]); wv.y = cvtpk(ov[8 * hf + 2] * rn * ga[2], ov[8 * hf + 3] * rn * ga[3]);
                wv.z = cvtpk(ov[8 * hf + 4] * rn * gb[0], ov[8 * hf + 5] * rn * gb[1]); wv.w = cvtpk(ov[8 * hf + 6] * rn * gb[2], ov[8 * hf + 7] * rn * gb[3]);
                *(GAS u32x4*)(op + 8 * hf) = wv; }
        }
        GSYNC();
        DTE(15);
        q = qn; par ^= 1;
    }
#undef GSYNC
#undef FETCH_UNIT
#undef FETCH_EARLY
#undef FETCH_LATE
#undef UNIT_B
#undef UNIT_TAU
}

typedef const __attribute__((address_space(4))) char* kargp_t;
#define KP() kargp_t kp_ = (kargp_t)__builtin_amdgcn_kernarg_segment_ptr(); asm volatile("" : "+s"(kp_)); unsigned char* const ws = *(unsigned char* const __attribute__((address_space(4)))*)(kp_ + 144); (void)ws
#define AIN(k) (*(const float* const __attribute__((address_space(4)))*)(kp_ + 8 * (k)))
#define AOUT() (*(float* const __attribute__((address_space(4)))*)(kp_ + 136))
static_assert(sizeof(Args) == 160, "Args layout: in[17] | out | ws | lo | hi");
__global__ void __launch_bounds__(NWAVES * 64, 2) fwd(Args args) {
    extern __shared__ __attribute__((aligned(16))) unsigned char lds_raw[];
    LAS unsigned char* lds = (LAS unsigned char*)lds_raw;
    const int wave = __builtin_amdgcn_readfirstlane(threadIdx.x >> 6);
    const int G = gridDim.x;
    const int gw = blockIdx.x * NWAVES + wave, NGW = G * NWAVES;
    volatile LAS unsigned* MISC = (volatile LAS unsigned*)(lds + LDS_MISC);
    if (threadIdx.x < 16) MISC[threadIdx.x] = 0u;
    __syncthreads();
    XcdBarrier bar; bar.bar = (unsigned*)(args.ws + WS_CTL) + CW_BAR; bar.x = 0; bar.st = nullptr; bar.w = wave;
    if (!MK_MULTI) bar = xcd_barrier_post((unsigned*)(args.ws + WS_CTL) + CW_BAR, MISC + 4, wave);
    const int lo = args.lo, hi = args.hi;
#define IN(k) (lo <= (k) && (k) < hi)
#define SEAM(k) do { if (IN(k) && IN((k) + 1)) xcd_barrier(bar); } while (0)
#define OPQ() int tid = wave * 64 + lane_id_v(); asm volatile("" : "+v"(tid)); const int lane = tid & 63; (void)lane
#ifdef TPROBE
#define TBEG(cls) do { if ((TPROBE >> (cls)) & 1) { if (threadIdx.x == 0) MISC[13] = (unsigned)__builtin_amdgcn_s_memrealtime(); } } while (0)
#define TEND(cls) do { if ((TPROBE >> (cls)) & 1) { if (threadIdx.x == 0) MISC[12] = MISC[12] + ((unsigned)__builtin_amdgcn_s_memrealtime() - MISC[13]); } } while (0)
#else
#define TBEG(cls) do { } while (0)
#define TEND(cls) do { } while (0)
#endif
#ifdef TPROBE_BODY
#define TENDB(cls) TEND(cls)
#define TENDS(cls) do { } while (0)
#else
#define TENDB(cls) do { } while (0)
#define TENDS(cls) TEND(cls)
#endif
    TBEG(0);
    if (PH(0) && IN(0)) _Pragma("unroll 1") for (int rep = 0; rep < REP_PA; ++rep) { OPQ(); prologue(args, lds, tid, lane, wave, G); }
    TENDB(0); SEAM(0); TENDS(0);
    TBEG(1);
    _Pragma("unroll 1") for (int pass = 0; pass < 2; ++pass) {
    if (((pass ^ (int)blockIdx.x) & 1) == 0) {
    if (PH(0) && IN(1)) _Pragma("unroll 1") for (int rep = 0; rep < REP_PB; ++rep) { OPQ(); prologue_b(args, lds, tid, lane, wave, G); }
    } else {
    if (PH(1) && IN(1)) _Pragma("unroll 1") for (int rep = 0; rep < REP_N; ++rep) { OPQ(); KP();
        pre_phase(AIN(0), AIN(2), (const float*)(ws + WS_MOD), (bf16_t*)(ws + WS_H), (float*)(ws + WS_SS), lane, gw, NGW); }
    } }
    TENDB(1); SEAM(1); TENDS(1);

    for (int l = 0; l < DEPTH; ++l) {
        const int s0 = 1 + 5 * l;
        TBEG(2);
        if (PH(2) && IN(s0 + 1)) _Pragma("unroll 1") for (int rep = 0; rep < REP_G2; ++rep) {
            KP(); stagger(STAG_I);
            const bf16_t* wl = (const bf16_t*)(ws + WS_W + (size_t)l * W_LAYER);
            pg8::Gemm g{(const bf16_t*)(ws + WS_H), wl + W_IN / 2, MROWS, NIN, DM}; pg8::StaticOrder S; S.init(MROWS, NIN, G, (int)blockIdx.x);
            pg8::EpiInProj E{(bf16_t*)(ws + WS_P), (bf16_t*)(ws + WS_VT), (float*)(ws + WS_WI), (const float*)(ws + WS_ROPE), (const float*)(ws + WS_ROPE) + SEQ * 32,
                             AIN(7) + l * 64, AIN(8) + l * 64, AIN(9) + l * 64, AIN(10) + l * 64, (const float*)(ws + WS_SS), (const float*)(ws + WS_B1) + (size_t)l * BATCH * NIN, (LAS float*)(lds + 131072)};
            pg8::gemm_phase<pg8::EpiInProj, pg8::StaticOrder, true, true>(lds, g, S, E, wave);
        }
        TENDB(2); SEAM(s0 + 1); TENDS(2); TBEG(3);
        if (PH(3) && IN(s0 + 2)) {
            OPQ(); KP();
            const bf16_t* P = (const bf16_t*)(ws + WS_P); const bf16_t* VT = (const bf16_t*)(ws + WS_VT); bf16_t* OB = (bf16_t*)(ws + WS_O);
            const float* gout = AIN(12) + l * 1024;
            const float gqa = wave_max(fabsf(AIN(7)[l * 64 + lane])), gka = wave_max(fabsf(AIN(8)[l * 64 + lane]));
            const float gqc = wave_max(fabsf(AIN(9)[l * 64 + lane])), gkc = wave_max(fabsf(AIN(10)[l * 64 + lane]));
            const float M2a = 8.f * gqa * gka * LOG2E, M2c = 8.f * gqc * gkc * LOG2E;
            _Pragma("unroll 1") for (int rep = 0; rep < REP_ATT; ++rep) {
            const int xs = (G % 8 == 0) ? (int)(blockIdx.x & 7) : 0, js = (G % 8 == 0) ? (int)(blockIdx.x >> 3) : (int)blockIdx.x, njs = (G % 8 == 0) ? G / 8 : G, nvs = (G % 8 == 0) ? 128 : 1024;
            TBEG(8); TBEG(11);
            if (PH(8)) _Pragma("unroll 1") for (int r2 = 0; r2 < REP_SWA; ++r2) for (int v = js; v < nvs; v += njs) { const int b = 4 * xs + (v >> 5), kv = (v >> 4) & 1, qb = v & 15;
                swa_block(b, kv, qb, P, VT, OB, M2c, AIN(11) + l * 8, gout, lds, tid, lane, wave); }
            TEND(8); TBEG(9);
            if (PH(9)) _Pragma("unroll 1") for (int r2 = 0; r2 < REP_SB; ++r2) for (int v = js; v < nvs; v += njs) { const int b = 4 * xs + (v >> 5), hb = (v >> 3) & 3, qb = v & 7;
                sb_block(b, hb, qb, P, VT, OB, gout, lds, tid, lane, wave); }
            TEND(9); TEND(11); TBEG(10);
            if (PH(10)) _Pragma("unroll 1") for (int r2 = 0; r2 < REP_DSA; ++r2) dsa_phase(P, VT, (const float*)(ws + WS_WI), OB, gout, M2a, (unsigned*)(ws + WS_CTL) + CW_QUEUE + 1024 * l + 256 * rep + 128 * r2, lds, tid, lane, wave);
            TEND(10);
            }
        }
        TENDB(3); SEAM(s0 + 2); TENDS(3); TBEG(4);
        if (PH(4) && IN(s0 + 3)) _Pragma("unroll 1") for (int rep = 0; rep < REP_G4; ++rep) {
            KP(); stagger(STAG_O);
            const bf16_t* wl = (const bf16_t*)(ws + WS_W + (size_t)l * W_LAYER); const float* modl = (const float*)(ws + WS_MOD) + (size_t)l * BATCH * 6144;
            pg8::Gemm g{(const bf16_t*)(ws + WS_O), wl + W_O / 2, MROWS, DM, DM}; pg8::StaticOrder S; S.init(MROWS, DM, G, (int)blockIdx.x);
            pg8::EpiResid E{l == 0 ? (const void*)AIN(0) : (const void*)(ws + WS_X16), rep ? (void*)(ws + WS_DUMMY) : (void*)(ws + WS_X16), modl + 2 * DM, rep ? (bf16_t*)(ws + WS_DUMMY) : (bf16_t*)(ws + WS_H),
                            AIN(3) + l * DM, modl + 4 * DM, rep ? (float*)(ws + WS_DUMMY) : (float*)(ws + WS_SS), 1, l == 0 ? 1 : 0, 0};
            pg8::gemm_phase<pg8::EpiResid, pg8::StaticOrder, true, true>(lds, g, S, E, wave);
        }
        TENDB(4); SEAM(s0 + 3); TENDS(4); TBEG(5);
        if (PH(6) && IN(s0 + 4)) _Pragma("unroll 1") for (int rep = 0; rep < REP_G6; ++rep) {
            KP(); stagger(STAG_G);
            const bf16_t* wl = (const bf16_t*)(ws + WS_W + (size_t)l * W_LAYER);
            pg8::Gemm g{(const bf16_t*)(ws + WS_H), wl + W_GU / 2, MROWS, NGU, DM}; pg8::StaticOrder S; S.init(MROWS, NGU, G, (int)blockIdx.x);
            pg8::EpiSwiGLU E{(bf16_t*)(ws + WS_ACT), (const float*)(ws + WS_SS), (const float*)(ws + WS_BG) + (size_t)l * BATCH * DFF, (const float*)(ws + WS_BU) + (size_t)l * BATCH * DFF};
            pg8::gemm_phase<pg8::EpiSwiGLU, pg8::StaticOrder, true, true>(lds, g, S, E, wave);
        }
        TENDB(5); SEAM(s0 + 4); TENDS(5); TBEG(6);
        if (PH(7) && IN(s0 + 5)) _Pragma("unroll 1") for (int rep = 0; rep < REP_G7; ++rep) {
            KP(); stagger(STAG_D);
            const bf16_t* wl = (const bf16_t*)(ws + WS_W + (size_t)l * W_LAYER); const float* mod = (const float*)(ws + WS_MOD); const float* modl = mod + (size_t)l * BATCH * 6144;
            pg8::Gemm g{(const bf16_t*)(ws + WS_ACT), wl + W_D / 2, MROWS, DM, DFF}; pg8::StaticOrder S; S.init(MROWS, DM, G, (int)blockIdx.x);
            const int ln = (l + 1 < DEPTH) ? l + 1 : l;
            const int last = (l + 1 == DEPTH);
            pg8::EpiResid E{(const void*)(ws + WS_X16), rep ? (void*)(ws + WS_DUMMY) : (last ? (void*)AOUT() : (void*)(ws + WS_X16)), modl + 5 * DM, rep ? (bf16_t*)(ws + WS_DUMMY) : (bf16_t*)(ws + WS_H),
                            AIN(2) + ln * DM, mod + (size_t)ln * BATCH * 6144 + DM, rep ? (float*)(ws + WS_DUMMY) : (float*)(ws + WS_SS), last ? 0 : 1, 0, (last && !rep) ? 1 : 0};
            pg8::gemm_phase<pg8::EpiResid, pg8::StaticOrder, true, true>(lds, g, S, E, wave);
        }
        TENDB(6); SEAM(s0 + 5); TENDS(6);
    }
#ifdef TPROBE
    __syncthreads();
    { unsigned tacc = MISC[12];
#ifdef TPROBE_BLK
      if ((int)blockIdx.x != (TPROBE_BLK)) tacc = 0u;
#endif
      const unsigned tend = (unsigned)__builtin_amdgcn_s_memrealtime(), span = tacc * (unsigned)(TPROBE_K);
      while ((unsigned)__builtin_amdgcn_s_memrealtime() - tend < span) __builtin_amdgcn_s_sleep(8); }
#endif
#undef IN
#undef SEAM
}

extern "C" void kernel_launch(void* const* d_in, const int* in_sizes, int n_in, void* d_out, int out_size, void* d_ws, size_t ws_size, hipStream_t stream) {
    static int grid = 0;
    if (grid == 0) {
        if (n_in != 17 || in_sizes[0] != MROWS * DM || out_size != MROWS * DM || ws_size < WS_END) {
            fprintf(stderr, "kernel_launch: unexpected problem (n_in %d, in0 %d, out %d, ws %zu); nothing launched\n", n_in, n_in > 0 ? in_sizes[0] : -1, out_size, ws_size); grid = -1; return; }
        int dev = 0, cus = 0, per_cu = 0;
        if (hipGetDevice(&dev) != hipSuccess || hipDeviceGetAttribute(&cus, hipDeviceAttributeMultiprocessorCount, dev) != hipSuccess) { grid = -1; return; }
        if (hipFuncSetAttribute((const void*)fwd, hipFuncAttributeMaxDynamicSharedMemorySize, LDS_BYTES) != hipSuccess) { fprintf(stderr, "kernel_launch: hipFuncSetAttribute failed\n"); grid = -1; return; }
        if (hipOccupancyMaxActiveBlocksPerMultiprocessor(&per_cu, (const void*)fwd, NWAVES * 64, LDS_BYTES) != hipSuccess || per_cu < 1) {
            fprintf(stderr, "kernel_launch: occupancy query reports %d workgroups per CU\n", per_cu); per_cu = 1; }
        (void)hipGetLastError();
        grid = cus;
    }
    if (grid < 0) return;
    if (hipMemsetAsync((char*)d_ws + WS_CTL, 0, CTL_BYTES, stream) != hipSuccess) return;
    Args a{};
    for (int i = 0; i < 17; ++i) a.in[i] = (const float*)d_in[i];
    a.out = (float*)d_out; a.ws = (unsigned char*)d_ws;
#if MK_MULTI
    for (int s = 0; s < NSTEPS; ++s) { a.lo = s; a.hi = s + 1; hipLaunchKernelGGL(fwd, dim3(grid), dim3(NWAVES * 64), LDS_BYTES, stream, a); }
#else
    a.lo = 0; a.hi = NSTEPS;
    hipLaunchKernelGGL(fwd, dim3(grid), dim3(NWAVES * 64), LDS_BYTES, stream, a);
#endif
}
```

```cpp
#include <hip/hip_runtime.h>
#include <cstdio>
#include <cstdint>

#ifndef MK_MULTI
#define MK_MULTI 0
#endif

#define LAS __attribute__((address_space(3)))
#define GAS __attribute__((address_space(1)))
__device__ __forceinline__ int lane_id_v() { int l; asm volatile("v_mbcnt_lo_u32_b32 %0, -1, 0\n\tv_mbcnt_hi_u32_b32 %0, -1, %0" : "=v"(l)); return l; }
namespace pg8 {
#define PG8_LAS __attribute__((address_space(3)))
typedef unsigned short bf16_t;
typedef short bf16x8 __attribute__((ext_vector_type(8)));
typedef float f32x4 __attribute__((ext_vector_type(4)));
typedef unsigned u32x4 __attribute__((ext_vector_type(4)));
constexpr int BM = 256, BK = 64, HALF = 128, HTB = HALF * BK * 2  , STAGE_BYTES = 8 * HTB, NXCD = 8, WGM = 8;

__host__ __device__ __forceinline__ int lds_byte(int r, int c) { const int st = (r >> 4) * 2 + (c >> 5), rr = r & 15, cc = c & 31, ob = rr * 64 + cc * 2; return st * 1024 + (ob ^ (((ob >> 9) & 1) << 5)); }
__host__ __device__ __forceinline__ void stage_rc(int b, int& R, int& C) { const int st = b / 1024, sb = b % 1024, swz = sb ^ (((sb >> 9) & 1) << 5); R = (st >> 1) * 16 + swz / 64; C = (st & 1) * 32 + (swz % 64) / 2; }
__host__ __device__ __forceinline__ int perm32(int rho) { const int n = rho >> 4, i = rho & 15; return 8 * (i >> 2) + 4 * n + (i & 3); }

struct Unit { int pm, pn; };
struct Gemm { const bf16_t* A; const bf16_t* Bt; int M, N, K; };

struct StaticOrder {
    int nM, nN, nwg, G, c;
    __host__ __device__ void init(int M, int N, int G_, int c_) { nM = M / BM; nN = N / BM; nwg = nM * nN; G = G_; c = c_; }
    __host__ __device__ bool next(int i, Unit& u) const {
        const long L = (long)i * G + c; if (L >= nwg) return false;
        int wgid = (int)L; { const int q = nwg / NXCD, r = nwg % NXCD, xcd = wgid % NXCD, off = wgid / NXCD; wgid = (xcd < r ? xcd * (q + 1) : r * (q + 1) + (xcd - r) * q) + off; }
        const int nig = WGM * nN, gid = wgid / nig, fm = gid * WGM, gsz = (nM - fm) < WGM ? (nM - fm) : WGM;
        u.pm = fm + ((wgid % nig) % gsz); u.pn = (wgid % nig) / gsz; return true;
    }
    __device__ __forceinline__ void a_ready(const Unit&) const {}
    __device__ __forceinline__ void done(const Unit&) const {}
};
#ifndef RELAX_V
#define RELAX_V 0
#endif
template <class Epi, class Sched, bool ALIGN_EPI = false, bool SP2 = false>
__device__ __forceinline__ void gemm_phase(PG8_LAS unsigned char* lds, const Gemm g, const Sched& S, const Epi& E, int wave_) {
    int tid_o = wave_ * 64 + lane_id_v(); asm volatile("" : "+v"(tid_o));
    const int tid = tid_o, wid = __builtin_amdgcn_readfirstlane(tid >> 6), lane = tid & 63, wr = wid >> 2, wc = wid & 3, fr = lane & 15, fq = lane >> 4;
    const int K = g.K, nt = K / BK;
    unsigned voffA[2], voffB[2];
#pragma unroll
    for (int i = 0; i < 2; ++i) { int R, C; stage_rc(tid * 16 + i * 8192, R, C); const int Rb = Epi::PERM ? ((R & ~31) + perm32(R & 31)) : R;
        voffA[i] = (unsigned)(R * K + C) * 2u; voffB[i] = (unsigned)(Rb * K + C) * 2u; }
    const size_t kstep = (size_t)(BK * 2);
    const size_t hstep = (size_t)HALF * K * 2;
    const size_t tstep = 2 * hstep;
    const unsigned ldsw = (unsigned)wid * 1024u;
    const int aoff = lds_byte(wr * 64 + fr, fq * 8), boff = lds_byte(wc * 32 + fr, fq * 8);
#define PG8_SA(b, h) (((b) * 2 + (h)) * HTB)
#define PG8_SB(b, h) ((4 + (b) * 2 + (h)) * HTB)
#define PG8_STAGE(bufoff, gbase, voff) do { _Pragma("unroll") for (int _i = 0; _i < 2; ++_i) \
        __builtin_amdgcn_global_load_lds((const unsigned*)((const char*)(gbase) + (voff)[_i]), (PG8_LAS unsigned*)(lds + (bufoff) + ldsw + _i * 8192), 16, 0, 0); } while (0)
#define PG8_LDA(dst, b, h) do { _Pragma("unroll") for (int m = 0; m < 4; ++m) _Pragma("unroll") for (int k = 0; k < 2; ++k) dst[m][k] = *(const PG8_LAS bf16x8*)(lds + PG8_SA(b, h) + aoff + m * 2048 + k * 1024); } while (0)
#define PG8_LDB(dst, b, h) do { _Pragma("unroll") for (int n = 0; n < 2; ++n) _Pragma("unroll") for (int k = 0; k < 2; ++k) dst[n][k] = *(const PG8_LAS bf16x8*)(lds + PG8_SB(b, h) + boff + n * 2048 + k * 1024); } while (0)
#define PG8_MMA(ai, bj, At, Bt) do { __builtin_amdgcn_s_setprio(1); _Pragma("unroll") for (int m = 0; m < 4; ++m) _Pragma("unroll") for (int n = 0; n < 2; ++n) _Pragma("unroll") for (int k = 0; k < 2; ++k) \
        acc[ai][bj][m][n] = __builtin_amdgcn_mfma_f32_16x16x32_bf16(Bt[n][k], At[m][k], acc[ai][bj][m][n], 0, 0, 0); __builtin_amdgcn_s_setprio(0); } while (0)
#define PG8_WAIT_V(n) asm volatile("s_waitcnt vmcnt(" #n ")" ::: "memory")
#define PG8_WAIT_L(n) asm volatile("s_waitcnt lgkmcnt(" #n ")" ::: "memory")
#define PG8_BAR __builtin_amdgcn_s_barrier()
#define PG8_SCHED __builtin_amdgcn_sched_barrier(0)
    Unit cur, nxt; int ui = 0;
    if (!S.next(0, cur)) return;
    f32x4 acc[2][2][4][2];
#pragma unroll
    for (int a = 0; a < 2; ++a)
#pragma unroll
        for (int b = 0; b < 2; ++b)
#pragma unroll
            for (int m = 0; m < 4; ++m)
#pragma unroll
                for (int n = 0; n < 2; ++n) acc[a][b][m][n] = (f32x4){0.f, 0.f, 0.f, 0.f};
    bf16x8 At[4][2], B0[2][2], B1[2][2];
    const char* cA = (const char*)g.A + (size_t)cur.pm * tstep; const char* cB = (const char*)g.Bt + (size_t)cur.pn * tstep;
    S.a_ready(cur);
    if constexpr (SP2) {
        PG8_STAGE(PG8_SB(0, 0), cB, voffB); PG8_STAGE(PG8_SB(0, 1), cB + hstep, voffB); PG8_STAGE(PG8_SA(0, 0), cA, voffA); PG8_STAGE(PG8_SA(0, 1), cA + hstep, voffA);
        if (wr == 1) PG8_BAR;
        PG8_WAIT_V(2); PG8_BAR;
        PG8_STAGE(PG8_SB(1, 0), cB + kstep, voffB); PG8_STAGE(PG8_SA(1, 0), cA + kstep, voffA); PG8_STAGE(PG8_SB(1, 1), cB + hstep + kstep, voffB);
        PG8_WAIT_V(6); PG8_BAR;
    } else {
        PG8_STAGE(PG8_SB(0, 0), cB, voffB); PG8_STAGE(PG8_SA(0, 0), cA, voffA); PG8_STAGE(PG8_SB(0, 1), cB + hstep, voffB); PG8_STAGE(PG8_SA(0, 1), cA + hstep, voffA);
        if (wr == 1) PG8_BAR;
        PG8_WAIT_V(4); PG8_BAR;
        PG8_STAGE(PG8_SB(1, 0), cB + kstep, voffB); PG8_STAGE(PG8_SA(1, 0), cA + kstep, voffA); PG8_STAGE(PG8_SB(1, 1), cB + hstep + kstep, voffB);
        PG8_WAIT_V(6); PG8_BAR;
    }
    for (;;) {
        const bool has_next = S.next(ui + 1, nxt);
        const char* nA = has_next ? (const char*)g.A + (size_t)nxt.pm * tstep : cA; const char* nB = has_next ? (const char*)g.Bt + (size_t)nxt.pn * tstep : cB;
#ifdef KREP_PROBE
        _Pragma("unroll 1") for (int kr = 0; kr < Epi::KREP; ++kr) {
        if (kr > 0) {
            _Pragma("unroll") for (int a = 0; a < 2; ++a) _Pragma("unroll") for (int b = 0; b < 2; ++b) _Pragma("unroll") for (int m = 0; m < 4; ++m) _Pragma("unroll") for (int n = 0; n < 2; ++n) acc[a][b][m][n] = (f32x4){0.f, 0.f, 0.f, 0.f};
        }
        const bool lastrep = (kr == Epi::KREP - 1);
#else
        const bool lastrep = true;
#endif
        for (int t = 0; t < nt; t += 2) {
            const bool last = (t == nt - 2);
            const char* a1 = cA + (size_t)(t + 1) * kstep;
            const char* a2 = last ? (lastrep ? nA : cA) : cA + (size_t)(t + 2) * kstep; const char* b2 = last ? (lastrep ? nB : cB) : cB + (size_t)(t + 2) * kstep;
            const char* a3 = a2 + kstep; const char* b3 = b2 + kstep;
            if (last && has_next) S.a_ready(nxt);
            if constexpr (SP2) {
            PG8_LDB(B0, 0, 0); PG8_LDB(B1, 0, 1); PG8_SCHED; PG8_LDA(At, 0, 0); PG8_STAGE(PG8_SA(1, 1), a1 + hstep, voffA);
            if constexpr (RELAX_V != 0) { const int rlx = __builtin_amdgcn_readfirstlane((t == 0 && ui > 0) ? 1 : 0);
                asm volatile("s_cmp_lg_u32 %0, 0\n\ts_cbranch_scc1 .Lrlx%=\n\ts_waitcnt vmcnt(8)\n.Lrlx%=:\n\ts_waitcnt vmcnt(%1)" :: "s"(rlx), "n"(8 + Epi::NVM) : "memory", "scc"); }
            else PG8_WAIT_V(8);
            PG8_WAIT_L(0); PG8_BAR; PG8_MMA(0, 0, At, B0); PG8_MMA(0, 1, At, B1); PG8_BAR; PG8_SCHED;
            PG8_LDA(At, 0, 1); PG8_STAGE(PG8_SB(0, 0), b2, voffB); PG8_STAGE(PG8_SB(0, 1), b2 + hstep, voffB); PG8_STAGE(PG8_SA(0, 0), a2, voffA);
            PG8_WAIT_V(8); PG8_WAIT_L(0); PG8_BAR; PG8_MMA(1, 0, At, B0); PG8_MMA(1, 1, At, B1); PG8_BAR; PG8_SCHED;
            PG8_LDB(B0, 1, 0); PG8_LDB(B1, 1, 1); PG8_SCHED; PG8_LDA(At, 1, 0); PG8_STAGE(PG8_SA(0, 1), a2 + hstep, voffA);
            PG8_WAIT_V(8); PG8_WAIT_L(0); PG8_BAR; PG8_MMA(0, 0, At, B0); PG8_MMA(0, 1, At, B1); PG8_BAR; PG8_SCHED;
            PG8_LDA(At, 1, 1); PG8_STAGE(PG8_SB(1, 0), b3, voffB); PG8_STAGE(PG8_SB(1, 1), b3 + hstep, voffB); PG8_STAGE(PG8_SA(1, 0), a3, voffA);
            PG8_WAIT_V(8); PG8_WAIT_L(0); PG8_BAR; PG8_MMA(1, 0, At, B0); PG8_MMA(1, 1, At, B1); PG8_BAR; PG8_SCHED;
            } else {
            PG8_LDB(B0, 0, 0); PG8_SCHED; PG8_LDA(At, 0, 0); PG8_STAGE(PG8_SA(1, 1), a1 + hstep, voffA);
            PG8_WAIT_L(8); PG8_BAR; PG8_WAIT_L(0); PG8_MMA(0, 0, At, B0); PG8_BAR; PG8_SCHED;
            PG8_LDB(B1, 0, 1); PG8_STAGE(PG8_SB(0, 0), b2, voffB);
            PG8_BAR; PG8_WAIT_L(0); PG8_MMA(0, 1, At, B1); PG8_BAR;
            PG8_LDA(At, 0, 1); PG8_STAGE(PG8_SA(0, 0), a2, voffA);
            PG8_BAR; PG8_WAIT_L(0); PG8_MMA(1, 0, At, B0); PG8_BAR; PG8_SCHED;
            PG8_STAGE(PG8_SB(0, 1), b2 + hstep, voffB);
            PG8_WAIT_V(6); PG8_BAR; PG8_MMA(1, 1, At, B1); PG8_BAR;
            PG8_LDB(B0, 1, 0); PG8_SCHED; PG8_LDA(At, 1, 0); PG8_STAGE(PG8_SA(0, 1), a2 + hstep, voffA);
            PG8_WAIT_L(8); PG8_BAR; PG8_WAIT_L(0); PG8_MMA(0, 0, At, B0); PG8_BAR; PG8_SCHED;
            PG8_LDB(B1, 1, 1); PG8_STAGE(PG8_SB(1, 0), b3, voffB);
            PG8_BAR; PG8_WAIT_L(0); PG8_MMA(0, 1, At, B1); PG8_BAR;
            PG8_LDA(At, 1, 1); PG8_STAGE(PG8_SA(1, 0), a3, voffA);
            PG8_BAR; PG8_WAIT_L(0); PG8_MMA(1, 0, At, B0); PG8_BAR; PG8_SCHED;
            PG8_STAGE(PG8_SB(1, 1), b3 + hstep, voffB);
            PG8_WAIT_V(6); PG8_BAR; PG8_MMA(1, 1, At, B1); PG8_BAR;
            }
        }
#ifdef KREP_PROBE
        }
#endif
        if constexpr (ALIGN_EPI) { if (wr == 0) PG8_BAR; }
#ifdef KREP_PROBE
        if constexpr (Epi::EREP > 1) { _Pragma("unroll 1") for (int er = 1; er < Epi::EREP; ++er) { int fr2 = fr, fq2 = fq; asm volatile("" : "+v"(fr2), "+v"(fq2)); E(acc, cur, wr, wc, fr2, fq2); asm volatile("" ::: "memory"); } }
#endif
#ifdef TPROBE
        if ((TPROBE >> Epi::TCLS) & 1) { if (tid == (TPROBE_TID)) ((volatile PG8_LAS unsigned*)(lds + 144128))[13] = (unsigned)__builtin_amdgcn_s_memrealtime(); }
#endif
        if constexpr (!Epi::AFTER_DRAIN) { E(acc, cur, wr, wc, fr, fq); S.done(cur); }
#ifdef TPROBE
        if ((TPROBE >> Epi::TCLS) & 1) { if (tid == (TPROBE_TID)) { asm volatile("s_waitcnt vmcnt(0)" ::: "memory"); volatile PG8_LAS unsigned* m_ = (volatile PG8_LAS unsigned*)(lds + 144128); m_[12] = m_[12] + ((unsigned)__builtin_amdgcn_s_memrealtime() - m_[13]); } }
#endif
        if (!has_next) break;
#pragma unroll
        for (int a = 0; a < 2; ++a)
#pragma unroll
            for (int b = 0; b < 2; ++b)
#pragma unroll
                for (int m = 0; m < 4; ++m)
#pragma unroll
                    for (int n = 0; n < 2; ++n) acc[a][b][m][n] = (f32x4){0.f, 0.f, 0.f, 0.f};
        cur = nxt; cA = nA; cB = nB; ++ui;
        if constexpr (ALIGN_EPI) { if (wr == 1) PG8_BAR; }
    }
    PG8_WAIT_V(0);
    if constexpr (!ALIGN_EPI) { if (wr == 0) PG8_BAR; }
    PG8_BAR;
    if constexpr (Epi::AFTER_DRAIN) { E.fused(acc, cur, wr, wc, fr, fq, lds, wid, lane); S.done(cur); }
#undef PG8_SA
#undef PG8_SB
#undef PG8_STAGE
#undef PG8_LDA
#undef PG8_LDB
#undef PG8_MMA
#undef PG8_WAIT_V
#undef PG8_WAIT_L
#undef PG8_BAR
#undef PG8_SCHED
}
}

#define XB_TMO      128
#define XB_XCNT(j)  (256  + 64 * (j))
#define XB_XSUB(j)  (1280 + 64 * (j))
#define XB_XGEN(j)  (2304 + 64 * (j))
#define XB_TOP      3328
#define XB_TOPGEN   3392
#define XCD_BAR_WORDS 3456
#define XB_SPIN_CAP (1u << 24)

__device__ __forceinline__ unsigned xb_ld(unsigned* p)              { return __hip_atomic_load(p, __ATOMIC_RELAXED, __HIP_MEMORY_SCOPE_AGENT); }
__device__ __forceinline__ unsigned xb_add(unsigned* p, unsigned v) { return __hip_atomic_fetch_add(p, v, __ATOMIC_RELAXED, __HIP_MEMORY_SCOPE_AGENT); }
__device__ __forceinline__ unsigned xb_xcc_id() { return (unsigned)__builtin_amdgcn_s_getreg((3 << 11) | 20) & 0xFu; }
#define XB_SPIN(cond, bar) do { unsigned _sp = 0; while (cond) { __builtin_amdgcn_s_sleep(1); \
    if ((++_sp & 255u) == 0u) { if (xb_ld(&(bar)[XB_TMO])) break; if (_sp > XB_SPIN_CAP) { atomicAdd(&(bar)[XB_TMO], 1u); break; } } } } while (0)

struct XcdBarrier {
    unsigned* bar; unsigned x; int w;
    volatile LAS unsigned* st;
};

#define XB_THREAD0(w) ((w) == 0 && lane_id_v() == 0)
__device__ __forceinline__ XcdBarrier xcd_barrier_post(unsigned* bar, volatile LAS unsigned* st, int w) {
    XcdBarrier b; b.bar = bar; b.x = xb_xcc_id(); b.st = st; b.w = w;
    if (XB_THREAD0(w)) (void)xb_add(&bar[XB_XCNT(b.x)], 1u);
    return b;
}
__device__ __forceinline__ void xcd_barrier_complete(unsigned* bar, unsigned x, unsigned& nloc, unsigned& nx) {
    const unsigned G = gridDim.x * gridDim.y * gridDim.z;
    unsigned sum, cnt, mine, sp = 0u;
    for (;;) {
        sum = 0u; cnt = 0u; mine = 0u;
#pragma unroll
        for (unsigned j = 0; j < 16; ++j) { const unsigned c = xb_ld(&bar[XB_XCNT(j)]); sum += c; cnt += (c > 0u) ? 1u : 0u; mine = (j == x) ? c : mine; }
        if (sum == G) break;
        __builtin_amdgcn_s_sleep(1);
        if ((++sp & 255u) == 0u) { if (xb_ld(&bar[XB_TMO])) break; if (sp > XB_SPIN_CAP) { atomicAdd(&bar[XB_TMO], 1u); break; } }
    }
    nloc = mine > 0u ? mine : 1u; nx = cnt > 0u ? cnt : 1u;
}

__device__ __forceinline__ void xcd_barrier(const XcdBarrier& b) {
    asm volatile("s_waitcnt vmcnt(0)" ::: "memory");
    __syncthreads();
    if (XB_THREAD0(b.w)) {
        unsigned* bar = b.bar;
        __builtin_amdgcn_s_waitcnt(0);
        unsigned nloc = b.st[0], nx = b.st[1];
        if (nloc == 0u) { xcd_barrier_complete(bar, b.x, nloc, nx); b.st[0] = nloc; b.st[1] = nx; }
        const unsigned old = xb_add(&bar[XB_XSUB(b.x)], 1u);
        const unsigned gen = old / nloc;
        if (old + 1u == (gen + 1u) * nloc) {
            __builtin_amdgcn_fence(__ATOMIC_RELEASE, "agent");
            asm volatile("s_waitcnt vmcnt(0)" ::: "memory");
            const unsigned og = xb_add(&bar[XB_TOP], 1u);
            const unsigned tg = og / nx;
            if (og + 1u == (tg + 1u) * nx) xb_add(&bar[XB_TOPGEN], 1u);
            else XB_SPIN(xb_ld(&bar[XB_TOPGEN]) == tg, bar);
            __builtin_amdgcn_fence(__ATOMIC_ACQUIRE, "agent");
            xb_add(&bar[XB_XGEN(b.x)], 1u);
            asm volatile("s_waitcnt vmcnt(0)" ::: "memory");
        } else {
            XB_SPIN(xb_ld(&bar[XB_XGEN(b.x)]) == gen, bar);
            __builtin_amdgcn_fence(__ATOMIC_ACQUIRE, "agent");
            asm volatile("s_waitcnt vmcnt(0)" ::: "memory");
        }
    }
    __syncthreads();
}

#define LAS __attribute__((address_space(3)))
#define GAS __attribute__((address_space(1)))
typedef unsigned short bf16_t;
typedef short bf16x8 __attribute__((ext_vector_type(8)));
typedef float f32x4 __attribute__((ext_vector_type(4)));
typedef float f32x2 __attribute__((ext_vector_type(2)));
typedef float f32x16 __attribute__((ext_vector_type(16)));
typedef unsigned u32x4 __attribute__((ext_vector_type(4)));
typedef unsigned u32x2 __attribute__((ext_vector_type(2)));
typedef __bf16 bf16x2v __attribute__((ext_vector_type(2)));

constexpr int NWAVES = 8;
constexpr int BATCH = 32, SEQ = 2048, DM = 1024, DEPTH = 4, MROWS = BATCH * SEQ;
constexpr int NIN = 2304, INCOLS = 2244, DFF = 2816, NGU = 2 * DFF, NVS = 7;
constexpr float EPS = 1e-6f, LOG2E = 1.4426950408889634f, C2 = 0.18033688011112042f;
constexpr int NSTEPS = 2 + 5 * DEPTH;
#ifndef TPROBE_TID
#define TPROBE_TID 0
#endif
#ifndef IDX_QD
#define IDX_QD 6
#endif
#ifndef PHMASK
#define PHMASK 0xffff
#endif
#define PH(i) ((PHMASK >> (i)) & 1)
#ifndef DSA_S
#define DSA_S 15
#endif
#ifndef REP_ATT
#define REP_ATT 1
#endif
#ifndef REP_SWA
#define REP_SWA 1
#endif
#ifndef REP_SB
#define REP_SB 1
#endif
#ifndef REP_DSA
#define REP_DSA 1
#endif
#ifndef DSA_R1
#define DSA_R1 1
#endif
#ifndef DSA_R2
#define DSA_R2 1
#endif
#ifndef DSA_R3
#define DSA_R3 1
#endif
#ifndef REP_BIS
#define REP_BIS 1
#endif
#ifndef REP_PA
#define REP_PA 1
#endif
#ifndef REP_PB
#define REP_PB 1
#endif
#ifndef TEST_SELN
#define TEST_SELN 2
#endif
#ifndef STAG_G
#define STAG_G 0
#endif
#ifndef STAG_O
#define STAG_O 0
#endif
#ifndef STAG_D
#define STAG_D 0
#endif
#ifndef STAG_I
#define STAG_I 0
#endif
#ifndef REP_G
#define REP_G 1
#endif
#ifndef REP_G2
#define REP_G2 REP_G
#endif
#ifndef REP_G4
#define REP_G4 REP_G
#endif
#ifndef REP_G6
#define REP_G6 REP_G
#endif
#ifndef REP_G7
#define REP_G7 REP_G
#endif
#ifndef REP_N
#define REP_N 1
#endif

constexpr size_t MiB = 1u << 20;
constexpr size_t WS_CTL = 0, CTL_BYTES = MiB;
constexpr size_t WS_ROPE = 1 * MiB;
constexpr size_t WS_MOD = 2 * MiB;
constexpr size_t WS_WI = 5 * MiB;
constexpr size_t WS_W = 8 * MiB, W_LAYER = 23 * MiB;
constexpr size_t W_IN = 0, W_O = 4608 * 1024, W_GU = W_O + 2 * MiB, W_D = W_GU + 11 * MiB;
constexpr size_t WS_H = 104 * MiB;
constexpr size_t WS_ACT = 232 * MiB;
constexpr size_t WS_P = WS_ACT;
constexpr size_t WS_VT = WS_ACT + 288 * MiB;
constexpr size_t WS_O = 584 * MiB;
constexpr size_t WS_SS = 712 * MiB;
constexpr size_t WS_B1 = 716 * MiB;
constexpr size_t WS_BG = 718 * MiB, WS_BU = 720 * MiB;
constexpr size_t WS_X16 = 724 * MiB;
constexpr size_t WS_END = 852 * MiB, WS_DUMMY = 852 * MiB;
static_assert(W_D + (size_t)DM * DFF * 2 <= W_LAYER && WS_W + DEPTH * W_LAYER <= WS_H && WS_VT + (size_t)BATCH * NVS * 64 * SEQ * 2 <= WS_END, "ws map");
static_assert((size_t)MROWS * NIN * 2 == 288 * MiB && (size_t)MROWS * DFF * 2 == 352 * MiB, "ws map 2");

constexpr int CW_BAR = 4096, CW_QUEUE = 8192;

constexpr int SC_STRIDE = 2052;
constexpr int SCH = 2056;
constexpr int G2_SC = 0;
constexpr int G2_MASK = 16 * SCH * 2, MASK_STRIDE = 66;
constexpr int G2_LSUM = G2_MASK + 16 * MASK_STRIDE * 4;
constexpr int G2_SSUM = G2_LSUM + 1024;
constexpr int G2_BYTES = G2_SSUM + 1024;
constexpr int LDS_MISC = 2 * G2_BYTES;
constexpr int LDS_BYTES = 147456;
static_assert(LDS_MISC + 64 <= LDS_BYTES && 4 * 64 * 64 * 4 <= G2_MASK && (G2_BYTES % 16) == 0 && LDS_MISC >= 131072 + 4096, "lds map");

#define LDS_WAIT() asm volatile("s_waitcnt lgkmcnt(0)" ::: "memory")
__device__ __forceinline__ unsigned cvtpk(float lo, float hi) { f32x2 v = {lo, hi}; bf16x2v b = __builtin_convertvector(v, bf16x2v); return __builtin_bit_cast(unsigned, b); }
__device__ __forceinline__ bf16x8 ldg16(const bf16_t* p) { return *(const GAS bf16x8*)p; }
#define RELU(x) __builtin_amdgcn_fmed3f((x), 0.f, __builtin_fabsf(x))
__device__ __forceinline__ float ex2(float x) { return __builtin_amdgcn_exp2f(x); }
__device__ __forceinline__ float lg2(float x) { return __builtin_amdgcn_logf(x); }
__device__ __forceinline__ int crow(int i, int h) { return (i & 3) + 8 * (i >> 2) + 4 * h; }
#define MFMA32(a, b, c) __builtin_amdgcn_mfma_f32_32x32x16_bf16((a), (b), (c), 0, 0, 0)
#define MFMA16(a, b, c) __builtin_amdgcn_mfma_f32_16x16x32_bf16((a), (b), (c), 0, 0, 0)
__device__ __forceinline__ bf16x8 pack8(const f32x16& x, int s) {
    u32x4 p; p.x = cvtpk(x[8 * s], x[8 * s + 1]); p.y = cvtpk(x[8 * s + 2], x[8 * s + 3]); p.z = cvtpk(x[8 * s + 4], x[8 * s + 5]); p.w = cvtpk(x[8 * s + 6], x[8 * s + 7]);
    return __builtin_bit_cast(bf16x8, p);
}
__device__ __forceinline__ f32x16 zero16() { f32x16 z; for (int i = 0; i < 16; ++i) z[i] = 0.f; return z; }
__device__ __forceinline__ int wsum_i(int v) {
    v += __builtin_amdgcn_update_dpp(0, v, 0x111, 0xf, 0xf, false);
    v += __builtin_amdgcn_update_dpp(0, v, 0x112, 0xf, 0xf, false);
    v += __builtin_amdgcn_update_dpp(0, v, 0x114, 0xf, 0xf, false);
    v += __builtin_amdgcn_update_dpp(0, v, 0x118, 0xf, 0xf, false);
    v += __builtin_amdgcn_update_dpp(0, v, 0x142, 0xa, 0xf, false);
    v += __builtin_amdgcn_update_dpp(0, v, 0x143, 0xc, 0xf, false);
    return __builtin_amdgcn_readlane(v, 63);
}
__device__ __forceinline__ void stagger(unsigned ticks) {
    const unsigned g = blockIdx.x & 3u;
    if (ticks && g) { const unsigned long long t0 = __builtin_amdgcn_s_memrealtime(); while (__builtin_amdgcn_s_memrealtime() - t0 < (unsigned long long)(g * ticks)) __builtin_amdgcn_s_sleep(8); }
}
__device__ __forceinline__ float wave_max(float v) {
#pragma unroll
    for (int o = 1; o < 64; o <<= 1) v = fmaxf(v, __shfl_xor(v, o));
    return v;
}
__device__ __forceinline__ float wave_sum(float v) {
#pragma unroll
    for (int o = 1; o < 64; o <<= 1) v += __shfl_xor(v, o);
    return v;
}

__device__ __forceinline__ int slot_col(int s) {
    if (s < 4) return 64 * s;
    if (s < 8) return 384 + 64 * (s - 4);
    if (s == 8) return 256;
    if (s == 9) return 320;
    if (s == 10) return 640;
    if (s == 11) return 704;
    if (s < 16) return 708 + 64 * (s - 12);
    if (s < 20) return 964 + 64 * (s - 16);
    if (s < 24) return 1220 + 64 * (s - 20);
    if (s < 32) return 1476 + 64 * (s - 24);
    if (s < 34) return 1988 + 64 * (s - 32);
    return 2116 + 64 * (s - 34);
}

namespace pg8 {
struct EpiInProj {
    static constexpr bool PERM = true, AFTER_DRAIN = false;
#ifndef KREP_I
#define KREP_I 1
#endif
#ifndef KREP_R
#define KREP_R 1
#endif
#ifndef KREP_S
#define KREP_S 1
#endif
#ifndef EREP_I
#define EREP_I 1
#endif
#ifndef EREP_R
#define EREP_R 1
#endif
#ifndef EREP_S
#define EREP_S 1
#endif
    static constexpr int KREP = KREP_I, EREP = EREP_I, TCLS = 20;
    static constexpr int NVM = 16;
    bf16_t* P; bf16_t* VT; float* WI; const float* cs; const float* sn; const float* qn_a; const float* kn_a; const float* qn_c; const float* kn_c;
    const float* SS; const float* bias;
    LAS float* xl;
    __device__ __forceinline__ void operator()(const f32x4 (&acc)[2][2][4][2], const Unit& u, int wr, int wc, int fr, int fq) const {
        const int slot = u.pn * 4 + wc;
        int mode = 0; const float* gain = nullptr; float osc = 1.f; int vslot = 0;
        if (slot < 4) { mode = 2; gain = qn_a; osc = C2; }
        else if (slot < 8) { mode = 1; }
        else if (slot == 8) { mode = 2; gain = kn_a; }
        else if (slot == 9) { mode = 3; vslot = 0; }
        else if (slot == 10) { mode = 1; }
        else if (slot == 11) { mode = 4; }
        else if (slot < 16) { mode = 0; osc = C2; }
        else if (slot < 20) { mode = 0; }
        else if (slot < 24) { mode = 3; vslot = 1 + (slot - 20); }
        else if (slot < 32) { mode = 2; gain = qn_c; osc = C2; }
        else if (slot < 34) { mode = 2; gain = kn_c; }
        else { mode = 3; vslot = 5 + (slot - 34); }
        const int rowt = u.pm * BM + wr * 64 + fr;
        const int b = rowt / SEQ; const int tt = rowt % SEQ;
        const int pfr = (fr & 3) | ((fr & 4) << 1) | ((fr & 8) >> 1);
        bf16_t* vb = VT + ((size_t)(b * NVS + vslot) * 64) * SEQ;
        float rsv[2][4];
        LAS float* wl = xl + (wr * 4 + wc) * 128;
        LAS float* wb = wl + 8 * fq; LAS float* wg = wl + 64 + 8 * fq;
        f32x4 rc[2], rsn[2];
        { f32x4 p4[2][4];
#pragma unroll
          for (int ai = 0; ai < 2; ++ai)
#pragma unroll
              for (int m = 0; m < 4; ++m) p4[ai][m] = *(const f32x4*)(SS + (size_t)(rowt + ai * HALF + m * 16) * 16 + 4 * fq);
          const int l64 = fr + 16 * fq;
          const float bval = bias[(size_t)((u.pm * BM) / SEQ) * NIN + slot_col(slot) + l64], gval = (mode == 2) ? gain[l64] : 1.f;
          if (mode == 1 || mode == 2) { const int t = rowt % SEQ;
#pragma unroll
              for (int n = 0; n < 2; ++n) { rc[n] = *(const f32x4*)(cs + t * 32 + 8 * fq + 4 * n); rsn[n] = *(const f32x4*)(sn + t * 32 + 8 * fq + 4 * n); } }
          wl[l64] = (mode == 0) ? bval * osc : bval; wl[64 + l64] = gval;
#pragma unroll
          for (int ai = 0; ai < 2; ++ai)
#pragma unroll
              for (int m = 0; m < 4; ++m) { float sq = (p4[ai][m][0] + p4[ai][m][1]) + (p4[ai][m][2] + p4[ai][m][3]); sq += __shfl_xor(sq, 16); sq += __shfl_xor(sq, 32);
                  rsv[ai][m] = __builtin_amdgcn_rsqf(sq * (1.f / DM) + EPS) * ((mode == 0) ? osc : 1.f); } }
        asm volatile("" ::: "memory");
#define ADJ_ROW(AI, M) const float rs = rsv[AI][M]; \
                f32x4 v1[2] = {acc[AI][0][M][0] * rs + *(LAS f32x4*)(wb), acc[AI][0][M][1] * rs + *(LAS f32x4*)(wb + 4)}, v2[2] = {acc[AI][1][M][0] * rs + *(LAS f32x4*)(wb + 32), acc[AI][1][M][1] * rs + *(LAS f32x4*)(wb + 36)}
#define STORE_ROW(ROW) do { u32x4 w1, w2; \
                w1.x = cvtpk(v1[0][0], v1[0][1]); w1.y = cvtpk(v1[0][2], v1[0][3]); w1.z = cvtpk(v1[1][0], v1[1][1]); w1.w = cvtpk(v1[1][2], v1[1][3]); \
                w2.x = cvtpk(v2[0][0], v2[0][1]); w2.y = cvtpk(v2[0][2], v2[0][3]); w2.z = cvtpk(v2[1][0], v2[1][1]); w2.w = cvtpk(v2[1][2], v2[1][3]); \
                bf16_t* op = P + (size_t)(ROW) * NIN + slot * 64 + 8 * fq; *(u32x4*)op = w1; *(u32x4*)(op + 32) = w2; } while (0)
        if (mode == 3) {
            LAS unsigned short* vt = (LAS unsigned short*)(xl + 1024) + (wr * 4 + wc) * 512;
            const int l64 = fr + 16 * fq;
            LAS unsigned short* vw = vt + 128 * fq + pfr;
            const LAS u32x4* vr = (const LAS u32x4*)(vt + 8 * l64);
            const unsigned gofs = (unsigned)((l64 >> 1) * SEQ + 8 * (l64 & 1));
            bf16_t* vgb = vb + (u.pm * BM + wr * 64) % SEQ;
#pragma unroll
            for (int ai = 0; ai < 2; ++ai)
#pragma unroll
                for (int m = 0; m < 4; ++m) { ADJ_ROW(ai, m);
#pragma unroll
                    for (int n = 0; n < 2; ++n)
#pragma unroll
                        for (int e = 0; e < 4; e += 2) { const unsigned w = cvtpk(v1[n][e], v1[n][e + 1]); vw[(4 * n + e) * 16] = (unsigned short)(w & 0xffffu); vw[(4 * n + e + 1) * 16] = (unsigned short)(w >> 16); }
                    const u32x4 r1 = *vr;
                    asm volatile("" ::: "memory");
#pragma unroll
                    for (int n = 0; n < 2; ++n)
#pragma unroll
                        for (int e = 0; e < 4; e += 2) { const unsigned w = cvtpk(v2[n][e], v2[n][e + 1]); vw[(4 * n + e) * 16] = (unsigned short)(w & 0xffffu); vw[(4 * n + e + 1) * 16] = (unsigned short)(w >> 16); }
                    const u32x4 r2 = *vr;
                    *(u32x4*)(vgb + (ai * HALF + m * 16) + gofs) = r1; *(u32x4*)(vgb + (32 * SEQ + ai * HALF + m * 16) + gofs) = r2;
                    asm volatile("" ::: "memory"); }
        } else if (mode == 4) {
#pragma unroll
            for (int ai = 0; ai < 2; ++ai)
#pragma unroll
                for (int m = 0; m < 4; ++m) { ADJ_ROW(ai, m); (void)v2; if (fq == 0) *(f32x4*)(WI + (size_t)(rowt + ai * HALF + m * 16) * 4) = v1[0]; asm volatile("" ::: "memory"); }
        } else if (mode == 0) {
#pragma unroll
            for (int ai = 0; ai < 2; ++ai)
#pragma unroll
                for (int m = 0; m < 4; ++m) { ADJ_ROW(ai, m); STORE_ROW(rowt + ai * HALF + m * 16); asm volatile("" ::: "memory"); }
        } else {
#pragma unroll
            for (int ai = 0; ai < 2; ++ai)
#pragma unroll
                for (int m = 0; m < 4; ++m) {
                    f32x4 nc[2], ns[2];
                    if ((ai * 4 + m) < 7) { const int k1 = ai * 4 + m + 1; const int t = (rowt + (k1 >> 2) * HALF + (k1 & 3) * 16) % SEQ;
#pragma unroll
                        for (int n = 0; n < 2; ++n) { nc[n] = *(const f32x4*)(cs + t * 32 + 8 * fq + 4 * n); ns[n] = *(const f32x4*)(sn + t * 32 + 8 * fq + 4 * n); } }
                    ADJ_ROW(ai, m);
                    if (mode == 2) {
                        float ss = 0.f;
#pragma unroll
                        for (int n = 0; n < 2; ++n)
#pragma unroll
                            for (int e = 0; e < 4; ++e) ss += v1[n][e] * v1[n][e] + v2[n][e] * v2[n][e];
                        ss += __shfl_xor(ss, 16); ss += __shfl_xor(ss, 32);
                        const float ri = __builtin_amdgcn_rsqf(ss * (1.f / 64.f) + EPS) * osc;
#pragma unroll
                        for (int n = 0; n < 2; ++n) { v1[n] = (v1[n] * ri) * *(LAS f32x4*)(wg + 4 * n); v2[n] = (v2[n] * ri) * *(LAS f32x4*)(wg + 32 + 4 * n); }
                    }
#pragma unroll
                    for (int n = 0; n < 2; ++n) { const f32x4 xa = v1[n], xb = v2[n]; v1[n] = xa * rc[n] - xb * rsn[n]; v2[n] = xb * rc[n] + xa * rsn[n]; }
                    STORE_ROW(rowt + ai * HALF + m * 16);
                    if ((ai * 4 + m) < 7) { rc[0] = nc[0]; rc[1] = nc[1]; rsn[0] = ns[0]; rsn[1] = ns[1]; }
                    asm volatile("" ::: "memory");
                }
        }
#undef ADJ_ROW
#undef STORE_ROW
    }
};
typedef _Float16 h16x8 __attribute__((ext_vector_type(8)));
typedef float f32x8 __attribute__((ext_vector_type(8)));
struct EpiResid {
    static constexpr bool PERM = true, AFTER_DRAIN = false;
    static constexpr int KREP = KREP_R, EREP = EREP_R, TCLS = 21;
    static constexpr int NVM = 36;
    const void* base; void* out; const float* gate;
    bf16_t* Hn; const float* lnn; const float* scn; float* SS; int do_next;
    int base_f32, out_f32;
    __device__ __forceinline__ void operator()(const f32x4 (&acc)[2][2][4][2], const Unit& u, int wr, int wc, int fr, int fq) const {
        const int row0 = u.pm * BM + wr * 64 + fr, col0 = u.pn * BM + wc * 32 + 8 * fq;
        const size_t bo = (size_t)((u.pm * BM) / SEQ) * 6144 + col0;
        f32x4 gv[2][2], vv[2][2];
#pragma unroll
        for (int bj = 0; bj < 2; ++bj)
#pragma unroll
            for (int n = 0; n < 2; ++n) { gv[bj][n] = *(const f32x4*)(gate + bo + bj * HALF + 4 * n);
                if (do_next) vv[bj][n] = *(const f32x4*)(lnn + col0 + bj * HALF + 4 * n) * (*(const f32x4*)(scn + bo + bj * HALF + 4 * n) + 1.f); }
#define RESID_ROW(AI, M, X0, X1, BJ) do { const int row_ = row0 + (AI) * HALF + (M) * 16; const size_t off_ = (size_t)row_ * DM + col0 + (BJ) * HALF; \
            if (out_f32) { *(f32x4*)((float*)out + off_) = X0; *(f32x4*)((float*)out + off_ + 4) = X1; } \
            else { f32x8 xx_; xx_[0] = X0[0]; xx_[1] = X0[1]; xx_[2] = X0[2]; xx_[3] = X0[3]; xx_[4] = X1[0]; xx_[5] = X1[1]; xx_[6] = X1[2]; xx_[7] = X1[3]; \
                   *(h16x8*)((_Float16*)out + off_) = __builtin_convertvector(xx_, h16x8); } \
            if (do_next) { ss += (X0[0] * X0[0] + X0[1] * X0[1]) + (X0[2] * X0[2] + X0[3] * X0[3]) + (X1[0] * X1[0] + X1[1] * X1[1]) + (X1[2] * X1[2] + X1[3] * X1[3]); \
                const f32x4 a0_ = X0 * vv[BJ][0], a1_ = X1 * vv[BJ][1]; \
                u32x4 w_; w_.x = cvtpk(a0_[0], a0_[1]); w_.y = cvtpk(a0_[2], a0_[3]); w_.z = cvtpk(a1_[0], a1_[1]); w_.w = cvtpk(a1_[2], a1_[3]); \
                *(u32x4*)(Hn + off_) = w_; } } while (0)
        if (base_f32) {
#pragma unroll
            for (int ai = 0; ai < 2; ++ai)
#pragma unroll
            for (int mh = 0; mh < 2; ++mh) {
                f32x4 bs[2][2][2];
#pragma unroll
                for (int mm = 0; mm < 2; ++mm) { const size_t off = (size_t)(row0 + ai * HALF + (2 * mh + mm) * 16) * DM + col0;
#pragma unroll
                    for (int bj = 0; bj < 2; ++bj) { bs[mm][bj][0] = *(const f32x4*)((const float*)base + off + bj * HALF); bs[mm][bj][1] = *(const f32x4*)((const float*)base + off + bj * HALF + 4); } }
#pragma unroll
                for (int mm = 0; mm < 2; ++mm) { const int m = 2 * mh + mm; float ss = 0.f;
#pragma unroll
                    for (int bj = 0; bj < 2; ++bj) { const f32x4 x0 = bs[mm][bj][0] + gv[bj][0] * acc[ai][bj][m][0], x1 = bs[mm][bj][1] + gv[bj][1] * acc[ai][bj][m][1]; RESID_ROW(ai, m, x0, x1, bj); }
                    if (do_next) { ss += __shfl_xor(ss, 16); ss += __shfl_xor(ss, 32); if (fq == 0) SS[(size_t)(row0 + ai * HALF + m * 16) * 16 + u.pn * 4 + wc] = ss; } }
                asm volatile("" ::: "memory");
            }
        } else {
#pragma unroll
            for (int ai = 0; ai < 2; ++ai) {
                h16x8 bh[4][2];
#pragma unroll
                for (int m = 0; m < 4; ++m) { const size_t off = (size_t)(row0 + ai * HALF + m * 16) * DM + col0;
#pragma unroll
                    for (int bj = 0; bj < 2; ++bj) bh[m][bj] = *(const h16x8*)((const _Float16*)base + off + bj * HALF); }
#pragma unroll
                for (int m = 0; m < 4; ++m) { float ss = 0.f;
#pragma unroll
                    for (int bj = 0; bj < 2; ++bj) { const f32x8 bf = __builtin_convertvector(bh[m][bj], f32x8);
                        const f32x4 x0 = (f32x4){bf[0], bf[1], bf[2], bf[3]} + gv[bj][0] * acc[ai][bj][m][0], x1 = (f32x4){bf[4], bf[5], bf[6], bf[7]} + gv[bj][1] * acc[ai][bj][m][1];
                        RESID_ROW(ai, m, x0, x1, bj); }
                    if (do_next) { ss += __shfl_xor(ss, 16); ss += __shfl_xor(ss, 32); if (fq == 0) SS[(size_t)(row0 + ai * HALF + m * 16) * 16 + u.pn * 4 + wc] = ss; } }
                asm volatile("" ::: "memory");
            }
        }
#undef RESID_ROW
    }
};
struct EpiSwiGLU {
    static constexpr bool PERM = true, AFTER_DRAIN = false;
    static constexpr int KREP = KREP_S, EREP = EREP_S, TCLS = 22;
    static constexpr int NVM = 20;
    bf16_t* ACT; const float* SS; const float* bg; const float* bu;
    __device__ __forceinline__ void operator()(const f32x4 (&acc)[2][2][4][2], const Unit& u, int wr, int wc, int fr, int fq) const {
        const int row0 = u.pm * BM + wr * 64 + fr, col0 = u.pn * HALF + wc * 32 + 8 * fq;
        const size_t bo = (size_t)((u.pm * BM) / SEQ) * DFF + col0;
        const f32x4 g0 = *(const f32x4*)(bg + bo), g1 = *(const f32x4*)(bg + bo + 4), u0 = *(const f32x4*)(bu + bo), u1 = *(const f32x4*)(bu + bo + 4);
        float rsv[2][4];
        { f32x4 p4[2][4];
#pragma unroll
          for (int ai = 0; ai < 2; ++ai)
#pragma unroll
              for (int m = 0; m < 4; ++m) p4[ai][m] = *(const f32x4*)(SS + (size_t)(row0 + ai * HALF + m * 16) * 16 + 4 * fq);
#pragma unroll
          for (int ai = 0; ai < 2; ++ai)
#pragma unroll
              for (int m = 0; m < 4; ++m) { float sq = (p4[ai][m][0] + p4[ai][m][1]) + (p4[ai][m][2] + p4[ai][m][3]); sq += __shfl_xor(sq, 16); sq += __shfl_xor(sq, 32);
                  rsv[ai][m] = __builtin_amdgcn_rsqf(sq * (1.f / DM) + EPS); } }
#pragma unroll
        for (int ai = 0; ai < 2; ++ai)
#pragma unroll
            for (int m = 0; m < 4; ++m) {
                const int row = row0 + ai * HALF + m * 16;
                const float rs = rsv[ai][m];
                const f32x4 ga[2] = {acc[ai][0][m][0] * rs + g0, acc[ai][0][m][1] * rs + g1}, ua[2] = {acc[ai][1][m][0] * rs + u0, acc[ai][1][m][1] * rs + u1};
                float r[8];
#pragma unroll
                for (int n = 0; n < 2; ++n)
#pragma unroll
                    for (int e = 0; e < 4; ++e) { const float g = ga[n][e]; r[4 * n + e] = g * __builtin_amdgcn_rcpf(1.f + ex2(-g * LOG2E)) * ua[n][e]; }
                u32x4 w; w.x = cvtpk(r[0], r[1]); w.y = cvtpk(r[2], r[3]); w.z = cvtpk(r[4], r[5]); w.w = cvtpk(r[6], r[7]);
                *(u32x4*)(ACT + (size_t)row * DFF + col0) = w;
            }
    }
};
}

#ifdef TPROBE
#define DTB(cls) do { if ((TPROBE >> (cls)) & 1) { if (threadIdx.x == 0) ((volatile LAS unsigned*)(lds + LDS_MISC))[13] = (unsigned)__builtin_amdgcn_s_memrealtime(); } } while (0)
#define DTE(cls) do { if ((TPROBE >> (cls)) & 1) { if (threadIdx.x == 0) { volatile LAS unsigned* m_ = (volatile LAS unsigned*)(lds + LDS_MISC); m_[12] = m_[12] + ((unsigned)__builtin_amdgcn_s_memrealtime() - m_[13]); } } } while (0)
#else
#define DTB(cls) do { } while (0)
#define DTE(cls) do { } while (0)
#endif
__device__ __forceinline__ void tr_item(const float* W, int ldw, int K, bf16_t* WT, int k0, int drow0, int sc, LAS float* scr, int lane) {
    float tv[32];
#pragma unroll
    for (int i = 0; i < 32; ++i) { const int kk = 2 * i + (lane >> 5); tv[i] = 0.f; if (sc >= 0) tv[i] = W[(size_t)(k0 + kk) * ldw + sc]; }
#pragma unroll
    for (int i = 0; i < 32; ++i) { const int kk = 2 * i + (lane >> 5); scr[kk * 33 + (lane & 31)] = tv[i]; }
    LDS_WAIT(); asm volatile("" ::: "memory");
    const int c = lane & 7;
#pragma unroll
    for (int j = 0; j < 4; ++j) { const int n = (lane >> 3) + 8 * j; const LAS float* s = scr + (8 * c) * 33 + n;
        u32x4 o; o.x = cvtpk(s[0 * 33], s[1 * 33]); o.y = cvtpk(s[2 * 33], s[3 * 33]); o.z = cvtpk(s[4 * 33], s[5 * 33]); o.w = cvtpk(s[6 * 33], s[7 * 33]);
        *(GAS u32x4*)(WT + (size_t)(drow0 + n) * K + k0 + 8 * c) = o; }
    LDS_WAIT(); asm volatile("" ::: "memory");
}

__device__ __forceinline__ void gemv32_ksplit(const float* wcol  , size_t ldw, const LAS float* cact  , LAS float* red  ,
                                              float* out  , size_t ldo, int nvalid  , float bias, int wave, int lane, int tid) {
    float acc[32];
#pragma unroll
    for (int i = 0; i < 32; ++i) acc[i] = 0.f;
    const float* w0 = wcol + (size_t)(128 * wave) * ldw;
    const LAS float* c0 = cact + (128 * wave) * 32;
    float wn[16];
#pragma unroll
    for (int j = 0; j < 16; ++j) wn[j] = w0[(size_t)j * ldw];
#pragma unroll 1
    for (int kk = 0; kk < 128; kk += 16) {
        float wv[16];
#pragma unroll
        for (int j = 0; j < 16; ++j) wv[j] = wn[j];
        if (kk + 16 < 128) {
#pragma unroll
            for (int j = 0; j < 16; ++j) wn[j] = w0[(size_t)(kk + 16 + j) * ldw];
        }
#pragma unroll
        for (int j = 0; j < 16; ++j) { const LAS f32x4* cp = (const LAS f32x4*)(c0 + (kk + j) * 32);
#pragma unroll
            for (int q = 0; q < 8; ++q) { const f32x4 c4 = cp[q]; acc[4 * q] += c4[0] * wv[j]; acc[4 * q + 1] += c4[1] * wv[j]; acc[4 * q + 2] += c4[2] * wv[j]; acc[4 * q + 3] += c4[3] * wv[j]; } }
    }
#pragma unroll
    for (int r = 0; r < 8; ++r) {
#pragma unroll
        for (int i = 0; i < 4; ++i) red[(wave * 4 + i) * 64 + lane] = acc[4 * r + i];
        __syncthreads();
        if (tid < 256) { const int bb = tid >> 6, cc = tid & 63; float sum = 0.f;
#pragma unroll
            for (int w = 0; w < 8; ++w) sum += red[(w * 4 + bb) * 64 + cc];
            if (cc < nvalid) out[(size_t)(4 * r + bb) * ldo + cc] = sum + bias; }
        __syncthreads();
    }
}

struct Args { const float* in[17]; float* out; unsigned char* ws; int lo, hi; };

__device__ __forceinline__ void prologue(const Args& a, LAS unsigned char* lds, int tid, int lane, int wave, int G) {
    unsigned char* ws = a.ws;
    const float* w_in = a.in[6]; const float* w_o = a.in[13]; const float* w_gate = a.in[14]; const float* w_up = a.in[15]; const float* w_down = a.in[16];
    LAS float* scr = (LAS float*)(lds + wave * 16384);
    const int gw = blockIdx.x * NWAVES + wave, NGW = G * NWAVES;
    constexpr int I_IN = 16 * 72, I_O = 16 * 32, I_GU = 16 * 176, I_D = 44 * 32, I_L = I_IN + I_O + I_GU + I_D;
#pragma unroll 1
    for (int pass = 0; pass < 2; ++pass) {
    if (((pass ^ (int)blockIdx.x) & 1) == 0) {
    for (int it = gw; it < DEPTH * I_L; it += NGW) {
        const int l = it / I_L; int r = it % I_L;
        bf16_t* wl = (bf16_t*)(ws + WS_W + (size_t)l * W_LAYER);
        if (r < I_IN) {
            const int kb = r / 72, nb = r % 72, np = 32 * nb + (lane & 31), p = np & 255;
            const int slot = (np >> 8) * 4 + ((p & 127) >> 5), dim = 32 * (p >> 7) + (p & 31);
            int sc = slot_col(slot) + dim; if (slot == 11 && dim >= 4) sc = -1;
            tr_item(w_in + (size_t)l * DM * INCOLS, INCOLS, DM, wl + W_IN / 2, 64 * kb, 32 * nb, sc, scr, lane); continue; }
        r -= I_IN;
        if (r < I_O) { const int kb = r / 32, nb = r % 32;
            tr_item(w_o + (size_t)l * DM * DM, DM, DM, wl + W_O / 2, 64 * kb, 32 * nb, 32 * nb + (lane & 31), scr, lane); continue; }
        r -= I_O;
        if (r < I_GU) { const int kb = r / 176, nb = r % 176, d0 = 32 * nb, p0 = d0 & 255;
            const float* src = (p0 < 128 ? w_gate : w_up) + (size_t)l * DM * DFF;
            tr_item(src, DFF, DM, wl + W_GU / 2, 64 * kb, d0, (d0 >> 8) * 128 + (p0 & 127) + (lane & 31), scr, lane); continue; }
        r -= I_GU;
        { const int kb = r / 32, nb = r % 32;
            tr_item(w_down + (size_t)l * DFF * DM, DM, DFF, wl + W_D / 2, 64 * kb, 32 * nb, 32 * nb + (lane & 31), scr, lane); }
    }
    {
        float* cs = (float*)(ws + WS_ROPE); float* sn = cs + SEQ * 32;
        for (int idx = blockIdx.x * 512 + tid; idx < SEQ * 32; idx += G * 512) {
            const int t = idx >> 5, i = idx & 31;
            double inv = 1.0; for (int k = 0; k < i; ++k) inv *= 0.7498942093324559;
            const float ang = (float)t * (float)inv;
            double rv = (double)ang * 0.15915494309189535; rv -= __builtin_floor(rv);
            const float fr = (float)rv;
            cs[idx] = __builtin_amdgcn_cosf(fr); sn[idx] = __builtin_amdgcn_sinf(fr);
        }
    }
    } else
    {
        const float* c = a.in[1]; const float* w_mod = a.in[4]; const float* b_mod = a.in[5];
        float* mod = (float*)(ws + WS_MOD);
        LAS float* cact = (LAS float*)lds;
        DTB(17);
        for (int idx = tid; idx < BATCH * DM; idx += 512) { const int b = idx >> 10, k = idx & 1023; const float v = c[idx]; cact[k * 32 + b] = v * __builtin_amdgcn_rcpf(1.f + ex2(-v * LOG2E)); }
        __syncthreads();
        for (int unit = blockIdx.x; unit < DEPTH * 6144 / 64; unit += G) {
            const int col = unit * 64 + lane, l = col / 6144, j = col % 6144;
            gemv32_ksplit(w_mod + (size_t)l * DM * 6144 + j, 6144, cact, (LAS float*)(lds + 131072), mod + (size_t)l * BATCH * 6144 + (j - lane), 6144, 64, b_mod[l * 6144 + j], wave, lane, tid);
        }
        DTE(17);
    }
    __syncthreads();
    }
}

__device__ __forceinline__ void prologue_b(const Args& a, LAS unsigned char* lds, int tid, int lane, int wave, int G) {
    unsigned char* ws = a.ws;
    const float* mod = (const float*)(ws + WS_MOD);
    LAS float* cact = (LAS float*)lds;
    constexpr int U_IN = (INCOLS + 63) / 64, U_FF = DFF / 64, U_L = U_IN + 2 * U_FF;
    for (int un = blockIdx.x; un < DEPTH * U_L; un += G) {
        const int l = un / U_L; int r = un % U_L; int type = 0; if (r >= U_IN) { r -= U_IN; type = 1; if (r >= U_FF) { r -= U_FF; type = 2; } }
        const float* shp = mod + (size_t)l * BATCH * 6144 + (type == 0 ? 0 : 3 * DM);
        for (int idx = tid; idx < BATCH * DM; idx += 512) { const int b = idx >> 10, k = idx & 1023; cact[k * 32 + b] = shp[(size_t)b * 6144 + k]; }
        __syncthreads();
        const int ncols = type == 0 ? INCOLS : DFF;
        const float* W = type == 0 ? a.in[6] + (size_t)l * DM * INCOLS : (type == 1 ? a.in[14] : a.in[15]) + (size_t)l * DM * DFF;
        const int col = r * 64 + lane, cc = col < ncols ? col : ncols - 1;
        const int ldb = type == 0 ? NIN : DFF;
        float* bo = (float*)(ws + (type == 0 ? WS_B1 : (type == 1 ? WS_BG : WS_BU))) + (size_t)l * BATCH * ldb + r * 64;
        gemv32_ksplit(W + cc, (size_t)ncols, cact, (LAS float*)(lds + 131072), bo, (size_t)ldb, ncols - r * 64 < 64 ? ncols - r * 64 : 64, 0.f, wave, lane, tid);
        __syncthreads();
    }
}

__device__ __forceinline__ float wsum_f(float v) {
#define DPP_ADD(CTRL, RM) v += __uint_as_float((unsigned)__builtin_amdgcn_update_dpp(0, (int)__float_as_uint(v), CTRL, RM, 0xf, false))
    DPP_ADD(0x111, 0xf); DPP_ADD(0x112, 0xf); DPP_ADD(0x114, 0xf); DPP_ADD(0x118, 0xf); DPP_ADD(0x142, 0xa); DPP_ADD(0x143, 0xc);
#undef DPP_ADD
    return __uint_as_float((unsigned)__builtin_amdgcn_readlane((int)__float_as_uint(v), 63));
}
__device__ __forceinline__ void pre_phase(const float* x, const float* ln, const float* modl  , bf16_t* H, float* SS, int lane, int gw, int NGW) {
    for (int m0 = 4 * gw; m0 < MROWS; m0 += 4 * NGW) {
        f32x4 v[4][4]; float s[4];
#pragma unroll
        for (int rr = 0; rr < 4; ++rr) { const GAS f32x4* xr = (const GAS f32x4*)(x + (size_t)(m0 + rr) * DM) + lane;
#pragma unroll
            for (int j = 0; j < 4; ++j) v[rr][j] = xr[64 * j]; }
#pragma unroll
        for (int rr = 0; rr < 4; ++rr) { float a = 0.f;
#pragma unroll
            for (int j = 0; j < 4; ++j) a += (v[rr][j].x * v[rr][j].x + v[rr][j].y * v[rr][j].y) + (v[rr][j].z * v[rr][j].z + v[rr][j].w * v[rr][j].w);
            s[rr] = wsum_f(a); }
        const int b = m0 / SEQ;
        const float* mb = modl + (size_t)b * 6144;
        f32x4 gv[4];
#pragma unroll
        for (int j = 0; j < 4; ++j) gv[j] = *((const GAS f32x4*)ln + lane + 64 * j) * (*((const GAS f32x4*)(mb + DM) + lane + 64 * j) + 1.f);
#pragma unroll
        for (int rr = 0; rr < 4; ++rr) {
            if (lane < 16) SS[(size_t)(m0 + rr) * 16 + lane] = (lane == 0) ? s[rr] : 0.f;
            GAS u32x2* o8 = (GAS u32x2*)(H + (size_t)(m0 + rr) * DM) + lane;
#pragma unroll
            for (int j = 0; j < 4; ++j) { const f32x4 y = v[rr][j] * gv[j]; u32x2 w; w.x = cvtpk(y.x, y.y); w.y = cvtpk(y.z, y.w); o8[64 * j] = w; }
        }
    }
}

__device__ __forceinline__ void store_head(const f32x16& o0, const f32x16& o1, float inv, const float* gout, bf16_t* orow, int h) {
    float ss = 0.f;
#pragma unroll
    for (int i = 0; i < 16; ++i) { const float a = o0[i] * inv, b = o1[i] * inv; ss += a * a + b * b; }
    ss += __shfl_xor(ss, 32);
    const float rn = __builtin_amdgcn_rsqf(ss * (1.f / 64.f) + EPS) * inv;
#pragma unroll
    for (int g = 0; g < 4; ++g) {
        const int d0 = 8 * g + 4 * h;
        const f32x4 ga = *(const f32x4*)(gout + d0), gb = *(const f32x4*)(gout + 32 + d0);
        u32x2 wa, wb;
        wa.x = cvtpk(o0[4 * g] * rn * ga[0], o0[4 * g + 1] * rn * ga[1]); wa.y = cvtpk(o0[4 * g + 2] * rn * ga[2], o0[4 * g + 3] * rn * ga[3]);
        wb.x = cvtpk(o1[4 * g] * rn * gb[0], o1[4 * g + 1] * rn * gb[1]); wb.y = cvtpk(o1[4 * g + 2] * rn * gb[2], o1[4 * g + 3] * rn * gb[3]);
        *(GAS u32x2*)(orow + d0) = wa; *(GAS u32x2*)(orow + 32 + d0) = wb;
    }
}

__device__ __forceinline__ void swa_unit(int b, int hc, int qt, const bf16_t* P, const bf16_t* VT, bf16_t* O, float M2, float sink2, const float* gout, int lane) {
    const int r = lane & 31, h = lane >> 5, t0 = qt * 32, kv = hc >> 2;
    const size_t rowbase = (size_t)b * SEQ;
    bf16x8 qf[4];
    { const bf16_t* qp = P + (rowbase + t0 + r) * NIN + (24 + hc) * 64 + 8 * h;
#pragma unroll
      for (int ks = 0; ks < 4; ++ks) qf[ks] = ldg16(qp + 16 * ks); }
    const bf16_t* kbase = P + rowbase * NIN + (32 + kv) * 64 + 8 * h + (size_t)r * NIN;
    const bf16_t* vbase = VT + ((size_t)(b * NVS + 5 + kv) * 64 + r) * SEQ + 8 * h;
    f32x16 o0 = zero16(), o1 = zero16(); float lsum = 0.f;
    const int t = t0 + r;
    const int kt_lo = qt - 4 < 0 ? 0 : qt - 4;
    bf16x8 kf[4];
#pragma unroll
    for (int ks = 0; ks < 4; ++ks) kf[ks] = ldg16(kbase + (size_t)(kt_lo * 32) * NIN + 16 * ks);
    for (int kt = kt_lo; kt <= qt; ++kt) {
        bf16x8 kn[4], vf[2][2];
#pragma unroll
        for (int dt = 0; dt < 2; ++dt)
#pragma unroll
            for (int s = 0; s < 2; ++s) vf[dt][s] = ldg16(vbase + (size_t)(dt * 32) * SEQ + kt * 32 + 16 * s);
        { const bf16_t* kp = kbase + (size_t)((kt < qt ? kt + 1 : kt) * 32) * NIN;
#pragma unroll
          for (int ks = 0; ks < 4; ++ks) kn[ks] = ldg16(kp + 16 * ks); }
        f32x16 sc = zero16();
#pragma unroll
        for (int ks = 0; ks < 4; ++ks) sc = MFMA32(kf[ks], qf[ks], sc);
#pragma unroll
        for (int i = 0; i < 16; ++i) { const int key = kt * 32 + crow(i, h); const bool valid = (unsigned)(t - key) < 128u;
            const float p = valid ? ex2(sc[i] - M2) : 0.f; sc[i] = p; lsum += p; }
        const bf16x8 p0 = pack8(sc, 0), p1 = pack8(sc, 1);
        o0 = MFMA32(vf[0][0], p0, o0); o0 = MFMA32(vf[0][1], p1, o0);
        o1 = MFMA32(vf[1][0], p0, o1); o1 = MFMA32(vf[1][1], p1, o1);
#pragma unroll
        for (int ks = 0; ks < 4; ++ks) kf[ks] = kn[ks];
    }
    lsum += __shfl_xor(lsum, 32); lsum += ex2(sink2 - M2);
    store_head(o0, o1, 1.f / lsum, gout, O + (rowbase + t0 + r) * DM + (8 + hc) * 64, h);
}

__device__ __forceinline__ void sb_unit(int b, int hb, int qt, const bf16_t* P, const bf16_t* VT, bf16_t* O, const float* gout, int lane) {
    const int r = lane & 31, h = lane >> 5, t0 = qt * 32;
    const size_t rowbase = (size_t)b * SEQ;
    bf16x8 qf[4];
    { const bf16_t* qp = P + (rowbase + t0 + r) * NIN + (12 + hb) * 64 + 8 * h;
#pragma unroll
      for (int ks = 0; ks < 4; ++ks) qf[ks] = ldg16(qp + 16 * ks); }
    const bf16_t* kbase = P + rowbase * NIN + (16 + hb) * 64 + 8 * h + (size_t)r * NIN;
    const bf16_t* vbase = VT + ((size_t)(b * NVS + 1 + hb) * 64 + r) * SEQ + 8 * h;
    f32x16 o0 = zero16(), o1 = zero16(); float C = 0.f;
    const int t = t0 + r;
    bf16x8 kf[4];
#pragma unroll
    for (int ks = 0; ks < 4; ++ks) kf[ks] = ldg16(kbase + (size_t)(qt * 32) * NIN + 16 * ks);
    for (int kt = qt; kt >= 0; --kt) {
        bf16x8 kn[4], vf[2][2];
#pragma unroll
        for (int dt = 0; dt < 2; ++dt)
#pragma unroll
            for (int s = 0; s < 2; ++s) vf[dt][s] = ldg16(vbase + (size_t)(dt * 32) * SEQ + kt * 32 + 16 * s);
        { const bf16_t* kp = kbase + (size_t)((kt > 0 ? kt - 1 : 0) * 32) * NIN;
#pragma unroll
          for (int ks = 0; ks < 4; ++ks) kn[ks] = ldg16(kp + 16 * ks); }
        f32x16 z = zero16();
#pragma unroll
        for (int ks = 0; ks < 4; ++ks) z = MFMA32(kf[ks], qf[ks], z);
        float L[16];
#pragma unroll
        for (int i = 0; i < 16; ++i) { const int key = kt * 32 + crow(i, h); const float zz = z[i];
            const float sp = RELU(zz) + lg2(1.f + ex2(-fabsf(zz)));
            L[i] = (key < t) ? -sp : 0.f; }
        float G4[4], Gp[4], ps[4], aft[4];
#pragma unroll
        for (int g = 0; g < 4; ++g) { G4[g] = (L[4 * g] + L[4 * g + 1]) + (L[4 * g + 2] + L[4 * g + 3]); Gp[g] = __shfl_xor(G4[g], 32); ps[g] = G4[g] + Gp[g]; }
        aft[3] = 0.f; aft[2] = ps[3]; aft[1] = aft[2] + ps[2]; aft[0] = aft[1] + ps[1];
#pragma unroll
        for (int g = 0; g < 4; ++g) {
            const float bg = C + aft[g] + (h == 0 ? Gp[g] : 0.f);
            const float b3 = bg, b2 = b3 + L[4 * g + 3], b1 = b2 + L[4 * g + 2], b0 = b1 + L[4 * g + 1];
            const float bt[4] = {b0, b1, b2, b3};
#pragma unroll
            for (int e = 0; e < 4; ++e) { const int i = 4 * g + e; const int key = kt * 32 + crow(i, h);
                z[i] = (key < t) ? ex2(z[i] + L[i] + bt[e]) : 0.f; }
        }
        C += aft[0] + ps[0];
        const bf16x8 p0 = pack8(z, 0), p1 = pack8(z, 1);
        o0 = MFMA32(vf[0][0], p0, o0); o0 = MFMA32(vf[0][1], p1, o0);
        o1 = MFMA32(vf[1][0], p0, o1); o1 = MFMA32(vf[1][1], p1, o1);
        if (__all(C < -160.f)) break;
#pragma unroll
        for (int ks = 0; ks < 4; ++ks) kf[ks] = kn[ks];
    }
    store_head(o0, o1, 1.f, gout, O + (rowbase + t0 + r) * DM + (4 + hb) * 64, h);
}

template <int NROWS, int VCH>
__device__ __forceinline__ void stage_kv(LAS unsigned char* ldsK, LAS unsigned char* ldsV, const bf16_t* kg  , const bf16_t* vg  , int tk0  , int tid) {
    constexpr int KCH = NROWS * 8 / 512, NTC = NROWS / 8, VCHT = 64 * NTC / 512;
    const int first_row = tk0 < 0 ? -tk0 : 0;
    const unsigned char* kb = (const unsigned char*)(kg + (size_t)(tk0 + first_row) * NIN);
    const unsigned char* vb = (const unsigned char*)(vg + (tk0 + first_row));
    u32x4 kr[KCH], vr[VCHT];
#pragma unroll
    for (int i = 0; i < KCH; ++i) { const int q = tid + 512 * i, row = q >> 3, c = q & 7; kr[i] = (u32x4){0u, 0u, 0u, 0u};
        if (row >= first_row) kr[i] = *(const GAS u32x4*)(kb + (unsigned)((row - first_row) * (NIN * 2) + 16 * c)); }
#pragma unroll
    for (int i = 0; i < VCHT; ++i) { const int q = tid + 512 * i, d = q / NTC, c = q % NTC; vr[i] = (u32x4){0u, 0u, 0u, 0u};
        if (8 * c >= first_row) vr[i] = *(const GAS u32x4*)(vb + (unsigned)(d * (SEQ * 2) + (8 * c - first_row) * 2)); }
#pragma unroll
    for (int i = 0; i < KCH; ++i) { const int q = tid + 512 * i, row = q >> 3, c = q & 7; *(LAS u32x4*)(ldsK + row * 128 + ((c ^ ((row >> 1) & 7)) << 4)) = kr[i]; }
#pragma unroll
    for (int i = 0; i < VCHT; ++i) { const int q = tid + 512 * i, d = q / NTC, c = q % NTC; *(LAS u32x4*)(ldsV + d * (VCH * 16) + ((c ^ (d & 15)) << 4)) = vr[i]; }
    asm volatile("" ::: "memory");
}
__device__ __forceinline__ bf16x8 lds_kfrag(LAS unsigned char* ldsK, int row, int ch) { return *(const LAS bf16x8*)(ldsK + row * 128 + ((ch ^ ((row >> 1) & 7)) << 4)); }
template <int VCH> __device__ __forceinline__ bf16x8 lds_vfrag(LAS unsigned char* ldsV, int d, int ch) { return *(const LAS bf16x8*)(ldsV + d * (VCH * 16) + ((ch ^ (d & 15)) << 4)); }

__device__ __forceinline__ void swa_dma(LAS unsigned char* buf, int b, int kv, int qb, const bf16_t* P, const bf16_t* VT, int tid, int wave) {
    const int tk0 = qb * 128 - 128;
    const unsigned char* kb = (const unsigned char*)(P + (size_t)b * SEQ * NIN + (32 + kv) * 64);
    const unsigned char* vb = (const unsigned char*)(VT + ((size_t)(b * NVS + 5 + kv) * 64) * SEQ);
#pragma unroll
    for (int i = 0; i < 4; ++i) { const int q = tid + 512 * i, R = q >> 3, cg = (q & 7) ^ ((R >> 1) & 7); int tok = tk0 + R; tok = tok < 0 ? 0 : tok;
        __builtin_amdgcn_global_load_lds((const unsigned*)(kb + (unsigned)(tok * (NIN * 2) + 16 * cg)), (LAS unsigned*)(buf + wave * 1024 + i * 8192), 16, 0, 0); }
#pragma unroll
    for (int i = 0; i < 4; ++i) { const int q = tid + 512 * i, d = q >> 5, cg = (q & 31) ^ (d & 15); int tok = tk0 + 8 * cg; tok = tok < 0 ? 0 : tok;
        __builtin_amdgcn_global_load_lds((const unsigned*)(vb + (unsigned)(d * (SEQ * 2) + tok * 2)), (LAS unsigned*)(buf + 32768 + wave * 1024 + i * 8192), 16, 0, 0); }
}
__device__ __forceinline__ void swa_block(int b, int kv, int qb, const bf16_t* P, const bf16_t* VT, bf16_t* O, float M2, const float* sinks  , const float* gout  ,
                                          LAS unsigned char* buf, LAS unsigned char* nbuf, bool has_next, int nb, int nkv, int nqb, int tid, int lane, int wave) {
    LAS unsigned char* ldsK = buf; LAS unsigned char* ldsV = buf + 32768;
    DTB(16);
    const int t0 = qb * 128, tk0 = t0 - 128;
    const size_t rowbase = (size_t)b * SEQ;
    const int r = lane & 31, h = lane >> 5, j = wave & 3, hc0 = kv * 4 + 2 * (wave >> 2), t0q = t0 + 32 * j;
    bf16x8 qf[2][4];
#pragma unroll
    for (int hd = 0; hd < 2; ++hd) { const bf16_t* qp = P + (rowbase + t0q + r) * NIN + (24 + hc0 + hd) * 64 + 8 * h;
#pragma unroll
        for (int ks = 0; ks < 4; ++ks) qf[hd][ks] = ldg16(qp + 16 * ks); }
    if (has_next) { swa_dma(nbuf, nb, nkv, nqb, P, VT, tid, wave); asm volatile("s_waitcnt vmcnt(8)" ::: "memory"); }
    else asm volatile("s_waitcnt vmcnt(0)" ::: "memory");
    __syncthreads();
    f32x16 o[2][2]; o[0][0] = zero16(); o[0][1] = zero16(); o[1][0] = zero16(); o[1][1] = zero16();
    float ls[2] = {0.f, 0.f};
    const int t = t0q + r;
    for (int i = (tk0 < 0 && j < 4) ? (4 > j ? 4 : j) : j; i <= j + 4; ++i) {
        bf16x8 kf[4], vf[2][2];
#pragma unroll
        for (int ks = 0; ks < 4; ++ks) kf[ks] = lds_kfrag(ldsK, 32 * i + r, 2 * ks + h);
#pragma unroll
        for (int dt = 0; dt < 2; ++dt)
#pragma unroll
            for (int s2 = 0; s2 < 2; ++s2) vf[dt][s2] = lds_vfrag<32>(ldsV, 32 * dt + r, 4 * i + 2 * s2 + h);
#pragma unroll
        for (int hd = 0; hd < 2; ++hd) {
            f32x16 sc;
#pragma unroll
            for (int e = 0; e < 16; ++e) sc[e] = -M2;
#pragma unroll
            for (int ks = 0; ks < 4; ++ks) sc = MFMA32(kf[ks], qf[hd][ks], sc);
            if (i == j || i == j + 4) {
#pragma unroll
                for (int e = 0; e < 16; ++e) { const int key = tk0 + 32 * i + crow(e, h); const bool valid = (unsigned)(t - key) < 128u;
                    const float p = valid ? ex2(sc[e]) : 0.f; sc[e] = p; ls[hd] += p; }
            } else {
#pragma unroll
                for (int e = 0; e < 16; ++e) { const float p = ex2(sc[e]); sc[e] = p; ls[hd] += p; }
            }
            const bf16x8 p0 = pack8(sc, 0), p1 = pack8(sc, 1);
            o[hd][0] = MFMA32(vf[0][0], p0, o[hd][0]); o[hd][0] = MFMA32(vf[0][1], p1, o[hd][0]);
            o[hd][1] = MFMA32(vf[1][0], p0, o[hd][1]); o[hd][1] = MFMA32(vf[1][1], p1, o[hd][1]);
        }
    }
#pragma unroll
    for (int hd = 0; hd < 2; ++hd) {
        float l2 = ls[hd]; l2 += __shfl_xor(l2, 32); l2 += ex2(sinks[hc0 + hd] * LOG2E - M2);
        store_head(o[hd][0], o[hd][1], 1.f / l2, gout + (8 + hc0 + hd) * 64, O + (rowbase + t0q + r) * DM + (8 + hc0 + hd) * 64, h);
    }
    __syncthreads();
    DTE(16);
}

__device__ __forceinline__ void sb_block(int b, int hb, int qb, const bf16_t* P, const bf16_t* VT, bf16_t* O, const float* gout  , LAS unsigned char* lds, int tid, int lane, int wave) {
    LAS unsigned char* ldsK = lds; LAS unsigned char* ldsV = lds + 57344;
    const int t0 = qb * 256, tk0 = t0 - 192;
    const size_t rowbase = (size_t)b * SEQ;
    const int r = lane & 31, h = lane >> 5, t0q = t0 + 32 * wave;
    bf16x8 qf[4];
    { const bf16_t* qp = P + (rowbase + t0q + r) * NIN + (12 + hb) * 64 + 8 * h;
#pragma unroll
      for (int ks = 0; ks < 4; ++ks) qf[ks] = ldg16(qp + 16 * ks); }
    const bf16_t* kg = P + rowbase * NIN + (16 + hb) * 64;
    const bf16_t* vg = VT + ((size_t)(b * NVS + 1 + hb) * 64) * SEQ;
    stage_kv<448, 64>(ldsK, ldsV, kg, vg, tk0, tid);
    __syncthreads();
    f32x16 o0 = zero16(), o1 = zero16(); float C = 0.f;
    const int t = t0q + r;
#pragma unroll 1
    for (int kt = t0q >> 5; kt >= 0; --kt) {
        bf16x8 kf[4], vf[2][2];
        const int i = kt - (tk0 >> 5);
        if (i >= 0) {
#pragma unroll
            for (int ks = 0; ks < 4; ++ks) kf[ks] = lds_kfrag(ldsK, 32 * i + r, 2 * ks + h);
#pragma unroll
            for (int dt = 0; dt < 2; ++dt)
#pragma unroll
                for (int s2 = 0; s2 < 2; ++s2) vf[dt][s2] = lds_vfrag<64>(ldsV, 32 * dt + r, 4 * i + 2 * s2 + h);
        } else {
            const bf16_t* kp = kg + (size_t)(kt * 32 + r) * NIN + 8 * h;
#pragma unroll
            for (int ks = 0; ks < 4; ++ks) kf[ks] = ldg16(kp + 16 * ks);
#pragma unroll
            for (int dt = 0; dt < 2; ++dt)
#pragma unroll
                for (int s2 = 0; s2 < 2; ++s2) vf[dt][s2] = ldg16(vg + (size_t)(dt * 32 + r) * SEQ + kt * 32 + 16 * s2 + 8 * h);
        }
        f32x16 z = zero16();
#pragma unroll
        for (int ks = 0; ks < 4; ++ks) z = MFMA32(kf[ks], qf[ks], z);
        float L[16];
        const bool diag = (kt == (t0q >> 5));
#pragma unroll
        for (int e = 0; e < 16; ++e) { const float zz = z[e];
            L[e] = -(RELU(zz) + lg2(1.f + ex2(-fabsf(zz)))); }
        if (diag) {
#pragma unroll
            for (int e = 0; e < 16; ++e) { const int key = kt * 32 + crow(e, h); L[e] = (key < t) ? L[e] : 0.f; }
        }
        float G4[4], Gp[4], ps[4], aft[4];
#pragma unroll
        for (int g = 0; g < 4; ++g) { G4[g] = (L[4 * g] + L[4 * g + 1]) + (L[4 * g + 2] + L[4 * g + 3]); Gp[g] = __shfl_xor(G4[g], 32); ps[g] = G4[g] + Gp[g]; }
        aft[3] = 0.f; aft[2] = ps[3]; aft[1] = aft[2] + ps[2]; aft[0] = aft[1] + ps[1];
#pragma unroll
        for (int g = 0; g < 4; ++g) {
            const float bg = C + aft[g] + (h == 0 ? Gp[g] : 0.f);
            const float b3 = bg, b2 = b3 + L[4 * g + 3], b1 = b2 + L[4 * g + 2], b0 = b1 + L[4 * g + 1];
            const float bt[4] = {b0, b1, b2, b3};
#pragma unroll
            for (int e = 0; e < 4; ++e) { const int ii = 4 * g + e; z[ii] = ex2(z[ii] + L[ii] + bt[e]); }
        }
        C += aft[0] + ps[0];
        if (diag) {
#pragma unroll
            for (int e = 0; e < 16; ++e) { const int key = kt * 32 + crow(e, h); z[e] = (key < t) ? z[e] : 0.f; }
        }
        const bf16x8 p0 = pack8(z, 0), p1 = pack8(z, 1);
        o0 = MFMA32(vf[0][0], p0, o0); o0 = MFMA32(vf[0][1], p1, o0);
        o1 = MFMA32(vf[1][0], p0, o1); o1 = MFMA32(vf[1][1], p1, o1);
        if (__all(C < -160.f)) break;
    }
    store_head(o0, o1, 1.f, gout + (4 + hb) * 64, O + (rowbase + t0q + r) * DM + (4 + hb) * 64, h);
    __syncthreads();
}

__device__ __forceinline__ void group_sync(volatile LAS unsigned* cnt, unsigned& target, int lane) {
    asm volatile("s_waitcnt lgkmcnt(0)" ::: "memory");
    target += 4u;
    if (lane == 0) __hip_atomic_fetch_add((LAS unsigned*)cnt, 1u, __ATOMIC_RELAXED, __HIP_MEMORY_SCOPE_WORKGROUP);
    while (*cnt - (target - 4u) < 4u) __builtin_amdgcn_s_sleep(1);
    asm volatile("" ::: "memory");
}
__device__ __forceinline__ void dsa_phase(const bf16_t* P, const bf16_t* VT, const float* WI, bf16_t* O, const float* gout  , float M2, unsigned* queue,
                                          LAS unsigned char* lds, int tid, int lane, int wave) {
    const int grp = wave >> 2, gwv = wave & 3;
    LAS unsigned char* gl = lds + grp * G2_BYTES;
    LAS _Float16* SC = (LAS _Float16*)(gl + G2_SC);
    LAS float* PART = (LAS float*)(gl + G2_SC);
    LAS unsigned* MASK = (LAS unsigned*)(gl + G2_MASK);
    LAS float* LSUM = (LAS float*)(gl + G2_LSUM);
    LAS float* SSUM = (LAS float*)(gl + G2_SSUM);
    volatile LAS unsigned* QW = (volatile LAS unsigned*)(lds + LDS_MISC) + 2 * grp;
    volatile LAS unsigned* GC = (volatile LAS unsigned*)(lds + LDS_MISC) + 8 + grp;
    unsigned gtarget = *GC;
    __syncthreads();
#define GSYNC() group_sync(GC, gtarget, lane)
    constexpr int NU = BATCH * 128, NUX = NU / 8;
    const unsigned xq = xb_xcc_id() & 7u;
#define FETCH_UNIT(DST) do { unsigned got_ = (unsigned)NU; \
        for (unsigned k_ = 0; k_ < 8u; ++k_) { const unsigned x_ = (xq + k_) & 7u; \
            if (__hip_atomic_load(queue + 16 * x_, __ATOMIC_RELAXED, __HIP_MEMORY_SCOPE_AGENT) >= (unsigned)NUX) continue; \
            const unsigned i_ = __hip_atomic_fetch_add(queue + 16 * x_, 1u, __ATOMIC_RELAXED, __HIP_MEMORY_SCOPE_AGENT); \
            if (i_ < (unsigned)NUX) { got_ = x_ * NUX + i_; break; } } \
        DST = got_; } while (0)
#define FETCH_EARLY() __hip_atomic_fetch_add(queue + 16 * xq, 1u, __ATOMIC_RELAXED, __HIP_MEMORY_SCOPE_AGENT)
#define FETCH_LATE(DST, I0) do { unsigned got_ = (unsigned)NU; \
        if ((I0) < (unsigned)NUX) got_ = xq * NUX + (I0); \
        else for (unsigned k_ = 1; k_ < 8u; ++k_) { const unsigned x_ = (xq + k_) & 7u; \
            if (__hip_atomic_load(queue + 16 * x_, __ATOMIC_RELAXED, __HIP_MEMORY_SCOPE_AGENT) >= (unsigned)NUX) continue; \
            const unsigned i_ = __hip_atomic_fetch_add(queue + 16 * x_, 1u, __ATOMIC_RELAXED, __HIP_MEMORY_SCOPE_AGENT); \
            if (i_ < (unsigned)NUX) { got_ = x_ * NUX + i_; break; } } \
        DST = got_; } while (0)
#define UNIT_B(Q) (4 * ((Q) / NUX) + (((Q) % NUX) & 3))
#define UNIT_TAU(Q) (127 - (((Q) % NUX) >> 2))
    if (gwv == 0 && lane == 0) FETCH_UNIT(QW[0]);
    GSYNC();
    int q = (int)QW[0], par = 0;
    bf16x8 qi[4][2]; f32x4 wq;
    { const int c = lane & 15, g = lane >> 4; const int qq = q < NU ? q : 0; const size_t row = (size_t)UNIT_B(qq) * SEQ + 16 * UNIT_TAU(qq) + c;
      const bf16_t* qp = P + row * NIN + 4 * 64 + 8 * g;
#pragma unroll
      for (int hh = 0; hh < 4; ++hh) { qi[hh][0] = ldg16(qp + hh * 64); qi[hh][1] = ldg16(qp + hh * 64 + 32); }
      wq = *(const GAS f32x4*)(WI + row * 4); }
    while (q < NU) {
        const int tau = UNIT_TAU(q), b = UNIT_B(q), t0 = 16 * tau;
        const size_t rowbase = (size_t)b * SEQ;
        DTB(12);
        unsigned fu0 = 0u;
        if (gwv == 0 && lane == 0) fu0 = FETCH_EARLY();
        {
            int lane1 = lane; asm volatile("" : "+v"(lane1));
            const int c = lane1 & 15, g = lane1 >> 4;
            const bf16_t* kp0 = P + (rowbase + c) * NIN + 10 * 64 + 8 * g;
#define IDX_TILE(KT, K0, K1) do { f32x4 sc_ = {0.f, 0.f, 0.f, 0.f}, a_[4]; \
                _Pragma("unroll") for (int hh = 0; hh < 4; ++hh) a_[hh] = MFMA16(K0, qi[hh][0], ((f32x4){0.f, 0.f, 0.f, 0.f}));        \
                _Pragma("unroll") for (int hh = 0; hh < 4; ++hh) a_[hh] = MFMA16(K1, qi[hh][1], a_[hh]); \
                asm volatile("" : "+v"(a_[0]), "+v"(a_[1]), "+v"(a_[2]), "+v"(a_[3])); \
                _Pragma("unroll") for (int hh = 0; hh < 4; ++hh) { \
                    _Pragma("unroll") for (int j = 0; j < 4; ++j) sc_[j] += wq[hh] * RELU(a_[hh][j]); } \
                LAS _Float16* sp_ = SC + c * SCH + (16 * ((KT) & 1) + 4 * g) * 64 + ((KT) >> 1);     \
                sp_[0] = (_Float16)sc_[0]; sp_[64] = (_Float16)sc_[1]; sp_[128] = (_Float16)sc_[2]; sp_[192] = (_Float16)sc_[3]; } while (0)
            bf16x8 ka0 = qi[0][0], ka1 = qi[0][1], kb0 = qi[0][0], kb1 = qi[0][1];
            if (gwv <= tau) { const bf16_t* kp = kp0 + (size_t)(gwv * 16) * NIN; ka0 = ldg16(kp); ka1 = ldg16(kp + 32); }
            if (gwv + 4 <= tau) { const bf16_t* kp = kp0 + (size_t)((gwv + 4) * 16) * NIN; kb0 = ldg16(kp); kb1 = ldg16(kp + 32); }
            for (int kt = gwv; kt <= tau; kt += 8) {
                bf16x8 na0 = ka0, na1 = ka1, nb0 = kb0, nb1 = kb1;
                if (kt + 8 <= tau) { const bf16_t* kp = kp0 + (size_t)((kt + 8) * 16) * NIN; na0 = ldg16(kp); na1 = ldg16(kp + 32); }
                if (kt + 12 <= tau) { const bf16_t* kp = kp0 + (size_t)((kt + 12) * 16) * NIN; nb0 = ldg16(kp); nb1 = ldg16(kp + 32); }
                IDX_TILE(kt, ka0, ka1);
                if (kt + 4 <= tau) IDX_TILE(kt + 4, kb0, kb1);
                ka0 = na0; ka1 = na1; kb0 = nb0; kb1 = nb1;
            }
#undef IDX_TILE
        }
        bf16x8 qf[2][4];
        { int lane2 = lane; asm volatile("" : "+v"(lane2));
          const int r = lane2 & 31, h = lane2 >> 5, c = r & 15;
#pragma unroll
          for (int nt = 0; nt < 2; ++nt) { const bf16_t* qp = P + (rowbase + t0 + c) * NIN + (2 * nt + (r >> 4)) * 64 + 8 * h;
#pragma unroll
              for (int ks = 0; ks < 4; ++ks) qf[nt][ks] = ldg16(qp + 16 * ks); } }
        GSYNC();
        DTE(12); DTB(13);
#define SEL_LOAD(PL, R) do { _Pragma("unroll") for (int i = 0; i < 16; ++i) { \
                const unsigned lo_ = (unsigned)__builtin_bit_cast(unsigned short, SC[(R) * SCH + 64 * i + lane]), hi_ = (unsigned)__builtin_bit_cast(unsigned short, SC[(R) * SCH + 64 * (i + 16) + lane]); \
                PL[i] = lo_ | (hi_ << 16); } } while (0)
#define TSTAGE(PL, J, MSK) _Pragma("unroll") for (int k_ = 0; k_ < 16; ++k_) if ((k_ & (J)) == 0) { const unsigned lo_ = PL[k_], hi_ = PL[k_ + (J)]; \
                PL[k_] = (lo_ & (MSK)) | ((hi_ << (J)) & ~(MSK)); PL[k_ + (J)] = ((lo_ >> (J)) & (MSK)) | (hi_ & ~(MSK)); }
#define SEL_PLANES(PL) do { TSTAGE(PL, 8, 0x00ff00ffu) TSTAGE(PL, 4, 0x0f0f0f0fu) TSTAGE(PL, 2, 0x33333333u) TSTAGE(PL, 1, 0x55555555u) \
                _Pragma("unroll") for (int bq = 0; bq < 15; ++bq) PL[bq] ^= PL[15]; PL[15] = ~PL[15]; } while (0)
#define SEL_STEP(PL, X, C, A, G, CNTG, NA, DONE) do { if (!DONE) { if (CNTG + C >= 256) { A = X; NA = C; } else { G |= X; CNTG += C; A &= ~PL; NA -= C; } DONE = (CNTG + NA == 256); } } while (0)
#define SEL_TIES(A, CNTG) do { const int need_ = 256 - CNTG, pc_ = __builtin_popcount(A); int inc_ = pc_; \
                inc_ += __builtin_amdgcn_update_dpp(0, inc_, 0x111, 0xf, 0xf, false); inc_ += __builtin_amdgcn_update_dpp(0, inc_, 0x112, 0xf, 0xf, false); \
                inc_ += __builtin_amdgcn_update_dpp(0, inc_, 0x114, 0xf, 0xf, false); inc_ += __builtin_amdgcn_update_dpp(0, inc_, 0x118, 0xf, 0xf, false); \
                inc_ += __builtin_amdgcn_update_dpp(0, inc_, 0x142, 0xa, 0xf, false); inc_ += __builtin_amdgcn_update_dpp(0, inc_, 0x143, 0xc, 0xf, false); \
                int take_ = need_ - (inc_ - pc_); take_ = take_ < 0 ? 0 : (take_ > pc_ ? pc_ : take_); \
                while (__builtin_popcount(A) > take_) A &= ~(0x80000000u >> __builtin_clz(A)); } while (0)
#pragma unroll 1
        for (int rp = 0; rp < 2; ++rp) {
            const int ra = 4 * gwv + 2 * rp, rb = ra + 1, na = t0 + ra + 1, nb = na + 1;
            const int cva = na - 32 * lane, cvb = nb - 32 * lane;
            unsigned Aa = cva >= 32 ? ~0u : (cva <= 0 ? 0u : ((1u << cva) - 1u)), Ab = cvb >= 32 ? ~0u : (cvb <= 0 ? 0u : ((1u << cvb) - 1u));
            unsigned Ga = 0u, Gb = 0u; int cntGa = 0, cntGb = 0, nAa = na, nAb = nb;
            bool donea = (na <= 256), doneb = (nb <= 256);
            if (!(donea && doneb)) {
                unsigned PA[16], PB[16];
                SEL_LOAD(PA, ra); SEL_LOAD(PB, rb);
                SEL_PLANES(PA); SEL_PLANES(PB);
#pragma unroll
                for (int bq = 15; bq >= 0; --bq) {
                    if (!(donea && doneb)) {
                        const unsigned Xa = Aa & PA[bq], Xb = Ab & PB[bq];
                        const unsigned tot = (unsigned)wsum_i(__builtin_popcount(Xa) + (__builtin_popcount(Xb) << 16));
                        const int ca = (int)(tot & 0xffffu), cb = (int)(tot >> 16);
                        SEL_STEP(PA[bq], Xa, ca, Aa, Ga, cntGa, nAa, donea);
                        SEL_STEP(PB[bq], Xb, cb, Ab, Gb, cntGb, nAb, doneb);
                    }
                }
                if (!donea) SEL_TIES(Aa, cntGa);
                if (!doneb) SEL_TIES(Ab, cntGb);
            }
            MASK[ra * MASK_STRIDE + lane] = Ga | Aa;
            MASK[rb * MASK_STRIDE + lane] = Gb | Ab;
        }
#undef SEL_LOAD
#undef TSTAGE
#undef SEL_PLANES
#undef SEL_STEP
#undef SEL_TIES
        if (gwv == 0 && lane == 0) FETCH_LATE(QW[par ^ 1], fu0);
        GSYNC();
        DTE(13); DTB(14);
        {
            int lane3 = lane; asm volatile("" : "+v"(lane3));
            const int r = lane3 & 31, h = lane3 >> 5, c = r & 15;
            f32x16 o[2][2]; float ls[2];
            o[0][0] = zero16(); o[0][1] = zero16(); o[1][0] = zero16(); o[1][1] = zero16(); ls[0] = 0.f; ls[1] = 0.f;
            const int nkt = ((t0 + 15) >> 5) + 1;
            f32x16 negm2; _Pragma("unroll") for (int i = 0; i < 16; ++i) negm2[i] = -M2;
            asm volatile("" : "+v"(negm2));
#define ATT_TILE(KT, KF, VF) do { const unsigned mw_ = MASK[c * MASK_STRIDE + (KT)] >> (4 * h); \
                int mk_[16]; _Pragma("unroll") for (int i = 0; i < 16; ++i) mk_[i] = __builtin_amdgcn_sbfe((int)mw_, crow(i, 0), 1);        \
                _Pragma("unroll") for (int nt = 0; nt < 2; ++nt) { \
                    f32x16 sc_ = negm2; \
                    _Pragma("unroll") for (int ks = 0; ks < 4; ++ks) sc_ = MFMA32(KF[ks], qf[nt][ks], sc_); \
                    _Pragma("unroll") for (int i = 0; i < 16; ++i) { const float p_ = __builtin_bit_cast(float, __builtin_bit_cast(int, ex2(sc_[i])) & mk_[i]); sc_[i] = p_; ls[nt] += p_; } \
                    const bf16x8 p0_ = pack8(sc_, 0), p1_ = pack8(sc_, 1); \
                    o[nt][0] = MFMA32(VF[0][0], p0_, o[nt][0]); o[nt][0] = MFMA32(VF[0][1], p1_, o[nt][0]); \
                    o[nt][1] = MFMA32(VF[1][0], p0_, o[nt][1]); o[nt][1] = MFMA32(VF[1][1], p1_, o[nt][1]); } } while (0)
            LAS unsigned char* const wslot = (LAS unsigned char*)PART + gwv * 16384;
            const unsigned char* const kgb = (const unsigned char*)(P + rowbase * NIN + 8 * 64);
            const unsigned char* const vgb = (const unsigned char*)(VT + ((size_t)(b * NVS) * 64) * SEQ);
            unsigned koff[4], voff[4];
#pragma unroll
            for (int i = 0; i < 4; ++i) { const int row = 8 * i + (lane3 >> 3), ch = (lane3 & 7) ^ ((row >> 1) & 7); koff[i] = (unsigned)(row * (NIN * 2) + 16 * ch);
                const int d = 16 * i + (lane3 >> 2), cv = (lane3 & 3) ^ ((d >> 2) & 3); voff[i] = (unsigned)(d * (SEQ * 2) + 16 * cv); }
#define DMA_TILE(KT, SLOT) do { const unsigned char* kt_ = kgb + (size_t)((KT) * 32) * (NIN * 2); const unsigned char* vt_ = vgb + (size_t)(KT) * 64; \
                _Pragma("unroll") for (int i = 0; i < 4; ++i) __builtin_amdgcn_global_load_lds((const unsigned*)(kt_ + koff[i]), (LAS unsigned*)(wslot + (SLOT) * 8192 + 1024 * i), 16, 0, 0); \
                _Pragma("unroll") for (int i = 0; i < 4; ++i) __builtin_amdgcn_global_load_lds((const unsigned*)(vt_ + voff[i]), (LAS unsigned*)(wslot + (SLOT) * 8192 + 4096 + 1024 * i), 16, 0, 0); } while (0)
            const int ntl = gwv < nkt ? (nkt - gwv + 3) >> 2 : 0;
            if (ntl > 0) DMA_TILE(gwv, 0);
            if (ntl > 1) DMA_TILE(gwv + 4, 1);
            for (int j = 0; j < ntl; ++j) {
                const int kt = gwv + 4 * j;
                if (j + 1 < ntl) asm volatile("s_waitcnt vmcnt(8)" ::: "memory"); else asm volatile("s_waitcnt vmcnt(0)" ::: "memory");
                LAS unsigned char* const sl = wslot + (j & 1) * 8192;
                bf16x8 kf[4], vf[2][2];
#pragma unroll
                for (int ks = 0; ks < 4; ++ks) kf[ks] = *(const LAS bf16x8*)(sl + r * 128 + (((2 * ks + h) ^ ((r >> 1) & 7)) << 4));
#pragma unroll
                for (int dt = 0; dt < 2; ++dt)
#pragma unroll
                    for (int s2 = 0; s2 < 2; ++s2) { const int d = 32 * dt + r; vf[dt][s2] = *(const LAS bf16x8*)(sl + 4096 + d * 64 + (((2 * s2 + h) ^ ((d >> 2) & 3)) << 4)); }
                asm volatile("s_waitcnt lgkmcnt(0)" ::: "memory");
                if (j + 2 < ntl) DMA_TILE(kt + 8, j & 1);
                ATT_TILE(kt, kf, vf);
            }
            asm volatile("s_waitcnt vmcnt(0) lgkmcnt(0)" ::: "memory");
#undef DMA_TILE
#undef ATT_TILE
#pragma unroll
            for (int nt = 0; nt < 2; ++nt) {
#pragma unroll
                for (int dt = 0; dt < 2; ++dt)
#pragma unroll
                    for (int i = 0; i < 16; ++i) PART[(gwv * 64 + 32 * dt + crow(i, h)) * 64 + 32 * nt + r] = o[nt][dt][i];
                float l2 = ls[nt]; l2 += __shfl_xor(l2, 32);
                if (h == 0) LSUM[gwv * 64 + 32 * nt + r] = l2;
            }
        }
        const int qn = (int)QW[par ^ 1];
        { int lane4 = lane; asm volatile("" : "+v"(lane4));
          const int c = lane4 & 15, g = lane4 >> 4; const int qq = qn < NU ? qn : 0; const size_t row = (size_t)UNIT_B(qq) * SEQ + 16 * UNIT_TAU(qq) + c;
          const bf16_t* qp = P + row * NIN + 4 * 64 + 8 * g;
#pragma unroll
          for (int hh = 0; hh < 4; ++hh) { qi[hh][0] = ldg16(qp + hh * 64); qi[hh][1] = ldg16(qp + hh * 64 + 32); }
          wq = *(const GAS f32x4*)(WI + row * 4); }
        GSYNC();
        DTE(14); DTB(15);
        {
            int n = lane; asm volatile("" : "+v"(n));
            float l = 0.f;
#pragma unroll
            for (int w = 0; w < 4; ++w) l += LSUM[w * 64 + n];
            const float inv = 1.f / l;
            float ov[16]; float ssp = 0.f;
#pragma unroll
            for (int dd = 0; dd < 16; ++dd) { float a = 0.f;
#pragma unroll
                for (int w = 0; w < 4; ++w) a += PART[(w * 64 + 16 * gwv + dd) * 64 + n];
                ov[dd] = a * inv; ssp += ov[dd] * ov[dd]; }
            SSUM[gwv * 64 + n] = ssp;
            GSYNC();
            float ss = 0.f;
#pragma unroll
            for (int w = 0; w < 4; ++w) ss += SSUM[w * 64 + n];
            const float rn = __builtin_amdgcn_rsqf(ss * (1.f / 64.f) + EPS);
            const int head = n >> 4, c = n & 15;
            bf16_t* op = O + (rowbase + t0 + c) * DM + head * 64 + 16 * gwv;
#pragma unroll
            for (int hf = 0; hf < 2; ++hf) {
                const f32x4 ga = *(const f32x4*)(gout + head * 64 + 16 * gwv + 8 * hf), gb = *(const f32x4*)(gout + head * 64 + 16 * gwv + 8 * hf + 4);
                u32x4 wv; wv.x = cvtpk(ov[8 * hf] * rn * ga[0], ov[8 * hf + 1] * rn * ga[1]); wv.y = cvtpk(ov[8 * hf + 2] * rn * ga[2], ov[8 * hf + 3] * rn * ga[3]);
                wv.z = cvtpk(ov[8 * hf + 4] * rn * gb[0], ov[8 * hf + 5] * rn * gb[1]); wv.w = cvtpk(ov[8 * hf + 6] * rn * gb[2], ov[8 * hf + 7] * rn * gb[3]);
                *(GAS u32x4*)(op + 8 * hf) = wv; }
        }
        GSYNC();
        DTE(15);
        q = qn; par ^= 1;
    }
#undef GSYNC
#undef FETCH_UNIT
#undef FETCH_EARLY
#undef FETCH_LATE
#undef UNIT_B
#undef UNIT_TAU
}

typedef const __attribute__((address_space(4))) char* kargp_t;
#define KP() kargp_t kp_ = (kargp_t)__builtin_amdgcn_kernarg_segment_ptr(); asm volatile("" : "+s"(kp_)); unsigned char* const ws = *(unsigned char* const __attribute__((address_space(4)))*)(kp_ + 144); (void)ws
#define AIN(k) (*(const float* const __attribute__((address_space(4)))*)(kp_ + 8 * (k)))
#define AOUT() (*(float* const __attribute__((address_space(4)))*)(kp_ + 136))
static_assert(sizeof(Args) == 160, "Args layout: in[17] | out | ws | lo | hi");
__global__ void __launch_bounds__(NWAVES * 64, 2) fwd(Args args) {
    extern __shared__ __attribute__((aligned(16))) unsigned char lds_raw[];
    LAS unsigned char* lds = (LAS unsigned char*)lds_raw;
    const int wave = __builtin_amdgcn_readfirstlane(threadIdx.x >> 6);
    const int G = gridDim.x;
    const int gw = blockIdx.x * NWAVES + wave, NGW = G * NWAVES;
    volatile LAS unsigned* MISC = (volatile LAS unsigned*)(lds + LDS_MISC);
    if (threadIdx.x < 16) MISC[threadIdx.x] = 0u;
    __syncthreads();
    XcdBarrier bar; bar.bar = (unsigned*)(args.ws + WS_CTL) + CW_BAR; bar.x = 0; bar.st = nullptr; bar.w = wave;
    if (!MK_MULTI) bar = xcd_barrier_post((unsigned*)(args.ws + WS_CTL) + CW_BAR, MISC + 4, wave);
    const int lo = args.lo, hi = args.hi;
#define IN(k) (lo <= (k) && (k) < hi)
#define SEAM(k) do { if (IN(k) && IN((k) + 1)) xcd_barrier(bar); } while (0)
#define OPQ() int tid = wave * 64 + lane_id_v(); asm volatile("" : "+v"(tid)); const int lane = tid & 63; (void)lane
#ifdef TPROBE
#define TBEG(cls) do { if ((TPROBE >> (cls)) & 1) { if (threadIdx.x == 0) MISC[13] = (unsigned)__builtin_amdgcn_s_memrealtime(); } } while (0)
#define TEND(cls) do { if ((TPROBE >> (cls)) & 1) { if (threadIdx.x == 0) MISC[12] = MISC[12] + ((unsigned)__builtin_amdgcn_s_memrealtime() - MISC[13]); } } while (0)
#else
#define TBEG(cls) do { } while (0)
#define TEND(cls) do { } while (0)
#endif
#ifdef TPROBE_BODY
#define TENDB(cls) TEND(cls)
#define TENDS(cls) do { } while (0)
#else
#define TENDB(cls) do { } while (0)
#define TENDS(cls) TEND(cls)
#endif
    TBEG(0);
    if (PH(0) && IN(0)) _Pragma("unroll 1") for (int rep = 0; rep < REP_PA; ++rep) { OPQ(); prologue(args, lds, tid, lane, wave, G); }
    TENDB(0); SEAM(0); TENDS(0);
    TBEG(1);
    _Pragma("unroll 1") for (int pass = 0; pass < 2; ++pass) {
    if (((pass ^ (int)blockIdx.x) & 1) == 0) {
    if (PH(0) && IN(1)) _Pragma("unroll 1") for (int rep = 0; rep < REP_PB; ++rep) { OPQ(); prologue_b(args, lds, tid, lane, wave, G); }
    } else {
    if (PH(1) && IN(1)) _Pragma("unroll 1") for (int rep = 0; rep < REP_N; ++rep) { OPQ(); KP();
        pre_phase(AIN(0), AIN(2), (const float*)(ws + WS_MOD), (bf16_t*)(ws + WS_H), (float*)(ws + WS_SS), lane, gw, NGW); }
    } }
    TENDB(1); SEAM(1); TENDS(1);

    for (int l = 0; l < DEPTH; ++l) {
        const int s0 = 1 + 5 * l;
        TBEG(2);
        if (PH(2) && IN(s0 + 1)) _Pragma("unroll 1") for (int rep = 0; rep < REP_G2; ++rep) {
            KP(); stagger(STAG_I);
            const bf16_t* wl = (const bf16_t*)(ws + WS_W + (size_t)l * W_LAYER);
            pg8::Gemm g{(const bf16_t*)(ws + WS_H), wl + W_IN / 2, MROWS, NIN, DM}; pg8::StaticOrder S; S.init(MROWS, NIN, G, (int)blockIdx.x);
            pg8::EpiInProj E{(bf16_t*)(ws + WS_P), (bf16_t*)(ws + WS_VT), (float*)(ws + WS_WI), (const float*)(ws + WS_ROPE), (const float*)(ws + WS_ROPE) + SEQ * 32,
                             AIN(7) + l * 64, AIN(8) + l * 64, AIN(9) + l * 64, AIN(10) + l * 64, (const float*)(ws + WS_SS), (const float*)(ws + WS_B1) + (size_t)l * BATCH * NIN, (LAS float*)(lds + 131072)};
            pg8::gemm_phase<pg8::EpiInProj, pg8::StaticOrder, true, true>(lds, g, S, E, wave);
        }
        TENDB(2); SEAM(s0 + 1); TENDS(2); TBEG(3);
        if (PH(3) && IN(s0 + 2)) {
            OPQ(); KP();
            const bf16_t* P = (const bf16_t*)(ws + WS_P); const bf16_t* VT = (const bf16_t*)(ws + WS_VT); bf16_t* OB = (bf16_t*)(ws + WS_O);
            const float* gout = AIN(12) + l * 1024;
            const float gqa = wave_max(fabsf(AIN(7)[l * 64 + lane])), gka = wave_max(fabsf(AIN(8)[l * 64 + lane]));
            const float gqc = wave_max(fabsf(AIN(9)[l * 64 + lane])), gkc = wave_max(fabsf(AIN(10)[l * 64 + lane]));
            const float M2a = 8.f * gqa * gka * LOG2E, M2c = 8.f * gqc * gkc * LOG2E;
            _Pragma("unroll 1") for (int rep = 0; rep < REP_ATT; ++rep) {
            const int xs = (G % 8 == 0) ? (int)(blockIdx.x & 7) : 0, js = (G % 8 == 0) ? (int)(blockIdx.x >> 3) : (int)blockIdx.x, njs = (G % 8 == 0) ? G / 8 : G, nvs = (G % 8 == 0) ? 128 : 1024;
            TBEG(8); TBEG(11);
            if (PH(8)) _Pragma("unroll 1") for (int r2 = 0; r2 < REP_SWA; ++r2) {
                if (js < nvs) swa_dma(lds, 4 * xs + (js >> 5), (js >> 4) & 1, js & 15, P, VT, tid, wave);
                int pb = 0;
                for (int v = js; v < nvs; v += njs, pb ^= 1) { const int b = 4 * xs + (v >> 5), kv = (v >> 4) & 1, qb = v & 15, vn = v + njs;
                    swa_block(b, kv, qb, P, VT, OB, M2c, AIN(11) + l * 8, gout, lds + pb * 65536, lds + (pb ^ 1) * 65536, vn < nvs, 4 * xs + (vn >> 5), (vn >> 4) & 1, vn & 15, tid, lane, wave); } }
            TEND(8); TBEG(9);
            if (PH(9)) _Pragma("unroll 1") for (int r2 = 0; r2 < REP_SB; ++r2) for (int v = js; v < nvs; v += njs) { const int b = 4 * xs + (v >> 5), hb = (v >> 3) & 3, qb = v & 7;
                sb_block(b, hb, qb, P, VT, OB, gout, lds, tid, lane, wave); }
            TEND(9); TEND(11); TBEG(10);
            if (PH(10)) _Pragma("unroll 1") for (int r2 = 0; r2 < REP_DSA; ++r2) dsa_phase(P, VT, (const float*)(ws + WS_WI), OB, gout, M2a, (unsigned*)(ws + WS_CTL) + CW_QUEUE + 1024 * l + 256 * rep + 128 * r2, lds, tid, lane, wave);
            TEND(10);
            }
        }
        TENDB(3); SEAM(s0 + 2); TENDS(3); TBEG(4);
        if (PH(4) && IN(s0 + 3)) _Pragma("unroll 1") for (int rep = 0; rep < REP_G4; ++rep) {
            KP(); stagger(STAG_O);
            const bf16_t* wl = (const bf16_t*)(ws + WS_W + (size_t)l * W_LAYER); const float* modl = (const float*)(ws + WS_MOD) + (size_t)l * BATCH * 6144;
            pg8::Gemm g{(const bf16_t*)(ws + WS_O), wl + W_O / 2, MROWS, DM, DM}; pg8::StaticOrder S; S.init(MROWS, DM, G, (int)blockIdx.x);
            pg8::EpiResid E{l == 0 ? (const void*)AIN(0) : (const void*)(ws + WS_X16), rep ? (void*)(ws + WS_DUMMY) : (void*)(ws + WS_X16), modl + 2 * DM, rep ? (bf16_t*)(ws + WS_DUMMY) : (bf16_t*)(ws + WS_H),
                            AIN(3) + l * DM, modl + 4 * DM, rep ? (float*)(ws + WS_DUMMY) : (float*)(ws + WS_SS), 1, l == 0 ? 1 : 0, 0};
            pg8::gemm_phase<pg8::EpiResid, pg8::StaticOrder, true, true>(lds, g, S, E, wave);
        }
        TENDB(4); SEAM(s0 + 3); TENDS(4); TBEG(5);
        if (PH(6) && IN(s0 + 4)) _Pragma("unroll 1") for (int rep = 0; rep < REP_G6; ++rep) {
            KP(); stagger(STAG_G);
            const bf16_t* wl = (const bf16_t*)(ws + WS_W + (size_t)l * W_LAYER);
            pg8::Gemm g{(const bf16_t*)(ws + WS_H), wl + W_GU / 2, MROWS, NGU, DM}; pg8::StaticOrder S; S.init(MROWS, NGU, G, (int)blockIdx.x);
            pg8::EpiSwiGLU E{(bf16_t*)(ws + WS_ACT), (const float*)(ws + WS_SS), (const float*)(ws + WS_BG) + (size_t)l * BATCH * DFF, (const float*)(ws + WS_BU) + (size_t)l * BATCH * DFF};
            pg8::gemm_phase<pg8::EpiSwiGLU, pg8::StaticOrder, true, true>(lds, g, S, E, wave);
        }
        TENDB(5); SEAM(s0 + 4); TENDS(5); TBEG(6);
        if (PH(7) && IN(s0 + 5)) _Pragma("unroll 1") for (int rep = 0; rep < REP_G7; ++rep) {
            KP(); stagger(STAG_D);
            const bf16_t* wl = (const bf16_t*)(ws + WS_W + (size_t)l * W_LAYER); const float* mod = (const float*)(ws + WS_MOD); const float* modl = mod + (size_t)l * BATCH * 6144;
            pg8::Gemm g{(const bf16_t*)(ws + WS_ACT), wl + W_D / 2, MROWS, DM, DFF}; pg8::StaticOrder S; S.init(MROWS, DM, G, (int)blockIdx.x);
            const int ln = (l + 1 < DEPTH) ? l + 1 : l;
            const int last = (l + 1 == DEPTH);
            pg8::EpiResid E{(const void*)(ws + WS_X16), rep ? (void*)(ws + WS_DUMMY) : (last ? (void*)AOUT() : (void*)(ws + WS_X16)), modl + 5 * DM, rep ? (bf16_t*)(ws + WS_DUMMY) : (bf16_t*)(ws + WS_H),
                            AIN(2) + ln * DM, mod + (size_t)ln * BATCH * 6144 + DM, rep ? (float*)(ws + WS_DUMMY) : (float*)(ws + WS_SS), last ? 0 : 1, 0, (last && !rep) ? 1 : 0};
            pg8::gemm_phase<pg8::EpiResid, pg8::StaticOrder, true, true>(lds, g, S, E, wave);
        }
        TENDB(6); SEAM(s0 + 5); TENDS(6);
    }
#ifdef TPROBE
    __syncthreads();
    { unsigned tacc = MISC[12];
#ifdef TPROBE_BLK
      if ((int)blockIdx.x != (TPROBE_BLK)) tacc = 0u;
#endif
      const unsigned tend = (unsigned)__builtin_amdgcn_s_memrealtime(), span = tacc * (unsigned)(TPROBE_K);
      while ((unsigned)__builtin_amdgcn_s_memrealtime() - tend < span) __builtin_amdgcn_s_sleep(8); }
#endif
#undef IN
#undef SEAM
}

extern "C" void kernel_launch(void* const* d_in, const int* in_sizes, int n_in, void* d_out, int out_size, void* d_ws, size_t ws_size, hipStream_t stream) {
    static int grid = 0;
    if (grid == 0) {
        if (n_in != 17 || in_sizes[0] != MROWS * DM || out_size != MROWS * DM || ws_size < WS_END) {
            fprintf(stderr, "kernel_launch: unexpected problem (n_in %d, in0 %d, out %d, ws %zu); nothing launched\n", n_in, n_in > 0 ? in_sizes[0] : -1, out_size, ws_size); grid = -1; return; }
        int dev = 0, cus = 0, per_cu = 0;
        if (hipGetDevice(&dev) != hipSuccess || hipDeviceGetAttribute(&cus, hipDeviceAttributeMultiprocessorCount, dev) != hipSuccess) { grid = -1; return; }
        if (hipFuncSetAttribute((const void*)fwd, hipFuncAttributeMaxDynamicSharedMemorySize, LDS_BYTES) != hipSuccess) { fprintf(stderr, "kernel_launch: hipFuncSetAttribute failed\n"); grid = -1; return; }
        if (hipOccupancyMaxActiveBlocksPerMultiprocessor(&per_cu, (const void*)fwd, NWAVES * 64, LDS_BYTES) != hipSuccess || per_cu < 1) {
            fprintf(stderr, "kernel_launch: occupancy query reports %d workgroups per CU\n", per_cu); per_cu = 1; }
        (void)hipGetLastError();
        grid = cus;
    }
    if (grid < 0) return;
    if (hipMemsetAsync((char*)d_ws + WS_CTL, 0, CTL_BYTES, stream) != hipSuccess) return;
    Args a{};
    for (int i = 0; i < 17; ++i) a.in[i] = (const float*)d_in[i];
    a.out = (float*)d_out; a.ws = (unsigned char*)d_ws;
#if MK_MULTI
    for (int s = 0; s < NSTEPS; ++s) { a.lo = s; a.hi = s + 1; hipLaunchKernelGGL(fwd, dim3(grid), dim3(NWAVES * 64), LDS_BYTES, stream, a); }
#else
    a.lo = 0; a.hi = NSTEPS;
    hipLaunchKernelGGL(fwd, dim3(grid), dim3(NWAVES * 64), LDS_BYTES, stream, a);
#endif
}
```
